# Optimizing an MI355X kernel written in HIP

```python
import math
import jax, jax.numpy as jnp
from jax import lax
import numpy as np

D_MODEL = 2048
BATCH = 1
SEQ = 16384
DEPTH = 1

SSM_GROUP_CH = 16
SSM_STATE = 64
SSM_GROUPS = 64
SSM_WIDTH = SSM_GROUPS * SSM_GROUP_CH
SSM_STEP_MIN = 1e-3
SSM_STEP_MAX = 1e-1
MLA_HEADS = 16
Q_LORA = 512
KV_LORA = 512
QK_NOPE = 128
QK_ROPE = 64
V_HEAD = 128
MLA_WIDTH = MLA_HEADS * V_HEAD
ROPE_THETA = 10000.0
Q_BLOCK = 128
MEM_LEN = 256
XA_HEADS = 4
XA_HEAD_DIM = 128
XA_WIDTH = XA_HEADS * XA_HEAD_DIM
N_EXPERTS = 32
TOP_K = 4
D_FF = 2048
SWIGLU_LIMIT = 7.0
SWIGLU_ALPHA = 1.702
MOE_ROW_BLOCK = 256
NORM_EPS = 1e-6
IN_S1 = SSM_WIDTH
IN_S2 = IN_S1 + Q_LORA
IN_S3 = IN_S2 + KV_LORA
IN_S4 = IN_S3 + QK_ROPE
IN_S5 = IN_S4 + D_MODEL
IN_COLS = IN_S5 + D_MODEL

kernel_name = 'hybrid_s5_mla_memxattn_moe_block'


def rms_norm(t, gain):
    t32 = t.astype(jnp.float32)
    y = t32 * lax.rsqrt(jnp.mean(t32 * t32, axis=-1, keepdims=True) + NORM_EPS)
    return (y * gain.astype(jnp.float32)).astype(t.dtype)


def rope_tables(positions):
    inv_freq = ROPE_THETA ** (-jnp.arange(0, QK_ROPE, 2, dtype=jnp.float32) / QK_ROPE)
    ang = positions.astype(jnp.float32)[..., None] * inv_freq
    return jnp.cos(ang)[:, :, None, :], jnp.sin(ang)[:, :, None, :]


def apply_rope(t, cos, sin):
    half = t.shape[-1] // 2
    t32 = t.astype(jnp.float32)
    t1, t2 = t32[..., :half], t32[..., half:]
    return jnp.concatenate([t1 * cos - t2 * sin, t1 * sin + t2 * cos], axis=-1).astype(t.dtype)


def _ssm_combine(left, right):
    a_l, b_l = left
    a_r, b_r = right
    return a_r * a_l, a_r * b_l + b_r


def s5_branch(u, lam_re, lam_im, log_step, b_re, b_im, c_re, c_im, d_skip, w_glu, b_glu):
    f32 = jnp.float32
    bsz, seqlen, _ = u.shape
    u32 = u.astype(f32).reshape(bsz, seqlen, SSM_GROUPS, SSM_GROUP_CH)
    lam = lax.complex(lam_re.astype(f32), lam_im.astype(f32))
    step = jnp.exp(log_step.astype(f32))[:, None]
    a_bar = jnp.exp(lam * step)
    b_mat = lax.complex(b_re.astype(f32), b_im.astype(f32))
    b_bar = ((a_bar - 1.0) / lam)[..., None] * b_mat
    bu = jnp.einsum('blgh,gph->blgp', u32.astype(jnp.complex64), b_bar)
    a_seq = jnp.broadcast_to(a_bar, bu.shape)
    _, states = lax.associative_scan(_ssm_combine, (a_seq, bu), axis=1)
    y = (jnp.einsum('blgp,ghp->blgh', states.real, c_re.astype(f32))
         - jnp.einsum('blgp,ghp->blgh', states.imag, c_im.astype(f32)))
    y = y + d_skip.astype(f32).reshape(SSM_GROUPS, SSM_GROUP_CH) * u32
    z = jax.nn.gelu(y.reshape(bsz, seqlen, SSM_WIDTH))
    out = z * jax.nn.sigmoid(z @ w_glu.astype(f32) + b_glu.astype(f32))
    return out.astype(u.dtype)


def causal_mla_attention(q_nope, q_pe, k_nope, k_pe, v):
    bsz, seqlen, n_heads, _ = q_nope.shape
    n_blocks = seqlen // Q_BLOCK
    scale = (QK_NOPE + QK_ROPE) ** -0.5
    key_idx = jnp.arange(seqlen)

    def to_blocks(t):
        return jnp.moveaxis(t.reshape(bsz, n_blocks, Q_BLOCK, *t.shape[2:]), 1, 0)

    def one_block(args):
        qn, qp, start = args
        s = (jnp.einsum('bqhd,bkhd->bhqk', qn, k_nope, preferred_element_type=jnp.float32)
             + jnp.einsum('bqhd,bkd->bhqk', qp, k_pe, preferred_element_type=jnp.float32)) * scale
        q_idx = start + jnp.arange(Q_BLOCK)
        s = jnp.where(q_idx[:, None] >= key_idx[None, :], s, -jnp.inf)
        p = jax.nn.softmax(s, axis=-1)
        return jnp.einsum('bhqk,bkhd->bqhd', p.astype(v.dtype), v)

    out = lax.map(one_block, (to_blocks(q_nope), to_blocks(q_pe), jnp.arange(n_blocks) * Q_BLOCK))
    return jnp.moveaxis(out, 0, 1).reshape(bsz, seqlen, n_heads, V_HEAD)


def mla_branch(q_a, kv_a, k_pe_raw, cos, sin, q_norm, w_uq, kv_norm, w_uk, w_uv):
    c_q = rms_norm(q_a, q_norm)
    q = jnp.einsum('blr,rhd->blhd', c_q, w_uq)
    q_nope = q[..., :QK_NOPE]
    q_pe = apply_rope(q[..., QK_NOPE:], cos, sin)
    c_kv = rms_norm(kv_a, kv_norm)
    k_nope = jnp.einsum('blr,rhd->blhd', c_kv, w_uk)
    v = jnp.einsum('blr,rhd->blhd', c_kv, w_uv)
    k_pe = apply_rope(k_pe_raw[:, :, None, :], cos, sin)[:, :, 0, :]
    return causal_mla_attention(q_nope, q_pe, k_nope, k_pe, v)


def hybrid_mixer(h, cos, sin, w_in, lam_re, lam_im, log_step, b_re, b_im, c_re, c_im, d_skip,
                 w_glu, b_glu, q_norm, w_uq, kv_norm, w_uk, w_uv, w_up_ssm, w_up_mla, w_out):
    bsz, seqlen, _ = h.shape
    proj = h @ w_in
    u_ssm, q_a, kv_a, k_pe_raw, g_ssm, g_mla = jnp.split(proj, [IN_S1, IN_S2, IN_S3, IN_S4, IN_S5], axis=-1)
    y_ssm = s5_branch(u_ssm, lam_re, lam_im, log_step, b_re, b_im, c_re, c_im, d_skip, w_glu, b_glu)
    y_mla = mla_branch(q_a, kv_a, k_pe_raw, cos, sin, q_norm, w_uq, kv_norm, w_uk, w_uv)
    y_mla = y_mla.reshape(bsz, seqlen, MLA_WIDTH)
    merged = (jax.nn.sigmoid(g_ssm) * (y_ssm @ w_up_ssm)
              + jax.nn.sigmoid(g_mla) * (y_mla @ w_up_mla))
    return merged @ w_out


def memory_cross_attention(hx, mem, mem_norm, w_q, w_k, w_v, w_o):
    bsz, seqlen, _ = hx.shape
    m = rms_norm(mem, mem_norm)
    q = (hx @ w_q).reshape(bsz, seqlen, XA_HEADS, XA_HEAD_DIM)
    k = (m @ w_k).reshape(bsz, MEM_LEN, XA_HEADS, XA_HEAD_DIM)
    v = (m @ w_v).reshape(bsz, MEM_LEN, XA_HEADS, XA_HEAD_DIM)
    s = jnp.einsum('blhd,bmhd->bhlm', q, k, preferred_element_type=jnp.float32) * (XA_HEAD_DIM ** -0.5)
    p = jax.nn.softmax(s, axis=-1)
    o = jnp.einsum('bhlm,bmhd->blhd', p.astype(v.dtype), v).reshape(bsz, seqlen, XA_WIDTH)
    return o @ w_o


def moe_ffn(h, router_w, router_b, w_gate_up, b_gate_up, w_down, b_down):
    bsz, seqlen, d = h.shape
    h_flat = h.reshape(-1, d)
    n_tok = h_flat.shape[0]
    logits = (h_flat @ router_w + router_b).astype(jnp.float32)
    top_vals, top_idx = lax.top_k(logits, TOP_K)
    top_w = jax.nn.softmax(top_vals, axis=-1)
    n_assign = n_tok * TOP_K
    n_blocks = -(-(n_assign + N_EXPERTS * (MOE_ROW_BLOCK - 1)) // MOE_ROW_BLOCK)
    flat_e = top_idx.reshape(-1)
    flat_tok = jnp.repeat(jnp.arange(n_tok, dtype=jnp.int32), TOP_K)
    flat_w = top_w.reshape(-1)
    order = jnp.argsort(flat_e)
    sorted_e = flat_e[order]
    counts = jnp.bincount(flat_e, length=N_EXPERTS)
    starts = jnp.cumsum(counts) - counts
    padded_counts = (counts + MOE_ROW_BLOCK - 1) // MOE_ROW_BLOCK * MOE_ROW_BLOCK
    padded_ends = jnp.cumsum(padded_counts)
    padded_starts = padded_ends - padded_counts
    dest = padded_starts[sorted_e] + (jnp.arange(n_assign) - starts[sorted_e])
    n_rows = n_blocks * MOE_ROW_BLOCK
    buf_tok = jnp.zeros((n_rows,), jnp.int32).at[dest].set(flat_tok[order])
    buf_w = jnp.zeros((n_rows,), jnp.float32).at[dest].set(flat_w[order])
    block_e = jnp.minimum(jnp.searchsorted(padded_ends, jnp.arange(n_blocks) * MOE_ROW_BLOCK, side='right'),
                          N_EXPERTS - 1)

    def expert_block(args):
        tok, e = args
        rows = h_flat[tok]
        gu = rows @ w_gate_up[e] + b_gate_up[e]
        gate, up = gu[:, :D_FF], gu[:, D_FF:]
        gate = jnp.minimum(gate, SWIGLU_LIMIT)
        up = jnp.clip(up, -SWIGLU_LIMIT, SWIGLU_LIMIT)
        act = (up + 1.0) * (gate * jax.nn.sigmoid(SWIGLU_ALPHA * gate))
        return act @ w_down[e] + b_down[e]

    out = lax.map(expert_block, (buf_tok.reshape(n_blocks, MOE_ROW_BLOCK), block_e)).reshape(n_rows, d)
    contrib = (out.astype(jnp.float32) * buf_w[:, None]).astype(h.dtype)
    y = jnp.zeros((n_tok, d), h.dtype).at[buf_tok].add(contrib)
    return y.reshape(bsz, seqlen, d)


def _normal(key, shape, scale):
    return scale * jax.random.normal(key, shape, jnp.float32)


def setup_inputs(seed: int = 0) -> dict:
    key = jax.random.key(seed)
    keys = iter(list(jax.random.split(key, 48)))
    f32 = jnp.float32
    L = DEPTH

    def gain(n):
        return 1.0 + _normal(next(keys), (L, n), 0.02)

    x = jax.random.normal(next(keys), (BATCH, SEQ, D_MODEL), f32)
    mem = jax.random.normal(next(keys), (BATCH, MEM_LEN, D_MODEL), f32)
    positions = jnp.broadcast_to(jnp.arange(SEQ, dtype=jnp.int32), (BATCH, SEQ))
    norm_mix = gain(D_MODEL)
    w_in = _normal(next(keys), (L, D_MODEL, IN_COLS), D_MODEL ** -0.5)
    ssm_lam_re = -0.5 + _normal(next(keys), (L, SSM_GROUPS, SSM_STATE), 0.01)
    ssm_lam_im = (jnp.pi * jnp.arange(SSM_STATE, dtype=f32))[None, None, :] + _normal(next(keys), (L, SSM_GROUPS, SSM_STATE), 0.01)
    ssm_log_step = jax.random.uniform(next(keys), (L, SSM_GROUPS), f32, math.log(SSM_STEP_MIN), math.log(SSM_STEP_MAX))
    ssm_b_re = _normal(next(keys), (L, SSM_GROUPS, SSM_STATE, SSM_GROUP_CH), (2 * SSM_GROUP_CH) ** -0.5)
    ssm_b_im = _normal(next(keys), (L, SSM_GROUPS, SSM_STATE, SSM_GROUP_CH), (2 * SSM_GROUP_CH) ** -0.5)
    ssm_c_re = _normal(next(keys), (L, SSM_GROUPS, SSM_GROUP_CH, SSM_STATE), 0.5)
    ssm_c_im = _normal(next(keys), (L, SSM_GROUPS, SSM_GROUP_CH, SSM_STATE), 0.5)
    ssm_d = _normal(next(keys), (L, SSM_WIDTH), 1.0)
    ssm_w_glu = _normal(next(keys), (L, SSM_WIDTH, SSM_WIDTH), SSM_WIDTH ** -0.5)
    ssm_b_glu = _normal(next(keys), (L, SSM_WIDTH), 0.02)
    mla_q_norm = gain(Q_LORA)
    mla_w_uq = _normal(next(keys), (L, Q_LORA, MLA_HEADS, QK_NOPE + QK_ROPE), Q_LORA ** -0.5)
    mla_kv_norm = gain(KV_LORA)
    mla_w_uk = _normal(next(keys), (L, KV_LORA, MLA_HEADS, QK_NOPE), KV_LORA ** -0.5)
    mla_w_uv = _normal(next(keys), (L, KV_LORA, MLA_HEADS, V_HEAD), KV_LORA ** -0.5)
    w_up_ssm = _normal(next(keys), (L, SSM_WIDTH, D_MODEL), SSM_WIDTH ** -0.5)
    w_up_mla = _normal(next(keys), (L, MLA_WIDTH, D_MODEL), MLA_WIDTH ** -0.5)
    w_out = _normal(next(keys), (L, D_MODEL, D_MODEL), D_MODEL ** -0.5)
    norm_xattn = gain(D_MODEL)
    norm_mem = gain(D_MODEL)
    xa_w_q = _normal(next(keys), (L, D_MODEL, XA_WIDTH), D_MODEL ** -0.5)
    xa_w_k = _normal(next(keys), (L, D_MODEL, XA_WIDTH), D_MODEL ** -0.5)
    xa_w_v = _normal(next(keys), (L, D_MODEL, XA_WIDTH), D_MODEL ** -0.5)
    xa_w_o = _normal(next(keys), (L, XA_WIDTH, D_MODEL), XA_WIDTH ** -0.5)
    norm_moe = gain(D_MODEL)
    router_w = _normal(next(keys), (L, D_MODEL, N_EXPERTS), D_MODEL ** -0.5)
    router_b = _normal(next(keys), (L, N_EXPERTS), 0.01)
    moe_w_gate_up = _normal(next(keys), (L, N_EXPERTS, D_MODEL, 2 * D_FF), D_MODEL ** -0.5)
    moe_b_gate_up = _normal(next(keys), (L, N_EXPERTS, 2 * D_FF), 0.02)
    moe_w_down = _normal(next(keys), (L, N_EXPERTS, D_FF, D_MODEL), D_FF ** -0.5)
    moe_b_down = _normal(next(keys), (L, N_EXPERTS, D_MODEL), 0.02)
    final_norm = 1.0 + _normal(next(keys), (D_MODEL,), 0.02)
    return {'x': x, 'mem': mem, 'positions': positions, 'norm_mix': norm_mix, 'w_in': w_in,
            'ssm_lam_re': ssm_lam_re, 'ssm_lam_im': ssm_lam_im, 'ssm_log_step': ssm_log_step,
            'ssm_b_re': ssm_b_re, 'ssm_b_im': ssm_b_im, 'ssm_c_re': ssm_c_re, 'ssm_c_im': ssm_c_im,
            'ssm_d': ssm_d, 'ssm_w_glu': ssm_w_glu, 'ssm_b_glu': ssm_b_glu,
            'mla_q_norm': mla_q_norm, 'mla_w_uq': mla_w_uq, 'mla_kv_norm': mla_kv_norm,
            'mla_w_uk': mla_w_uk, 'mla_w_uv': mla_w_uv, 'w_up_ssm': w_up_ssm, 'w_up_mla': w_up_mla,
            'w_out': w_out, 'norm_xattn': norm_xattn, 'norm_mem': norm_mem, 'xa_w_q': xa_w_q,
            'xa_w_k': xa_w_k, 'xa_w_v': xa_w_v, 'xa_w_o': xa_w_o, 'norm_moe': norm_moe,
            'router_w': router_w, 'router_b': router_b, 'moe_w_gate_up': moe_w_gate_up,
            'moe_b_gate_up': moe_b_gate_up, 'moe_w_down': moe_w_down, 'moe_b_down': moe_b_down,
            'final_norm': final_norm}


def reference(x, mem, positions, norm_mix, w_in, ssm_lam_re, ssm_lam_im, ssm_log_step, ssm_b_re, ssm_b_im,
              ssm_c_re, ssm_c_im, ssm_d, ssm_w_glu, ssm_b_glu, mla_q_norm, mla_w_uq, mla_kv_norm, mla_w_uk,
              mla_w_uv, w_up_ssm, w_up_mla, w_out, norm_xattn, norm_mem, xa_w_q, xa_w_k, xa_w_v, xa_w_o,
              norm_moe, router_w, router_b, moe_w_gate_up, moe_b_gate_up, moe_w_down, moe_b_down, final_norm):
    cos, sin = rope_tables(positions)
    for l in range(DEPTH):
        h = rms_norm(x, norm_mix[l])
        x = x + hybrid_mixer(h, cos, sin, w_in[l], ssm_lam_re[l], ssm_lam_im[l], ssm_log_step[l],
                             ssm_b_re[l], ssm_b_im[l], ssm_c_re[l], ssm_c_im[l], ssm_d[l], ssm_w_glu[l],
                             ssm_b_glu[l], mla_q_norm[l], mla_w_uq[l], mla_kv_norm[l], mla_w_uk[l], mla_w_uv[l],
                             w_up_ssm[l], w_up_mla[l], w_out[l])
        x = x + memory_cross_attention(rms_norm(x, norm_xattn[l]), mem, norm_mem[l],
                                       xa_w_q[l], xa_w_k[l], xa_w_v[l], xa_w_o[l])
        x = x + moe_ffn(rms_norm(x, norm_moe[l]), router_w[l], router_b[l], moe_w_gate_up[l],
                        moe_b_gate_up[l], moe_w_down[l], moe_b_down[l])
    return rms_norm(x, final_norm)
```

```cpp
#include <hip/hip_runtime.h>
#include <cstdio>
#include <cstdint>
#include <cstring>

#define LAS __attribute__((address_space(3)))
#define GAS __attribute__((address_space(1)))
typedef unsigned short bf16_t;
typedef short bf16x8 __attribute__((ext_vector_type(8)));
typedef short s16x4 __attribute__((ext_vector_type(4)));
typedef float f32x4 __attribute__((ext_vector_type(4)));
typedef float f32x2 __attribute__((ext_vector_type(2)));
typedef float f32x16 __attribute__((ext_vector_type(16)));
typedef unsigned u32x4 __attribute__((ext_vector_type(4)));
typedef unsigned u32x2 __attribute__((ext_vector_type(2)));
typedef GAS unsigned gu32;

constexpr int SEQ = 16384, DM = 2048;
constexpr int SSM_W = 1024, SSM_G = 64, SSM_P = 64, SSM_H = 16;
constexpr int QL = 512, KVL = 512, NHEAD = 16, DNOPE = 128, DROPE = 64, DV = 128;
constexpr int IN_COLS = 6208;
constexpr int MEML = 256, XH = 4, XW = 512;
constexpr int NEXP = 32, TOPK = 4, DFF = 2048;
constexpr int NSLOT = SEQ * TOPK + NEXP * 256;
constexpr int MAXBLK = NSLOT / 256;
constexpr float EPS = 1e-6f;
constexpr int NWAVES = 8;

#define LDS_WAIT() asm volatile("s_waitcnt lgkmcnt(0)" ::: "memory")
#define VM_WAIT() asm volatile("s_waitcnt vmcnt(0)" ::: "memory")
#define SBAR() __builtin_amdgcn_sched_barrier(0)
__device__ __forceinline__ unsigned cvtpk(float lo, float hi) { unsigned r; asm volatile("v_cvt_pk_bf16_f32 %0, %1, %2" : "=v"(r) : "v"(lo), "v"(hi)); return r; }
__device__ __forceinline__ float bf2f(unsigned short b) { return __uint_as_float(((unsigned)b) << 16); }
__device__ __forceinline__ float bflo(unsigned w) { return __uint_as_float(w << 16); }
__device__ __forceinline__ float bfhi(unsigned w) { return __uint_as_float(w & 0xffff0000u); }
__device__ __forceinline__ unsigned short f2bf(float f) { return (unsigned short)(cvtpk(f, f) & 0xffffu); }
__device__ __forceinline__ u32x4 pack8f(f32x4 a, f32x4 b) { u32x4 w = {cvtpk(a[0], a[1]), cvtpk(a[2], a[3]), cvtpk(b[0], b[1]), cvtpk(b[2], b[3])}; return w; }
__device__ __forceinline__ void unpack8(u32x4 w, f32x4& a, f32x4& b) { a = (f32x4){bflo(w.x), bfhi(w.x), bflo(w.y), bfhi(w.y)}; b = (f32x4){bflo(w.z), bfhi(w.z), bflo(w.w), bfhi(w.w)}; }
__device__ __forceinline__ float fsigmoid(float x) { return __builtin_amdgcn_rcpf(1.0f + __builtin_amdgcn_exp2f(-1.4426950408889634f * x)); }
__device__ __forceinline__ float gelu_tanh(float x) {
    const float u = 0.7978845608028654f * (x + 0.044715f * x * x * x);
    return x * fsigmoid(2.0f * u);
}
__device__ __forceinline__ float wave_sum(float v) {
#pragma unroll
    for (int o = 1; o < 64; o <<= 1) v += __shfl_xor(v, o);
    return v;
}

#define XB_TMO      128
#define XB_XCNT(j)  (256  + 64 * (j))
#define XB_XSUB(j)  (1280 + 64 * (j))
#define XB_XGEN(j)  (2304 + 64 * (j))
#define XB_TOP      3328
#define XB_TOPGEN   3392
#define XCD_BAR_WORDS 3456
#define XB_SPIN_CAP (1u << 18)
__device__ __forceinline__ unsigned xb_ld(unsigned* p)              { return __hip_atomic_load(p, __ATOMIC_RELAXED, __HIP_MEMORY_SCOPE_AGENT); }
__device__ __forceinline__ unsigned xb_add(unsigned* p, unsigned v) { return __hip_atomic_fetch_add(p, v, __ATOMIC_RELAXED, __HIP_MEMORY_SCOPE_AGENT); }
__device__ __forceinline__ unsigned xb_xcc_id() { return (unsigned)__builtin_amdgcn_s_getreg((3 << 11) | 20) & 0xFu; }
#define XB_SPIN(cond, bar) do { unsigned _sp = 0; while (cond) { __builtin_amdgcn_s_sleep(1); \
    if ((++_sp & 255u) == 0u) { if (xb_ld(&(bar)[XB_TMO])) break; if (_sp > XB_SPIN_CAP) { atomicAdd(&(bar)[XB_TMO], 1u); break; } } } } while (0)
struct XcdBarrier { unsigned* bar; unsigned x; volatile LAS unsigned* st; };
__device__ __forceinline__ XcdBarrier xcd_barrier_post(unsigned* bar, volatile LAS unsigned* st) {
    XcdBarrier b; b.bar = bar; b.x = xb_xcc_id(); b.st = st;
    if (threadIdx.x == 0) (void)xb_add(&bar[XB_XCNT(b.x)], 1u);
    return b;
}
__device__ __forceinline__ void xcd_barrier_complete(unsigned* bar, unsigned x, unsigned& nloc, unsigned& nx) {
    const unsigned G = gridDim.x * gridDim.y * gridDim.z;
    unsigned sum, cnt, mine, sp = 0u;
    for (;;) {
        sum = 0u; cnt = 0u; mine = 0u;
#pragma unroll
        for (unsigned j = 0; j < 16; ++j) { const unsigned c = xb_ld(&bar[XB_XCNT(j)]); sum += c; cnt += (c > 0u) ? 1u : 0u; mine = (j == x) ? c : mine; }
        if (sum == G) break;
        __builtin_amdgcn_s_sleep(1);
        if ((++sp & 255u) == 0u) { if (xb_ld(&bar[XB_TMO])) break; if (sp > XB_SPIN_CAP) { atomicAdd(&bar[XB_TMO], 1u); break; } }
    }
    nloc = mine > 0u ? mine : 1u; nx = cnt > 0u ? cnt : 1u;
}
__device__ __forceinline__ void xcd_barrier(const XcdBarrier& b) {
    asm volatile("s_waitcnt vmcnt(0)" ::: "memory");
    __syncthreads();
    if (threadIdx.x == 0) {
        unsigned* bar = b.bar;
        __builtin_amdgcn_s_waitcnt(0);
        unsigned nloc = b.st[0], nx = b.st[1];
        if (nloc == 0u) { xcd_barrier_complete(bar, b.x, nloc, nx); b.st[0] = nloc; b.st[1] = nx; }
        const unsigned old = xb_add(&bar[XB_XSUB(b.x)], 1u);
        const unsigned gen = old / nloc;
        if (old + 1u == (gen + 1u) * nloc) {
            __builtin_amdgcn_fence(__ATOMIC_RELEASE, "agent");
            asm volatile("s_waitcnt vmcnt(0)" ::: "memory");
            const unsigned og = xb_add(&bar[XB_TOP], 1u);
            const unsigned tg = og / nx;
            if (og + 1u == (tg + 1u) * nx) xb_add(&bar[XB_TOPGEN], 1u);
            else XB_SPIN(xb_ld(&bar[XB_TOPGEN]) == tg, bar);
            __builtin_amdgcn_fence(__ATOMIC_ACQUIRE, "agent");
            xb_add(&bar[XB_XGEN(b.x)], 1u);
            asm volatile("s_waitcnt vmcnt(0)" ::: "memory");
        } else {
            XB_SPIN(xb_ld(&bar[XB_XGEN(b.x)]) == gen, bar);
            __builtin_amdgcn_fence(__ATOMIC_ACQUIRE, "agent");
            asm volatile("s_waitcnt vmcnt(0)" ::: "memory");
        }
    }
    __syncthreads();
}
namespace pg8 {
constexpr int BM = 256, BK = 64, HALF = 128, HTB = HALF * BK * 2, NXCD = 8, WGM = 8;
__host__ __device__ __forceinline__ int lds_byte(int r, int c) { const int st = (r >> 4) * 2 + (c >> 5), rr = r & 15, cc = c & 31, ob = rr * 64 + cc * 2; return st * 1024 + (ob ^ (((ob >> 9) & 1) << 5)); }
__host__ __device__ __forceinline__ void stage_rc(int b, int& R, int& C) { const int st = b / 1024, sb = b % 1024, swz = sb ^ (((sb >> 9) & 1) << 5); R = (st >> 1) * 16 + swz / 64; C = (st & 1) * 32 + (swz % 64) / 2; }
__host__ __device__ __forceinline__ int perm32(int rho) { const int n = rho >> 4, i = rho & 15; return 8 * (i >> 2) + 4 * n + (i & 3); }

struct Unit { int pm, pn, e; };
struct Gemm { const bf16_t* A; const bf16_t* Bt; int lda, ldb, K; size_t bstride; };

struct StaticOrder {
    int nM, nN, nwg, G, c;
    __device__ void init(int M, int N, int G_, int c_) { nM = M / BM; nN = N / BM; nwg = nM * nN; G = G_; c = c_; }
    __device__ bool next(int i, Unit& u) const {
        const long L = (long)i * G + c; if (L >= nwg) return false;
        int wgid = (int)L; { const int q = nwg / NXCD, r = nwg % NXCD, xcd = wgid % NXCD, off = wgid / NXCD; wgid = (xcd < r ? xcd * (q + 1) : r * (q + 1) + (xcd - r) * q) + off; }
        const int nig = WGM * nN, gid = wgid / nig, fm = gid * WGM, gsz = (nM - fm) < WGM ? (nM - fm) : WGM;
        u.pm = fm + ((wgid % nig) % gsz); u.pn = (wgid % nig) / gsz; u.e = 0; return true;
    }
};
struct MoeOrder {
    StaticOrder so; const int* blk_e;
    __device__ void init(int nblk, int N, int G_, int c_, const int* be) { so.nM = nblk; so.nN = N / BM; so.nwg = so.nM * so.nN; so.G = G_; so.c = c_; blk_e = be; }
    __device__ bool next(int i, Unit& u) const { if (!so.next(i, u)) return false; u.e = __builtin_amdgcn_readfirstlane(blk_e[u.pm]); return true; }
};

template <class Epi, class Sched>
__device__ __forceinline__ void gemm_phase(LAS unsigned char* lds, const Gemm g, const Sched& S, const Epi& E) {
    constexpr bool ALIGN_EPI = true;
    const int tid = threadIdx.x, wid = __builtin_amdgcn_readfirstlane(tid >> 6), lane = tid & 63, wr = wid >> 2, wc = wid & 3, fr = lane & 15, fq = lane >> 4;
    const int K = g.K, nt = K / BK;
    unsigned voffA[2], voffB[2];
#pragma unroll
    for (int i = 0; i < 2; ++i) { int R, C; stage_rc(tid * 16 + i * 8192, R, C); const int Rb = Epi::PERM ? ((R & ~31) + perm32(R & 31)) : R;
        voffA[i] = (unsigned)(R * g.lda + C) * 2u; voffB[i] = (unsigned)(Rb * g.ldb + C) * 2u; }
    const size_t kstep = (size_t)(BK * 2);
    const size_t hstepA = (size_t)HALF * g.lda * 2, hstepB = (size_t)HALF * g.ldb * 2;
    const unsigned ldsw = (unsigned)wid * 1024u;
    const int aoff = lds_byte(wr * 64 + fr, fq * 8), boff = lds_byte(wc * 32 + fr, fq * 8);
#define PG8_SA(b, h) (((b) * 2 + (h)) * HTB)
#define PG8_SB(b, h) ((4 + (b) * 2 + (h)) * HTB)
#define PG8_STAGE(bufoff, gbase, voff) do { _Pragma("unroll") for (int _i = 0; _i < 2; ++_i) \
        __builtin_amdgcn_global_load_lds((const unsigned*)((const char*)(gbase) + (voff)[_i]), (LAS unsigned*)(lds + (bufoff) + ldsw + _i * 8192), 16, 0, 0); } while (0)
#define PG8_LDA(dst, b, h) do { _Pragma("unroll") for (int m = 0; m < 4; ++m) _Pragma("unroll") for (int k = 0; k < 2; ++k) dst[m][k] = *(const LAS bf16x8*)(lds + PG8_SA(b, h) + aoff + m * 2048 + k * 1024); } while (0)
#define PG8_LDB(dst, b, h) do { _Pragma("unroll") for (int n = 0; n < 2; ++n) _Pragma("unroll") for (int k = 0; k < 2; ++k) dst[n][k] = *(const LAS bf16x8*)(lds + PG8_SB(b, h) + boff + n * 2048 + k * 1024); } while (0)
#define PG8_MMA(ai, bj, At, Bt) do { __builtin_amdgcn_s_setprio(1); _Pragma("unroll") for (int m = 0; m < 4; ++m) _Pragma("unroll") for (int n = 0; n < 2; ++n) _Pragma("unroll") for (int k = 0; k < 2; ++k) \
        acc[ai][bj][m][n] = __builtin_amdgcn_mfma_f32_16x16x32_bf16(Bt[n][k], At[m][k], acc[ai][bj][m][n], 0, 0, 0); __builtin_amdgcn_s_setprio(0); } while (0)
#define PG8_WAIT_V(n) asm volatile("s_waitcnt vmcnt(" #n ")" ::: "memory")
#define PG8_WAIT_L(n) asm volatile("s_waitcnt lgkmcnt(" #n ")" ::: "memory")
#define PG8_BAR __builtin_amdgcn_s_barrier()
#define PG8_SCHED __builtin_amdgcn_sched_barrier(0)
#define PG8_ABASE(u) ((const char*)g.A + (size_t)(u).pm * BM * g.lda * 2)
#define PG8_BBASE(u) ((const char*)g.Bt + ((size_t)(u).e * g.bstride + (size_t)(u).pn * BM * g.ldb) * 2)
    Unit cur, nxt; int ui = 0;
    if (!S.next(0, cur)) return;
    f32x4 acc[2][2][4][2];
#pragma unroll
    for (int a = 0; a < 2; ++a)
#pragma unroll
        for (int b = 0; b < 2; ++b)
#pragma unroll
            for (int m = 0; m < 4; ++m)
#pragma unroll
                for (int n = 0; n < 2; ++n) acc[a][b][m][n] = (f32x4){0.f, 0.f, 0.f, 0.f};
    bf16x8 At[4][2], B0[2][2], B1[2][2];
    const char* cA = PG8_ABASE(cur); const char* cB = PG8_BBASE(cur);
    PG8_STAGE(PG8_SB(0, 0), cB, voffB); PG8_STAGE(PG8_SB(0, 1), cB + hstepB, voffB); PG8_STAGE(PG8_SA(0, 0), cA, voffA); PG8_STAGE(PG8_SA(0, 1), cA + hstepA, voffA);
    if (wr == 1) PG8_BAR;
    PG8_WAIT_V(2); PG8_BAR;
    PG8_STAGE(PG8_SB(1, 0), cB + kstep, voffB); PG8_STAGE(PG8_SA(1, 0), cA + kstep, voffA); PG8_STAGE(PG8_SB(1, 1), cB + hstepB + kstep, voffB);
    PG8_WAIT_V(6); PG8_BAR;
    for (;;) {
        const bool has_next = S.next(ui + 1, nxt);
        const char* nA = has_next ? PG8_ABASE(nxt) : cA; const char* nB = has_next ? PG8_BBASE(nxt) : cB;
        for (int t = 0; t < nt; t += 2) {
            const bool last = (t == nt - 2);
            const char* a1 = cA + (size_t)(t + 1) * kstep;
            const char* a2 = last ? nA : cA + (size_t)(t + 2) * kstep; const char* b2 = last ? nB : cB + (size_t)(t + 2) * kstep;
            const char* a3 = a2 + kstep; const char* b3 = b2 + kstep;
            PG8_LDB(B0, 0, 0); PG8_LDB(B1, 0, 1); PG8_SCHED; PG8_LDA(At, 0, 0); PG8_STAGE(PG8_SA(1, 1), a1 + hstepA, voffA);
            PG8_WAIT_V(8); PG8_WAIT_L(0); PG8_BAR; PG8_MMA(0, 0, At, B0); PG8_MMA(0, 1, At, B1); PG8_BAR; PG8_SCHED;
            PG8_LDA(At, 0, 1); PG8_STAGE(PG8_SB(0, 0), b2, voffB); PG8_STAGE(PG8_SB(0, 1), b2 + hstepB, voffB); PG8_STAGE(PG8_SA(0, 0), a2, voffA);
            PG8_WAIT_V(8); PG8_WAIT_L(0); PG8_BAR; PG8_MMA(1, 0, At, B0); PG8_MMA(1, 1, At, B1); PG8_BAR; PG8_SCHED;
            PG8_LDB(B0, 1, 0); PG8_LDB(B1, 1, 1); PG8_SCHED; PG8_LDA(At, 1, 0); PG8_STAGE(PG8_SA(0, 1), a2 + hstepA, voffA);
            PG8_WAIT_V(8); PG8_WAIT_L(0); PG8_BAR; PG8_MMA(0, 0, At, B0); PG8_MMA(0, 1, At, B1); PG8_BAR; PG8_SCHED;
            PG8_LDA(At, 1, 1); PG8_STAGE(PG8_SB(1, 0), b3, voffB); PG8_STAGE(PG8_SB(1, 1), b3 + hstepB, voffB); PG8_STAGE(PG8_SA(1, 0), a3, voffA);
            PG8_WAIT_V(8); PG8_WAIT_L(0); PG8_BAR; PG8_MMA(1, 0, At, B0); PG8_MMA(1, 1, At, B1); PG8_BAR; PG8_SCHED;
        }
        if constexpr (ALIGN_EPI) { if (wr == 0) PG8_BAR; }
        E(acc, cur, wr, wc, fr, fq);
        if (!has_next) break;
#pragma unroll
        for (int a = 0; a < 2; ++a)
#pragma unroll
            for (int b = 0; b < 2; ++b)
#pragma unroll
                for (int m = 0; m < 4; ++m)
#pragma unroll
                    for (int n = 0; n < 2; ++n) acc[a][b][m][n] = (f32x4){0.f, 0.f, 0.f, 0.f};
        cur = nxt; cA = nA; cB = nB; ++ui;
        if constexpr (ALIGN_EPI) { if (wr == 1) PG8_BAR; }
    }
    PG8_WAIT_V(0);
    if constexpr (!ALIGN_EPI) { if (wr == 0) PG8_BAR; }
    PG8_BAR;
#undef PG8_SA
#undef PG8_SB
#undef PG8_STAGE
#undef PG8_LDA
#undef PG8_LDB
#undef PG8_MMA
#undef PG8_WAIT_V
#undef PG8_WAIT_L
#undef PG8_BAR
#undef PG8_SCHED
#undef PG8_ABASE
#undef PG8_BBASE
}

#define EPI_ROW(u, ai, m) ((u).pm * BM + (ai) * HALF + wr * 64 + (m) * 16 + fr)
#define EPI_CB(bj) ((bj) * HALF + wc * 32 + 8 * fq)
typedef f32x4 AccT[2][2][4][2];

__device__ __forceinline__ f32x4 sig4(f32x4 v) { return (f32x4){fsigmoid(v[0]), fsigmoid(v[1]), fsigmoid(v[2]), fsigmoid(v[3])}; }
__device__ __forceinline__ float sq4(f32x4 v) { return (v[0] * v[0] + v[1] * v[1]) + (v[2] * v[2] + v[3] * v[3]); }

struct EpiProj {
    static constexpr bool PERM = true;
    bf16_t *ub, *qa, *kva, *sgs, *sgm; float *qss, *kvss;
    __device__ __forceinline__ void operator()(const AccT& acc, const Unit& u, int wr, int wc, int fr, int fq) const {
        const int pn = u.pn; bf16_t* dst; int ld, c0; float* ss = nullptr; int ssl = 0; bool sg = false;
        if (pn < 4) { dst = ub; ld = SSM_W; c0 = pn * BM; }
        else if (pn < 6) { dst = qa; ld = QL; c0 = (pn - 4) * BM; ss = qss; ssl = (pn - 4) * 4 + wc; }
        else if (pn < 8) { dst = kva; ld = KVL; c0 = (pn - 6) * BM; ss = kvss; ssl = (pn - 6) * 4 + wc; }
        else if (pn < 16) { dst = sgs; ld = DM; c0 = (pn - 8) * BM; sg = true; }
        else { dst = sgm; ld = DM; c0 = (pn - 16) * BM; sg = true; }
#pragma unroll
        for (int ai = 0; ai < 2; ++ai)
#pragma unroll
            for (int m = 0; m < 4; ++m) { const int row = EPI_ROW(u, ai, m); float s = 0.f;
#pragma unroll
                for (int bj = 0; bj < 2; ++bj) { f32x4 v0 = acc[ai][bj][m][0], v1 = acc[ai][bj][m][1];
                    if (sg) { v0 = sig4(v0); v1 = sig4(v1); }
                    s += sq4(v0) + sq4(v1);
                    *(u32x4*)(dst + (size_t)row * ld + c0 + EPI_CB(bj)) = pack8f(v0, v1); }
                if (ss) { s += __shfl_xor(s, 16); s += __shfl_xor(s, 32); if (fq == 0) ss[(size_t)row * 8 + ssl] = s; } }
    }
};
__device__ __forceinline__ float row_rs8(const float* ss, int row, float invn) { const f32x4 a = *(const f32x4*)(ss + (size_t)row * 8), b = *(const f32x4*)(ss + (size_t)row * 8 + 4);
    return __builtin_amdgcn_rsqf(((a[0] + a[1]) + (a[2] + a[3]) + (b[0] + b[1]) + (b[2] + b[3])) * invn + EPS); }
__device__ __forceinline__ float row_rs32(const float* ss, int row, float invn) { float s = 0.f;
#pragma unroll
    for (int i = 0; i < 8; ++i) { const f32x4 a = *(const f32x4*)(ss + (size_t)row * 32 + 4 * i); s += (a[0] + a[1]) + (a[2] + a[3]); }
    return __builtin_amdgcn_rsqf(s * invn + EPS); }

struct EpiQup {
    static constexpr bool PERM = true;
    bf16_t *qn, *qr; const float *ss, *cosT, *sinT;
    __device__ __forceinline__ void operator()(const AccT& acc, const Unit& u, int wr, int wc, int fr, int fq) const {
        const int pn = u.pn;
#pragma unroll
        for (int ai = 0; ai < 2; ++ai)
#pragma unroll
            for (int m = 0; m < 4; ++m) { const int row = EPI_ROW(u, ai, m); const float rs = row_rs8(ss, row, 1.0f / QL);
                if (pn < 8) {
#pragma unroll
                    for (int bj = 0; bj < 2; ++bj) *(u32x4*)(qn + (size_t)row * DM + pn * BM + EPI_CB(bj)) = pack8f(acc[ai][bj][m][0] * rs, acc[ai][bj][m][1] * rs);
                } else {
                    const int head = 4 * (pn - 8) + wc;
                    const f32x4 c0 = *(const f32x4*)(cosT + (size_t)row * 32 + 8 * fq), c1 = *(const f32x4*)(cosT + (size_t)row * 32 + 8 * fq + 4);
                    const f32x4 s0 = *(const f32x4*)(sinT + (size_t)row * 32 + 8 * fq), s1 = *(const f32x4*)(sinT + (size_t)row * 32 + 8 * fq + 4);
                    const f32x4 a0 = acc[ai][0][m][0] * rs, a1 = acc[ai][0][m][1] * rs, b0 = acc[ai][1][m][0] * rs, b1 = acc[ai][1][m][1] * rs;
                    *(u32x4*)(qr + (size_t)row * (NHEAD * DROPE) + head * DROPE + 8 * fq) = pack8f(a0 * c0 - b0 * s0, a1 * c1 - b1 * s1);
                    *(u32x4*)(qr + (size_t)row * (NHEAD * DROPE) + head * DROPE + 32 + 8 * fq) = pack8f(a0 * s0 + b0 * c0, a1 * s1 + b1 * c1);
                } }
    }
};
struct EpiKVup {
    static constexpr bool PERM = true;
    bf16_t *kn, *vv; const float* ss;
    __device__ __forceinline__ void operator()(const AccT& acc, const Unit& u, int wr, int wc, int fr, int fq) const {
        bf16_t* dst = u.pn < 8 ? kn : vv; const int c0 = (u.pn & 7) * BM;
#pragma unroll
        for (int ai = 0; ai < 2; ++ai)
#pragma unroll
            for (int m = 0; m < 4; ++m) { const int row = EPI_ROW(u, ai, m); const float rs = row_rs8(ss, row, 1.0f / KVL);
#pragma unroll
                for (int bj = 0; bj < 2; ++bj) *(u32x4*)(dst + (size_t)row * DM + c0 + EPI_CB(bj)) = pack8f(acc[ai][bj][m][0] * rs, acc[ai][bj][m][1] * rs); }
    }
};
struct EpiPlain {
    static constexpr bool PERM = true;
    bf16_t* O; int ld;
    __device__ __forceinline__ void operator()(const AccT& acc, const Unit& u, int wr, int wc, int fr, int fq) const {
#pragma unroll
        for (int ai = 0; ai < 2; ++ai)
#pragma unroll
            for (int m = 0; m < 4; ++m) { const int row = EPI_ROW(u, ai, m);
#pragma unroll
                for (int bj = 0; bj < 2; ++bj) *(u32x4*)(O + (size_t)row * ld + u.pn * BM + EPI_CB(bj)) = pack8f(acc[ai][bj][m][0], acc[ai][bj][m][1]); }
    }
};
struct EpiGlu {
    static constexpr bool PERM = true;
    const bf16_t* z; const float* bias; bf16_t* ys;
    __device__ __forceinline__ void operator()(const AccT& acc, const Unit& u, int wr, int wc, int fr, int fq) const {
#pragma unroll
        for (int bj = 0; bj < 2; ++bj) { const int col = u.pn * BM + EPI_CB(bj); const f32x4 b0 = *(const f32x4*)(bias + col), b1 = *(const f32x4*)(bias + col + 4);
#pragma unroll
            for (int ai = 0; ai < 2; ++ai)
#pragma unroll
                for (int m = 0; m < 4; ++m) { const size_t off = (size_t)EPI_ROW(u, ai, m) * SSM_W + col; f32x4 z0, z1; unpack8(*(const u32x4*)(z + off), z0, z1);
                    *(u32x4*)(ys + off) = pack8f(z0 * sig4(acc[ai][bj][m][0] + b0), z1 * sig4(acc[ai][bj][m][1] + b1)); } }
    }
};
struct EpiGate {
    static constexpr bool PERM = true;
    const bf16_t* gate; const bf16_t* addend; bf16_t* O;
    __device__ __forceinline__ void operator()(const AccT& acc, const Unit& u, int wr, int wc, int fr, int fq) const {
#pragma unroll
        for (int ai = 0; ai < 2; ++ai)
#pragma unroll
            for (int m = 0; m < 4; ++m)
#pragma unroll
                for (int bj = 0; bj < 2; ++bj) { const size_t off = (size_t)EPI_ROW(u, ai, m) * DM + u.pn * BM + EPI_CB(bj); f32x4 g0, g1; unpack8(*(const u32x4*)(gate + off), g0, g1);
                    f32x4 r0 = g0 * acc[ai][bj][m][0], r1 = g1 * acc[ai][bj][m][1];
                    if (addend) { f32x4 t0, t1; unpack8(*(const u32x4*)(addend + off), t0, t1); r0 += t0; r1 += t1; }
                    *(u32x4*)(O + off) = pack8f(r0, r1); }
    }
};
struct EpiResid {
    static constexpr bool PERM = true;
    const float* xi; float* xo; bf16_t* xb; float* ss;
    __device__ __forceinline__ void operator()(const AccT& acc, const Unit& u, int wr, int wc, int fr, int fq) const {
#pragma unroll
        for (int ai = 0; ai < 2; ++ai)
#pragma unroll
            for (int m = 0; m < 4; ++m) { const int row = EPI_ROW(u, ai, m); float s = 0.f;
#pragma unroll
                for (int bj = 0; bj < 2; ++bj) { const size_t off = (size_t)row * DM + u.pn * BM + EPI_CB(bj);
                    const f32x4 r0 = *(const f32x4*)(xi + off) + acc[ai][bj][m][0], r1 = *(const f32x4*)(xi + off + 4) + acc[ai][bj][m][1];
                    *(f32x4*)(xo + off) = r0; *(f32x4*)(xo + off + 4) = r1; s += sq4(r0) + sq4(r1);
                    if (xb) *(u32x4*)(xb + off) = pack8f(r0, r1); }
                s += __shfl_xor(s, 16); s += __shfl_xor(s, 32); if (fq == 0) ss[(size_t)row * 32 + u.pn * 4 + wc] = s; }
    }
};
struct EpiXq {
    static constexpr bool PERM = true;
    bf16_t* O; const float* ss;
    __device__ __forceinline__ void operator()(const AccT& acc, const Unit& u, int wr, int wc, int fr, int fq) const {
#pragma unroll
        for (int ai = 0; ai < 2; ++ai)
#pragma unroll
            for (int m = 0; m < 4; ++m) { const int row = EPI_ROW(u, ai, m); const float rs = row_rs32(ss, row, 1.0f / DM);
#pragma unroll
                for (int bj = 0; bj < 2; ++bj) *(u32x4*)(O + (size_t)row * XW + u.pn * BM + EPI_CB(bj)) = pack8f(acc[ai][bj][m][0] * rs, acc[ai][bj][m][1] * rs); }
    }
};
struct EpiMoeGU {
    static constexpr bool PERM = true;
    const float* bias; bf16_t* act;
    __device__ __forceinline__ void operator()(const AccT& acc, const Unit& u, int wr, int wc, int fr, int fq) const {
        const int j0 = u.pn * HALF + wc * 32 + 8 * fq; const float* bg = bias + (size_t)u.e * (2 * DFF) + j0;
        const f32x4 g0 = *(const f32x4*)bg, g1 = *(const f32x4*)(bg + 4), u0 = *(const f32x4*)(bg + DFF), u1 = *(const f32x4*)(bg + DFF + 4);
#pragma unroll
        for (int ai = 0; ai < 2; ++ai)
#pragma unroll
            for (int m = 0; m < 4; ++m) { const int row = EPI_ROW(u, ai, m); f32x4 r[2];
#pragma unroll
                for (int n = 0; n < 2; ++n) { const f32x4 gt = acc[ai][0][m][n] + (n ? g1 : g0), up = acc[ai][1][m][n] + (n ? u1 : u0);
#pragma unroll
                    for (int j = 0; j < 4; ++j) { const float gc = fminf(gt[j], 7.0f), uc = fminf(fmaxf(up[j], -7.0f), 7.0f); r[n][j] = (uc + 1.0f) * (gc * fsigmoid(1.702f * gc)); } }
                *(u32x4*)(act + (size_t)row * DFF + j0) = pack8f(r[0], r[1]); }
    }
};
struct EpiMoeDown {
    static constexpr bool PERM = true;
    const float* bias; bf16_t* O;
    __device__ __forceinline__ void operator()(const AccT& acc, const Unit& u, int wr, int wc, int fr, int fq) const {
#pragma unroll
        for (int bj = 0; bj < 2; ++bj) { const int col = u.pn * BM + EPI_CB(bj); const float* bp = bias + (size_t)u.e * DM + col; const f32x4 b0 = *(const f32x4*)bp, b1 = *(const f32x4*)(bp + 4);
#pragma unroll
            for (int ai = 0; ai < 2; ++ai)
#pragma unroll
                for (int m = 0; m < 4; ++m) *(u32x4*)(O + (size_t)EPI_ROW(u, ai, m) * DM + col) = pack8f(acc[ai][bj][m][0] + b0, acc[ai][bj][m][1] + b1); }
    }
};
#undef EPI_ROW
#undef EPI_CB
}
namespace att {
constexpr int NW = 8, QBLK = 32, KVBLK = 64, QB = NW * QBLK;
constexpr int SHM_V = KVBLK * 128 * 2, SHM_K = KVBLK * 128 * 2, SHM_KR = KVBLK * 64 * 2;
constexpr int OFF_V = 0, OFF_K = 2 * SHM_V, OFF_KR = OFF_K + 2 * SHM_K, OFF_WS = OFF_KR + 2 * SHM_KR, OFF_QR = OFF_WS + NW * 64 * 4, LDS_BYTES = OFF_QR + NW * 4096;
constexpr float THR = 8.f;
#define KSWZ(row, colB) ((row) * 256 + ((colB) ^ (((row) & 7) << 4)))
__device__ __forceinline__ int v_st(int k, int c) { const int kk = (k & ~0xC) | ((k & 4) << 1) | ((k & 8) >> 1); return ((kk >> 3) * 4 + (c >> 5)) * 512 + ((kk & 7) * 32 + (c & 31)) * 2; }
__device__ __forceinline__ int v_rd_base(int lane) { return ((lane & 3) << 3) | (((lane >> 2) & 3) << 6) | (((lane >> 4) & 1) << 5) | (((lane >> 5) & 1) << 8); }
constexpr int v_rd_off(int d0, int ks, int half) { return d0 * 512 + ks * 4096 + half * 2048; }
__device__ __forceinline__ int crow(int r, int hi) { return (r & 3) + 8 * (r >> 2) + 4 * hi; }

__device__ __forceinline__ void mask_tile(f32x16& p0, f32x16& p1, int dq) {
    const float NEG = -__builtin_inff();
#pragma unroll
    for (int r = 0; r < 16; ++r) {
        const int c = (r & 3) + 8 * (r >> 2);
        if (dq - c < 0) p0[r] = NEG;
        if (dq - c - 32 < 0) p1[r] = NEG;
    }
}
template <bool ROPE>
__device__ __forceinline__ void partialSM(f32x16& p0, f32x16& p1, float& m_reg, float& mn, float& alpha) {
    constexpr float SCALE = ROPE ? 0.07216878364870323f : 0.08838834764831845f;
    float pmax = p0[0];
#pragma unroll
    for (int r = 1; r < 16; ++r) pmax = fmaxf(pmax, p0[r]);
#pragma unroll
    for (int r = 0; r < 16; ++r) pmax = fmaxf(pmax, p1[r]);
    { auto rr = __builtin_amdgcn_permlane32_swap(__float_as_uint(pmax), __float_as_uint(pmax), false, false);
      pmax = fmaxf(__uint_as_float(rr[0]), __uint_as_float(rr[1])); }
    constexpr float C2 = 1.4426950408889634f * SCALE;
    if (__builtin_expect(__all((pmax - m_reg) * SCALE <= THR), 1)) { mn = m_reg; alpha = 1.f; }
    else { mn = fmaxf(m_reg, pmax); alpha = __builtin_amdgcn_exp2f((m_reg - mn) * C2); m_reg = mn; }
    const float mnL = -mn * C2;
#pragma unroll
    for (int r = 0; r < 16; ++r) p0[r] = fmaf(p0[r], C2, mnL);
#pragma unroll
    for (int r = 0; r < 16; ++r) p1[r] = fmaf(p1[r], C2, mnL);
#pragma unroll
    for (int r = 0; r < 16; ++r) p0[r] = __builtin_amdgcn_exp2f(p0[r]);
}
__device__ __forceinline__ void finishSM(f32x16& p0, f32x16& p1, float alpha, float& l_reg, bf16x8& pa0, bf16x8& pa1, bf16x8& pa2, bf16x8& pa3) {
#pragma unroll
    for (int r = 0; r < 16; ++r) p1[r] = __builtin_amdgcn_exp2f(p1[r]);
    float ps = 0;
#pragma unroll
    for (int r = 0; r < 16; ++r) ps += p0[r];
#pragma unroll
    for (int r = 0; r < 16; ++r) ps += p1[r];
    { auto rr = __builtin_amdgcn_permlane32_swap(__float_as_uint(ps), __float_as_uint(ps), false, false);
      ps = __uint_as_float(rr[0]) + __uint_as_float(rr[1]); }
    l_reg = l_reg * alpha + ps;
#define PK4(P, B_, OUT) do { unsigned a0 = cvtpk(P[B_+0], P[B_+1]), a1 = cvtpk(P[B_+2], P[B_+3]);                          \
        unsigned b0 = cvtpk(P[B_+4], P[B_+5]), b1 = cvtpk(P[B_+6], P[B_+7]);                                             \
        auto r0 = __builtin_amdgcn_permlane32_swap(a0, b0, false, false); auto r1 = __builtin_amdgcn_permlane32_swap(a1, b1, false, false); \
        u32x4 w = {r0[0], r1[0], r0[1], r1[1]}; OUT = *reinterpret_cast<bf16x8*>(&w); } while (0)
    PK4(p0, 0, pa0); PK4(p0, 8, pa1); PK4(p1, 0, pa2); PK4(p1, 8, pa3);
#undef PK4
}
template <int KB, bool ROPE>
__device__ __forceinline__ void qkt(f32x16& p0, f32x16& p1, const char* K_lds, int r32, int hi, const bf16x8* qr, const char* qrl) {
    p0 = f32x16{}; p1 = f32x16{};
    const char* kb[4];
#pragma unroll
    for (int dd = 0; dd < 4; ++dd) kb[dd] = K_lds + KB * SHM_K + KSWZ(r32, (dd * 16 + hi * 8) * 2);
#pragma unroll
    for (int d0 = 0; d0 < 8; ++d0) { const char* a = kb[d0 & 3] + (d0 >> 2) * 128;
        bf16x8 b0 = *reinterpret_cast<const bf16x8*>(a);
        bf16x8 b1 = *reinterpret_cast<const bf16x8*>(a + 32 * 256);
        p0 = __builtin_amdgcn_mfma_f32_32x32x16_bf16(b0, qr[d0], p0, 0, 0, 0);
        p1 = __builtin_amdgcn_mfma_f32_32x32x16_bf16(b1, qr[d0], p1, 0, 0, 0); }
    if constexpr (ROPE) {
        constexpr int RO = 2 * SHM_K - KB * SHM_K + KB * SHM_KR;
#pragma unroll
        for (int d0 = 0; d0 < 4; ++d0) { const char* a = kb[d0] + RO;
            bf16x8 b0 = *reinterpret_cast<const bf16x8*>(a);
            bf16x8 b1 = *reinterpret_cast<const bf16x8*>(a + 128);
            const bf16x8 q = *reinterpret_cast<const bf16x8*>(qrl + d0 * 1024);
            p0 = __builtin_amdgcn_mfma_f32_32x32x16_bf16(b0, q, p0, 0, 0, 0);
            p1 = __builtin_amdgcn_mfma_f32_32x32x16_bf16(b1, q, p1, 0, 0, 0); }
    }
}
template <int VB>
__device__ __forceinline__ void pv_tile(f32x16* o, int vb0, bf16x8 pa0, bf16x8 pa1, bf16x8 pa2, bf16x8 pa3) {
#define TRRD(dst, off) asm volatile("ds_read_b64_tr_b16 %0, %1 offset:%2" : "=&v"(dst) : "v"(vb0), "i"(off) : "memory")
#define PV_D0(d0) do { s16x4 l0, l1, l2, l3, h0, h1, h2, h3; constexpr int b_ = VB * SHM_V + v_rd_off(d0, 0, 0);  \
        TRRD(l0, b_); TRRD(h0, b_ + 2048); TRRD(l1, b_ + 4096); TRRD(h1, b_ + 6144); TRRD(l2, b_ + 8192); TRRD(h2, b_ + 10240); TRRD(l3, b_ + 12288); TRRD(h3, b_ + 14336); \
        asm volatile("s_waitcnt lgkmcnt(0)" ::: "memory"); SBAR();   \
        o[d0] = __builtin_amdgcn_mfma_f32_32x32x16_bf16(pa0, (bf16x8){l0[0], l0[1], l0[2], l0[3], h0[0], h0[1], h0[2], h0[3]}, o[d0], 0, 0, 0);   \
        o[d0] = __builtin_amdgcn_mfma_f32_32x32x16_bf16(pa1, (bf16x8){l1[0], l1[1], l1[2], l1[3], h1[0], h1[1], h1[2], h1[3]}, o[d0], 0, 0, 0);   \
        o[d0] = __builtin_amdgcn_mfma_f32_32x32x16_bf16(pa2, (bf16x8){l2[0], l2[1], l2[2], l2[3], h2[0], h2[1], h2[2], h2[3]}, o[d0], 0, 0, 0);   \
        o[d0] = __builtin_amdgcn_mfma_f32_32x32x16_bf16(pa3, (bf16x8){l3[0], l3[1], l3[2], l3[3], h3[0], h3[1], h3[2], h3[3]}, o[d0], 0, 0, 0); } while (0)
    PV_D0(0); PV_D0(1); PV_D0(2); PV_D0(3);
#undef PV_D0
#undef TRRD
}

struct BlockRef { const bf16_t* Q; const bf16_t* QR; const bf16_t* K; const bf16_t* KR; const bf16_t* V; bf16_t* O; int P0; };
struct Strides { int qs, qrs, ks, vs, os, skv; };
template <bool ROPE> struct Seam { bf16x8 qr[ROPE ? 12 : 8];     bf16x8 st_v0, st_v1, st_k0, st_k1, st_kr; };
#define LD8(p) (*reinterpret_cast<const bf16x8*>(p))
#define VMW() asm volatile("s_waitcnt vmcnt(0)" ::: "memory")
#define VMWN(n) asm volatile("s_waitcnt vmcnt(%0)" :: "i"(n) : "memory")
#define SLOAD_H(R, k0) do { const char* vb_ = (const char*)(R).V + (size_t)(k0) * T.vs * 2; const char* kb_ = (const char*)(R).K + (size_t)(k0) * T.ks * 2;   \
                            S.st_v0 = LD8(vb_ + vo_v); S.st_v1 = LD8(vb_ + (size_t)T.vs * 64 + vo_v);              \
                            S.st_k0 = LD8(kb_ + vo_k); S.st_k1 = LD8(kb_ + (size_t)T.ks * 64 + vo_k);              \
                            if constexpr (ROPE) S.st_kr = LD8((const char*)(R).KR + (size_t)(k0) * (DROPE * 2) + vo_kr); } while (0)
#define SWRITE_HK(bf) do { *(bf16x8*)(K_lds + (bf) * SHM_K + kws) = S.st_k0; *(bf16x8*)(K_lds + (bf) * SHM_K + kws + 32 * 256) = S.st_k1;                \
                           if constexpr (ROPE) *(bf16x8*)(K_lds + 2 * SHM_K + (bf) * SHM_KR + krws) = S.st_kr; } while (0)
#define SWRITE_HV(bf) do { *(bf16x8*)(V_lds + (bf) * SHM_V + vst0) = S.st_v0; *(bf16x8*)(V_lds + (bf) * SHM_V + vst1) = S.st_v1; } while (0)
#define SWRITE_H(bf) do { SWRITE_HV(bf); SWRITE_HK(bf); } while (0)
#define QLOAD(R) do { const char* qb_ = (const char*)(R).Q + (size_t)(wid * QBLK) * T.qs * 2; const unsigned qo_ = (unsigned)(r32 * T.qs + hi * 8) * 2u;    \
                      _Pragma("unroll") for (int d0 = 0; d0 < 8; ++d0) S.qr[d0] = LD8(qb_ + qo_ + d0 * 32);    \
                      if constexpr (ROPE) { const char* qrb_ = (const char*)(R).QR + (size_t)(wid * QBLK) * T.qrs * 2; const unsigned qro_ = (unsigned)(r32 * T.qrs + hi * 8) * 2u;   \
                          _Pragma("unroll") for (int d0 = 0; d0 < 4; ++d0) S.qr[8 + d0] = LD8(qrb_ + qro_ + d0 * 32); } } while (0)
#define QPARK() do { if constexpr (ROPE) { _Pragma("unroll") for (int d0 = 0; d0 < 4; ++d0) *(bf16x8*)(qrl + d0 * 1024) = S.qr[8 + d0]; } } while (0)
#define STAGE_IDX() const int sr = tid >> 4, sc = (tid & 15) * 8, kws = KSWZ(sr, sc * 2); \
                    const int rk = tid >> 3, rc = tid & 7, krws = (rk & 31) * 256 + ((((rk >> 5) * 8 + rc) * 16) ^ (((rk & 31) & 7) << 4)); \
                    const unsigned vo_v = (unsigned)(sr * T.vs + sc) * 2u, vo_k = (unsigned)(sr * T.ks + sc) * 2u, vo_kr = (unsigned)(rk * DROPE + rc * 8) * 2u

template <bool ROPE, bool CAUSAL>
__device__ __forceinline__ void attn_prime(const BlockRef& cur, const Strides& T, char* lds, Seam<ROPE>& S) {
    const int tid = threadIdx.x, wid = __builtin_amdgcn_readfirstlane(tid >> 6), lane = tid & 63, r32 = lane & 31, hi = lane >> 5;
    STAGE_IDX(); char* K_lds = lds + OFF_K; char* qrl = lds + OFF_QR + wid * 4096 + lane * 16;
    QLOAD(cur);
    SLOAD_H(cur, 0); VMW(); SWRITE_HK(0); QPARK();
    __syncthreads();
}
template <bool ROPE, bool CAUSAL>
__device__ __forceinline__ void attn_block(const BlockRef& cur, const BlockRef& nxt, const Strides& T, char* lds, Seam<ROPE>& S) {
    const int tid = threadIdx.x, wid = __builtin_amdgcn_readfirstlane(tid >> 6), lane = tid & 63, r32 = lane & 31, hi = lane >> 5;
    int j_hi = CAUSAL ? (cur.P0 + QB - 1) / KVBLK + 1 : T.skv / KVBLK; if (j_hi > T.skv / KVBLK) j_hi = T.skv / KVBLK;
    const int NT = j_hi;
    const int qlo = cur.P0 + wid * QBLK, qm = qlo + r32 - 4 * hi;
    char* V_lds = lds + OFF_V; char* K_lds = lds + OFF_K; char* qrl = lds + OFF_QR + wid * 4096 + lane * 16;
    float* ws = (float*)(lds + OFF_WS) + wid * 64; float* li_l = ws, * al_l = ws + 32;
    float m_reg = -1e30f, l_reg = 0; f32x16 o[4] = {};
    STAGE_IDX(); const int vst0 = v_st(sr, sc), vst1 = v_st(32 + sr, sc);
    const int vb0 = (int)(uintptr_t)V_lds + v_rd_base(lane);
#define RESC(a) do { if (__any((a) < 1.f)) { if (hi == 0) al_l[r32] = (a); asm volatile("s_waitcnt lgkmcnt(0)" ::: "memory");              \
                     for (int d_ = 0; d_ < 4; ++d_) for (int r = 0; r < 16; ++r) o[d_][r] *= al_l[crow(r, hi)]; } } while (0)
#define KBASE(t) ((t) * KVBLK)
#define MASKT(P0_, P1_, t) do { if constexpr (CAUSAL) { const int kb_ = KBASE(t); if (kb_ + KVBLK - 1 > qlo) mask_tile(P0_, P1_, qm - kb_); } } while (0)
    constexpr int NQL = ROPE ? 12 : 8;
#define SEAM_K0() do { VMWN(NQL); SWRITE_HK(0); SBAR(); } while (0)
    f32x16 pA0, pA1, pB0, pB1; float mnA, mnB, alA, alB; bf16x8 pa0, pa1, pa2, pa3;
    SWRITE_HV(0); SBAR();
    if (NT > 1) { SLOAD_H(cur, KBASE(1)); }
    SBAR(); qkt<0, ROPE>(pA0, pA1, K_lds, r32, hi, S.qr, qrl);
    MASKT(pA0, pA1, 0); partialSM<ROPE>(pA0, pA1, m_reg, mnA, alA);
    if (NT > 1) { VMW(); SWRITE_H(1); }
    __syncthreads();
#define HALF_STEP(PX0, PX1, mnX, alX, PY0, PY1, alY, t, KB, VB, SB) do {                                                      \
        SBAR(); qkt<KB, ROPE>(PX0, PX1, K_lds, r32, hi, S.qr, qrl);                                                                \
        finishSM(PY0, PY1, alY, l_reg, pa0, pa1, pa2, pa3); SBAR();                                                           \
        if ((t) + 1 < NT) { SLOAD_H(cur, KBASE((t) + 1)); SBAR(); }                                                           \
        pv_tile<VB>(o, vb0, pa0, pa1, pa2, pa3); MASKT(PX0, PX1, (t)); partialSM<ROPE>(PX0, PX1, m_reg, mnX, alX);            \
        __syncthreads();                                                                                                      \
        if ((t) + 1 < NT) { VMW(); SWRITE_H(SB); }                                                                            \
        RESC(alX); __syncthreads(); } while (0)
    for (int t = 1; t + 1 < NT; t += 2) {
        HALF_STEP(pB0, pB1, mnB, alB, pA0, pA1, alA, t, 1, 0, 0);
        HALF_STEP(pA0, pA1, mnA, alA, pB0, pB1, alB, t + 1, 0, 1, 1);
    }
    const bool even = (NT & 1) == 0;
    if (even) { SBAR(); qkt<1, ROPE>(pB0, pB1, K_lds, r32, hi, S.qr, qrl); SBAR(); }
    SLOAD_H(nxt, 0); SBAR();
    QLOAD(nxt);
    SBAR();
    finishSM(pA0, pA1, alA, l_reg, pa0, pa1, pa2, pa3); SBAR();
    pv_tile<0>(o, vb0, pa0, pa1, pa2, pa3);
    if (even) { MASKT(pB0, pB1, NT - 1); partialSM<ROPE>(pB0, pB1, m_reg, mnB, alB); __syncthreads(); RESC(alB);
        finishSM(pB0, pB1, alB, l_reg, pa0, pa1, pa2, pa3); SBAR(); pv_tile<1>(o, vb0, pa0, pa1, pa2, pa3); }
    SBAR(); SEAM_K0();
    if (hi == 0) li_l[r32] = l_reg; asm volatile("s_waitcnt lgkmcnt(0)" ::: "memory");
    float rli[16];
#pragma unroll
    for (int r = 0; r < 16; ++r) rli[r] = __builtin_amdgcn_rcpf(li_l[crow(r, hi)]);
    bf16_t* Ow = cur.O + (size_t)(wid * QBLK) * T.os;
#pragma unroll
    for (int r = 0; r < 16; ++r) { const int orow = crow(r, hi);
#pragma unroll
        for (int d0 = 0; d0 < 4; ++d0) { const float v = o[d0][r] * rli[r];
            const float vn = __shfl_xor(v, 1);
            if ((r32 & 1) == 0) *(unsigned*)(Ow + (size_t)orow * T.os + d0 * 32 + r32) = cvtpk(v, vn); } }
    QPARK();
    __syncthreads();
#undef RESC
#undef KBASE
#undef MASKT
#undef SEAM_K0
#undef HALF_STEP
}

template <bool ROPE>
__device__ __forceinline__ void qkt_rt(f32x16& p0, f32x16& p1, const char* K_lds, int buf, const int (&koff)[4], const bf16x8* qr, const char* qrl) {
    p0 = f32x16{}; p1 = f32x16{};
    const char* kbase = K_lds + buf * SHM_K;
#pragma unroll
    for (int d0 = 0; d0 < 8; ++d0) { const char* a = kbase + koff[d0 & 3] + (d0 >> 2) * 128;
        bf16x8 b0 = *reinterpret_cast<const bf16x8*>(a);
        bf16x8 b1 = *reinterpret_cast<const bf16x8*>(a + 32 * 256);
        p0 = __builtin_amdgcn_mfma_f32_32x32x16_bf16(b0, qr[d0], p0, 0, 0, 0);
        p1 = __builtin_amdgcn_mfma_f32_32x32x16_bf16(b1, qr[d0], p1, 0, 0, 0); }
    if constexpr (ROPE) {
        const char* rbase = K_lds + 2 * SHM_K + buf * SHM_KR;
#pragma unroll
        for (int d0 = 0; d0 < 4; ++d0) { const char* a = rbase + koff[d0];
            bf16x8 b0 = *reinterpret_cast<const bf16x8*>(a);
            bf16x8 b1 = *reinterpret_cast<const bf16x8*>(a + 128);
            const bf16x8 q = *reinterpret_cast<const bf16x8*>(qrl + d0 * 1024);
            p0 = __builtin_amdgcn_mfma_f32_32x32x16_bf16(b0, q, p0, 0, 0, 0);
            p1 = __builtin_amdgcn_mfma_f32_32x32x16_bf16(b1, q, p1, 0, 0, 0); }
    }
}
template <bool ROPE, bool CAUSAL>
__device__ __forceinline__ void attn_block_simple(const BlockRef& cur, const Strides& T, char* lds) {
    const int tid = threadIdx.x, wid = __builtin_amdgcn_readfirstlane(tid >> 6), lane = tid & 63, r32 = lane & 31, hi = lane >> 5;
    int j_hi = CAUSAL ? (cur.P0 + QB - 1) / KVBLK + 1 : T.skv / KVBLK; if (j_hi > T.skv / KVBLK) j_hi = T.skv / KVBLK;
    const int NT = j_hi;
    const int qlo = cur.P0 + wid * QBLK, qm = qlo + r32 - 4 * hi;
    char* V_lds = lds + OFF_V; char* K_lds = lds + OFF_K;
    float* ws = (float*)(lds + OFF_WS) + wid * 64; float* li_l = ws, * al_l = ws + 32;
    float m_reg = -1e30f, l_reg = 0; f32x16 o[4] = {};
    STAGE_IDX(); const int vst0 = v_st(sr, sc), vst1 = v_st(32 + sr, sc);
    const int vb0 = (int)(uintptr_t)V_lds + v_rd_base(lane);
    int koff[4];
#pragma unroll
    for (int dd = 0; dd < 4; ++dd) koff[dd] = KSWZ(r32, (dd * 16 + hi * 8) * 2);
    Seam<ROPE> S; char* qrl = lds + OFF_QR + wid * 4096 + lane * 16;
    QLOAD(cur);
    SLOAD_H(cur, 0); VMW(); SWRITE_H(0); QPARK();
    __syncthreads();
    for (int t = 0; t < NT; ++t) {
        const int buf = t & 1;
        if (t + 1 < NT) { SLOAD_H(cur, (t + 1) * KVBLK); }
        SBAR();
        f32x16 p0, p1; qkt_rt<ROPE>(p0, p1, K_lds, buf, koff, S.qr, qrl);
        if constexpr (CAUSAL) { const int kb_ = t * KVBLK; if (kb_ + KVBLK - 1 > qlo) mask_tile(p0, p1, qm - kb_); }
        float mn, al; partialSM<ROPE>(p0, p1, m_reg, mn, al);
        if (__any(al < 1.f)) { if (hi == 0) al_l[r32] = al; asm volatile("s_waitcnt lgkmcnt(0)" ::: "memory");
            for (int d_ = 0; d_ < 4; ++d_) for (int r = 0; r < 16; ++r) o[d_][r] *= al_l[crow(r, hi)]; }
        bf16x8 pa0, pa1, pa2, pa3; finishSM(p0, p1, al, l_reg, pa0, pa1, pa2, pa3); SBAR();
        pv_tile<0>(o, vb0 + buf * SHM_V, pa0, pa1, pa2, pa3);
        if (t + 1 < NT) { VMW(); SWRITE_H(buf ^ 1); }
        __syncthreads();
    }
    if (hi == 0) li_l[r32] = l_reg; asm volatile("s_waitcnt lgkmcnt(0)" ::: "memory");
    float rli[16];
#pragma unroll
    for (int r = 0; r < 16; ++r) rli[r] = __builtin_amdgcn_rcpf(li_l[crow(r, hi)]);
    bf16_t* Ow = cur.O + (size_t)(wid * QBLK) * T.os;
#pragma unroll
    for (int r = 0; r < 16; ++r) { const int orow = crow(r, hi);
#pragma unroll
        for (int d0 = 0; d0 < 4; ++d0) { const float v = o[d0][r] * rli[r];
            const float vn = __shfl_xor(v, 1);
            if ((r32 & 1) == 0) *(unsigned*)(Ow + (size_t)orow * T.os + d0 * 32 + r32) = cvtpk(v, vn); } }
    __syncthreads();
}
#undef LD8
#undef VMW
#undef VMWN
#undef SLOAD_H
#undef SWRITE_HK
#undef SWRITE_HV
#undef SWRITE_H
#undef QLOAD
#undef QPARK
#undef STAGE_IDX
}
__device__ __forceinline__ float sq4v(f32x4 v) { return pg8::sq4(v); }
__device__ __forceinline__ float row_rs32g(const float* ss, int row) { return pg8::row_rs32(ss, row, 1.0f / DM); }
struct Params {
    const float *x, *mem; const int* pos; const float *norm_mix, *w_in, *lam_re, *lam_im, *log_step, *b_re, *b_im, *c_re, *c_im, *ssm_d, *w_glu, *b_glu;
    const float *q_norm, *w_uq, *kv_norm, *w_uk, *w_uv, *w_up_ssm, *w_up_mla, *w_out, *norm_xattn, *norm_mem, *xa_wq, *xa_wk, *xa_wv, *xa_wo;
    const float *norm_moe, *router_w, *router_b, *w_gu, *b_gu, *w_dn, *b_dn, *final_norm;
    float* out;
    unsigned* ctl;
    bf16_t *WinT, *WkpeT, *WgluT, *WuqT, *WukvT, *WupsT, *WupmT, *WoutT, *WxqT, *WxkvT, *WxoT, *WguT, *WdnT;
    float* WrT;
    bf16_t *hn, *memn; float *cosT, *sinT; float* abar; bf16_t *bbarT, *cmat;
    bf16_t *ub, *qa, *kva; float *qss, *kvss; bf16_t *sgs, *sgm, *kpe;
    bf16_t *qn, *qr, *kn, *vv, *ymla;
    float* send; bf16_t *zb, *ys, *t1, *mg;
    float* x1; bf16_t* x1b; float* ss1;
    bf16_t *memkv, *qx, *ox;
    float* x2; float* ss2;
    int* topi; float* topw; int* rank; int* slot; int* wgcnt; int* blke;
    bf16_t *xg, *act, *orow;
    int ph_lo, ph_hi;
};

struct Frame { LAS unsigned char* lds; int wave, vcu, G, gw, NGW; };

template <class RowMap>
__device__ __forceinline__ void p0_transpose_item(const float* W, int ldw, int K, bf16_t* WT, const float* gain, LAS float* scr, int kb, int nb, int lane, const RowMap& rowmap) {
    const int k0 = 64 * kb, n0 = 32 * nb;
#pragma unroll 8
    for (int i = 0; i < 32; ++i) { const int kk = 2 * i + (lane >> 5); float v = W[(size_t)(k0 + kk) * ldw + n0 + (lane & 31)]; if (gain) v *= gain[k0 + kk]; scr[kk * 33 + (lane & 31)] = v; }
    LDS_WAIT(); asm volatile("" ::: "memory");
    const int c = lane & 7;
#pragma unroll
    for (int j = 0; j < 4; ++j) { const int n = (lane >> 3) + 8 * j; const LAS float* s = scr + (8 * c) * 33 + n;
        u32x4 o; o.x = cvtpk(s[0 * 33], s[1 * 33]); o.y = cvtpk(s[2 * 33], s[3 * 33]); o.z = cvtpk(s[4 * 33], s[5 * 33]); o.w = cvtpk(s[6 * 33], s[7 * 33]);
        *(u32x4*)(WT + (size_t)rowmap(n0 + n) * K + k0 + 8 * c) = o; }
    LDS_WAIT(); asm volatile("" ::: "memory");
}
struct MapId { int off; __device__ __forceinline__ int operator()(int n) const { return n + off; } };
struct MapUq { __device__ __forceinline__ int operator()(int n) const { const int h = n / 192, d = n % 192; if (d < 128) return h * 128 + d;
    const int dd = d - 128, half = dd >> 5, i = dd & 31; return 2048 + 256 * (h >> 2) + half * 128 + (h & 3) * 32 + i; } };
struct MapGU { __device__ __forceinline__ int operator()(int n) const { const int up = n >= DFF, j = up ? n - DFF : n; return 256 * (j >> 7) + up * 128 + (j & 127); } };

__device__ __forceinline__ void rms_row_bf16(const float* xrow, const float* gain, bf16_t* orow, int lane) {
    f32x4 v[8]; float s = 0.f;
#pragma unroll
    for (int j = 0; j < 8; ++j) { v[j] = *(const f32x4*)(xrow + 256 * j + 4 * lane); s += sq4v(v[j]); }
    const float rs = __builtin_amdgcn_rsqf(wave_sum(s) * (1.0f / DM) + EPS);
#pragma unroll
    for (int j = 0; j < 8; ++j) { const f32x4 g = *(const f32x4*)(gain + 256 * j + 4 * lane); const f32x4 r = v[j] * rs * g;
        u32x2 o = {cvtpk(r[0], r[1]), cvtpk(r[2], r[3])}; *(u32x2*)(orow + 256 * j + 4 * lane) = o; }
}

__device__ __forceinline__ void cmul(float ar, float ai, float br, float bi, float& cr, float& ci) { cr = ar * br - ai * bi; ci = ar * bi + ai * br; }

__device__ __forceinline__ void p0_prologue(const Params& p, Frame& F) {
    LAS float* scr = (LAS float*)(F.lds + F.wave * 16384);
    const int gw = F.gw, NGW = F.NGW, lane = ((int)threadIdx.x & 63);
#define TJOB(W, LDW, COFF, NCOLS, KK, DST, GAIN, MAP) { const int nblk = (NCOLS) / 32, nit = ((KK) / 64) * nblk; \
        for (int it = gw; it < nit; it += NGW) p0_transpose_item((W) + (COFF), (LDW), (KK), (DST), (GAIN), scr, it / nblk, it % nblk, lane, (MAP)); }
    TJOB(p.w_in, IN_COLS, 0, 2048, DM, p.WinT, nullptr, MapId{0});
    TJOB(p.w_in, IN_COLS, 2048, 64, DM, p.WkpeT, nullptr, MapId{0});
    TJOB(p.w_in, IN_COLS, 2112, 4096, DM, p.WinT, nullptr, MapId{2048});
    TJOB(p.w_glu, SSM_W, 0, SSM_W, SSM_W, p.WgluT, nullptr, MapId{0});
    TJOB(p.w_uq, NHEAD * 192, 0, NHEAD * 192, QL, p.WuqT, p.q_norm, MapUq{});
    TJOB(p.w_uk, NHEAD * 128, 0, NHEAD * 128, KVL, p.WukvT, p.kv_norm, MapId{0});
    TJOB(p.w_uv, NHEAD * 128, 0, NHEAD * 128, KVL, p.WukvT, p.kv_norm, MapId{2048});
    TJOB(p.w_up_ssm, DM, 0, DM, SSM_W, p.WupsT, nullptr, MapId{0});
    TJOB(p.w_up_mla, DM, 0, DM, DM, p.WupmT, nullptr, MapId{0});
    TJOB(p.w_out, DM, 0, DM, DM, p.WoutT, nullptr, MapId{0});
    TJOB(p.xa_wq, XW, 0, XW, DM, p.WxqT, p.norm_xattn, MapId{0});
    TJOB(p.xa_wk, XW, 0, XW, DM, p.WxkvT, nullptr, MapId{0});
    TJOB(p.xa_wv, XW, 0, XW, DM, p.WxkvT, nullptr, MapId{512});
    TJOB(p.xa_wo, DM, 0, DM, XW, p.WxoT, nullptr, MapId{0});
    for (int e = 0; e < NEXP; ++e) {
        TJOB(p.w_gu + (size_t)e * DM * 2 * DFF, 2 * DFF, 0, 2 * DFF, DM, p.WguT + (size_t)e * 2 * DFF * DM, nullptr, MapGU{});
        TJOB(p.w_dn + (size_t)e * DFF * DM, DM, 0, DM, DFF, p.WdnT + (size_t)e * DM * DFF, nullptr, MapId{0});
    }
#undef TJOB
    for (int m = gw; m < SEQ; m += NGW) rms_row_bf16(p.x + (size_t)m * DM, p.norm_mix, p.hn + (size_t)m * DM, lane);
    for (int m = gw; m < MEML; m += NGW) rms_row_bf16(p.mem + (size_t)m * DM, p.norm_mem, p.memn + (size_t)m * DM, lane);
    const int gt = gw * 64 + lane, NGT = NGW * 64;
    for (int i = gt; i < SEQ * 32; i += NGT) {
        const int t = i >> 5, f = i & 31;
        const float invf = __builtin_powf(10000.0f, -(float)(2 * f) / 64.0f);
        const float ang = (float)p.pos[t] * invf;
        const double rev = (double)ang * 0.15915494309189535; const float fr = (float)(rev - __builtin_floor(rev));
        p.cosT[i] = __builtin_amdgcn_cosf(fr); p.sinT[i] = __builtin_amdgcn_sinf(fr);
    }
    for (int i = gt; i < DM * NEXP; i += NGT) p.WrT[i] = p.router_w[i] * p.norm_moe[i >> 5];
    for (int i = gt; i < SSM_G * SSM_P; i += NGT) {
        const int g = i >> 6;
        const float dt = __builtin_expf(p.log_step[g]), lr = p.lam_re[i], li = p.lam_im[i];
        const float mag = __builtin_expf(lr * dt); const double rev = (double)(li * dt) * 0.15915494309189535; const float fr = (float)(rev - __builtin_floor(rev));
        const float ar = mag * __builtin_amdgcn_cosf(fr), ai = mag * __builtin_amdgcn_sinf(fr);
        p.abar[2 * i] = ar; p.abar[2 * i + 1] = ai;
        const float den = 1.0f / (lr * lr + li * li); float fr_, fi_; cmul(ar - 1.0f, ai, lr * den, -li * den, fr_, fi_);
        const int pst = i & 63;
#pragma unroll
        for (int h = 0; h < SSM_H; ++h) { const float br = p.b_re[(size_t)i * SSM_H + h], bi = p.b_im[(size_t)i * SSM_H + h]; float cr, ci; cmul(fr_, fi_, br, bi, cr, ci);
            p.bbarT[((size_t)g * 128 + pst) * 16 + h] = f2bf(cr); p.bbarT[((size_t)g * 128 + 64 + pst) * 16 + h] = f2bf(ci); }
    }
    for (int i = gt; i < SSM_G * SSM_H * SSM_P; i += NGT) {
        const int gh = i >> 6, pst = i & 63;
        p.cmat[(size_t)gh * 128 + pst] = f2bf(p.c_re[i]); p.cmat[(size_t)gh * 128 + 64 + pst] = f2bf(-p.c_im[i]);
    }
}

__device__ __forceinline__ void kpe_phase(const Params& p, Frame& F) {
    const int lane = ((int)threadIdx.x & 63), r = lane & 31, hi = lane >> 5;
    for (int tile = F.wave * F.G + F.vcu; tile < SEQ / 32; tile += F.NGW) {
        const int t0 = tile * 32; f32x16 a0 = {}, a1 = {};
        const bf16_t* ap = p.hn + (size_t)(t0 + r) * DM + 8 * hi; const bf16_t* b0p = p.WkpeT + (size_t)r * DM + 8 * hi; const bf16_t* b1p = b0p + (size_t)32 * DM;
#pragma unroll 4
        for (int s = 0; s < DM / 16; ++s) { const bf16x8 a = *(const bf16x8*)(ap + 16 * s), b0 = *(const bf16x8*)(b0p + 16 * s), b1 = *(const bf16x8*)(b1p + 16 * s);
            a0 = __builtin_amdgcn_mfma_f32_32x32x16_bf16(a, b0, a0, 0, 0, 0); a1 = __builtin_amdgcn_mfma_f32_32x32x16_bf16(a, b1, a1, 0, 0, 0); }
#pragma unroll
        for (int i = 0; i < 16; ++i) { const int tok = t0 + (i & 3) + 8 * (i >> 2) + 4 * hi; const float c = p.cosT[(size_t)tok * 32 + r], s = p.sinT[(size_t)tok * 32 + r];
            p.kpe[(size_t)tok * DROPE + r] = f2bf(a0[i] * c - a1[i] * s); p.kpe[(size_t)tok * DROPE + 32 + r] = f2bf(a0[i] * s + a1[i] * c); }
    }
}

constexpr int S5_TC = 256, S5_NCH = SEQ / S5_TC;
struct S5Consts { float a1r[2], a1i[2], a2r[2], a2i[2], a3r[2], a3i[2], a4r[2], a4i[2], a8r[2], a8i[2], a32r[2], a32i[2], a256r[2], a256i[2]; };
__device__ __forceinline__ void s5_consts(const Params& p, int g, int r, S5Consts& c) {
#pragma unroll
    for (int s = 0; s < 2; ++s) { const f32x2 a = *(const f32x2*)(p.abar + 2 * (g * 64 + 32 * s + r)); c.a1r[s] = a[0]; c.a1i[s] = a[1];
        cmul(c.a1r[s], c.a1i[s], c.a1r[s], c.a1i[s], c.a2r[s], c.a2i[s]); cmul(c.a2r[s], c.a2i[s], c.a1r[s], c.a1i[s], c.a3r[s], c.a3i[s]); cmul(c.a2r[s], c.a2i[s], c.a2r[s], c.a2i[s], c.a4r[s], c.a4i[s]);
        cmul(c.a4r[s], c.a4i[s], c.a4r[s], c.a4i[s], c.a8r[s], c.a8i[s]); float tr, ti; cmul(c.a8r[s], c.a8i[s], c.a8r[s], c.a8i[s], tr, ti); cmul(tr, ti, tr, ti, c.a32r[s], c.a32i[s]);
        float ur, ui; cmul(c.a32r[s], c.a32i[s], c.a32r[s], c.a32i[s], tr, ti); cmul(tr, ti, tr, ti, ur, ui); cmul(ur, ui, ur, ui, c.a256r[s], c.a256i[s]); }
}
__device__ __forceinline__ void s5_bu(const Params& p, int g, int t0, int r, int hi, const bf16x8 (&bfr)[4], f32x16 (&acc)[4]) {
    const bf16x8 a = *(const bf16x8*)(p.ub + (size_t)(t0 + r) * SSM_W + g * 16 + 8 * hi);
#pragma unroll
    for (int ct = 0; ct < 4; ++ct) { acc[ct] = f32x16{}; acc[ct] = __builtin_amdgcn_mfma_f32_32x32x16_bf16(a, bfr[ct], acc[ct], 0, 0, 0); }
}
__device__ __forceinline__ void s5_pass_a(const Params& p, Frame& F) {
    const int lane = ((int)threadIdx.x & 63), r = lane & 31, hi = lane >> 5;
    for (int unit = F.gw; unit < S5_NCH * SSM_G; unit += F.NGW) {
        const int g = unit % SSM_G, ch = unit / SSM_G;
        S5Consts c; s5_consts(p, g, r, c);
        bf16x8 bfr[4];
#pragma unroll
        for (int ct = 0; ct < 4; ++ct) bfr[ct] = *(const bf16x8*)(p.bbarT + ((size_t)g * 128 + 32 * ct + r) * 16 + 8 * hi);
        float Sr[2] = {0.f, 0.f}, Si[2] = {0.f, 0.f};
        for (int tl = 0; tl < S5_TC / 32; ++tl) {
            f32x16 acc[4]; s5_bu(p, g, ch * S5_TC + tl * 32, r, hi, bfr, acc);
#pragma unroll
            for (int s = 0; s < 2; ++s) { float Pr = 0.f, Pi = 0.f;
#pragma unroll
                for (int q = 0; q < 4; ++q) { float er = acc[s][4 * q], ei = acc[2 + s][4 * q];
#pragma unroll
                    for (int j = 1; j < 4; ++j) { float tr, ti; cmul(er, ei, c.a1r[s], c.a1i[s], tr, ti); er = tr + acc[s][4 * q + j]; ei = ti + acc[2 + s][4 * q + j]; }
                    float tr, ti; cmul(Pr, Pi, c.a8r[s], c.a8i[s], tr, ti); Pr = tr + er; Pi = ti + ei; }
                if (hi == 0) { float tr, ti; cmul(Pr, Pi, c.a4r[s], c.a4i[s], tr, ti); Pr = tr; Pi = ti; }
                Pr += __shfl_xor(Pr, 32); Pi += __shfl_xor(Pi, 32);
                float tr, ti; cmul(Sr[s], Si[s], c.a32r[s], c.a32i[s], tr, ti); Sr[s] = tr + Pr; Si[s] = ti + Pi; }
        }
        if (hi == 0) {
#pragma unroll
            for (int s = 0; s < 2; ++s) *(f32x2*)(p.send + 2 * ((size_t)(ch * SSM_G + g) * 64 + 32 * s + r)) = (f32x2){Sr[s], Si[s]}; }
    }
}
constexpr int S5_XS = 272;
__device__ __forceinline__ void s5_pass_c(const Params& p, Frame& F) {
    const int lane = ((int)threadIdx.x & 63), r = lane & 31, hi = lane >> 5, l15 = lane & 15, l4 = lane >> 4;
    LAS unsigned char* xl = F.lds + F.wave * (32 * S5_XS);
    for (int unit = F.gw; unit < S5_NCH * SSM_G; unit += F.NGW) {
        const int g = unit % SSM_G, ch = unit / SSM_G;
        S5Consts c; s5_consts(p, g, r, c);
        bf16x8 bfr[4], cfr[4];
#pragma unroll
        for (int ct = 0; ct < 4; ++ct) bfr[ct] = *(const bf16x8*)(p.bbarT + ((size_t)g * 128 + 32 * ct + r) * 16 + 8 * hi);
#pragma unroll
        for (int ks = 0; ks < 4; ++ks) cfr[ks] = *(const bf16x8*)(p.cmat + ((size_t)g * 16 + l15) * 128 + 32 * ks + 8 * l4);
        const f32x4 dsk = *(const f32x4*)(p.ssm_d + g * 16 + 4 * l4);
        float Xr[2] = {0.f, 0.f}, Xi[2] = {0.f, 0.f};
        for (int cp = 0; cp < ch; ++cp) {
#pragma unroll
            for (int s = 0; s < 2; ++s) { const f32x2 e = *(const f32x2*)(p.send + 2 * ((size_t)(cp * SSM_G + g) * 64 + 32 * s + r)); float tr, ti; cmul(Xr[s], Xi[s], c.a256r[s], c.a256i[s], tr, ti); Xr[s] = tr + e[0]; Xi[s] = ti + e[1]; } }
        for (int tl = 0; tl < S5_TC / 32; ++tl) {
            const int t0 = ch * S5_TC + tl * 32;
            f32x16 acc[4]; s5_bu(p, g, t0, r, hi, bfr, acc);
#pragma unroll
            for (int s = 0; s < 2; ++s) {
                float er[4], ei[4];
#pragma unroll
                for (int q = 0; q < 4; ++q) {
#pragma unroll
                    for (int j = 1; j < 4; ++j) { float tr, ti; cmul(acc[s][4 * q + j - 1], acc[2 + s][4 * q + j - 1], c.a1r[s], c.a1i[s], tr, ti); acc[s][4 * q + j] += tr; acc[2 + s][4 * q + j] += ti; }
                    er[q] = acc[s][4 * q + 3]; ei[q] = acc[2 + s][4 * q + 3]; }
                float cr = Xr[s], ci = Xi[s], cinr[4], cini[4];
#pragma unroll
                for (int q = 0; q < 4; ++q) { const float pr = __shfl_xor(er[q], 32), pi = __shfl_xor(ei[q], 32);
                    const float e0r = hi ? pr : er[q], e0i = hi ? pi : ei[q], e1r = hi ? er[q] : pr, e1i = hi ? ei[q] : pi;
                    float tr, ti; const float c0r = cr, c0i = ci; cmul(cr, ci, c.a4r[s], c.a4i[s], tr, ti); cr = tr + e0r; ci = ti + e0i;
                    const float c1r = cr, c1i = ci; cmul(cr, ci, c.a4r[s], c.a4i[s], tr, ti); cr = tr + e1r; ci = ti + e1i;
                    cinr[q] = hi ? c1r : c0r; cini[q] = hi ? c1i : c0i; }
                Xr[s] = cr; Xi[s] = ci;
#pragma unroll
                for (int q = 0; q < 4; ++q) { float tr, ti;
                    cmul(cinr[q], cini[q], c.a1r[s], c.a1i[s], tr, ti); acc[s][4 * q + 0] += tr; acc[2 + s][4 * q + 0] += ti;
                    cmul(cinr[q], cini[q], c.a2r[s], c.a2i[s], tr, ti); acc[s][4 * q + 1] += tr; acc[2 + s][4 * q + 1] += ti;
                    cmul(cinr[q], cini[q], c.a3r[s], c.a3i[s], tr, ti); acc[s][4 * q + 2] += tr; acc[2 + s][4 * q + 2] += ti;
                    cmul(cinr[q], cini[q], c.a4r[s], c.a4i[s], tr, ti); acc[s][4 * q + 3] += tr; acc[2 + s][4 * q + 3] += ti; }
            }
#pragma unroll
            for (int ct = 0; ct < 4; ++ct)
#pragma unroll
                for (int i = 0; i < 16; ++i) *(LAS unsigned short*)(xl + ((i & 3) + 8 * (i >> 2) + 4 * hi) * S5_XS + (32 * ct + r) * 2) = f2bf(acc[ct][i]);
            LDS_WAIT(); asm volatile("" ::: "memory");
#pragma unroll
            for (int nt = 0; nt < 2; ++nt) { f32x4 y = {0.f, 0.f, 0.f, 0.f};
#pragma unroll
                for (int ks = 0; ks < 4; ++ks) { const bf16x8 b = *(const LAS bf16x8*)(xl + (16 * nt + l15) * S5_XS + (32 * ks + 8 * l4) * 2); y = __builtin_amdgcn_mfma_f32_16x16x32_bf16(cfr[ks], b, y, 0, 0, 0); }
                const size_t off = (size_t)(t0 + 16 * nt + l15) * SSM_W + g * 16 + 4 * l4; const u32x2 uw = *(const u32x2*)(p.ub + off);
                const float y0 = y[0] + dsk[0] * bflo(uw.x), y1 = y[1] + dsk[1] * bfhi(uw.x), y2 = y[2] + dsk[2] * bflo(uw.y), y3 = y[3] + dsk[3] * bfhi(uw.y);
                u32x2 o = {cvtpk(gelu_tanh(y0), gelu_tanh(y1)), cvtpk(gelu_tanh(y2), gelu_tanh(y3))}; *(u32x2*)(p.zb + off) = o; }
            LDS_WAIT(); asm volatile("" ::: "memory");
        }
    }
}

__device__ __forceinline__ void router_phase(const Params& p, Frame& F) {
    LAS float* red = (LAS float*)F.lds; LAS float* lg = red + 8 * 32 * 33; LAS int* asg = (LAS int*)(lg + 32 * 33); LAS int* cnt = asg + 256;
    const int lane = ((int)threadIdx.x & 63), i32 = lane & 31, kh = lane >> 5, w = F.wave, tid = (int)threadIdx.x;
    for (int vb = blockIdx.x; vb < SEQ / 64; vb += F.G) {
        if (tid < 32) cnt[tid] = 0;
        for (int tl = 0; tl < 2; ++tl) {
            const int t0 = vb * 64 + tl * 32;
            f32x16 acc = {};
            const float* ap = p.x2 + (size_t)(t0 + i32) * DM + 256 * w + 4 * kh; const float* bp = p.WrT + (size_t)(256 * w + 4 * kh) * NEXP + i32;
#pragma unroll 4
            for (int q = 0; q < 32; ++q) { const f32x4 a = *(const f32x4*)(ap + 8 * q);
#pragma unroll
                for (int e = 0; e < 4; ++e) acc = __builtin_amdgcn_mfma_f32_32x32x2f32(a[e], bp[(size_t)(8 * q + e) * NEXP], acc, 0, 0, 0); }
#pragma unroll
            for (int i = 0; i < 16; ++i) red[(w * 32 + (i & 3) + 8 * (i >> 2) + 4 * kh) * 33 + i32] = acc[i];
            __syncthreads();
            for (int o = tid; o < 1024; o += 512) { const int tok = o >> 5, e = o & 31; float s = 0.f;
#pragma unroll
                for (int ww = 0; ww < 8; ++ww) s += red[(ww * 32 + tok) * 33 + e];
                lg[tok * 33 + e] = s * row_rs32g(p.ss2, t0 + tok) + p.router_b[e]; }
            __syncthreads();
            if (tid < 32) { const int tok = tid; float v[4] = {-__builtin_inff(), -__builtin_inff(), -__builtin_inff(), -__builtin_inff()}; int id[4] = {0, 0, 0, 0};
                for (int e = 0; e < 32; ++e) { float x = lg[tok * 33 + e]; int xi = e;
#pragma unroll
                    for (int k = 0; k < 4; ++k) { const bool gt = x > v[k]; const float tv = gt ? v[k] : x; const int ti = gt ? id[k] : xi; v[k] = gt ? x : v[k]; id[k] = gt ? xi : id[k]; x = tv; xi = ti; } }
                const float e1 = __builtin_expf(v[1] - v[0]), e2 = __builtin_expf(v[2] - v[0]), e3 = __builtin_expf(v[3] - v[0]); const float inv = 1.0f / (1.0f + e1 + e2 + e3);
                const size_t o4 = (size_t)(t0 + tok) * 4;
                *(f32x4*)(p.topw + o4) = (f32x4){inv, e1 * inv, e2 * inv, e3 * inv};
                p.topi[o4] = id[0]; p.topi[o4 + 1] = id[1]; p.topi[o4 + 2] = id[2]; p.topi[o4 + 3] = id[3];
#pragma unroll
                for (int k = 0; k < 4; ++k) asg[(tl * 32 + tok) * 4 + k] = id[k]; }
            __syncthreads();
        }
        if (tid < 256) { const int e = asg[tid]; int rk = 0; for (int j = 0; j < tid; ++j) rk += (asg[j] == e) ? 1 : 0;
            p.rank[(size_t)vb * 256 + tid] = rk; atomicAdd((int*)&cnt[e], 1); }
        __syncthreads();
        if (tid < 32) p.wgcnt[vb * 32 + tid] = cnt[tid];
        __syncthreads();
    }
}
__device__ __forceinline__ void assign_phase(const Params& p, Frame& F) {
    LAS int* part = (LAS int*)F.lds; LAS int* pbef = part + 512; LAS int* base = pbef + 512; LAS int* pst = base + 32; LAS int* slots = pst + 33;
    const int tid = (int)threadIdx.x, lane = ((int)threadIdx.x & 63);
    for (int vb = blockIdx.x; vb < SEQ / 64; vb += F.G) {
        { const int e = tid & 31, pr = tid >> 5; int s = 0, sb = 0;
          for (int b = pr * 16; b < pr * 16 + 16; ++b) { const int c = p.wgcnt[b * 32 + e]; s += c; sb += (b < vb) ? c : 0; }
          part[pr * 32 + e] = s; pbef[pr * 32 + e] = sb; }
        __syncthreads();
        if (tid < 32) { int tot = 0, bef = 0; for (int pr = 0; pr < 16; ++pr) { tot += part[pr * 32 + tid]; bef += pbef[pr * 32 + tid]; } part[tid] = tot; pbef[tid] = bef; }
        __syncthreads();
        if (tid == 0) { int acc = 0; for (int e = 0; e < 32; ++e) { pst[e] = acc; const int nb = (part[e] + 255) >> 8;
                if (vb == 0) for (int b = 0; b < nb; ++b) p.blke[(acc >> 8) + b] = e;
                acc += nb << 8; }
            pst[32] = acc; if (vb == 0) p.blke[MAXBLK] = acc >> 8; }
        __syncthreads();
        if (tid < 32) base[tid] = pst[tid] + pbef[tid];
        __syncthreads();
        if (tid < 256) { const int tok = vb * 64 + (tid >> 2); const int e = p.topi[(size_t)tok * 4 + (tid & 3)]; const int sl = base[e] + p.rank[(size_t)vb * 256 + tid];
            p.slot[(size_t)tok * 4 + (tid & 3)] = sl; slots[tid] = sl; }
        __syncthreads();
        for (int tk = F.wave; tk < 64; tk += NWAVES) { const int tok = vb * 64 + tk; const float* xr = p.x2 + (size_t)tok * DM; const float rs = row_rs32g(p.ss2, tok);
#pragma unroll
            for (int j = 0; j < 4; ++j) { const int c = 512 * j + 8 * lane; const f32x4 g0 = *(const f32x4*)(p.norm_moe + c), g1 = *(const f32x4*)(p.norm_moe + c + 4);
                const u32x4 o = pack8f(*(const f32x4*)(xr + c) * rs * g0, *(const f32x4*)(xr + c + 4) * rs * g1);
#pragma unroll
                for (int k = 0; k < 4; ++k) *(u32x4*)(p.xg + (size_t)slots[tk * 4 + k] * DM + c) = o; } }
        __syncthreads();
    }
}
__device__ __forceinline__ void combine_phase(const Params& p, Frame& F) {
    const int lane = ((int)threadIdx.x & 63);
    for (int tok = F.gw; tok < SEQ; tok += F.NGW) {
        const f32x4 w = *(const f32x4*)(p.topw + (size_t)tok * 4); int sl[4];
#pragma unroll
        for (int k = 0; k < 4; ++k) sl[k] = p.slot[(size_t)tok * 4 + k];
        f32x4 v[4][2]; float s = 0.f;
#pragma unroll
        for (int j = 0; j < 4; ++j) { const int c = 512 * j + 8 * lane; v[j][0] = *(const f32x4*)(p.x2 + (size_t)tok * DM + c); v[j][1] = *(const f32x4*)(p.x2 + (size_t)tok * DM + c + 4);
#pragma unroll
            for (int k = 0; k < 4; ++k) { f32x4 a, b; unpack8(*(const u32x4*)(p.orow + (size_t)sl[k] * DM + c), a, b); v[j][0] += a * w[k]; v[j][1] += b * w[k]; }
            s += sq4v(v[j][0]) + sq4v(v[j][1]); }
        const float rs = __builtin_amdgcn_rsqf(wave_sum(s) * (1.0f / DM) + EPS);
#pragma unroll
        for (int j = 0; j < 4; ++j) { const int c = 512 * j + 8 * lane;
            *(f32x4*)(p.out + (size_t)tok * DM + c) = v[j][0] * rs * *(const f32x4*)(p.final_norm + c); *(f32x4*)(p.out + (size_t)tok * DM + c + 4) = v[j][1] * rs * *(const f32x4*)(p.final_norm + c + 4); }
    }
}
template <bool ROPE, bool CAUSAL, class Refs>
__device__ __forceinline__ void attn_stream(const Refs& R, const att::Strides& T, char* lds) {
    const int n = R.count(); if (n <= 0) return;
    att::Seam<ROPE> S; att::BlockRef cur = R.ref(0);
    att::attn_prime<ROPE, CAUSAL>(cur, T, lds, S);
    for (int i = 0; i < n; ++i) { const att::BlockRef nxt = (i + 1 < n) ? R.ref(i + 1) : cur; att::attn_block<ROPE, CAUSAL>(cur, nxt, T, lds, S); cur = nxt; }
}
struct MlaRefs {
    const Params* p; int b, G;
    __device__ __forceinline__ int count() const { return b < 512 ? 2 * ((512 - b + G - 1) / G) : 0; }
    __device__ __forceinline__ att::BlockRef ref(int i) const {
        const int L = b + (i >> 1) * G, xcd = L & 7, k = L >> 3, head = (k >> 5) * 8 + xcd, y = k & 31, qb = (i & 1) ? 63 - y : y;
        att::BlockRef r; const size_t row0 = (size_t)qb * 256;
        r.Q = p->qn + row0 * DM + head * DNOPE; r.QR = p->qr + row0 * (NHEAD * DROPE) + head * DROPE; r.K = p->kn + head * DNOPE; r.KR = p->kpe; r.V = p->vv + head * DV;
        r.O = p->ymla + row0 * DM + head * DV; r.P0 = qb * 256; return r; }
};
struct XaRefs {
    const Params* p; int b, G;
    __device__ __forceinline__ int count() const { return b < 256 ? (256 - b + G - 1) / G : 0; }
    __device__ __forceinline__ att::BlockRef ref(int i) const {
        const int L = b + i * G, head = L & 3, qb = L >> 2; att::BlockRef r; const size_t row0 = (size_t)qb * 256;
        r.Q = p->qx + row0 * XW + head * 128; r.QR = nullptr; r.K = p->memkv + head * 128; r.KR = nullptr; r.V = p->memkv + XW + head * 128; r.O = p->ox + row0 * XW + head * 128; r.P0 = 0; return r; }
};

constexpr int RING_BYTES = 131072, MISC_OFF = RING_BYTES + 320, LDS_BYTES = 147456;
constexpr int NPHASE = 16;
#ifndef MK_ONE_LAUNCH
#define MK_ONE_LAUNCH 0
#endif

__global__ void __launch_bounds__(NWAVES * 64, 2) hybrid_fwd(Params p) {
    extern __shared__ __attribute__((aligned(16))) unsigned char lds[];
    Frame F;
    F.lds = (LAS unsigned char*)lds; F.wave = __builtin_amdgcn_readfirstlane((int)threadIdx.x >> 6);
    F.G = gridDim.x; { const int bx = blockIdx.x; F.vcu = (F.G % 8 == 0) ? (bx % 8) * (F.G / 8) + bx / 8 : bx; }
    F.gw = F.vcu * NWAVES + F.wave; F.NGW = F.G * NWAVES;
    volatile LAS unsigned* MISC = (volatile LAS unsigned*)(F.lds + MISC_OFF);
    for (int u = threadIdx.x; u < (LDS_BYTES - RING_BYTES) / 4; u += NWAVES * 64) ((LAS unsigned*)(F.lds + RING_BYTES))[u] = 0u;
    __syncthreads();
    const int lo = p.ph_lo, hi = p.ph_hi;
    XcdBarrier bar; bar.bar = p.ctl + 4096; bar.x = 0; bar.st = nullptr;
    if (hi - lo > 1) bar = xcd_barrier_post(p.ctl + 4096, MISC + 8);
#ifndef PHMASK
#define PHMASK 0xFFFF
#endif
#define IN(k) ((((PHMASK) >> (k)) & 1) && lo <= (k) && (k) < hi)
#define SEAM(k) do { if (IN(k) && IN((k) + 1)) xcd_barrier(bar); } while (0)
    const int G = F.G, bx = blockIdx.x;
    LAS unsigned char* ring = F.lds;

    if (IN(0)) { p0_prologue(p, F); } SEAM(0);
    if (IN(1)) { kpe_phase(p, F);
        pg8::Gemm g{p.hn, p.WinT, DM, DM, DM, 0}; pg8::StaticOrder S; S.init(SEQ, 6144, G, bx);
        pg8::EpiProj E{p.ub, p.qa, p.kva, p.sgs, p.sgm, p.qss, p.kvss}; pg8::gemm_phase(ring, g, S, E); } SEAM(1);
    if (IN(2)) { s5_pass_a(p, F);
        { pg8::Gemm g{p.qa, p.WuqT, QL, QL, QL, 0}; pg8::StaticOrder S; S.init(SEQ, 3072, G, bx); pg8::EpiQup E{p.qn, p.qr, p.qss, p.cosT, p.sinT}; pg8::gemm_phase(ring, g, S, E); }
        { pg8::Gemm g{p.kva, p.WukvT, KVL, KVL, KVL, 0}; pg8::StaticOrder S; S.init(SEQ, 4096, G, bx); pg8::EpiKVup E{p.kn, p.vv, p.kvss}; pg8::gemm_phase(ring, g, S, E); }
        { pg8::Gemm g{p.memn, p.WxkvT, DM, DM, DM, 0}; pg8::StaticOrder S; S.init(MEML, 2 * XW, G, bx); pg8::EpiPlain E{p.memkv, 2 * XW}; pg8::gemm_phase(ring, g, S, E); } } SEAM(2);
    if (IN(3)) {
#ifndef NO_S5C
        s5_pass_c(p, F); __syncthreads();
#endif
#ifndef NO_MLA
        const att::Strides T{DM, NHEAD * DROPE, DM, DM, DM, SEQ}; const MlaRefs R{&p, bx, G}; for (int i = 0, n = R.count(); i < n; ++i) att::attn_block_simple<true, true>(R.ref(i), T, (char*)lds);
#endif
    } SEAM(3);
    if (IN(4)) { pg8::Gemm g{p.zb, p.WgluT, SSM_W, SSM_W, SSM_W, 0}; pg8::StaticOrder S; S.init(SEQ, SSM_W, G, bx); pg8::EpiGlu E{p.zb, p.b_glu, p.ys}; pg8::gemm_phase(ring, g, S, E); } SEAM(4);
    if (IN(5)) { pg8::Gemm g{p.ys, p.WupsT, SSM_W, SSM_W, SSM_W, 0}; pg8::StaticOrder S; S.init(SEQ, DM, G, bx); pg8::EpiGate E{p.sgs, nullptr, p.t1}; pg8::gemm_phase(ring, g, S, E); } SEAM(5);
    if (IN(6)) { pg8::Gemm g{p.ymla, p.WupmT, DM, DM, DM, 0}; pg8::StaticOrder S; S.init(SEQ, DM, G, bx); pg8::EpiGate E{p.sgm, p.t1, p.mg}; pg8::gemm_phase(ring, g, S, E); } SEAM(6);
    if (IN(7)) { pg8::Gemm g{p.mg, p.WoutT, DM, DM, DM, 0}; pg8::StaticOrder S; S.init(SEQ, DM, G, bx); pg8::EpiResid E{p.x, p.x1, p.x1b, p.ss1}; pg8::gemm_phase(ring, g, S, E); } SEAM(7);
    if (IN(8)) { pg8::Gemm g{p.x1b, p.WxqT, DM, DM, DM, 0}; pg8::StaticOrder S; S.init(SEQ, XW, G, bx); pg8::EpiXq E{p.qx, p.ss1}; pg8::gemm_phase(ring, g, S, E); } SEAM(8);
    if (IN(9)) { const att::Strides T{XW, 0, 2 * XW, 2 * XW, XW, MEML}; const XaRefs R{&p, bx, G}; attn_stream<false, false>(R, T, (char*)lds); } SEAM(9);
    if (IN(10)) { pg8::Gemm g{p.ox, p.WxoT, XW, XW, XW, 0}; pg8::StaticOrder S; S.init(SEQ, DM, G, bx); pg8::EpiResid E{p.x1, p.x2, nullptr, p.ss2}; pg8::gemm_phase(ring, g, S, E); } SEAM(10);
    if (IN(11)) { router_phase(p, F); } SEAM(11);
    if (IN(12)) { assign_phase(p, F); } SEAM(12);
    if (IN(13)) { const int nblk = __builtin_amdgcn_readfirstlane(p.blke[MAXBLK]);
        pg8::Gemm g{p.xg, p.WguT, DM, DM, DM, (size_t)2 * DFF * DM}; pg8::MoeOrder S; S.init(nblk, 2 * DFF, G, bx, p.blke); pg8::EpiMoeGU E{p.b_gu, p.act}; pg8::gemm_phase(ring, g, S, E); } SEAM(13);
    if (IN(14)) { const int nblk = __builtin_amdgcn_readfirstlane(p.blke[MAXBLK]);
        pg8::Gemm g{p.act, p.WdnT, DFF, DFF, DFF, (size_t)DM * DFF}; pg8::MoeOrder S; S.init(nblk, DM, G, bx, p.blke); pg8::EpiMoeDown E{p.b_dn, p.orow}; pg8::gemm_phase(ring, g, S, E); } SEAM(14);
    if (IN(15)) { combine_phase(p, F); }
#undef IN
#undef SEAM
}

extern "C" void kernel_launch(void* const* d_in, const int* in_sizes, int n_in, void* d_out, int out_size, void* d_ws, size_t ws_size, hipStream_t stream) {
    static int grid = 0;
    if (grid == 0) {
        if (n_in != 37 || in_sizes[0] != SEQ * DM || out_size != SEQ * DM) { fprintf(stderr, "kernel_launch: unexpected shapes (n_in %d)\n", n_in); grid = -1; return; }
        int dev = 0, cus = 0;
        if (hipGetDevice(&dev) != hipSuccess || hipDeviceGetAttribute(&cus, hipDeviceAttributeMultiprocessorCount, dev) != hipSuccess) { grid = -1; return; }
        if (hipFuncSetAttribute((const void*)hybrid_fwd, hipFuncAttributeMaxDynamicSharedMemorySize, LDS_BYTES) != hipSuccess) { fprintf(stderr, "kernel_launch: hipFuncSetAttribute failed\n"); grid = -1; return; }
        int per_cu = 0;
        if (hipOccupancyMaxActiveBlocksPerMultiprocessor(&per_cu, (const void*)hybrid_fwd, NWAVES * 64, LDS_BYTES) != hipSuccess || per_cu < 1) { fprintf(stderr, "kernel_launch: occupancy query says %d\n", per_cu); }
        (void)hipGetLastError();
        grid = cus > 0 ? cus : 256;
    }
    if (grid < 0) return;
    Params p; memset(&p, 0, sizeof(p));
    const float* const* in = (const float* const*)d_in;
    p.x = in[0]; p.mem = in[1]; p.pos = (const int*)d_in[2]; p.norm_mix = in[3]; p.w_in = in[4]; p.lam_re = in[5]; p.lam_im = in[6]; p.log_step = in[7]; p.b_re = in[8]; p.b_im = in[9];
    p.c_re = in[10]; p.c_im = in[11]; p.ssm_d = in[12]; p.w_glu = in[13]; p.b_glu = in[14]; p.q_norm = in[15]; p.w_uq = in[16]; p.kv_norm = in[17]; p.w_uk = in[18]; p.w_uv = in[19];
    p.w_up_ssm = in[20]; p.w_up_mla = in[21]; p.w_out = in[22]; p.norm_xattn = in[23]; p.norm_mem = in[24]; p.xa_wq = in[25]; p.xa_wk = in[26]; p.xa_wv = in[27]; p.xa_wo = in[28];
    p.norm_moe = in[29]; p.router_w = in[30]; p.router_b = in[31]; p.w_gu = in[32]; p.b_gu = in[33]; p.w_dn = in[34]; p.b_dn = in[35]; p.final_norm = in[36];
    p.out = (float*)d_out;
    size_t off = 0; unsigned char* ws = (unsigned char*)d_ws;
    auto take = [&](size_t bytes) { unsigned char* r = ws + off; off += (bytes + 4095) & ~(size_t)4095; return r; };
    p.ctl = (unsigned*)take(1 << 20);
    p.WinT = (bf16_t*)take((size_t)6144 * DM * 2); p.WkpeT = (bf16_t*)take((size_t)64 * DM * 2); p.WgluT = (bf16_t*)take((size_t)SSM_W * SSM_W * 2); p.WuqT = (bf16_t*)take((size_t)3072 * QL * 2);
    p.WukvT = (bf16_t*)take((size_t)4096 * KVL * 2); p.WupsT = (bf16_t*)take((size_t)DM * SSM_W * 2); p.WupmT = (bf16_t*)take((size_t)DM * DM * 2); p.WoutT = (bf16_t*)take((size_t)DM * DM * 2);
    p.WxqT = (bf16_t*)take((size_t)XW * DM * 2); p.WxkvT = (bf16_t*)take((size_t)2 * XW * DM * 2); p.WxoT = (bf16_t*)take((size_t)DM * XW * 2);
    p.WguT = (bf16_t*)take((size_t)NEXP * 2 * DFF * DM * 2); p.WdnT = (bf16_t*)take((size_t)NEXP * DM * DFF * 2); p.WrT = (float*)take((size_t)DM * NEXP * 4);
    p.hn = (bf16_t*)take((size_t)SEQ * DM * 2); p.memn = (bf16_t*)take((size_t)MEML * DM * 2); p.cosT = (float*)take((size_t)SEQ * 32 * 4); p.sinT = (float*)take((size_t)SEQ * 32 * 4);
    p.abar = (float*)take((size_t)SSM_G * SSM_P * 8); p.bbarT = (bf16_t*)take((size_t)SSM_G * 128 * 16 * 2); p.cmat = (bf16_t*)take((size_t)SSM_G * 16 * 128 * 2);
    p.ub = (bf16_t*)take((size_t)SEQ * SSM_W * 2); p.qa = (bf16_t*)take((size_t)SEQ * QL * 2); p.kva = (bf16_t*)take((size_t)SEQ * KVL * 2); p.qss = (float*)take((size_t)SEQ * 8 * 4); p.kvss = (float*)take((size_t)SEQ * 8 * 4);
    p.sgs = (bf16_t*)take((size_t)SEQ * DM * 2); p.sgm = (bf16_t*)take((size_t)SEQ * DM * 2); p.kpe = (bf16_t*)take((size_t)SEQ * DROPE * 2);
    p.qn = (bf16_t*)take((size_t)SEQ * DM * 2); p.qr = (bf16_t*)take((size_t)SEQ * NHEAD * DROPE * 2); p.kn = (bf16_t*)take((size_t)SEQ * DM * 2); p.vv = (bf16_t*)take((size_t)SEQ * DM * 2); p.ymla = (bf16_t*)take((size_t)SEQ * DM * 2);
    p.send = (float*)take((size_t)S5_NCH * SSM_G * 64 * 8); p.zb = (bf16_t*)take((size_t)SEQ * SSM_W * 2); p.ys = (bf16_t*)take((size_t)SEQ * SSM_W * 2); p.t1 = (bf16_t*)take((size_t)SEQ * DM * 2); p.mg = (bf16_t*)take((size_t)SEQ * DM * 2);
    p.x1 = (float*)take((size_t)SEQ * DM * 4); p.x1b = (bf16_t*)take((size_t)SEQ * DM * 2); p.ss1 = (float*)take((size_t)SEQ * 32 * 4);
    p.memkv = (bf16_t*)take((size_t)MEML * 2 * XW * 2); p.qx = (bf16_t*)take((size_t)SEQ * XW * 2); p.ox = (bf16_t*)take((size_t)SEQ * XW * 2);
    p.x2 = (float*)take((size_t)SEQ * DM * 4); p.ss2 = (float*)take((size_t)SEQ * 32 * 4);
    p.topi = (int*)take((size_t)SEQ * 4 * 4); p.topw = (float*)take((size_t)SEQ * 4 * 4); p.rank = (int*)take((size_t)SEQ * 4 * 4); p.slot = (int*)take((size_t)SEQ * 4 * 4); p.wgcnt = (int*)take((size_t)256 * 32 * 4); p.blke = (int*)take((size_t)(MAXBLK + 8) * 4);
    p.xg = (bf16_t*)take((size_t)NSLOT * DM * 2); p.act = (bf16_t*)take((size_t)NSLOT * DFF * 2); p.orow = (bf16_t*)take((size_t)NSLOT * DM * 2);
    if (off > ws_size) { fprintf(stderr, "kernel_launch: workspace too small: need %zu have %zu\n", off, ws_size); return; }
    (void)hipMemsetAsync(p.ctl, 0, 1 << 20, stream);
#if MK_ONE_LAUNCH
    p.ph_lo = 0; p.ph_hi = NPHASE;
    hipLaunchKernelGGL(hybrid_fwd, dim3(grid), dim3(NWAVES * 64), LDS_BYTES, stream, p);
#else
    for (int k = 0; k < NPHASE; ++k) { p.ph_lo = k; p.ph_hi = k + 1; hipLaunchKernelGGL(hybrid_fwd, dim3(grid), dim3(NWAVES * 64), LDS_BYTES, stream, p); }
#endif
}
```

```cpp
#include <hip/hip_runtime.h>
#include <cstdio>
#include <cstdint>
#include <cstring>

#define LAS __attribute__((address_space(3)))
#define GAS __attribute__((address_space(1)))
typedef unsigned short bf16_t;
typedef short bf16x8 __attribute__((ext_vector_type(8)));
typedef short s16x4 __attribute__((ext_vector_type(4)));
typedef float f32x4 __attribute__((ext_vector_type(4)));
typedef float f32x2 __attribute__((ext_vector_type(2)));
typedef float f32x16 __attribute__((ext_vector_type(16)));
typedef unsigned u32x4 __attribute__((ext_vector_type(4)));
typedef unsigned u32x2 __attribute__((ext_vector_type(2)));
typedef GAS unsigned gu32;

constexpr int SEQ = 16384, DM = 2048;
constexpr int SSM_W = 1024, SSM_G = 64, SSM_P = 64, SSM_H = 16;
constexpr int QL = 512, KVL = 512, NHEAD = 16, DNOPE = 128, DROPE = 64, DV = 128;
constexpr int IN_COLS = 6208;
constexpr int MEML = 256, XH = 4, XW = 512;
constexpr int NEXP = 32, TOPK = 4, DFF = 2048;
constexpr int NSLOT = SEQ * TOPK + NEXP * 256;
constexpr int MAXBLK = NSLOT / 256;
constexpr float EPS = 1e-6f;
constexpr int NWAVES = 8;

#define LDS_WAIT() asm volatile("s_waitcnt lgkmcnt(0)" ::: "memory")
#define VM_WAIT() asm volatile("s_waitcnt vmcnt(0)" ::: "memory")
#define SBAR() __builtin_amdgcn_sched_barrier(0)
__device__ __forceinline__ unsigned cvtpk(float lo, float hi) { unsigned r; asm volatile("v_cvt_pk_bf16_f32 %0, %1, %2" : "=v"(r) : "v"(lo), "v"(hi)); return r; }
__device__ __forceinline__ float bf2f(unsigned short b) { return __uint_as_float(((unsigned)b) << 16); }
__device__ __forceinline__ float bflo(unsigned w) { return __uint_as_float(w << 16); }
__device__ __forceinline__ float bfhi(unsigned w) { return __uint_as_float(w & 0xffff0000u); }
__device__ __forceinline__ unsigned short f2bf(float f) { return (unsigned short)(cvtpk(f, f) & 0xffffu); }
__device__ __forceinline__ u32x4 pack8f(f32x4 a, f32x4 b) { u32x4 w = {cvtpk(a[0], a[1]), cvtpk(a[2], a[3]), cvtpk(b[0], b[1]), cvtpk(b[2], b[3])}; return w; }
__device__ __forceinline__ void unpack8(u32x4 w, f32x4& a, f32x4& b) { a = (f32x4){bflo(w.x), bfhi(w.x), bflo(w.y), bfhi(w.y)}; b = (f32x4){bflo(w.z), bfhi(w.z), bflo(w.w), bfhi(w.w)}; }
__device__ __forceinline__ float fsigmoid(float x) { return __builtin_amdgcn_rcpf(1.0f + __builtin_amdgcn_exp2f(-1.4426950408889634f * x)); }
__device__ __forceinline__ float gelu_tanh(float x) {
    const float u = 0.7978845608028654f * (x + 0.044715f * x * x * x);
    return x * fsigmoid(2.0f * u);
}
__device__ __forceinline__ float wave_sum(float v) {
#pragma unroll
    for (int o = 1; o < 64; o <<= 1) v += __shfl_xor(v, o);
    return v;
}

#define XB_TMO      128
#define XB_XCNT(j)  (256  + 64 * (j))
#define XB_XSUB(j)  (1280 + 64 * (j))
#define XB_XGEN(j)  (2304 + 64 * (j))
#define XB_TOP      3328
#define XB_TOPGEN   3392
#define XCD_BAR_WORDS 3456
#define XB_SPIN_CAP (1u << 18)
__device__ __forceinline__ unsigned xb_ld(unsigned* p)              { return __hip_atomic_load(p, __ATOMIC_RELAXED, __HIP_MEMORY_SCOPE_AGENT); }
__device__ __forceinline__ unsigned xb_add(unsigned* p, unsigned v) { return __hip_atomic_fetch_add(p, v, __ATOMIC_RELAXED, __HIP_MEMORY_SCOPE_AGENT); }
__device__ __forceinline__ unsigned xb_xcc_id() { return (unsigned)__builtin_amdgcn_s_getreg((3 << 11) | 20) & 0xFu; }
#define XB_SPIN(cond, bar) do { unsigned _sp = 0; while (cond) { __builtin_amdgcn_s_sleep(1); \
    if ((++_sp & 255u) == 0u) { if (xb_ld(&(bar)[XB_TMO])) break; if (_sp > XB_SPIN_CAP) { atomicAdd(&(bar)[XB_TMO], 1u); break; } } } } while (0)
struct XcdBarrier { unsigned* bar; unsigned x; volatile LAS unsigned* st; };
__device__ __forceinline__ XcdBarrier xcd_barrier_post(unsigned* bar, volatile LAS unsigned* st) {
    XcdBarrier b; b.bar = bar; b.x = xb_xcc_id(); b.st = st;
    if (threadIdx.x == 0) (void)xb_add(&bar[XB_XCNT(b.x)], 1u);
    return b;
}
__device__ __forceinline__ void xcd_barrier_complete(unsigned* bar, unsigned x, unsigned& nloc, unsigned& nx) {
    const unsigned G = gridDim.x * gridDim.y * gridDim.z;
    unsigned sum, cnt, mine, sp = 0u;
    for (;;) {
        sum = 0u; cnt = 0u; mine = 0u;
#pragma unroll
        for (unsigned j = 0; j < 16; ++j) { const unsigned c = xb_ld(&bar[XB_XCNT(j)]); sum += c; cnt += (c > 0u) ? 1u : 0u; mine = (j == x) ? c : mine; }
        if (sum == G) break;
        __builtin_amdgcn_s_sleep(1);
        if ((++sp & 255u) == 0u) { if (xb_ld(&bar[XB_TMO])) break; if (sp > XB_SPIN_CAP) { atomicAdd(&bar[XB_TMO], 1u); break; } }
    }
    nloc = mine > 0u ? mine : 1u; nx = cnt > 0u ? cnt : 1u;
}
__device__ __forceinline__ void xcd_barrier(const XcdBarrier& b) {
    asm volatile("s_waitcnt vmcnt(0)" ::: "memory");
    __syncthreads();
    if (threadIdx.x == 0) {
        unsigned* bar = b.bar;
        __builtin_amdgcn_s_waitcnt(0);
        unsigned nloc = b.st[0], nx = b.st[1];
        if (nloc == 0u) { xcd_barrier_complete(bar, b.x, nloc, nx); b.st[0] = nloc; b.st[1] = nx; }
        const unsigned old = xb_add(&bar[XB_XSUB(b.x)], 1u);
        const unsigned gen = old / nloc;
        if (old + 1u == (gen + 1u) * nloc) {
            __builtin_amdgcn_fence(__ATOMIC_RELEASE, "agent");
            asm volatile("s_waitcnt vmcnt(0)" ::: "memory");
            const unsigned og = xb_add(&bar[XB_TOP], 1u);
            const unsigned tg = og / nx;
            if (og + 1u == (tg + 1u) * nx) xb_add(&bar[XB_TOPGEN], 1u);
            else XB_SPIN(xb_ld(&bar[XB_TOPGEN]) == tg, bar);
            __builtin_amdgcn_fence(__ATOMIC_ACQUIRE, "agent");
            xb_add(&bar[XB_XGEN(b.x)], 1u);
            asm volatile("s_waitcnt vmcnt(0)" ::: "memory");
        } else {
            XB_SPIN(xb_ld(&bar[XB_XGEN(b.x)]) == gen, bar);
            __builtin_amdgcn_fence(__ATOMIC_ACQUIRE, "agent");
            asm volatile("s_waitcnt vmcnt(0)" ::: "memory");
        }
    }
    __syncthreads();
}
namespace pg8 {
constexpr int BM = 256, BK = 64, HALF = 128, HTB = HALF * BK * 2, NXCD = 8, WGM = 8;
__host__ __device__ __forceinline__ int lds_byte(int r, int c) { const int st = (r >> 4) * 2 + (c >> 5), rr = r & 15, cc = c & 31, ob = rr * 64 + cc * 2; return st * 1024 + (ob ^ (((ob >> 9) & 1) << 5)); }
__host__ __device__ __forceinline__ void stage_rc(int b, int& R, int& C) { const int st = b / 1024, sb = b % 1024, swz = sb ^ (((sb >> 9) & 1) << 5); R = (st >> 1) * 16 + swz / 64; C = (st & 1) * 32 + (swz % 64) / 2; }
__host__ __device__ __forceinline__ int perm32(int rho) { const int n = rho >> 4, i = rho & 15; return 8 * (i >> 2) + 4 * n + (i & 3); }

struct Unit { int pm, pn, e; };
struct Gemm { const bf16_t* A; const bf16_t* Bt; int lda, ldb, K; size_t bstride; };

struct StaticOrder {
    int nM, nN, nwg, G, c;
    __device__ void init(int M, int N, int G_, int c_) { nM = M / BM; nN = N / BM; nwg = nM * nN; G = G_; c = c_; }
    __device__ bool next(int i, Unit& u) const {
        const long L = (long)i * G + c; if (L >= nwg) return false;
        int wgid = (int)L; { const int q = nwg / NXCD, r = nwg % NXCD, xcd = wgid % NXCD, off = wgid / NXCD; wgid = (xcd < r ? xcd * (q + 1) : r * (q + 1) + (xcd - r) * q) + off; }
        const int nig = WGM * nN, gid = wgid / nig, fm = gid * WGM, gsz = (nM - fm) < WGM ? (nM - fm) : WGM;
        u.pm = fm + ((wgid % nig) % gsz); u.pn = (wgid % nig) / gsz; u.e = 0; return true;
    }
};
struct MoeOrder {
    StaticOrder so; const int* blk_e;
    __device__ void init(int nblk, int N, int G_, int c_, const int* be) { so.nM = nblk; so.nN = N / BM; so.nwg = so.nM * so.nN; so.G = G_; so.c = c_; blk_e = be; }
    __device__ bool next(int i, Unit& u) const { if (!so.next(i, u)) return false; u.e = __builtin_amdgcn_readfirstlane(blk_e[u.pm]); return true; }
};

template <class Epi, class Sched>
__device__ __forceinline__ void gemm_phase(LAS unsigned char* lds, const Gemm g, const Sched& S, const Epi& E) {
    constexpr bool ALIGN_EPI = true;
    const int tid = threadIdx.x, wid = __builtin_amdgcn_readfirstlane(tid >> 6), lane = tid & 63, wr = wid >> 2, wc = wid & 3, fr = lane & 15, fq = lane >> 4;
    const int K = g.K, nt = K / BK;
    unsigned voffA[2], voffB[2];
#pragma unroll
    for (int i = 0; i < 2; ++i) { int R, C; stage_rc(tid * 16 + i * 8192, R, C); const int Rb = Epi::PERM ? ((R & ~31) + perm32(R & 31)) : R;
        voffA[i] = (unsigned)(R * g.lda + C) * 2u; voffB[i] = (unsigned)(Rb * g.ldb + C) * 2u; }
    const size_t kstep = (size_t)(BK * 2);
    const size_t hstepA = (size_t)HALF * g.lda * 2, hstepB = (size_t)HALF * g.ldb * 2;
    const unsigned ldsw = (unsigned)wid * 1024u;
    const int aoff = lds_byte(wr * 64 + fr, fq * 8), boff = lds_byte(wc * 32 + fr, fq * 8);
#define PG8_SA(b, h) (((b) * 2 + (h)) * HTB)
#define PG8_SB(b, h) ((4 + (b) * 2 + (h)) * HTB)
#define PG8_STAGE(bufoff, gbase, voff) do { _Pragma("unroll") for (int _i = 0; _i < 2; ++_i) \
        __builtin_amdgcn_global_load_lds((const unsigned*)((const char*)(gbase) + (voff)[_i]), (LAS unsigned*)(lds + (bufoff) + ldsw + _i * 8192), 16, 0, 0); } while (0)
#define PG8_LDA(dst, b, h) do { _Pragma("unroll") for (int m = 0; m < 4; ++m) _Pragma("unroll") for (int k = 0; k < 2; ++k) dst[m][k] = *(const LAS bf16x8*)(lds + PG8_SA(b, h) + aoff + m * 2048 + k * 1024); } while (0)
#define PG8_LDB(dst, b, h) do { _Pragma("unroll") for (int n = 0; n < 2; ++n) _Pragma("unroll") for (int k = 0; k < 2; ++k) dst[n][k] = *(const LAS bf16x8*)(lds + PG8_SB(b, h) + boff + n * 2048 + k * 1024); } while (0)
#define PG8_MMA(ai, bj, At, Bt) do { __builtin_amdgcn_s_setprio(1); _Pragma("unroll") for (int m = 0; m < 4; ++m) _Pragma("unroll") for (int n = 0; n < 2; ++n) _Pragma("unroll") for (int k = 0; k < 2; ++k) \
        acc[ai][bj][m][n] = __builtin_amdgcn_mfma_f32_16x16x32_bf16(Bt[n][k], At[m][k], acc[ai][bj][m][n], 0, 0, 0); __builtin_amdgcn_s_setprio(0); } while (0)
#define PG8_WAIT_V(n) asm volatile("s_waitcnt vmcnt(" #n ")" ::: "memory")
#define PG8_WAIT_L(n) asm volatile("s_waitcnt lgkmcnt(" #n ")" ::: "memory")
#define PG8_BAR __builtin_amdgcn_s_barrier()
#define PG8_SCHED __builtin_amdgcn_sched_barrier(0)
#define PG8_ABASE(u) ((const char*)g.A + (size_t)(u).pm * BM * g.lda * 2)
#define PG8_BBASE(u) ((const char*)g.Bt + ((size_t)(u).e * g.bstride + (size_t)(u).pn * BM * g.ldb) * 2)
    Unit cur, nxt; int ui = 0;
    if (!S.next(0, cur)) return;
    f32x4 acc[2][2][4][2];
#pragma unroll
    for (int a = 0; a < 2; ++a)
#pragma unroll
        for (int b = 0; b < 2; ++b)
#pragma unroll
            for (int m = 0; m < 4; ++m)
#pragma unroll
                for (int n = 0; n < 2; ++n) acc[a][b][m][n] = (f32x4){0.f, 0.f, 0.f, 0.f};
    bf16x8 At[4][2], B0[2][2], B1[2][2];
    const char* cA = PG8_ABASE(cur); const char* cB = PG8_BBASE(cur);
    PG8_STAGE(PG8_SB(0, 0), cB, voffB); PG8_STAGE(PG8_SB(0, 1), cB + hstepB, voffB); PG8_STAGE(PG8_SA(0, 0), cA, voffA); PG8_STAGE(PG8_SA(0, 1), cA + hstepA, voffA);
    if (wr == 1) PG8_BAR;
    PG8_WAIT_V(2); PG8_BAR;
    PG8_STAGE(PG8_SB(1, 0), cB + kstep, voffB); PG8_STAGE(PG8_SA(1, 0), cA + kstep, voffA); PG8_STAGE(PG8_SB(1, 1), cB + hstepB + kstep, voffB);
    PG8_WAIT_V(6); PG8_BAR;
    for (;;) {
        const bool has_next = S.next(ui + 1, nxt);
        const char* nA = has_next ? PG8_ABASE(nxt) : cA; const char* nB = has_next ? PG8_BBASE(nxt) : cB;
        for (int t = 0; t < nt; t += 2) {
            const bool last = (t == nt - 2);
            const char* a1 = cA + (size_t)(t + 1) * kstep;
            const char* a2 = last ? nA : cA + (size_t)(t + 2) * kstep; const char* b2 = last ? nB : cB + (size_t)(t + 2) * kstep;
            const char* a3 = a2 + kstep; const char* b3 = b2 + kstep;
            PG8_LDB(B0, 0, 0); PG8_LDB(B1, 0, 1); PG8_SCHED; PG8_LDA(At, 0, 0); PG8_STAGE(PG8_SA(1, 1), a1 + hstepA, voffA);
            PG8_WAIT_V(8); PG8_WAIT_L(0); PG8_BAR; PG8_MMA(0, 0, At, B0); PG8_MMA(0, 1, At, B1); PG8_BAR; PG8_SCHED;
            PG8_LDA(At, 0, 1); PG8_STAGE(PG8_SB(0, 0), b2, voffB); PG8_STAGE(PG8_SB(0, 1), b2 + hstepB, voffB); PG8_STAGE(PG8_SA(0, 0), a2, voffA);
            PG8_WAIT_V(8); PG8_WAIT_L(0); PG8_BAR; PG8_MMA(1, 0, At, B0); PG8_MMA(1, 1, At, B1); PG8_BAR; PG8_SCHED;
            PG8_LDB(B0, 1, 0); PG8_LDB(B1, 1, 1); PG8_SCHED; PG8_LDA(At, 1, 0); PG8_STAGE(PG8_SA(0, 1), a2 + hstepA, voffA);
            PG8_WAIT_V(8); PG8_WAIT_L(0); PG8_BAR; PG8_MMA(0, 0, At, B0); PG8_MMA(0, 1, At, B1); PG8_BAR; PG8_SCHED;
            PG8_LDA(At, 1, 1); PG8_STAGE(PG8_SB(1, 0), b3, voffB); PG8_STAGE(PG8_SB(1, 1), b3 + hstepB, voffB); PG8_STAGE(PG8_SA(1, 0), a3, voffA);
            PG8_WAIT_V(8); PG8_WAIT_L(0); PG8_BAR; PG8_MMA(1, 0, At, B0); PG8_MMA(1, 1, At, B1); PG8_BAR; PG8_SCHED;
        }
        if constexpr (ALIGN_EPI) { if (wr == 0) PG8_BAR; }
        E(acc, cur, wr, wc, fr, fq);
        if (!has_next) break;
#pragma unroll
        for (int a = 0; a < 2; ++a)
#pragma unroll
            for (int b = 0; b < 2; ++b)
#pragma unroll
                for (int m = 0; m < 4; ++m)
#pragma unroll
                    for (int n = 0; n < 2; ++n) acc[a][b][m][n] = (f32x4){0.f, 0.f, 0.f, 0.f};
        cur = nxt; cA = nA; cB = nB; ++ui;
        if constexpr (ALIGN_EPI) { if (wr == 1) PG8_BAR; }
    }
    PG8_WAIT_V(0);
    if constexpr (!ALIGN_EPI) { if (wr == 0) PG8_BAR; }
    PG8_BAR;
#undef PG8_SA
#undef PG8_SB
#undef PG8_STAGE
#undef PG8_LDA
#undef PG8_LDB
#undef PG8_MMA
#undef PG8_WAIT_V
#undef PG8_WAIT_L
#undef PG8_BAR
#undef PG8_SCHED
#undef PG8_ABASE
#undef PG8_BBASE
}

#define EPI_ROW(u, ai, m) ((u).pm * BM + (ai) * HALF + wr * 64 + (m) * 16 + fr)
#define EPI_CB(bj) ((bj) * HALF + wc * 32 + 8 * fq)
typedef f32x4 AccT[2][2][4][2];

__device__ __forceinline__ f32x4 sig4(f32x4 v) { return (f32x4){fsigmoid(v[0]), fsigmoid(v[1]), fsigmoid(v[2]), fsigmoid(v[3])}; }
__device__ __forceinline__ float sq4(f32x4 v) { return (v[0] * v[0] + v[1] * v[1]) + (v[2] * v[2] + v[3] * v[3]); }

struct EpiProj {
    static constexpr bool PERM = true;
    bf16_t *ub, *qa, *kva, *sgs, *sgm; float *qss, *kvss;
    __device__ __forceinline__ void operator()(const AccT& acc, const Unit& u, int wr, int wc, int fr, int fq) const {
        const int pn = u.pn; bf16_t* dst; int ld, c0; float* ss = nullptr; int ssl = 0; bool sg = false;
        if (pn < 4) { dst = ub; ld = SSM_W; c0 = pn * BM; }
        else if (pn < 6) { dst = qa; ld = QL; c0 = (pn - 4) * BM; ss = qss; ssl = (pn - 4) * 4 + wc; }
        else if (pn < 8) { dst = kva; ld = KVL; c0 = (pn - 6) * BM; ss = kvss; ssl = (pn - 6) * 4 + wc; }
        else if (pn < 16) { dst = sgs; ld = DM; c0 = (pn - 8) * BM; sg = true; }
        else { dst = sgm; ld = DM; c0 = (pn - 16) * BM; sg = true; }
#pragma unroll
        for (int ai = 0; ai < 2; ++ai)
#pragma unroll
            for (int m = 0; m < 4; ++m) { const int row = EPI_ROW(u, ai, m); float s = 0.f;
#pragma unroll
                for (int bj = 0; bj < 2; ++bj) { f32x4 v0 = acc[ai][bj][m][0], v1 = acc[ai][bj][m][1];
                    if (sg) { v0 = sig4(v0); v1 = sig4(v1); }
                    s += sq4(v0) + sq4(v1);
                    *(u32x4*)(dst + (size_t)row * ld + c0 + EPI_CB(bj)) = pack8f(v0, v1); }
                if (ss) { s += __shfl_xor(s, 16); s += __shfl_xor(s, 32); if (fq == 0) ss[(size_t)row * 8 + ssl] = s; } }
    }
};
__device__ __forceinline__ float row_rs8(const float* ss, int row, float invn) { const f32x4 a = *(const f32x4*)(ss + (size_t)row * 8), b = *(const f32x4*)(ss + (size_t)row * 8 + 4);
    return __builtin_amdgcn_rsqf(((a[0] + a[1]) + (a[2] + a[3]) + (b[0] + b[1]) + (b[2] + b[3])) * invn + EPS); }
__device__ __forceinline__ float row_rs32(const float* ss, int row, float invn) { float s = 0.f;
#pragma unroll
    for (int i = 0; i < 8; ++i) { const f32x4 a = *(const f32x4*)(ss + (size_t)row * 32 + 4 * i); s += (a[0] + a[1]) + (a[2] + a[3]); }
    return __builtin_amdgcn_rsqf(s * invn + EPS); }

struct EpiQup {
    static constexpr bool PERM = true;
    bf16_t *qn, *qr; const float *ss, *cosT, *sinT;
    __device__ __forceinline__ void operator()(const AccT& acc, const Unit& u, int wr, int wc, int fr, int fq) const {
        const int pn = u.pn;
#pragma unroll
        for (int ai = 0; ai < 2; ++ai)
#pragma unroll
            for (int m = 0; m < 4; ++m) { const int row = EPI_ROW(u, ai, m); const float rs = row_rs8(ss, row, 1.0f / QL);
                if (pn < 8) {
#pragma unroll
                    for (int bj = 0; bj < 2; ++bj) *(u32x4*)(qn + (size_t)row * DM + pn * BM + EPI_CB(bj)) = pack8f(acc[ai][bj][m][0] * rs, acc[ai][bj][m][1] * rs);
                } else {
                    const int head = 4 * (pn - 8) + wc;
                    const f32x4 c0 = *(const f32x4*)(cosT + (size_t)row * 32 + 8 * fq), c1 = *(const f32x4*)(cosT + (size_t)row * 32 + 8 * fq + 4);
                    const f32x4 s0 = *(const f32x4*)(sinT + (size_t)row * 32 + 8 * fq), s1 = *(const f32x4*)(sinT + (size_t)row * 32 + 8 * fq + 4);
                    const f32x4 a0 = acc[ai][0][m][0] * rs, a1 = acc[ai][0][m][1] * rs, b0 = acc[ai][1][m][0] * rs, b1 = acc[ai][1][m][1] * rs;
                    *(u32x4*)(qr + (size_t)row * (NHEAD * DROPE) + head * DROPE + 8 * fq) = pack8f(a0 * c0 - b0 * s0, a1 * c1 - b1 * s1);
                    *(u32x4*)(qr + (size_t)row * (NHEAD * DROPE) + head * DROPE + 32 + 8 * fq) = pack8f(a0 * s0 + b0 * c0, a1 * s1 + b1 * c1);
                } }
    }
};
struct EpiKVup {
    static constexpr bool PERM = true;
    bf16_t *kn, *vv; const float* ss;
    __device__ __forceinline__ void operator()(const AccT& acc, const Unit& u, int wr, int wc, int fr, int fq) const {
        bf16_t* dst = u.pn < 8 ? kn : vv; const int c0 = (u.pn & 7) * BM;
#pragma unroll
        for (int ai = 0; ai < 2; ++ai)
#pragma unroll
            for (int m = 0; m < 4; ++m) { const int row = EPI_ROW(u, ai, m); const float rs = row_rs8(ss, row, 1.0f / KVL);
#pragma unroll
                for (int bj = 0; bj < 2; ++bj) *(u32x4*)(dst + (size_t)row * DM + c0 + EPI_CB(bj)) = pack8f(acc[ai][bj][m][0] * rs, acc[ai][bj][m][1] * rs); }
    }
};
struct EpiPlain {
    static constexpr bool PERM = true;
    bf16_t* O; int ld;
    __device__ __forceinline__ void operator()(const AccT& acc, const Unit& u, int wr, int wc, int fr, int fq) const {
#pragma unroll
        for (int ai = 0; ai < 2; ++ai)
#pragma unroll
            for (int m = 0; m < 4; ++m) { const int row = EPI_ROW(u, ai, m);
#pragma unroll
                for (int bj = 0; bj < 2; ++bj) *(u32x4*)(O + (size_t)row * ld + u.pn * BM + EPI_CB(bj)) = pack8f(acc[ai][bj][m][0], acc[ai][bj][m][1]); }
    }
};
struct EpiGlu {
    static constexpr bool PERM = true;
    const bf16_t* z; const float* bias; bf16_t* ys;
    __device__ __forceinline__ void operator()(const AccT& acc, const Unit& u, int wr, int wc, int fr, int fq) const {
#pragma unroll
        for (int bj = 0; bj < 2; ++bj) { const int col = u.pn * BM + EPI_CB(bj); const f32x4 b0 = *(const f32x4*)(bias + col), b1 = *(const f32x4*)(bias + col + 4);
#pragma unroll
            for (int ai = 0; ai < 2; ++ai)
#pragma unroll
                for (int m = 0; m < 4; ++m) { const size_t off = (size_t)EPI_ROW(u, ai, m) * SSM_W + col; f32x4 z0, z1; unpack8(*(const u32x4*)(z + off), z0, z1);
                    *(u32x4*)(ys + off) = pack8f(z0 * sig4(acc[ai][bj][m][0] + b0), z1 * sig4(acc[ai][bj][m][1] + b1)); } }
    }
};
struct EpiGate {
    static constexpr bool PERM = true;
    const bf16_t* gate; const bf16_t* addend; bf16_t* O;
    __device__ __forceinline__ void operator()(const AccT& acc, const Unit& u, int wr, int wc, int fr, int fq) const {
#pragma unroll
        for (int ai = 0; ai < 2; ++ai)
#pragma unroll
            for (int m = 0; m < 4; ++m)
#pragma unroll
                for (int bj = 0; bj < 2; ++bj) { const size_t off = (size_t)EPI_ROW(u, ai, m) * DM + u.pn * BM + EPI_CB(bj); f32x4 g0, g1; unpack8(*(const u32x4*)(gate + off), g0, g1);
                    f32x4 r0 = g0 * acc[ai][bj][m][0], r1 = g1 * acc[ai][bj][m][1];
                    if (addend) { f32x4 t0, t1; unpack8(*(const u32x4*)(addend + off), t0, t1); r0 += t0; r1 += t1; }
                    *(u32x4*)(O + off) = pack8f(r0, r1); }
    }
};
struct EpiResid {
    static constexpr bool PERM = true;
    const float* xi; float* xo; bf16_t* xb; float* ss;
    __device__ __forceinline__ void operator()(const AccT& acc, const Unit& u, int wr, int wc, int fr, int fq) const {
#pragma unroll
        for (int ai = 0; ai < 2; ++ai)
#pragma unroll
            for (int m = 0; m < 4; ++m) { const int row = EPI_ROW(u, ai, m); float s = 0.f;
#pragma unroll
                for (int bj = 0; bj < 2; ++bj) { const size_t off = (size_t)row * DM + u.pn * BM + EPI_CB(bj);
                    const f32x4 r0 = *(const f32x4*)(xi + off) + acc[ai][bj][m][0], r1 = *(const f32x4*)(xi + off + 4) + acc[ai][bj][m][1];
                    *(f32x4*)(xo + off) = r0; *(f32x4*)(xo + off + 4) = r1; s += sq4(r0) + sq4(r1);
                    if (xb) *(u32x4*)(xb + off) = pack8f(r0, r1); }
                s += __shfl_xor(s, 16); s += __shfl_xor(s, 32); if (fq == 0) ss[(size_t)row * 32 + u.pn * 4 + wc] = s; }
    }
};
struct EpiXq {
    static constexpr bool PERM = true;
    bf16_t* O; const float* ss;
    __device__ __forceinline__ void operator()(const AccT& acc, const Unit& u, int wr, int wc, int fr, int fq) const {
#pragma unroll
        for (int ai = 0; ai < 2; ++ai)
#pragma unroll
            for (int m = 0; m < 4; ++m) { const int row = EPI_ROW(u, ai, m); const float rs = row_rs32(ss, row, 1.0f / DM);
#pragma unroll
                for (int bj = 0; bj < 2; ++bj) *(u32x4*)(O + (size_t)row * XW + u.pn * BM + EPI_CB(bj)) = pack8f(acc[ai][bj][m][0] * rs, acc[ai][bj][m][1] * rs); }
    }
};
struct EpiMoeGU {
    static constexpr bool PERM = true;
    const float* bias; bf16_t* act;
    __device__ __forceinline__ void operator()(const AccT& acc, const Unit& u, int wr, int wc, int fr, int fq) const {
        const int j0 = u.pn * HALF + wc * 32 + 8 * fq; const float* bg = bias + (size_t)u.e * (2 * DFF) + j0;
        const f32x4 g0 = *(const f32x4*)bg, g1 = *(const f32x4*)(bg + 4), u0 = *(const f32x4*)(bg + DFF), u1 = *(const f32x4*)(bg + DFF + 4);
#pragma unroll
        for (int ai = 0; ai < 2; ++ai)
#pragma unroll
            for (int m = 0; m < 4; ++m) { const int row = EPI_ROW(u, ai, m); f32x4 r[2];
#pragma unroll
                for (int n = 0; n < 2; ++n) { const f32x4 gt = acc[ai][0][m][n] + (n ? g1 : g0), up = acc[ai][1][m][n] + (n ? u1 : u0);
#pragma unroll
                    for (int j = 0; j < 4; ++j) { const float gc = fminf(gt[j], 7.0f), uc = fminf(fmaxf(up[j], -7.0f), 7.0f); r[n][j] = (uc + 1.0f) * (gc * fsigmoid(1.702f * gc)); } }
                *(u32x4*)(act + (size_t)row * DFF + j0) = pack8f(r[0], r[1]); }
    }
};
struct EpiMoeDown {
    static constexpr bool PERM = true;
    const float* bias; bf16_t* O;
    __device__ __forceinline__ void operator()(const AccT& acc, const Unit& u, int wr, int wc, int fr, int fq) const {
#pragma unroll
        for (int bj = 0; bj < 2; ++bj) { const int col = u.pn * BM + EPI_CB(bj); const float* bp = bias + (size_t)u.e * DM + col; const f32x4 b0 = *(const f32x4*)bp, b1 = *(const f32x4*)(bp + 4);
#pragma unroll
            for (int ai = 0; ai < 2; ++ai)
#pragma unroll
                for (int m = 0; m < 4; ++m) *(u32x4*)(O + (size_t)EPI_ROW(u, ai, m) * DM + col) = pack8f(acc[ai][bj][m][0] + b0, acc[ai][bj][m][1] + b1); }
    }
};
#undef EPI_ROW
#undef EPI_CB
}
namespace att {
constexpr int NW = 8, QBLK = 32, KVBLK = 64, QB = NW * QBLK;
constexpr int SHM_V = KVBLK * 128 * 2, SHM_K = KVBLK * 128 * 2, SHM_KR = KVBLK * 64 * 2;
constexpr int OFF_V = 0, OFF_K = 2 * SHM_V, OFF_KR = OFF_K + 2 * SHM_K, OFF_WS = OFF_KR + 2 * SHM_KR, OFF_QR = OFF_WS + NW * 64 * 4, LDS_BYTES = OFF_QR + NW * 4096;
constexpr float THR = 8.f;
#define KSWZ(row, colB) ((row) * 256 + ((colB) ^ (((row) & 7) << 4)))
__device__ __forceinline__ int v_st(int k, int c) { const int kk = (k & ~0xC) | ((k & 4) << 1) | ((k & 8) >> 1); return ((kk >> 3) * 4 + (c >> 5)) * 512 + ((kk & 7) * 32 + (c & 31)) * 2; }
__device__ __forceinline__ int v_rd_base(int lane) { return ((lane & 3) << 3) | (((lane >> 2) & 3) << 6) | (((lane >> 4) & 1) << 5) | (((lane >> 5) & 1) << 8); }
constexpr int v_rd_off(int d0, int ks, int half) { return d0 * 512 + ks * 4096 + half * 2048; }
__device__ __forceinline__ int crow(int r, int hi) { return (r & 3) + 8 * (r >> 2) + 4 * hi; }

__device__ __forceinline__ void mask_tile(f32x16& p0, f32x16& p1, int dq) {
    const float NEG = -__builtin_inff();
#pragma unroll
    for (int r = 0; r < 16; ++r) {
        const int c = (r & 3) + 8 * (r >> 2);
        if (dq - c < 0) p0[r] = NEG;
        if (dq - c - 32 < 0) p1[r] = NEG;
    }
}
template <bool ROPE>
__device__ __forceinline__ void partialSM(f32x16& p0, f32x16& p1, float& m_reg, float& mn, float& alpha) {
    constexpr float SCALE = ROPE ? 0.07216878364870323f : 0.08838834764831845f;
    float pmax = p0[0];
#pragma unroll
    for (int r = 1; r < 16; ++r) pmax = fmaxf(pmax, p0[r]);
#pragma unroll
    for (int r = 0; r < 16; ++r) pmax = fmaxf(pmax, p1[r]);
    { auto rr = __builtin_amdgcn_permlane32_swap(__float_as_uint(pmax), __float_as_uint(pmax), false, false);
      pmax = fmaxf(__uint_as_float(rr[0]), __uint_as_float(rr[1])); }
    constexpr float C2 = 1.4426950408889634f * SCALE;
    if (__builtin_expect(__all((pmax - m_reg) * SCALE <= THR), 1)) { mn = m_reg; alpha = 1.f; }
    else { mn = fmaxf(m_reg, pmax); alpha = __builtin_amdgcn_exp2f((m_reg - mn) * C2); m_reg = mn; }
    const float mnL = -mn * C2;
#pragma unroll
    for (int r = 0; r < 16; ++r) p0[r] = fmaf(p0[r], C2, mnL);
#pragma unroll
    for (int r = 0; r < 16; ++r) p1[r] = fmaf(p1[r], C2, mnL);
#pragma unroll
    for (int r = 0; r < 16; ++r) p0[r] = __builtin_amdgcn_exp2f(p0[r]);
}
__device__ __forceinline__ void finishSM(f32x16& p0, f32x16& p1, float alpha, float& l_reg, bf16x8& pa0, bf16x8& pa1, bf16x8& pa2, bf16x8& pa3) {
#pragma unroll
    for (int r = 0; r < 16; ++r) p1[r] = __builtin_amdgcn_exp2f(p1[r]);
    float ps = 0;
#pragma unroll
    for (int r = 0; r < 16; ++r) ps += p0[r];
#pragma unroll
    for (int r = 0; r < 16; ++r) ps += p1[r];
    { auto rr = __builtin_amdgcn_permlane32_swap(__float_as_uint(ps), __float_as_uint(ps), false, false);
      ps = __uint_as_float(rr[0]) + __uint_as_float(rr[1]); }
    l_reg = l_reg * alpha + ps;
#define PK4(P, B_, OUT) do { unsigned a0 = cvtpk(P[B_+0], P[B_+1]), a1 = cvtpk(P[B_+2], P[B_+3]);                          \
        unsigned b0 = cvtpk(P[B_+4], P[B_+5]), b1 = cvtpk(P[B_+6], P[B_+7]);                                             \
        auto r0 = __builtin_amdgcn_permlane32_swap(a0, b0, false, false); auto r1 = __builtin_amdgcn_permlane32_swap(a1, b1, false, false); \
        u32x4 w = {r0[0], r1[0], r0[1], r1[1]}; OUT = *reinterpret_cast<bf16x8*>(&w); } while (0)
    PK4(p0, 0, pa0); PK4(p0, 8, pa1); PK4(p1, 0, pa2); PK4(p1, 8, pa3);
#undef PK4
}
template <int KB, bool ROPE>
__device__ __forceinline__ void qkt(f32x16& p0, f32x16& p1, const char* K_lds, int r32, int hi, const bf16x8* qr, const char* qrl) {
    p0 = f32x16{}; p1 = f32x16{};
    const char* kb[4];
#pragma unroll
    for (int dd = 0; dd < 4; ++dd) kb[dd] = K_lds + KB * SHM_K + KSWZ(r32, (dd * 16 + hi * 8) * 2);
#pragma unroll
    for (int d0 = 0; d0 < 8; ++d0) { const char* a = kb[d0 & 3] + (d0 >> 2) * 128;
        bf16x8 b0 = *reinterpret_cast<const bf16x8*>(a);
        bf16x8 b1 = *reinterpret_cast<const bf16x8*>(a + 32 * 256);
        p0 = __builtin_amdgcn_mfma_f32_32x32x16_bf16(b0, qr[d0], p0, 0, 0, 0);
        p1 = __builtin_amdgcn_mfma_f32_32x32x16_bf16(b1, qr[d0], p1, 0, 0, 0); }
    if constexpr (ROPE) {
        constexpr int RO = 2 * SHM_K - KB * SHM_K + KB * SHM_KR;
#pragma unroll
        for (int d0 = 0; d0 < 4; ++d0) { const char* a = kb[d0] + RO;
            bf16x8 b0 = *reinterpret_cast<const bf16x8*>(a);
            bf16x8 b1 = *reinterpret_cast<const bf16x8*>(a + 128);
            const bf16x8 q = *reinterpret_cast<const bf16x8*>(qrl + d0 * 1024);
            p0 = __builtin_amdgcn_mfma_f32_32x32x16_bf16(b0, q, p0, 0, 0, 0);
            p1 = __builtin_amdgcn_mfma_f32_32x32x16_bf16(b1, q, p1, 0, 0, 0); }
    }
}
template <int VB>
__device__ __forceinline__ void pv_tile(f32x16* o, int vb0, bf16x8 pa0, bf16x8 pa1, bf16x8 pa2, bf16x8 pa3) {
#define TRRD(dst, off) asm volatile("ds_read_b64_tr_b16 %0, %1 offset:%2" : "=&v"(dst) : "v"(vb0), "i"(off) : "memory")
#define PV_D0(d0) do { s16x4 l0, l1, l2, l3, h0, h1, h2, h3; constexpr int b_ = VB * SHM_V + v_rd_off(d0, 0, 0);  \
        TRRD(l0, b_); TRRD(h0, b_ + 2048); TRRD(l1, b_ + 4096); TRRD(h1, b_ + 6144); TRRD(l2, b_ + 8192); TRRD(h2, b_ + 10240); TRRD(l3, b_ + 12288); TRRD(h3, b_ + 14336); \
        asm volatile("s_waitcnt lgkmcnt(0)" ::: "memory"); SBAR();   \
        o[d0] = __builtin_amdgcn_mfma_f32_32x32x16_bf16(pa0, (bf16x8){l0[0], l0[1], l0[2], l0[3], h0[0], h0[1], h0[2], h0[3]}, o[d0], 0, 0, 0);   \
        o[d0] = __builtin_amdgcn_mfma_f32_32x32x16_bf16(pa1, (bf16x8){l1[0], l1[1], l1[2], l1[3], h1[0], h1[1], h1[2], h1[3]}, o[d0], 0, 0, 0);   \
        o[d0] = __builtin_amdgcn_mfma_f32_32x32x16_bf16(pa2, (bf16x8){l2[0], l2[1], l2[2], l2[3], h2[0], h2[1], h2[2], h2[3]}, o[d0], 0, 0, 0);   \
        o[d0] = __builtin_amdgcn_mfma_f32_32x32x16_bf16(pa3, (bf16x8){l3[0], l3[1], l3[2], l3[3], h3[0], h3[1], h3[2], h3[3]}, o[d0], 0, 0, 0); } while (0)
    PV_D0(0); PV_D0(1); PV_D0(2); PV_D0(3);
#undef PV_D0
#undef TRRD
}

struct BlockRef { const bf16_t* Q; const bf16_t* QR; const bf16_t* K; const bf16_t* KR; const bf16_t* V; bf16_t* O; int P0; };
struct Strides { int qs, qrs, ks, vs, os, skv; };
template <bool ROPE> struct Seam { bf16x8 qr[ROPE ? 12 : 8];     bf16x8 st_v0, st_v1, st_k0, st_k1, st_kr; };
#define LD8(p) (*reinterpret_cast<const bf16x8*>(p))
#define VMW() asm volatile("s_waitcnt vmcnt(0)" ::: "memory")
#define VMWN(n) asm volatile("s_waitcnt vmcnt(%0)" :: "i"(n) : "memory")
#define SLOAD_H(R, k0) do { const char* vb_ = (const char*)(R).V + (size_t)(k0) * T.vs * 2; const char* kb_ = (const char*)(R).K + (size_t)(k0) * T.ks * 2;   \
                            S.st_v0 = LD8(vb_ + vo_v); S.st_v1 = LD8(vb_ + (size_t)T.vs * 64 + vo_v);              \
                            S.st_k0 = LD8(kb_ + vo_k); S.st_k1 = LD8(kb_ + (size_t)T.ks * 64 + vo_k);              \
                            if constexpr (ROPE) S.st_kr = LD8((const char*)(R).KR + (size_t)(k0) * (DROPE * 2) + vo_kr); } while (0)
#define SWRITE_HK(bf) do { *(bf16x8*)(K_lds + (bf) * SHM_K + kws) = S.st_k0; *(bf16x8*)(K_lds + (bf) * SHM_K + kws + 32 * 256) = S.st_k1;                \
                           if constexpr (ROPE) *(bf16x8*)(K_lds + 2 * SHM_K + (bf) * SHM_KR + krws) = S.st_kr; } while (0)
#define SWRITE_HV(bf) do { *(bf16x8*)(V_lds + (bf) * SHM_V + vst0) = S.st_v0; *(bf16x8*)(V_lds + (bf) * SHM_V + vst1) = S.st_v1; } while (0)
#define SWRITE_H(bf) do { SWRITE_HV(bf); SWRITE_HK(bf); } while (0)
#define QLOAD(R) do { const char* qb_ = (const char*)(R).Q + (size_t)(wid * QBLK) * T.qs * 2; const unsigned qo_ = (unsigned)(r32 * T.qs + hi * 8) * 2u;    \
                      _Pragma("unroll") for (int d0 = 0; d0 < 8; ++d0) S.qr[d0] = LD8(qb_ + qo_ + d0 * 32);    \
                      if constexpr (ROPE) { const char* qrb_ = (const char*)(R).QR + (size_t)(wid * QBLK) * T.qrs * 2; const unsigned qro_ = (unsigned)(r32 * T.qrs + hi * 8) * 2u;   \
                          _Pragma("unroll") for (int d0 = 0; d0 < 4; ++d0) S.qr[8 + d0] = LD8(qrb_ + qro_ + d0 * 32); } } while (0)
#define QPARK() do { if constexpr (ROPE) { _Pragma("unroll") for (int d0 = 0; d0 < 4; ++d0) *(bf16x8*)(qrl + d0 * 1024) = S.qr[8 + d0]; } } while (0)
#define STAGE_IDX() const int sr = tid >> 4, sc = (tid & 15) * 8, kws = KSWZ(sr, sc * 2); \
                    const int rk = tid >> 3, rc = tid & 7, krws = (rk & 31) * 256 + ((((rk >> 5) * 8 + rc) * 16) ^ (((rk & 31) & 7) << 4)); \
                    const unsigned vo_v = (unsigned)(sr * T.vs + sc) * 2u, vo_k = (unsigned)(sr * T.ks + sc) * 2u, vo_kr = (unsigned)(rk * DROPE + rc * 8) * 2u

template <bool ROPE, bool CAUSAL>
__device__ __forceinline__ void attn_prime(const BlockRef& cur, const Strides& T, char* lds, Seam<ROPE>& S) {
    const int tid = threadIdx.x, wid = __builtin_amdgcn_readfirstlane(tid >> 6), lane = tid & 63, r32 = lane & 31, hi = lane >> 5;
    STAGE_IDX(); char* K_lds = lds + OFF_K; char* qrl = lds + OFF_QR + wid * 4096 + lane * 16;
    QLOAD(cur);
    SLOAD_H(cur, 0); VMW(); SWRITE_HK(0); QPARK();
    __syncthreads();
}
template <bool ROPE, bool CAUSAL>
__device__ __forceinline__ void attn_block(const BlockRef& cur, const BlockRef& nxt, const Strides& T, char* lds, Seam<ROPE>& S) {
    const int tid = threadIdx.x, wid = __builtin_amdgcn_readfirstlane(tid >> 6), lane = tid & 63, r32 = lane & 31, hi = lane >> 5;
    int j_hi = CAUSAL ? (cur.P0 + QB - 1) / KVBLK + 1 : T.skv / KVBLK; if (j_hi > T.skv / KVBLK) j_hi = T.skv / KVBLK;
    const int NT = j_hi;
    const int qlo = cur.P0 + wid * QBLK, qm = qlo + r32 - 4 * hi;
    char* V_lds = lds + OFF_V; char* K_lds = lds + OFF_K; char* qrl = lds + OFF_QR + wid * 4096 + lane * 16;
    float* ws = (float*)(lds + OFF_WS) + wid * 64; float* li_l = ws, * al_l = ws + 32;
    float m_reg = -1e30f, l_reg = 0; f32x16 o[4] = {};
    STAGE_IDX(); const int vst0 = v_st(sr, sc), vst1 = v_st(32 + sr, sc);
    const int vb0 = (int)(uintptr_t)V_lds + v_rd_base(lane);
#define RESC(a) do { if (__any((a) < 1.f)) { if (hi == 0) al_l[r32] = (a); asm volatile("s_waitcnt lgkmcnt(0)" ::: "memory");              \
                     for (int d_ = 0; d_ < 4; ++d_) for (int r = 0; r < 16; ++r) o[d_][r] *= al_l[crow(r, hi)]; } } while (0)
#define KBASE(t) ((t) * KVBLK)
#define MASKT(P0_, P1_, t) do { if constexpr (CAUSAL) { const int kb_ = KBASE(t); if (kb_ + KVBLK - 1 > qlo) mask_tile(P0_, P1_, qm - kb_); } } while (0)
    constexpr int NQL = ROPE ? 12 : 8;
#define SEAM_K0() do { VMWN(NQL); SWRITE_HK(0); SBAR(); } while (0)
    f32x16 pA0, pA1, pB0, pB1; float mnA, mnB, alA, alB; bf16x8 pa0, pa1, pa2, pa3;
    SWRITE_HV(0); SBAR();
    if (NT > 1) { SLOAD_H(cur, KBASE(1)); }
    SBAR(); qkt<0, ROPE>(pA0, pA1, K_lds, r32, hi, S.qr, qrl);
    MASKT(pA0, pA1, 0); partialSM<ROPE>(pA0, pA1, m_reg, mnA, alA);
    if (NT > 1) { VMW(); SWRITE_H(1); }
    __syncthreads();
#define HALF_STEP(PX0, PX1, mnX, alX, PY0, PY1, alY, t, KB, VB, SB) do {                                                      \
        SBAR(); qkt<KB, ROPE>(PX0, PX1, K_lds, r32, hi, S.qr, qrl);                                                                \
        finishSM(PY0, PY1, alY, l_reg, pa0, pa1, pa2, pa3); SBAR();                                                           \
        if ((t) + 1 < NT) { SLOAD_H(cur, KBASE((t) + 1)); SBAR(); }                                                           \
        pv_tile<VB>(o, vb0, pa0, pa1, pa2, pa3); MASKT(PX0, PX1, (t)); partialSM<ROPE>(PX0, PX1, m_reg, mnX, alX);            \
        __syncthreads();                                                                                                      \
        if ((t) + 1 < NT) { VMW(); SWRITE_H(SB); }                                                                            \
        RESC(alX); __syncthreads(); } while (0)
    for (int t = 1; t + 1 < NT; t += 2) {
        HALF_STEP(pB0, pB1, mnB, alB, pA0, pA1, alA, t, 1, 0, 0);
        HALF_STEP(pA0, pA1, mnA, alA, pB0, pB1, alB, t + 1, 0, 1, 1);
    }
    const bool even = (NT & 1) == 0;
    if (even) { SBAR(); qkt<1, ROPE>(pB0, pB1, K_lds, r32, hi, S.qr, qrl); SBAR(); }
    SLOAD_H(nxt, 0); SBAR();
    QLOAD(nxt);
    SBAR();
    finishSM(pA0, pA1, alA, l_reg, pa0, pa1, pa2, pa3); SBAR();
    pv_tile<0>(o, vb0, pa0, pa1, pa2, pa3);
    if (even) { MASKT(pB0, pB1, NT - 1); partialSM<ROPE>(pB0, pB1, m_reg, mnB, alB); __syncthreads(); RESC(alB);
        finishSM(pB0, pB1, alB, l_reg, pa0, pa1, pa2, pa3); SBAR(); pv_tile<1>(o, vb0, pa0, pa1, pa2, pa3); }
    SBAR(); SEAM_K0();
    if (hi == 0) li_l[r32] = l_reg; asm volatile("s_waitcnt lgkmcnt(0)" ::: "memory");
    float rli[16];
#pragma unroll
    for (int r = 0; r < 16; ++r) rli[r] = __builtin_amdgcn_rcpf(li_l[crow(r, hi)]);
    bf16_t* Ow = cur.O + (size_t)(wid * QBLK) * T.os;
#pragma unroll
    for (int r = 0; r < 16; ++r) { const int orow = crow(r, hi);
#pragma unroll
        for (int d0 = 0; d0 < 4; ++d0) { const float v = o[d0][r] * rli[r];
            const float vn = __shfl_xor(v, 1);
            if ((r32 & 1) == 0) *(unsigned*)(Ow + (size_t)orow * T.os + d0 * 32 + r32) = cvtpk(v, vn); } }
    QPARK();
    __syncthreads();
#undef RESC
#undef KBASE
#undef MASKT
#undef SEAM_K0
#undef HALF_STEP
}

template <bool ROPE>
__device__ __forceinline__ void qkt_rt(f32x16& p0, f32x16& p1, const char* K_lds, int buf, const int (&koff)[4], const bf16x8* qr, const char* qrl) {
    p0 = f32x16{}; p1 = f32x16{};
    const char* kbase = K_lds + buf * SHM_K;
#pragma unroll
    for (int d0 = 0; d0 < 8; ++d0) { const char* a = kbase + koff[d0 & 3] + (d0 >> 2) * 128;
        bf16x8 b0 = *reinterpret_cast<const bf16x8*>(a);
        bf16x8 b1 = *reinterpret_cast<const bf16x8*>(a + 32 * 256);
        p0 = __builtin_amdgcn_mfma_f32_32x32x16_bf16(b0, qr[d0], p0, 0, 0, 0);
        p1 = __builtin_amdgcn_mfma_f32_32x32x16_bf16(b1, qr[d0], p1, 0, 0, 0); }
    if constexpr (ROPE) {
        const char* rbase = K_lds + 2 * SHM_K + buf * SHM_KR;
#pragma unroll
        for (int d0 = 0; d0 < 4; ++d0) { const char* a = rbase + koff[d0];
            bf16x8 b0 = *reinterpret_cast<const bf16x8*>(a);
            bf16x8 b1 = *reinterpret_cast<const bf16x8*>(a + 128);
            const bf16x8 q = *reinterpret_cast<const bf16x8*>(qrl + d0 * 1024);
            p0 = __builtin_amdgcn_mfma_f32_32x32x16_bf16(b0, q, p0, 0, 0, 0);
            p1 = __builtin_amdgcn_mfma_f32_32x32x16_bf16(b1, q, p1, 0, 0, 0); }
    }
}
template <bool ROPE, bool CAUSAL>
__device__ __forceinline__ void attn_block_simple(const BlockRef& cur, const Strides& T, char* lds) {
    const int tid = threadIdx.x, wid = __builtin_amdgcn_readfirstlane(tid >> 6), lane = tid & 63, r32 = lane & 31, hi = lane >> 5;
    int j_hi = CAUSAL ? (cur.P0 + QB - 1) / KVBLK + 1 : T.skv / KVBLK; if (j_hi > T.skv / KVBLK) j_hi = T.skv / KVBLK;
    const int NT = j_hi;
    const int qlo = cur.P0 + wid * QBLK, qm = qlo + r32 - 4 * hi;
    char* V_lds = lds + OFF_V; char* K_lds = lds + OFF_K;
    float* ws = (float*)(lds + OFF_WS) + wid * 64; float* li_l = ws, * al_l = ws + 32;
    float m_reg = -1e30f, l_reg = 0; f32x16 o[4] = {};
    STAGE_IDX(); const int vst0 = v_st(sr, sc), vst1 = v_st(32 + sr, sc);
    const int vb0 = (int)(uintptr_t)V_lds + v_rd_base(lane);
    int koff[4];
#pragma unroll
    for (int dd = 0; dd < 4; ++dd) koff[dd] = KSWZ(r32, (dd * 16 + hi * 8) * 2);
    Seam<ROPE> S; char* qrl = lds + OFF_QR + wid * 4096 + lane * 16;
    QLOAD(cur);
    SLOAD_H(cur, 0); VMW(); SWRITE_H(0); QPARK();
    __syncthreads();
    for (int t = 0; t < NT; ++t) {
        const int buf = t & 1;
        if (t + 1 < NT) { SLOAD_H(cur, (t + 1) * KVBLK); }
        SBAR();
        f32x16 p0, p1; qkt_rt<ROPE>(p0, p1, K_lds, buf, koff, S.qr, qrl);
        if constexpr (CAUSAL) { const int kb_ = t * KVBLK; if (kb_ + KVBLK - 1 > qlo) mask_tile(p0, p1, qm - kb_); }
        float mn, al; partialSM<ROPE>(p0, p1, m_reg, mn, al);
        if (__any(al < 1.f)) { if (hi == 0) al_l[r32] = al; asm volatile("s_waitcnt lgkmcnt(0)" ::: "memory");
            for (int d_ = 0; d_ < 4; ++d_) for (int r = 0; r < 16; ++r) o[d_][r] *= al_l[crow(r, hi)]; }
        bf16x8 pa0, pa1, pa2, pa3; finishSM(p0, p1, al, l_reg, pa0, pa1, pa2, pa3); SBAR();
        pv_tile<0>(o, vb0 + buf * SHM_V, pa0, pa1, pa2, pa3);
        if (t + 1 < NT) { VMW(); SWRITE_H(buf ^ 1); }
        __syncthreads();
    }
    if (hi == 0) li_l[r32] = l_reg; asm volatile("s_waitcnt lgkmcnt(0)" ::: "memory");
    float rli[16];
#pragma unroll
    for (int r = 0; r < 16; ++r) rli[r] = __builtin_amdgcn_rcpf(li_l[crow(r, hi)]);
    bf16_t* Ow = cur.O + (size_t)(wid * QBLK) * T.os;
#pragma unroll
    for (int r = 0; r < 16; ++r) { const int orow = crow(r, hi);
#pragma unroll
        for (int d0 = 0; d0 < 4; ++d0) { const float v = o[d0][r] * rli[r];
            const float vn = __shfl_xor(v, 1);
            if ((r32 & 1) == 0) *(unsigned*)(Ow + (size_t)orow * T.os + d0 * 32 + r32) = cvtpk(v, vn); } }
    __syncthreads();
}
#undef LD8
#undef VMW
#undef VMWN
#undef SLOAD_H
#undef SWRITE_HK
#undef SWRITE_HV
#undef SWRITE_H
#undef QLOAD
#undef QPARK
#undef STAGE_IDX
}
__device__ __forceinline__ float sq4v(f32x4 v) { return pg8::sq4(v); }
__device__ __forceinline__ float row_rs32g(const float* ss, int row) { return pg8::row_rs32(ss, row, 1.0f / DM); }
struct Params {
    const float *x, *mem; const int* pos; const float *norm_mix, *w_in, *lam_re, *lam_im, *log_step, *b_re, *b_im, *c_re, *c_im, *ssm_d, *w_glu, *b_glu;
    const float *q_norm, *w_uq, *kv_norm, *w_uk, *w_uv, *w_up_ssm, *w_up_mla, *w_out, *norm_xattn, *norm_mem, *xa_wq, *xa_wk, *xa_wv, *xa_wo;
    const float *norm_moe, *router_w, *router_b, *w_gu, *b_gu, *w_dn, *b_dn, *final_norm;
    float* out;
    unsigned* ctl;
    bf16_t *WinT, *WkpeT, *WgluT, *WuqT, *WukvT, *WupsT, *WupmT, *WoutT, *WxqT, *WxkvT, *WxoT, *WguT, *WdnT;
    float* WrT;
    bf16_t *hn, *memn; float *cosT, *sinT; float* abar; bf16_t *bbarT, *cmat;
    bf16_t *ub, *qa, *kva; float *qss, *kvss; bf16_t *sgs, *sgm, *kpe;
    bf16_t *qn, *qr, *kn, *vv, *ymla;
    float* send; bf16_t *zb, *ys, *t1, *mg;
    float* x1; bf16_t* x1b; float* ss1;
    bf16_t *memkv, *qx, *ox;
    float* x2; float* ss2;
    int* topi; float* topw; int* rank; int* slot; int* wgcnt; int* blke;
    bf16_t *xg, *act, *orow;
    int ph_lo, ph_hi;
};

struct Frame { LAS unsigned char* lds; int wave, vcu, G, gw, NGW; };

template <class RowMap>
__device__ __forceinline__ void p0_transpose_item(const float* W, int ldw, int K, bf16_t* WT, const float* gain, LAS float* scr, int kb, int nb, int lane, const RowMap& rowmap) {
    const int k0 = 64 * kb, n0 = 32 * nb;
#pragma unroll 8
    for (int i = 0; i < 32; ++i) { const int kk = 2 * i + (lane >> 5); float v = W[(size_t)(k0 + kk) * ldw + n0 + (lane & 31)]; if (gain) v *= gain[k0 + kk]; scr[kk * 33 + (lane & 31)] = v; }
    LDS_WAIT(); asm volatile("" ::: "memory");
    const int c = lane & 7;
#pragma unroll
    for (int j = 0; j < 4; ++j) { const int n = (lane >> 3) + 8 * j; const LAS float* s = scr + (8 * c) * 33 + n;
        u32x4 o; o.x = cvtpk(s[0 * 33], s[1 * 33]); o.y = cvtpk(s[2 * 33], s[3 * 33]); o.z = cvtpk(s[4 * 33], s[5 * 33]); o.w = cvtpk(s[6 * 33], s[7 * 33]);
        *(u32x4*)(WT + (size_t)rowmap(n0 + n) * K + k0 + 8 * c) = o; }
    LDS_WAIT(); asm volatile("" ::: "memory");
}
struct MapId { int off; __device__ __forceinline__ int operator()(int n) const { return n + off; } };
struct MapUq { __device__ __forceinline__ int operator()(int n) const { const int h = n / 192, d = n % 192; if (d < 128) return h * 128 + d;
    const int dd = d - 128, half = dd >> 5, i = dd & 31; return 2048 + 256 * (h >> 2) + half * 128 + (h & 3) * 32 + i; } };
struct MapGU { __device__ __forceinline__ int operator()(int n) const { const int up = n >= DFF, j = up ? n - DFF : n; return 256 * (j >> 7) + up * 128 + (j & 127); } };

__device__ __forceinline__ void rms_row_bf16(const float* xrow, const float* gain, bf16_t* orow, int lane) {
    f32x4 v[8]; float s = 0.f;
#pragma unroll
    for (int j = 0; j < 8; ++j) { v[j] = *(const f32x4*)(xrow + 256 * j + 4 * lane); s += sq4v(v[j]); }
    const float rs = __builtin_amdgcn_rsqf(wave_sum(s) * (1.0f / DM) + EPS);
#pragma unroll
    for (int j = 0; j < 8; ++j) { const f32x4 g = *(const f32x4*)(gain + 256 * j + 4 * lane); const f32x4 r = v[j] * rs * g;
        u32x2 o = {cvtpk(r[0], r[1]), cvtpk(r[2], r[3])}; *(u32x2*)(orow + 256 * j + 4 * lane) = o; }
}

__device__ __forceinline__ void cmul(float ar, float ai, float br, float bi, float& cr, float& ci) { cr = ar * br - ai * bi; ci = ar * bi + ai * br; }

__device__ __forceinline__ void p0_prologue(const Params& p, Frame& F) {
    LAS float* scr = (LAS float*)(F.lds + F.wave * 16384);
    const int gw = F.gw, NGW = F.NGW, lane = ((int)threadIdx.x & 63);
#define TJOB(W, LDW, COFF, NCOLS, KK, DST, GAIN, MAP) { const int nblk = (NCOLS) / 32, nit = ((KK) / 64) * nblk; \
        for (int it = gw; it < nit; it += NGW) p0_transpose_item((W) + (COFF), (LDW), (KK), (DST), (GAIN), scr, it / nblk, it % nblk, lane, (MAP)); }
    TJOB(p.w_in, IN_COLS, 0, 2048, DM, p.WinT, nullptr, MapId{0});
    TJOB(p.w_in, IN_COLS, 2048, 64, DM, p.WkpeT, nullptr, MapId{0});
    TJOB(p.w_in, IN_COLS, 2112, 4096, DM, p.WinT, nullptr, MapId{2048});
    TJOB(p.w_glu, SSM_W, 0, SSM_W, SSM_W, p.WgluT, nullptr, MapId{0});
    TJOB(p.w_uq, NHEAD * 192, 0, NHEAD * 192, QL, p.WuqT, p.q_norm, MapUq{});
    TJOB(p.w_uk, NHEAD * 128, 0, NHEAD * 128, KVL, p.WukvT, p.kv_norm, MapId{0});
    TJOB(p.w_uv, NHEAD * 128, 0, NHEAD * 128, KVL, p.WukvT, p.kv_norm, MapId{2048});
    TJOB(p.w_up_ssm, DM, 0, DM, SSM_W, p.WupsT, nullptr, MapId{0});
    TJOB(p.w_up_mla, DM, 0, DM, DM, p.WupmT, nullptr, MapId{0});
    TJOB(p.w_out, DM, 0, DM, DM, p.WoutT, nullptr, MapId{0});
    TJOB(p.xa_wq, XW, 0, XW, DM, p.WxqT, p.norm_xattn, MapId{0});
    TJOB(p.xa_wk, XW, 0, XW, DM, p.WxkvT, nullptr, MapId{0});
    TJOB(p.xa_wv, XW, 0, XW, DM, p.WxkvT, nullptr, MapId{512});
    TJOB(p.xa_wo, DM, 0, DM, XW, p.WxoT, nullptr, MapId{0});
    for (int e = 0; e < NEXP; ++e) {
        TJOB(p.w_gu + (size_t)e * DM * 2 * DFF, 2 * DFF, 0, 2 * DFF, DM, p.WguT + (size_t)e * 2 * DFF * DM, nullptr, MapGU{});
        TJOB(p.w_dn + (size_t)e * DFF * DM, DM, 0, DM, DFF, p.WdnT + (size_t)e * DM * DFF, nullptr, MapId{0});
    }
#undef TJOB
    for (int m = gw; m < SEQ; m += NGW) rms_row_bf16(p.x + (size_t)m * DM, p.norm_mix, p.hn + (size_t)m * DM, lane);
    for (int m = gw; m < MEML; m += NGW) rms_row_bf16(p.mem + (size_t)m * DM, p.norm_mem, p.memn + (size_t)m * DM, lane);
    const int gt = gw * 64 + lane, NGT = NGW * 64;
    for (int i = gt; i < SEQ * 32; i += NGT) {
        const int t = i >> 5, f = i & 31;
        const float invf = __builtin_powf(10000.0f, -(float)(2 * f) / 64.0f);
        const float ang = (float)p.pos[t] * invf;
        const double rev = (double)ang * 0.15915494309189535; const float fr = (float)(rev - __builtin_floor(rev));
        p.cosT[i] = __builtin_amdgcn_cosf(fr); p.sinT[i] = __builtin_amdgcn_sinf(fr);
    }
    for (int i = gt; i < DM * NEXP; i += NGT) p.WrT[i] = p.router_w[i] * p.norm_moe[i >> 5];
    for (int i = gt; i < SSM_G * SSM_P; i += NGT) {
        const int g = i >> 6;
        const float dt = __builtin_expf(p.log_step[g]), lr = p.lam_re[i], li = p.lam_im[i];
        const float mag = __builtin_expf(lr * dt); const double rev = (double)(li * dt) * 0.15915494309189535; const float fr = (float)(rev - __builtin_floor(rev));
        const float ar = mag * __builtin_amdgcn_cosf(fr), ai = mag * __builtin_amdgcn_sinf(fr);
        p.abar[2 * i] = ar; p.abar[2 * i + 1] = ai;
        const float den = 1.0f / (lr * lr + li * li); float fr_, fi_; cmul(ar - 1.0f, ai, lr * den, -li * den, fr_, fi_);
        const int pst = i & 63;
#pragma unroll
        for (int h = 0; h < SSM_H; ++h) { const float br = p.b_re[(size_t)i * SSM_H + h], bi = p.b_im[(size_t)i * SSM_H + h]; float cr, ci; cmul(fr_, fi_, br, bi, cr, ci);
            p.bbarT[((size_t)g * 128 + pst) * 16 + h] = f2bf(cr); p.bbarT[((size_t)g * 128 + 64 + pst) * 16 + h] = f2bf(ci); }
    }
    for (int i = gt; i < SSM_G * SSM_H * SSM_P; i += NGT) {
        const int gh = i >> 6, pst = i & 63;
        p.cmat[(size_t)gh * 128 + pst] = f2bf(p.c_re[i]); p.cmat[(size_t)gh * 128 + 64 + pst] = f2bf(-p.c_im[i]);
    }
}

__device__ __forceinline__ void kpe_phase(const Params& p, Frame& F) {
    const int lane = ((int)threadIdx.x & 63), r = lane & 31, hi = lane >> 5;
    for (int tile = F.wave * F.G + F.vcu; tile < SEQ / 32; tile += F.NGW) {
        const int t0 = tile * 32; f32x16 a0 = {}, a1 = {};
        const bf16_t* ap = p.hn + (size_t)(t0 + r) * DM + 8 * hi; const bf16_t* b0p = p.WkpeT + (size_t)r * DM + 8 * hi; const bf16_t* b1p = b0p + (size_t)32 * DM;
#pragma unroll 4
        for (int s = 0; s < DM / 16; ++s) { const bf16x8 a = *(const bf16x8*)(ap + 16 * s), b0 = *(const bf16x8*)(b0p + 16 * s), b1 = *(const bf16x8*)(b1p + 16 * s);
            a0 = __builtin_amdgcn_mfma_f32_32x32x16_bf16(a, b0, a0, 0, 0, 0); a1 = __builtin_amdgcn_mfma_f32_32x32x16_bf16(a, b1, a1, 0, 0, 0); }
#pragma unroll
        for (int i = 0; i < 16; ++i) { const int tok = t0 + (i & 3) + 8 * (i >> 2) + 4 * hi; const float c = p.cosT[(size_t)tok * 32 + r], s = p.sinT[(size_t)tok * 32 + r];
            p.kpe[(size_t)tok * DROPE + r] = f2bf(a0[i] * c - a1[i] * s); p.kpe[(size_t)tok * DROPE + 32 + r] = f2bf(a0[i] * s + a1[i] * c); }
    }
}

constexpr int S5_TC = 256, S5_NCH = SEQ / S5_TC;
struct S5Consts { float a1r[2], a1i[2], a2r[2], a2i[2], a3r[2], a3i[2], a4r[2], a4i[2], a8r[2], a8i[2], a32r[2], a32i[2], a256r[2], a256i[2]; };
__device__ __forceinline__ void s5_consts(const Params& p, int g, int r, S5Consts& c) {
#pragma unroll
    for (int s = 0; s < 2; ++s) { const f32x2 a = *(const f32x2*)(p.abar + 2 * (g * 64 + 32 * s + r)); c.a1r[s] = a[0]; c.a1i[s] = a[1];
        cmul(c.a1r[s], c.a1i[s], c.a1r[s], c.a1i[s], c.a2r[s], c.a2i[s]); cmul(c.a2r[s], c.a2i[s], c.a1r[s], c.a1i[s], c.a3r[s], c.a3i[s]); cmul(c.a2r[s], c.a2i[s], c.a2r[s], c.a2i[s], c.a4r[s], c.a4i[s]);
        cmul(c.a4r[s], c.a4i[s], c.a4r[s], c.a4i[s], c.a8r[s], c.a8i[s]); float tr, ti; cmul(c.a8r[s], c.a8i[s], c.a8r[s], c.a8i[s], tr, ti); cmul(tr, ti, tr, ti, c.a32r[s], c.a32i[s]);
        float ur, ui; cmul(c.a32r[s], c.a32i[s], c.a32r[s], c.a32i[s], tr, ti); cmul(tr, ti, tr, ti, ur, ui); cmul(ur, ui, ur, ui, c.a256r[s], c.a256i[s]); }
}
__device__ __forceinline__ void s5_bu(const Params& p, int g, int t0, int r, int hi, const bf16x8 (&bfr)[4], f32x16 (&acc)[4]) {
    const bf16x8 a = *(const bf16x8*)(p.ub + (size_t)(t0 + r) * SSM_W + g * 16 + 8 * hi);
#pragma unroll
    for (int ct = 0; ct < 4; ++ct) { acc[ct] = f32x16{}; acc[ct] = __builtin_amdgcn_mfma_f32_32x32x16_bf16(a, bfr[ct], acc[ct], 0, 0, 0); }
}
__device__ __forceinline__ void s5_pass_a(const Params& p, Frame& F) {
    const int lane = ((int)threadIdx.x & 63), r = lane & 31, hi = lane >> 5;
    for (int unit = F.gw; unit < S5_NCH * SSM_G; unit += F.NGW) {
        const int g = unit % SSM_G, ch = unit / SSM_G;
        S5Consts c; s5_consts(p, g, r, c);
        bf16x8 bfr[4];
#pragma unroll
        for (int ct = 0; ct < 4; ++ct) bfr[ct] = *(const bf16x8*)(p.bbarT + ((size_t)g * 128 + 32 * ct + r) * 16 + 8 * hi);
        float Sr[2] = {0.f, 0.f}, Si[2] = {0.f, 0.f};
        for (int tl = 0; tl < S5_TC / 32; ++tl) {
            f32x16 acc[4]; s5_bu(p, g, ch * S5_TC + tl * 32, r, hi, bfr, acc);
#pragma unroll
            for (int s = 0; s < 2; ++s) { float Pr = 0.f, Pi = 0.f;
#pragma unroll
                for (int q = 0; q < 4; ++q) { float er = acc[s][4 * q], ei = acc[2 + s][4 * q];
#pragma unroll
                    for (int j = 1; j < 4; ++j) { float tr, ti; cmul(er, ei, c.a1r[s], c.a1i[s], tr, ti); er = tr + acc[s][4 * q + j]; ei = ti + acc[2 + s][4 * q + j]; }
                    float tr, ti; cmul(Pr, Pi, c.a8r[s], c.a8i[s], tr, ti); Pr = tr + er; Pi = ti + ei; }
                if (hi == 0) { float tr, ti; cmul(Pr, Pi, c.a4r[s], c.a4i[s], tr, ti); Pr = tr; Pi = ti; }
                Pr += __shfl_xor(Pr, 32); Pi += __shfl_xor(Pi, 32);
                float tr, ti; cmul(Sr[s], Si[s], c.a32r[s], c.a32i[s], tr, ti); Sr[s] = tr + Pr; Si[s] = ti + Pi; }
        }
        if (hi == 0) {
#pragma unroll
            for (int s = 0; s < 2; ++s) *(f32x2*)(p.send + 2 * ((size_t)(ch * SSM_G + g) * 64 + 32 * s + r)) = (f32x2){Sr[s], Si[s]}; }
    }
}
constexpr int S5_XS = 272;
__device__ __forceinline__ void s5_pass_c(const Params& p, Frame& F) {
    const int lane = ((int)threadIdx.x & 63), r = lane & 31, hi = lane >> 5, l15 = lane & 15, l4 = lane >> 4;
    LAS unsigned char* xl = F.lds + F.wave * (32 * S5_XS);
    for (int unit = F.gw; unit < S5_NCH * SSM_G; unit += F.NGW) {
        const int g = unit % SSM_G, ch = unit / SSM_G;
        S5Consts c; s5_consts(p, g, r, c);
        bf16x8 bfr[4], cfr[4];
#pragma unroll
        for (int ct = 0; ct < 4; ++ct) bfr[ct] = *(const bf16x8*)(p.bbarT + ((size_t)g * 128 + 32 * ct + r) * 16 + 8 * hi);
#pragma unroll
        for (int ks = 0; ks < 4; ++ks) cfr[ks] = *(const bf16x8*)(p.cmat + ((size_t)g * 16 + l15) * 128 + 32 * ks + 8 * l4);
        const f32x4 dsk = *(const f32x4*)(p.ssm_d + g * 16 + 4 * l4);
        float Xr[2] = {0.f, 0.f}, Xi[2] = {0.f, 0.f};
        for (int cp = 0; cp < ch; ++cp) {
#pragma unroll
            for (int s = 0; s < 2; ++s) { const f32x2 e = *(const f32x2*)(p.send + 2 * ((size_t)(cp * SSM_G + g) * 64 + 32 * s + r)); float tr, ti; cmul(Xr[s], Xi[s], c.a256r[s], c.a256i[s], tr, ti); Xr[s] = tr + e[0]; Xi[s] = ti + e[1]; } }
        for (int tl = 0; tl < S5_TC / 32; ++tl) {
            const int t0 = ch * S5_TC + tl * 32;
            f32x16 acc[4]; s5_bu(p, g, t0, r, hi, bfr, acc);
#pragma unroll
            for (int s = 0; s < 2; ++s) {
                float er[4], ei[4];
#pragma unroll
                for (int q = 0; q < 4; ++q) {
#pragma unroll
                    for (int j = 1; j < 4; ++j) { float tr, ti; cmul(acc[s][4 * q + j - 1], acc[2 + s][4 * q + j - 1], c.a1r[s], c.a1i[s], tr, ti); acc[s][4 * q + j] += tr; acc[2 + s][4 * q + j] += ti; }
                    er[q] = acc[s][4 * q + 3]; ei[q] = acc[2 + s][4 * q + 3]; }
                float cr = Xr[s], ci = Xi[s], cinr[4], cini[4];
#pragma unroll
                for (int q = 0; q < 4; ++q) { const float pr = __shfl_xor(er[q], 32), pi = __shfl_xor(ei[q], 32);
                    const float e0r = hi ? pr : er[q], e0i = hi ? pi : ei[q], e1r = hi ? er[q] : pr, e1i = hi ? ei[q] : pi;
                    float tr, ti; const float c0r = cr, c0i = ci; cmul(cr, ci, c.a4r[s], c.a4i[s], tr, ti); cr = tr + e0r; ci = ti + e0i;
                    const float c1r = cr, c1i = ci; cmul(cr, ci, c.a4r[s], c.a4i[s], tr, ti); cr = tr + e1r; ci = ti + e1i;
                    cinr[q] = hi ? c1r : c0r; cini[q] = hi ? c1i : c0i; }
                Xr[s] = cr; Xi[s] = ci;
#pragma unroll
                for (int q = 0; q < 4; ++q) { float tr, ti;
                    cmul(cinr[q], cini[q], c.a1r[s], c.a1i[s], tr, ti); acc[s][4 * q + 0] += tr; acc[2 + s][4 * q + 0] += ti;
                    cmul(cinr[q], cini[q], c.a2r[s], c.a2i[s], tr, ti); acc[s][4 * q + 1] += tr; acc[2 + s][4 * q + 1] += ti;
                    cmul(cinr[q], cini[q], c.a3r[s], c.a3i[s], tr, ti); acc[s][4 * q + 2] += tr; acc[2 + s][4 * q + 2] += ti;
                    cmul(cinr[q], cini[q], c.a4r[s], c.a4i[s], tr, ti); acc[s][4 * q + 3] += tr; acc[2 + s][4 * q + 3] += ti; }
            }
#pragma unroll
            for (int ct = 0; ct < 4; ++ct)
#pragma unroll
                for (int i = 0; i < 16; ++i) *(LAS unsigned short*)(xl + ((i & 3) + 8 * (i >> 2) + 4 * hi) * S5_XS + (32 * ct + r) * 2) = f2bf(acc[ct][i]);
            LDS_WAIT(); asm volatile("" ::: "memory");
#pragma unroll
            for (int nt = 0; nt < 2; ++nt) { f32x4 y = {0.f, 0.f, 0.f, 0.f};
#pragma unroll
                for (int ks = 0; ks < 4; ++ks) { const bf16x8 b = *(const LAS bf16x8*)(xl + (16 * nt + l15) * S5_XS + (32 * ks + 8 * l4) * 2); y = __builtin_amdgcn_mfma_f32_16x16x32_bf16(cfr[ks], b, y, 0, 0, 0); }
                const size_t off = (size_t)(t0 + 16 * nt + l15) * SSM_W + g * 16 + 4 * l4; const u32x2 uw = *(const u32x2*)(p.ub + off);
                const float y0 = y[0] + dsk[0] * bflo(uw.x), y1 = y[1] + dsk[1] * bfhi(uw.x), y2 = y[2] + dsk[2] * bflo(uw.y), y3 = y[3] + dsk[3] * bfhi(uw.y);
                u32x2 o = {cvtpk(gelu_tanh(y0), gelu_tanh(y1)), cvtpk(gelu_tanh(y2), gelu_tanh(y3))}; *(u32x2*)(p.zb + off) = o; }
            LDS_WAIT(); asm volatile("" ::: "memory");
        }
    }
}

__device__ __forceinline__ void router_phase(const Params& p, Frame& F) {
    LAS float* red = (LAS float*)F.lds; LAS float* lg = red + 8 * 32 * 33; LAS int* asg = (LAS int*)(lg + 32 * 33); LAS int* cnt = asg + 256;
    const int lane = ((int)threadIdx.x & 63), i32 = lane & 31, kh = lane >> 5, w = F.wave, tid = (int)threadIdx.x;
    for (int vb = blockIdx.x; vb < SEQ / 64; vb += F.G) {
        if (tid < 32) cnt[tid] = 0;
        for (int tl = 0; tl < 2; ++tl) {
            const int t0 = vb * 64 + tl * 32;
            f32x16 acc = {};
            const float* ap = p.x2 + (size_t)(t0 + i32) * DM + 256 * w + 4 * kh; const float* bp = p.WrT + (size_t)(256 * w + 4 * kh) * NEXP + i32;
#pragma unroll 4
            for (int q = 0; q < 32; ++q) { const f32x4 a = *(const f32x4*)(ap + 8 * q);
#pragma unroll
                for (int e = 0; e < 4; ++e) acc = __builtin_amdgcn_mfma_f32_32x32x2f32(a[e], bp[(size_t)(8 * q + e) * NEXP], acc, 0, 0, 0); }
#pragma unroll
            for (int i = 0; i < 16; ++i) red[(w * 32 + (i & 3) + 8 * (i >> 2) + 4 * kh) * 33 + i32] = acc[i];
            __syncthreads();
            for (int o = tid; o < 1024; o += 512) { const int tok = o >> 5, e = o & 31; float s = 0.f;
#pragma unroll
                for (int ww = 0; ww < 8; ++ww) s += red[(ww * 32 + tok) * 33 + e];
                lg[tok * 33 + e] = s * row_rs32g(p.ss2, t0 + tok) + p.router_b[e]; }
            __syncthreads();
            if (tid < 32) { const int tok = tid; float v[4] = {-__builtin_inff(), -__builtin_inff(), -__builtin_inff(), -__builtin_inff()}; int id[4] = {0, 0, 0, 0};
                for (int e = 0; e < 32; ++e) { float x = lg[tok * 33 + e]; int xi = e;
#pragma unroll
                    for (int k = 0; k < 4; ++k) { const bool gt = x > v[k]; const float tv = gt ? v[k] : x; const int ti = gt ? id[k] : xi; v[k] = gt ? x : v[k]; id[k] = gt ? xi : id[k]; x = tv; xi = ti; } }
                const float e1 = __builtin_expf(v[1] - v[0]), e2 = __builtin_expf(v[2] - v[0]), e3 = __builtin_expf(v[3] - v[0]); const float inv = 1.0f / (1.0f + e1 + e2 + e3);
                const size_t o4 = (size_t)(t0 + tok) * 4;
                *(f32x4*)(p.topw + o4) = (f32x4){inv, e1 * inv, e2 * inv, e3 * inv};
                p.topi[o4] = id[0]; p.topi[o4 + 1] = id[1]; p.topi[o4 + 2] = id[2]; p.topi[o4 + 3] = id[3];
#pragma unroll
                for (int k = 0; k < 4; ++k) asg[(tl * 32 + tok) * 4 + k] = id[k]; }
            __syncthreads();
        }
        if (tid < 256) { const int e = asg[tid]; int rk = 0; for (int j = 0; j < tid; ++j) rk += (asg[j] == e) ? 1 : 0;
            p.rank[(size_t)vb * 256 + tid] = rk; atomicAdd((int*)&cnt[e], 1); }
        __syncthreads();
        if (tid < 32) p.wgcnt[vb * 32 + tid] = cnt[tid];
        __syncthreads();
    }
}
__device__ __forceinline__ void assign_phase(const Params& p, Frame& F) {
    LAS int* part = (LAS int*)F.lds; LAS int* pbef = part + 512; LAS int* base = pbef + 512; LAS int* pst = base + 32; LAS int* slots = pst + 33;
    const int tid = (int)threadIdx.x, lane = ((int)threadIdx.x & 63);
    for (int vb = blockIdx.x; vb < SEQ / 64; vb += F.G) {
        { const int e = tid & 31, pr = tid >> 5; int s = 0, sb = 0;
          for (int b = pr * 16; b < pr * 16 + 16; ++b) { const int c = p.wgcnt[b * 32 + e]; s += c; sb += (b < vb) ? c : 0; }
          part[pr * 32 + e] = s; pbef[pr * 32 + e] = sb; }
        __syncthreads();
        if (tid < 32) { int tot = 0, bef = 0; for (int pr = 0; pr < 16; ++pr) { tot += part[pr * 32 + tid]; bef += pbef[pr * 32 + tid]; } part[tid] = tot; pbef[tid] = bef; }
        __syncthreads();
        if (tid == 0) { int acc = 0; for (int e = 0; e < 32; ++e) { pst[e] = acc; const int nb = (part[e] + 255) >> 8;
                if (vb == 0) for (int b = 0; b < nb; ++b) p.blke[(acc >> 8) + b] = e;
                acc += nb << 8; }
            pst[32] = acc; if (vb == 0) p.blke[MAXBLK] = acc >> 8; }
        __syncthreads();
        if (tid < 32) base[tid] = pst[tid] + pbef[tid];
        __syncthreads();
        if (tid < 256) { const int tok = vb * 64 + (tid >> 2); const int e = p.topi[(size_t)tok * 4 + (tid & 3)]; const int sl = base[e] + p.rank[(size_t)vb * 256 + tid];
            p.slot[(size_t)tok * 4 + (tid & 3)] = sl; slots[tid] = sl; }
        __syncthreads();
        for (int tk = F.wave; tk < 64; tk += NWAVES) { const int tok = vb * 64 + tk; const float* xr = p.x2 + (size_t)tok * DM; const float rs = row_rs32g(p.ss2, tok);
#pragma unroll
            for (int j = 0; j < 4; ++j) { const int c = 512 * j + 8 * lane; const f32x4 g0 = *(const f32x4*)(p.norm_moe + c), g1 = *(const f32x4*)(p.norm_moe + c + 4);
                const u32x4 o = pack8f(*(const f32x4*)(xr + c) * rs * g0, *(const f32x4*)(xr + c + 4) * rs * g1);
#pragma unroll
                for (int k = 0; k < 4; ++k) *(u32x4*)(p.xg + (size_t)slots[tk * 4 + k] * DM + c) = o; } }
        __syncthreads();
    }
}
__device__ __forceinline__ void combine_phase(const Params& p, Frame& F) {
    const int lane = ((int)threadIdx.x & 63);
    for (int tok = F.gw; tok < SEQ; tok += F.NGW) {
        const f32x4 w = *(const f32x4*)(p.topw + (size_t)tok * 4); int sl[4];
#pragma unroll
        for (int k = 0; k < 4; ++k) sl[k] = p.slot[(size_t)tok * 4 + k];
        f32x4 v[4][2]; float s = 0.f;
#pragma unroll
        for (int j = 0; j < 4; ++j) { const int c = 512 * j + 8 * lane; v[j][0] = *(const f32x4*)(p.x2 + (size_t)tok * DM + c); v[j][1] = *(const f32x4*)(p.x2 + (size_t)tok * DM + c + 4);
#pragma unroll
            for (int k = 0; k < 4; ++k) { f32x4 a, b; unpack8(*(const u32x4*)(p.orow + (size_t)sl[k] * DM + c), a, b); v[j][0] += a * w[k]; v[j][1] += b * w[k]; }
            s += sq4v(v[j][0]) + sq4v(v[j][1]); }
        const float rs = __builtin_amdgcn_rsqf(wave_sum(s) * (1.0f / DM) + EPS);
#pragma unroll
        for (int j = 0; j < 4; ++j) { const int c = 512 * j + 8 * lane;
            *(f32x4*)(p.out + (size_t)tok * DM + c) = v[j][0] * rs * *(const f32x4*)(p.final_norm + c); *(f32x4*)(p.out + (size_t)tok * DM + c + 4) = v[j][1] * rs * *(const f32x4*)(p.final_norm + c + 4); }
    }
}
template <bool ROPE, bool CAUSAL, class Refs>
__device__ __forceinline__ void attn_stream(const Refs& R, const att::Strides& T, char* lds) {
    const int n = R.count(); if (n <= 0) return;
    att::Seam<ROPE> S; att::BlockRef cur = R.ref(0);
    att::attn_prime<ROPE, CAUSAL>(cur, T, lds, S);
    for (int i = 0; i < n; ++i) { const att::BlockRef nxt = (i + 1 < n) ? R.ref(i + 1) : cur; att::attn_block<ROPE, CAUSAL>(cur, nxt, T, lds, S); cur = nxt; }
}
struct MlaRefs {
    const Params* p; int b, G;
    __device__ __forceinline__ int count() const { return b < 512 ? 2 * ((512 - b + G - 1) / G) : 0; }
    __device__ __forceinline__ att::BlockRef ref(int i) const {
        const int L = b + (i >> 1) * G, xcd = L & 7, k = L >> 3, head = (k >> 5) * 8 + xcd, y = k & 31, qb = (i & 1) ? 63 - y : y;
        att::BlockRef r; const size_t row0 = (size_t)qb * 256;
        r.Q = p->qn + row0 * DM + head * DNOPE; r.QR = p->qr + row0 * (NHEAD * DROPE) + head * DROPE; r.K = p->kn + head * DNOPE; r.KR = p->kpe; r.V = p->vv + head * DV;
        r.O = p->ymla + row0 * DM + head * DV; r.P0 = qb * 256; return r; }
};
struct XaRefs {
    const Params* p; int b, G;
    __device__ __forceinline__ int count() const { return b < 256 ? (256 - b + G - 1) / G : 0; }
    __device__ __forceinline__ att::BlockRef ref(int i) const {
        const int L = b + i * G, head = L & 3, qb = L >> 2; att::BlockRef r; const size_t row0 = (size_t)qb * 256;
        r.Q = p->qx + row0 * XW + head * 128; r.QR = nullptr; r.K = p->memkv + head * 128; r.KR = nullptr; r.V = p->memkv + XW + head * 128; r.O = p->ox + row0 * XW + head * 128; r.P0 = 0; return r; }
};

constexpr int RING_BYTES = 131072, MISC_OFF = RING_BYTES + 320, LDS_BYTES = 147456;
constexpr int NPHASE = 16;
#ifndef MK_ONE_LAUNCH
#define MK_ONE_LAUNCH 1
#endif

__global__ void __launch_bounds__(NWAVES * 64, 2) hybrid_fwd(Params p) {
    extern __shared__ __attribute__((aligned(16))) unsigned char lds[];
    Frame F;
    F.lds = (LAS unsigned char*)lds; F.wave = __builtin_amdgcn_readfirstlane((int)threadIdx.x >> 6);
    F.G = gridDim.x; { const int bx = blockIdx.x; F.vcu = (F.G % 8 == 0) ? (bx % 8) * (F.G / 8) + bx / 8 : bx; }
    F.gw = F.vcu * NWAVES + F.wave; F.NGW = F.G * NWAVES;
    volatile LAS unsigned* MISC = (volatile LAS unsigned*)(F.lds + MISC_OFF);
    for (int u = threadIdx.x; u < (LDS_BYTES - RING_BYTES) / 4; u += NWAVES * 64) ((LAS unsigned*)(F.lds + RING_BYTES))[u] = 0u;
    __syncthreads();
    const int lo = p.ph_lo, hi = p.ph_hi;
    XcdBarrier bar; bar.bar = p.ctl + 4096; bar.x = 0; bar.st = nullptr;
    if (hi - lo > 1) bar = xcd_barrier_post(p.ctl + 4096, MISC + 8);
#ifndef PHMASK
#define PHMASK 0xFFFF
#endif
#define IN(k) ((((PHMASK) >> (k)) & 1) && lo <= (k) && (k) < hi)
#define SEAM(k) do { if (IN(k) && IN((k) + 1)) xcd_barrier(bar); } while (0)
    const int G = F.G, bx = blockIdx.x;
    LAS unsigned char* ring = F.lds;

    if (IN(0)) { p0_prologue(p, F); } SEAM(0);
    if (IN(1)) { kpe_phase(p, F);
        pg8::Gemm g{p.hn, p.WinT, DM, DM, DM, 0}; pg8::StaticOrder S; S.init(SEQ, 6144, G, bx);
        pg8::EpiProj E{p.ub, p.qa, p.kva, p.sgs, p.sgm, p.qss, p.kvss}; pg8::gemm_phase(ring, g, S, E); } SEAM(1);
    if (IN(2)) { s5_pass_a(p, F);
        { pg8::Gemm g{p.qa, p.WuqT, QL, QL, QL, 0}; pg8::StaticOrder S; S.init(SEQ, 3072, G, bx); pg8::EpiQup E{p.qn, p.qr, p.qss, p.cosT, p.sinT}; pg8::gemm_phase(ring, g, S, E); }
        { pg8::Gemm g{p.kva, p.WukvT, KVL, KVL, KVL, 0}; pg8::StaticOrder S; S.init(SEQ, 4096, G, bx); pg8::EpiKVup E{p.kn, p.vv, p.kvss}; pg8::gemm_phase(ring, g, S, E); }
        { pg8::Gemm g{p.memn, p.WxkvT, DM, DM, DM, 0}; pg8::StaticOrder S; S.init(MEML, 2 * XW, G, bx); pg8::EpiPlain E{p.memkv, 2 * XW}; pg8::gemm_phase(ring, g, S, E); } } SEAM(2);
    if (IN(3)) {
#ifndef NO_S5C
        s5_pass_c(p, F); __syncthreads();
#endif
#ifndef NO_MLA
        const att::Strides T{DM, NHEAD * DROPE, DM, DM, DM, SEQ}; const MlaRefs R{&p, bx, G}; for (int i = 0, n = R.count(); i < n; ++i) att::attn_block_simple<true, true>(R.ref(i), T, (char*)lds);
#endif
    } SEAM(3);
    if (IN(4)) { pg8::Gemm g{p.zb, p.WgluT, SSM_W, SSM_W, SSM_W, 0}; pg8::StaticOrder S; S.init(SEQ, SSM_W, G, bx); pg8::EpiGlu E{p.zb, p.b_glu, p.ys}; pg8::gemm_phase(ring, g, S, E); } SEAM(4);
    if (IN(5)) { pg8::Gemm g{p.ys, p.WupsT, SSM_W, SSM_W, SSM_W, 0}; pg8::StaticOrder S; S.init(SEQ, DM, G, bx); pg8::EpiGate E{p.sgs, nullptr, p.t1}; pg8::gemm_phase(ring, g, S, E); } SEAM(5);
    if (IN(6)) { pg8::Gemm g{p.ymla, p.WupmT, DM, DM, DM, 0}; pg8::StaticOrder S; S.init(SEQ, DM, G, bx); pg8::EpiGate E{p.sgm, p.t1, p.mg}; pg8::gemm_phase(ring, g, S, E); } SEAM(6);
    if (IN(7)) { pg8::Gemm g{p.mg, p.WoutT, DM, DM, DM, 0}; pg8::StaticOrder S; S.init(SEQ, DM, G, bx); pg8::EpiResid E{p.x, p.x1, p.x1b, p.ss1}; pg8::gemm_phase(ring, g, S, E); } SEAM(7);
    if (IN(8)) { pg8::Gemm g{p.x1b, p.WxqT, DM, DM, DM, 0}; pg8::StaticOrder S; S.init(SEQ, XW, G, bx); pg8::EpiXq E{p.qx, p.ss1}; pg8::gemm_phase(ring, g, S, E); } SEAM(8);
    if (IN(9)) { const att::Strides T{XW, 0, 2 * XW, 2 * XW, XW, MEML}; const XaRefs R{&p, bx, G}; attn_stream<false, false>(R, T, (char*)lds); } SEAM(9);
    if (IN(10)) { pg8::Gemm g{p.ox, p.WxoT, XW, XW, XW, 0}; pg8::StaticOrder S; S.init(SEQ, DM, G, bx); pg8::EpiResid E{p.x1, p.x2, nullptr, p.ss2}; pg8::gemm_phase(ring, g, S, E); } SEAM(10);
    if (IN(11)) { router_phase(p, F); } SEAM(11);
    if (IN(12)) { assign_phase(p, F); } SEAM(12);
    if (IN(13)) { const int nblk = __builtin_amdgcn_readfirstlane(p.blke[MAXBLK]);
        pg8::Gemm g{p.xg, p.WguT, DM, DM, DM, (size_t)2 * DFF * DM}; pg8::MoeOrder S; S.init(nblk, 2 * DFF, G, bx, p.blke); pg8::EpiMoeGU E{p.b_gu, p.act}; pg8::gemm_phase(ring, g, S, E); } SEAM(13);
    if (IN(14)) { const int nblk = __builtin_amdgcn_readfirstlane(p.blke[MAXBLK]);
        pg8::Gemm g{p.act, p.WdnT, DFF, DFF, DFF, (size_t)DM * DFF}; pg8::MoeOrder S; S.init(nblk, DM, G, bx, p.blke); pg8::EpiMoeDown E{p.b_dn, p.orow}; pg8::gemm_phase(ring, g, S, E); } SEAM(14);
    if (IN(15)) { combine_phase(p, F); }
#undef IN
#undef SEAM
}

extern "C" void kernel_launch(void* const* d_in, const int* in_sizes, int n_in, void* d_out, int out_size, void* d_ws, size_t ws_size, hipStream_t stream) {
    static int grid = 0;
    if (grid == 0) {
        if (n_in != 37 || in_sizes[0] != SEQ * DM || out_size != SEQ * DM) { fprintf(stderr, "kernel_launch: unexpected shapes (n_in %d)\n", n_in); grid = -1; return; }
        int dev = 0, cus = 0;
        if (hipGetDevice(&dev) != hipSuccess || hipDeviceGetAttribute(&cus, hipDeviceAttributeMultiprocessorCount, dev) != hipSuccess) { grid = -1; return; }
        if (hipFuncSetAttribute((const void*)hybrid_fwd, hipFuncAttributeMaxDynamicSharedMemorySize, LDS_BYTES) != hipSuccess) { fprintf(stderr, "kernel_launch: hipFuncSetAttribute failed\n"); grid = -1; return; }
        int per_cu = 0;
        if (hipOccupancyMaxActiveBlocksPerMultiprocessor(&per_cu, (const void*)hybrid_fwd, NWAVES * 64, LDS_BYTES) != hipSuccess || per_cu < 1) { fprintf(stderr, "kernel_launch: occupancy query says %d\n", per_cu); }
        (void)hipGetLastError();
        grid = cus > 0 ? cus : 256;
    }
    if (grid < 0) return;
    Params p; memset(&p, 0, sizeof(p));
    const float* const* in = (const float* const*)d_in;
    p.x = in[0]; p.mem = in[1]; p.pos = (const int*)d_in[2]; p.norm_mix = in[3]; p.w_in = in[4]; p.lam_re = in[5]; p.lam_im = in[6]; p.log_step = in[7]; p.b_re = in[8]; p.b_im = in[9];
    p.c_re = in[10]; p.c_im = in[11]; p.ssm_d = in[12]; p.w_glu = in[13]; p.b_glu = in[14]; p.q_norm = in[15]; p.w_uq = in[16]; p.kv_norm = in[17]; p.w_uk = in[18]; p.w_uv = in[19];
    p.w_up_ssm = in[20]; p.w_up_mla = in[21]; p.w_out = in[22]; p.norm_xattn = in[23]; p.norm_mem = in[24]; p.xa_wq = in[25]; p.xa_wk = in[26]; p.xa_wv = in[27]; p.xa_wo = in[28];
    p.norm_moe = in[29]; p.router_w = in[30]; p.router_b = in[31]; p.w_gu = in[32]; p.b_gu = in[33]; p.w_dn = in[34]; p.b_dn = in[35]; p.final_norm = in[36];
    p.out = (float*)d_out;
    size_t off = 0; unsigned char* ws = (unsigned char*)d_ws;
    auto take = [&](size_t bytes) { unsigned char* r = ws + off; off += (bytes + 4095) & ~(size_t)4095; return r; };
    p.ctl = (unsigned*)take(1 << 20);
    p.WinT = (bf16_t*)take((size_t)6144 * DM * 2); p.WkpeT = (bf16_t*)take((size_t)64 * DM * 2); p.WgluT = (bf16_t*)take((size_t)SSM_W * SSM_W * 2); p.WuqT = (bf16_t*)take((size_t)3072 * QL * 2);
    p.WukvT = (bf16_t*)take((size_t)4096 * KVL * 2); p.WupsT = (bf16_t*)take((size_t)DM * SSM_W * 2); p.WupmT = (bf16_t*)take((size_t)DM * DM * 2); p.WoutT = (bf16_t*)take((size_t)DM * DM * 2);
    p.WxqT = (bf16_t*)take((size_t)XW * DM * 2); p.WxkvT = (bf16_t*)take((size_t)2 * XW * DM * 2); p.WxoT = (bf16_t*)take((size_t)DM * XW * 2);
    p.WguT = (bf16_t*)take((size_t)NEXP * 2 * DFF * DM * 2); p.WdnT = (bf16_t*)take((size_t)NEXP * DM * DFF * 2); p.WrT = (float*)take((size_t)DM * NEXP * 4);
    p.hn = (bf16_t*)take((size_t)SEQ * DM * 2); p.memn = (bf16_t*)take((size_t)MEML * DM * 2); p.cosT = (float*)take((size_t)SEQ * 32 * 4); p.sinT = (float*)take((size_t)SEQ * 32 * 4);
    p.abar = (float*)take((size_t)SSM_G * SSM_P * 8); p.bbarT = (bf16_t*)take((size_t)SSM_G * 128 * 16 * 2); p.cmat = (bf16_t*)take((size_t)SSM_G * 16 * 128 * 2);
    p.ub = (bf16_t*)take((size_t)SEQ * SSM_W * 2); p.qa = (bf16_t*)take((size_t)SEQ * QL * 2); p.kva = (bf16_t*)take((size_t)SEQ * KVL * 2); p.qss = (float*)take((size_t)SEQ * 8 * 4); p.kvss = (float*)take((size_t)SEQ * 8 * 4);
    p.sgs = (bf16_t*)take((size_t)SEQ * DM * 2); p.sgm = (bf16_t*)take((size_t)SEQ * DM * 2); p.kpe = (bf16_t*)take((size_t)SEQ * DROPE * 2);
    p.qn = (bf16_t*)take((size_t)SEQ * DM * 2); p.qr = (bf16_t*)take((size_t)SEQ * NHEAD * DROPE * 2); p.kn = (bf16_t*)take((size_t)SEQ * DM * 2); p.vv = (bf16_t*)take((size_t)SEQ * DM * 2); p.ymla = (bf16_t*)take((size_t)SEQ * DM * 2);
    p.send = (float*)take((size_t)S5_NCH * SSM_G * 64 * 8); p.zb = (bf16_t*)take((size_t)SEQ * SSM_W * 2); p.ys = (bf16_t*)take((size_t)SEQ * SSM_W * 2); p.t1 = (bf16_t*)take((size_t)SEQ * DM * 2); p.mg = (bf16_t*)take((size_t)SEQ * DM * 2);
    p.x1 = (float*)take((size_t)SEQ * DM * 4); p.x1b = (bf16_t*)take((size_t)SEQ * DM * 2); p.ss1 = (float*)take((size_t)SEQ * 32 * 4);
    p.memkv = (bf16_t*)take((size_t)MEML * 2 * XW * 2); p.qx = (bf16_t*)take((size_t)SEQ * XW * 2); p.ox = (bf16_t*)take((size_t)SEQ * XW * 2);
    p.x2 = (float*)take((size_t)SEQ * DM * 4); p.ss2 = (float*)take((size_t)SEQ * 32 * 4);
    p.topi = (int*)take((size_t)SEQ * 4 * 4); p.topw = (float*)take((size_t)SEQ * 4 * 4); p.rank = (int*)take((size_t)SEQ * 4 * 4); p.slot = (int*)take((size_t)SEQ * 4 * 4); p.wgcnt = (int*)take((size_t)256 * 32 * 4); p.blke = (int*)take((size_t)(MAXBLK + 8) * 4);
    p.xg = (bf16_t*)take((size_t)NSLOT * DM * 2); p.act = (bf16_t*)take((size_t)NSLOT * DFF * 2); p.orow = (bf16_t*)take((size_t)NSLOT * DM * 2);
    if (off > ws_size) { fprintf(stderr, "kernel_launch: workspace too small: need %zu have %zu\n", off, ws_size); return; }
    (void)hipMemsetAsync(p.ctl, 0, 1 << 20, stream);
#if MK_ONE_LAUNCH
    p.ph_lo = 0; p.ph_hi = NPHASE;
    hipLaunchKernelGGL(hybrid_fwd, dim3(grid), dim3(NWAVES * 64), LDS_BYTES, stream, p);
#else
    for (int k = 0; k < NPHASE; ++k) { p.ph_lo = k; p.ph_hi = k + 1; hipLaunchKernelGGL(hybrid_fwd, dim3(grid), dim3(NWAVES * 64), LDS_BYTES, stream, p); }
#endif
}
```

```cpp
#include <hip/hip_runtime.h>
#include <cstdio>
#include <cstdint>
#include <cstring>

#define LAS __attribute__((address_space(3)))
#define GAS __attribute__((address_space(1)))
typedef unsigned short bf16_t;
typedef short bf16x8 __attribute__((ext_vector_type(8)));
typedef short s16x4 __attribute__((ext_vector_type(4)));
typedef float f32x4 __attribute__((ext_vector_type(4)));
typedef float f32x2 __attribute__((ext_vector_type(2)));
typedef float f32x16 __attribute__((ext_vector_type(16)));
typedef unsigned u32x4 __attribute__((ext_vector_type(4)));
typedef unsigned u32x2 __attribute__((ext_vector_type(2)));
typedef GAS unsigned gu32;

constexpr int SEQ = 16384, DM = 2048;
constexpr int SSM_W = 1024, SSM_G = 64, SSM_P = 64, SSM_H = 16;
constexpr int QL = 512, KVL = 512, NHEAD = 16, DNOPE = 128, DROPE = 64, DV = 128;
constexpr int IN_COLS = 6208;
constexpr int MEML = 256, XH = 4, XW = 512;
constexpr int NEXP = 32, TOPK = 4, DFF = 2048;
constexpr int NSLOT = SEQ * TOPK + NEXP * 256;
constexpr int MAXBLK = NSLOT / 256;
constexpr float EPS = 1e-6f;
constexpr int NWAVES = 8;

#define LDS_WAIT() asm volatile("s_waitcnt lgkmcnt(0)" ::: "memory")
#define VM_WAIT() asm volatile("s_waitcnt vmcnt(0)" ::: "memory")
#define SBAR() __builtin_amdgcn_sched_barrier(0)
__device__ __forceinline__ unsigned cvtpk(float lo, float hi) { unsigned r; asm volatile("v_cvt_pk_bf16_f32 %0, %1, %2" : "=v"(r) : "v"(lo), "v"(hi)); return r; }
__device__ __forceinline__ float bf2f(unsigned short b) { return __uint_as_float(((unsigned)b) << 16); }
__device__ __forceinline__ float bflo(unsigned w) { return __uint_as_float(w << 16); }
__device__ __forceinline__ float bfhi(unsigned w) { return __uint_as_float(w & 0xffff0000u); }
__device__ __forceinline__ unsigned short f2bf(float f) { return (unsigned short)(cvtpk(f, f) & 0xffffu); }
__device__ __forceinline__ u32x4 pack8f(f32x4 a, f32x4 b) { u32x4 w = {cvtpk(a[0], a[1]), cvtpk(a[2], a[3]), cvtpk(b[0], b[1]), cvtpk(b[2], b[3])}; return w; }
__device__ __forceinline__ void unpack8(u32x4 w, f32x4& a, f32x4& b) { a = (f32x4){bflo(w.x), bfhi(w.x), bflo(w.y), bfhi(w.y)}; b = (f32x4){bflo(w.z), bfhi(w.z), bflo(w.w), bfhi(w.w)}; }
__device__ __forceinline__ float fsigmoid(float x) { return __builtin_amdgcn_rcpf(1.0f + __builtin_amdgcn_exp2f(-1.4426950408889634f * x)); }
__device__ __forceinline__ float gelu_tanh(float x) {
    const float u = 0.7978845608028654f * (x + 0.044715f * x * x * x);
    return x * fsigmoid(2.0f * u);
}
__device__ __forceinline__ float wave_sum(float v) {
#pragma unroll
    for (int o = 1; o < 64; o <<= 1) v += __shfl_xor(v, o);
    return v;
}

#define XB_TMO      128
#define XB_XCNT(j)  (256  + 64 * (j))
#define XB_XSUB(j)  (1280 + 64 * (j))
#define XB_XGEN(j)  (2304 + 64 * (j))
#define XB_TOP      3328
#define XB_TOPGEN   3392
#define XCD_BAR_WORDS 3456
#define XB_SPIN_CAP (1u << 18)
__device__ __forceinline__ unsigned xb_ld(unsigned* p)              { return __hip_atomic_load(p, __ATOMIC_RELAXED, __HIP_MEMORY_SCOPE_AGENT); }
__device__ __forceinline__ unsigned xb_add(unsigned* p, unsigned v) { return __hip_atomic_fetch_add(p, v, __ATOMIC_RELAXED, __HIP_MEMORY_SCOPE_AGENT); }
__device__ __forceinline__ unsigned xb_xcc_id() { return (unsigned)__builtin_amdgcn_s_getreg((3 << 11) | 20) & 0xFu; }
#define XB_SPIN(cond, bar) do { unsigned _sp = 0; while (cond) { __builtin_amdgcn_s_sleep(1); \
    if ((++_sp & 255u) == 0u) { if (xb_ld(&(bar)[XB_TMO])) break; if (_sp > XB_SPIN_CAP) { atomicAdd(&(bar)[XB_TMO], 1u); break; } } } } while (0)
struct XcdBarrier { unsigned* bar; unsigned x; volatile LAS unsigned* st; };
__device__ __forceinline__ XcdBarrier xcd_barrier_post(unsigned* bar, volatile LAS unsigned* st) {
    XcdBarrier b; b.bar = bar; b.x = xb_xcc_id(); b.st = st;
    if (threadIdx.x == 0) (void)xb_add(&bar[XB_XCNT(b.x)], 1u);
    return b;
}
__device__ __forceinline__ void xcd_barrier_complete(unsigned* bar, unsigned x, unsigned& nloc, unsigned& nx) {
    const unsigned G = gridDim.x * gridDim.y * gridDim.z;
    unsigned sum, cnt, mine, sp = 0u;
    for (;;) {
        sum = 0u; cnt = 0u; mine = 0u;
#pragma unroll
        for (unsigned j = 0; j < 16; ++j) { const unsigned c = xb_ld(&bar[XB_XCNT(j)]); sum += c; cnt += (c > 0u) ? 1u : 0u; mine = (j == x) ? c : mine; }
        if (sum == G) break;
        __builtin_amdgcn_s_sleep(1);
        if ((++sp & 255u) == 0u) { if (xb_ld(&bar[XB_TMO])) break; if (sp > XB_SPIN_CAP) { atomicAdd(&bar[XB_TMO], 1u); break; } }
    }
    nloc = mine > 0u ? mine : 1u; nx = cnt > 0u ? cnt : 1u;
}
__device__ __forceinline__ void xcd_barrier(const XcdBarrier& b) {
    asm volatile("s_waitcnt vmcnt(0)" ::: "memory");
    __syncthreads();
    if (threadIdx.x == 0) {
        unsigned* bar = b.bar;
        __builtin_amdgcn_s_waitcnt(0);
        unsigned nloc = b.st[0], nx = b.st[1];
        if (nloc == 0u) { xcd_barrier_complete(bar, b.x, nloc, nx); b.st[0] = nloc; b.st[1] = nx; }
        const unsigned old = xb_add(&bar[XB_XSUB(b.x)], 1u);
        const unsigned gen = old / nloc;
        if (old + 1u == (gen + 1u) * nloc) {
            __builtin_amdgcn_fence(__ATOMIC_RELEASE, "agent");
            asm volatile("s_waitcnt vmcnt(0)" ::: "memory");
            const unsigned og = xb_add(&bar[XB_TOP], 1u);
            const unsigned tg = og / nx;
            if (og + 1u == (tg + 1u) * nx) xb_add(&bar[XB_TOPGEN], 1u);
            else XB_SPIN(xb_ld(&bar[XB_TOPGEN]) == tg, bar);
            __builtin_amdgcn_fence(__ATOMIC_ACQUIRE, "agent");
            xb_add(&bar[XB_XGEN(b.x)], 1u);
            asm volatile("s_waitcnt vmcnt(0)" ::: "memory");
        } else {
            XB_SPIN(xb_ld(&bar[XB_XGEN(b.x)]) == gen, bar);
            __builtin_amdgcn_fence(__ATOMIC_ACQUIRE, "agent");
            asm volatile("s_waitcnt vmcnt(0)" ::: "memory");
        }
    }
    __syncthreads();
}
namespace pg8 {
constexpr int BM = 256, BK = 64, HALF = 128, HTB = HALF * BK * 2, NXCD = 8, WGM = 8;
__host__ __device__ __forceinline__ int lds_byte(int r, int c) { const int st = (r >> 4) * 2 + (c >> 5), rr = r & 15, cc = c & 31, ob = rr * 64 + cc * 2; return st * 1024 + (ob ^ (((ob >> 9) & 1) << 5)); }
__host__ __device__ __forceinline__ void stage_rc(int b, int& R, int& C) { const int st = b / 1024, sb = b % 1024, swz = sb ^ (((sb >> 9) & 1) << 5); R = (st >> 1) * 16 + swz / 64; C = (st & 1) * 32 + (swz % 64) / 2; }
__host__ __device__ __forceinline__ int perm32(int rho) { const int n = rho >> 4, i = rho & 15; return 8 * (i >> 2) + 4 * n + (i & 3); }

struct Unit { int pm, pn, e; };
struct Gemm { const bf16_t* A; const bf16_t* Bt; int lda, ldb, K; size_t bstride; };

struct StaticOrder {
    int nM, nN, nwg, G, c;
    __device__ void init(int M, int N, int G_, int c_) { nM = M / BM; nN = N / BM; nwg = nM * nN; G = G_; c = c_; }
    __device__ bool next(int i, Unit& u) const {
        const long L = (long)i * G + c; if (L >= nwg) return false;
        int wgid = (int)L; { const int q = nwg / NXCD, r = nwg % NXCD, xcd = wgid % NXCD, off = wgid / NXCD; wgid = (xcd < r ? xcd * (q + 1) : r * (q + 1) + (xcd - r) * q) + off; }
        const int nig = WGM * nN, gid = wgid / nig, fm = gid * WGM, gsz = (nM - fm) < WGM ? (nM - fm) : WGM;
        u.pm = fm + ((wgid % nig) % gsz); u.pn = (wgid % nig) / gsz; u.e = 0; return true;
    }
};
struct MoeOrder {
    StaticOrder so; const int* blk_e;
    __device__ void init(int nblk, int N, int G_, int c_, const int* be) { so.nM = nblk; so.nN = N / BM; so.nwg = so.nM * so.nN; so.G = G_; so.c = c_; blk_e = be; }
    __device__ bool next(int i, Unit& u) const { if (!so.next(i, u)) return false; u.e = __builtin_amdgcn_readfirstlane(blk_e[u.pm]); return true; }
};

template <class Epi, class Sched>
__device__ __forceinline__ void gemm_phase(LAS unsigned char* lds, const Gemm g, const Sched& S, const Epi& E) {
    constexpr bool ALIGN_EPI = true;
    const int tid = threadIdx.x, wid = __builtin_amdgcn_readfirstlane(tid >> 6), lane = tid & 63, wr = wid >> 2, wc = wid & 3, fr = lane & 15, fq = lane >> 4;
    const int K = g.K, nt = K / BK;
    unsigned voffA[2], voffB[2];
#pragma unroll
    for (int i = 0; i < 2; ++i) { int R, C; stage_rc(tid * 16 + i * 8192, R, C); const int Rb = Epi::PERM ? ((R & ~31) + perm32(R & 31)) : R;
        voffA[i] = (unsigned)(R * g.lda + C) * 2u; voffB[i] = (unsigned)(Rb * g.ldb + C) * 2u; }
    const size_t kstep = (size_t)(BK * 2);
    const size_t hstepA = (size_t)HALF * g.lda * 2, hstepB = (size_t)HALF * g.ldb * 2;
    const unsigned ldsw = (unsigned)wid * 1024u;
    const int aoff = lds_byte(wr * 64 + fr, fq * 8), boff = lds_byte(wc * 32 + fr, fq * 8);
#define PG8_SA(b, h) (((b) * 2 + (h)) * HTB)
#define PG8_SB(b, h) ((4 + (b) * 2 + (h)) * HTB)
#define PG8_STAGE(bufoff, gbase, voff) do { _Pragma("unroll") for (int _i = 0; _i < 2; ++_i) \
        __builtin_amdgcn_global_load_lds((const unsigned*)((const char*)(gbase) + (voff)[_i]), (LAS unsigned*)(lds + (bufoff) + ldsw + _i * 8192), 16, 0, 0); } while (0)
#define PG8_LDA(dst, b, h) do { _Pragma("unroll") for (int m = 0; m < 4; ++m) _Pragma("unroll") for (int k = 0; k < 2; ++k) dst[m][k] = *(const LAS bf16x8*)(lds + PG8_SA(b, h) + aoff + m * 2048 + k * 1024); } while (0)
#define PG8_LDB(dst, b, h) do { _Pragma("unroll") for (int n = 0; n < 2; ++n) _Pragma("unroll") for (int k = 0; k < 2; ++k) dst[n][k] = *(const LAS bf16x8*)(lds + PG8_SB(b, h) + boff + n * 2048 + k * 1024); } while (0)
#define PG8_MMA(ai, bj, At, Bt) do { __builtin_amdgcn_s_setprio(1); _Pragma("unroll") for (int m = 0; m < 4; ++m) _Pragma("unroll") for (int n = 0; n < 2; ++n) _Pragma("unroll") for (int k = 0; k < 2; ++k) \
        acc[ai][bj][m][n] = __builtin_amdgcn_mfma_f32_16x16x32_bf16(Bt[n][k], At[m][k], acc[ai][bj][m][n], 0, 0, 0); __builtin_amdgcn_s_setprio(0); } while (0)
#define PG8_WAIT_V(n) asm volatile("s_waitcnt vmcnt(" #n ")" ::: "memory")
#define PG8_WAIT_L(n) asm volatile("s_waitcnt lgkmcnt(" #n ")" ::: "memory")
#define PG8_BAR __builtin_amdgcn_s_barrier()
#define PG8_SCHED __builtin_amdgcn_sched_barrier(0)
#define PG8_ABASE(u) ((const char*)g.A + (size_t)(u).pm * BM * g.lda * 2)
#define PG8_BBASE(u) ((const char*)g.Bt + ((size_t)(u).e * g.bstride + (size_t)(u).pn * BM * g.ldb) * 2)
    Unit cur, nxt; int ui = 0;
    if (!S.next(0, cur)) return;
    f32x4 acc[2][2][4][2];
#pragma unroll
    for (int a = 0; a < 2; ++a)
#pragma unroll
        for (int b = 0; b < 2; ++b)
#pragma unroll
            for (int m = 0; m < 4; ++m)
#pragma unroll
                for (int n = 0; n < 2; ++n) acc[a][b][m][n] = (f32x4){0.f, 0.f, 0.f, 0.f};
    bf16x8 At[4][2], B0[2][2], B1[2][2];
    const char* cA = PG8_ABASE(cur); const char* cB = PG8_BBASE(cur);
    PG8_STAGE(PG8_SB(0, 0), cB, voffB); PG8_STAGE(PG8_SB(0, 1), cB + hstepB, voffB); PG8_STAGE(PG8_SA(0, 0), cA, voffA); PG8_STAGE(PG8_SA(0, 1), cA + hstepA, voffA);
    if (wr == 1) PG8_BAR;
    PG8_WAIT_V(2); PG8_BAR;
    PG8_STAGE(PG8_SB(1, 0), cB + kstep, voffB); PG8_STAGE(PG8_SA(1, 0), cA + kstep, voffA); PG8_STAGE(PG8_SB(1, 1), cB + hstepB + kstep, voffB);
    PG8_WAIT_V(6); PG8_BAR;
    for (;;) {
        const bool has_next = S.next(ui + 1, nxt);
        const char* nA = has_next ? PG8_ABASE(nxt) : cA; const char* nB = has_next ? PG8_BBASE(nxt) : cB;
        for (int t = 0; t < nt; t += 2) {
            const bool last = (t == nt - 2);
            const char* a1 = cA + (size_t)(t + 1) * kstep;
            const char* a2 = last ? nA : cA + (size_t)(t + 2) * kstep; const char* b2 = last ? nB : cB + (size_t)(t + 2) * kstep;
            const char* a3 = a2 + kstep; const char* b3 = b2 + kstep;
            PG8_LDB(B0, 0, 0); PG8_LDB(B1, 0, 1); PG8_SCHED; PG8_LDA(At, 0, 0); PG8_STAGE(PG8_SA(1, 1), a1 + hstepA, voffA);
            PG8_WAIT_V(8); PG8_WAIT_L(0); PG8_BAR; PG8_MMA(0, 0, At, B0); PG8_MMA(0, 1, At, B1); PG8_BAR; PG8_SCHED;
            PG8_LDA(At, 0, 1); PG8_STAGE(PG8_SB(0, 0), b2, voffB); PG8_STAGE(PG8_SB(0, 1), b2 + hstepB, voffB); PG8_STAGE(PG8_SA(0, 0), a2, voffA);
            PG8_WAIT_V(8); PG8_WAIT_L(0); PG8_BAR; PG8_MMA(1, 0, At, B0); PG8_MMA(1, 1, At, B1); PG8_BAR; PG8_SCHED;
            PG8_LDB(B0, 1, 0); PG8_LDB(B1, 1, 1); PG8_SCHED; PG8_LDA(At, 1, 0); PG8_STAGE(PG8_SA(0, 1), a2 + hstepA, voffA);
            PG8_WAIT_V(8); PG8_WAIT_L(0); PG8_BAR; PG8_MMA(0, 0, At, B0); PG8_MMA(0, 1, At, B1); PG8_BAR; PG8_SCHED;
            PG8_LDA(At, 1, 1); PG8_STAGE(PG8_SB(1, 0), b3, voffB); PG8_STAGE(PG8_SB(1, 1), b3 + hstepB, voffB); PG8_STAGE(PG8_SA(1, 0), a3, voffA);
            PG8_WAIT_V(8); PG8_WAIT_L(0); PG8_BAR; PG8_MMA(1, 0, At, B0); PG8_MMA(1, 1, At, B1); PG8_BAR; PG8_SCHED;
        }
        if constexpr (ALIGN_EPI) { if (wr == 0) PG8_BAR; }
        E(acc, cur, wr, wc, fr, fq);
        if (!has_next) break;
#pragma unroll
        for (int a = 0; a < 2; ++a)
#pragma unroll
            for (int b = 0; b < 2; ++b)
#pragma unroll
                for (int m = 0; m < 4; ++m)
#pragma unroll
                    for (int n = 0; n < 2; ++n) acc[a][b][m][n] = (f32x4){0.f, 0.f, 0.f, 0.f};
        cur = nxt; cA = nA; cB = nB; ++ui;
        if constexpr (ALIGN_EPI) { if (wr == 1) PG8_BAR; }
    }
    PG8_WAIT_V(0);
    if constexpr (!ALIGN_EPI) { if (wr == 0) PG8_BAR; }
    PG8_BAR;
#undef PG8_SA
#undef PG8_SB
#undef PG8_STAGE
#undef PG8_LDA
#undef PG8_LDB
#undef PG8_MMA
#undef PG8_WAIT_V
#undef PG8_WAIT_L
#undef PG8_BAR
#undef PG8_SCHED
#undef PG8_ABASE
#undef PG8_BBASE
}

#define EPI_ROW(u, ai, m) ((u).pm * BM + (ai) * HALF + wr * 64 + (m) * 16 + fr)
#define EPI_CB(bj) ((bj) * HALF + wc * 32 + 8 * fq)
typedef f32x4 AccT[2][2][4][2];

__device__ __forceinline__ f32x4 sig4(f32x4 v) { return (f32x4){fsigmoid(v[0]), fsigmoid(v[1]), fsigmoid(v[2]), fsigmoid(v[3])}; }
__device__ __forceinline__ float sq4(f32x4 v) { return (v[0] * v[0] + v[1] * v[1]) + (v[2] * v[2] + v[3] * v[3]); }

struct EpiProj {
    static constexpr bool PERM = true;
    bf16_t *ub, *qa, *kva, *sgs, *sgm; float *qss, *kvss;
    __device__ __forceinline__ void operator()(const AccT& acc, const Unit& u, int wr, int wc, int fr, int fq) const {
        const int pn = u.pn; bf16_t* dst; int ld, c0; float* ss = nullptr; int ssl = 0; bool sg = false;
        if (pn < 4) { dst = ub; ld = SSM_W; c0 = pn * BM; }
        else if (pn < 6) { dst = qa; ld = QL; c0 = (pn - 4) * BM; ss = qss; ssl = (pn - 4) * 4 + wc; }
        else if (pn < 8) { dst = kva; ld = KVL; c0 = (pn - 6) * BM; ss = kvss; ssl = (pn - 6) * 4 + wc; }
        else if (pn < 16) { dst = sgs; ld = DM; c0 = (pn - 8) * BM; sg = true; }
        else { dst = sgm; ld = DM; c0 = (pn - 16) * BM; sg = true; }
#pragma unroll
        for (int ai = 0; ai < 2; ++ai)
#pragma unroll
            for (int m = 0; m < 4; ++m) { const int row = EPI_ROW(u, ai, m); float s = 0.f;
#pragma unroll
                for (int bj = 0; bj < 2; ++bj) { f32x4 v0 = acc[ai][bj][m][0], v1 = acc[ai][bj][m][1];
                    if (sg) { v0 = sig4(v0); v1 = sig4(v1); }
                    s += sq4(v0) + sq4(v1);
                    *(u32x4*)(dst + (size_t)row * ld + c0 + EPI_CB(bj)) = pack8f(v0, v1); }
                if (ss) { s += __shfl_xor(s, 16); s += __shfl_xor(s, 32); if (fq == 0) ss[((size_t)(ssl >> 2) * SEQ + row) * 4 + (ssl & 3)] = s; } }
    }
};
__device__ __forceinline__ float row_rs8(const float* ss, int row, float invn) { const f32x4 a = *(const f32x4*)(ss + (size_t)row * 4), b = *(const f32x4*)(ss + ((size_t)SEQ + row) * 4);
    return __builtin_amdgcn_rsqf(((a[0] + a[1]) + (a[2] + a[3]) + (b[0] + b[1]) + (b[2] + b[3])) * invn + EPS); }
__device__ __forceinline__ float row_rs32(const float* ss, int row, float invn) { float s = 0.f;
#pragma unroll
    for (int i = 0; i < 8; ++i) { const f32x4 a = *(const f32x4*)(ss + ((size_t)i * SEQ + row) * 4); s += (a[0] + a[1]) + (a[2] + a[3]); }
    return __builtin_amdgcn_rsqf(s * invn + EPS); }

struct EpiQup {
    static constexpr bool PERM = true;
    bf16_t *qn, *qr; const float *ss, *cosT, *sinT;
    __device__ __forceinline__ void operator()(const AccT& acc, const Unit& u, int wr, int wc, int fr, int fq) const {
        const int pn = u.pn;
#pragma unroll
        for (int ai = 0; ai < 2; ++ai)
#pragma unroll
            for (int m = 0; m < 4; ++m) { const int row = EPI_ROW(u, ai, m); const float rs = row_rs8(ss, row, 1.0f / QL);
                if (pn < 8) {
#pragma unroll
                    for (int bj = 0; bj < 2; ++bj) *(u32x4*)(qn + (size_t)row * DM + pn * BM + EPI_CB(bj)) = pack8f(acc[ai][bj][m][0] * rs, acc[ai][bj][m][1] * rs);
                } else {
                    const int head = 4 * (pn - 8) + wc;
                    const f32x4 c0 = *(const f32x4*)(cosT + (size_t)row * 32 + 8 * fq), c1 = *(const f32x4*)(cosT + (size_t)row * 32 + 8 * fq + 4);
                    const f32x4 s0 = *(const f32x4*)(sinT + (size_t)row * 32 + 8 * fq), s1 = *(const f32x4*)(sinT + (size_t)row * 32 + 8 * fq + 4);
                    const f32x4 a0 = acc[ai][0][m][0] * rs, a1 = acc[ai][0][m][1] * rs, b0 = acc[ai][1][m][0] * rs, b1 = acc[ai][1][m][1] * rs;
                    *(u32x4*)(qr + (size_t)row * (NHEAD * DROPE) + head * DROPE + 8 * fq) = pack8f(a0 * c0 - b0 * s0, a1 * c1 - b1 * s1);
                    *(u32x4*)(qr + (size_t)row * (NHEAD * DROPE) + head * DROPE + 32 + 8 * fq) = pack8f(a0 * s0 + b0 * c0, a1 * s1 + b1 * c1);
                } }
    }
};
struct EpiKVup {
    static constexpr bool PERM = true;
    bf16_t *kn, *vv; const float* ss;
    __device__ __forceinline__ void operator()(const AccT& acc, const Unit& u, int wr, int wc, int fr, int fq) const {
        bf16_t* dst = u.pn < 8 ? kn : vv; const int c0 = (u.pn & 7) * BM;
#pragma unroll
        for (int ai = 0; ai < 2; ++ai)
#pragma unroll
            for (int m = 0; m < 4; ++m) { const int row = EPI_ROW(u, ai, m); const float rs = row_rs8(ss, row, 1.0f / KVL);
#pragma unroll
                for (int bj = 0; bj < 2; ++bj) *(u32x4*)(dst + (size_t)row * DM + c0 + EPI_CB(bj)) = pack8f(acc[ai][bj][m][0] * rs, acc[ai][bj][m][1] * rs); }
    }
};
struct EpiPlain {
    static constexpr bool PERM = true;
    bf16_t* O; int ld;
    __device__ __forceinline__ void operator()(const AccT& acc, const Unit& u, int wr, int wc, int fr, int fq) const {
#pragma unroll
        for (int ai = 0; ai < 2; ++ai)
#pragma unroll
            for (int m = 0; m < 4; ++m) { const int row = EPI_ROW(u, ai, m);
#pragma unroll
                for (int bj = 0; bj < 2; ++bj) *(u32x4*)(O + (size_t)row * ld + u.pn * BM + EPI_CB(bj)) = pack8f(acc[ai][bj][m][0], acc[ai][bj][m][1]); }
    }
};
struct EpiGlu {
    static constexpr bool PERM = true;
    const bf16_t* z; const float* bias; bf16_t* ys;
    __device__ __forceinline__ void operator()(const AccT& acc, const Unit& u, int wr, int wc, int fr, int fq) const {
#pragma unroll
        for (int bj = 0; bj < 2; ++bj) { const int col = u.pn * BM + EPI_CB(bj); const f32x4 b0 = *(const f32x4*)(bias + col), b1 = *(const f32x4*)(bias + col + 4);
#pragma unroll
            for (int ai = 0; ai < 2; ++ai)
#pragma unroll
                for (int m = 0; m < 4; ++m) { const size_t off = (size_t)EPI_ROW(u, ai, m) * SSM_W + col; f32x4 z0, z1; unpack8(*(const u32x4*)(z + off), z0, z1);
                    *(u32x4*)(ys + off) = pack8f(z0 * sig4(acc[ai][bj][m][0] + b0), z1 * sig4(acc[ai][bj][m][1] + b1)); } }
    }
};
struct EpiGate {
    static constexpr bool PERM = true;
    const bf16_t* gate; const bf16_t* addend; bf16_t* O;
    __device__ __forceinline__ void operator()(const AccT& acc, const Unit& u, int wr, int wc, int fr, int fq) const {
#pragma unroll
        for (int ai = 0; ai < 2; ++ai)
#pragma unroll
            for (int m = 0; m < 4; ++m)
#pragma unroll
                for (int bj = 0; bj < 2; ++bj) { const size_t off = (size_t)EPI_ROW(u, ai, m) * DM + u.pn * BM + EPI_CB(bj); f32x4 g0, g1; unpack8(*(const u32x4*)(gate + off), g0, g1);
                    f32x4 r0 = g0 * acc[ai][bj][m][0], r1 = g1 * acc[ai][bj][m][1];
                    if (addend) { f32x4 t0, t1; unpack8(*(const u32x4*)(addend + off), t0, t1); r0 += t0; r1 += t1; }
                    *(u32x4*)(O + off) = pack8f(r0, r1); }
    }
};
struct EpiResid {
    static constexpr bool PERM = true;
    const float* xi; float* xo; bf16_t* xb; float* ss;
    __device__ __forceinline__ void operator()(const AccT& acc, const Unit& u, int wr, int wc, int fr, int fq) const {
#pragma unroll
        for (int ai = 0; ai < 2; ++ai)
#pragma unroll
            for (int m = 0; m < 4; ++m) { const int row = EPI_ROW(u, ai, m); float s = 0.f;
#pragma unroll
                for (int bj = 0; bj < 2; ++bj) { const size_t off = (size_t)row * DM + u.pn * BM + EPI_CB(bj);
                    const f32x4 r0 = *(const f32x4*)(xi + off) + acc[ai][bj][m][0], r1 = *(const f32x4*)(xi + off + 4) + acc[ai][bj][m][1];
                    *(f32x4*)(xo + off) = r0; *(f32x4*)(xo + off + 4) = r1; s += sq4(r0) + sq4(r1);
                    if (xb) *(u32x4*)(xb + off) = pack8f(r0, r1); }
                s += __shfl_xor(s, 16); s += __shfl_xor(s, 32); if (fq == 0) ss[((size_t)u.pn * SEQ + row) * 4 + wc] = s; }
    }
};
struct EpiXq {
    static constexpr bool PERM = true;
    bf16_t* O; const float* ss;
    __device__ __forceinline__ void operator()(const AccT& acc, const Unit& u, int wr, int wc, int fr, int fq) const {
#pragma unroll
        for (int ai = 0; ai < 2; ++ai)
#pragma unroll
            for (int m = 0; m < 4; ++m) { const int row = EPI_ROW(u, ai, m); const float rs = row_rs32(ss, row, 1.0f / DM);
#pragma unroll
                for (int bj = 0; bj < 2; ++bj) *(u32x4*)(O + (size_t)row * XW + u.pn * BM + EPI_CB(bj)) = pack8f(acc[ai][bj][m][0] * rs, acc[ai][bj][m][1] * rs); }
    }
};
struct EpiMoeGU {
    static constexpr bool PERM = true;
    const float* bias; bf16_t* act;
    __device__ __forceinline__ void operator()(const AccT& acc, const Unit& u, int wr, int wc, int fr, int fq) const {
        const int j0 = u.pn * HALF + wc * 32 + 8 * fq; const float* bg = bias + (size_t)u.e * (2 * DFF) + j0;
        const f32x4 g0 = *(const f32x4*)bg, g1 = *(const f32x4*)(bg + 4), u0 = *(const f32x4*)(bg + DFF), u1 = *(const f32x4*)(bg + DFF + 4);
#pragma unroll
        for (int ai = 0; ai < 2; ++ai)
#pragma unroll
            for (int m = 0; m < 4; ++m) { const int row = EPI_ROW(u, ai, m); f32x4 r[2];
#pragma unroll
                for (int n = 0; n < 2; ++n) { const f32x4 gt = acc[ai][0][m][n] + (n ? g1 : g0), up = acc[ai][1][m][n] + (n ? u1 : u0);
#pragma unroll
                    for (int j = 0; j < 4; ++j) { const float gc = fminf(gt[j], 7.0f), uc = fminf(fmaxf(up[j], -7.0f), 7.0f); r[n][j] = (uc + 1.0f) * (gc * fsigmoid(1.702f * gc)); } }
                *(u32x4*)(act + (size_t)row * DFF + j0) = pack8f(r[0], r[1]); }
    }
};
struct EpiMoeDown {
    static constexpr bool PERM = true;
    const float* bias; bf16_t* O;
    __device__ __forceinline__ void operator()(const AccT& acc, const Unit& u, int wr, int wc, int fr, int fq) const {
#pragma unroll
        for (int bj = 0; bj < 2; ++bj) { const int col = u.pn * BM + EPI_CB(bj); const float* bp = bias + (size_t)u.e * DM + col; const f32x4 b0 = *(const f32x4*)bp, b1 = *(const f32x4*)(bp + 4);
#pragma unroll
            for (int ai = 0; ai < 2; ++ai)
#pragma unroll
                for (int m = 0; m < 4; ++m) *(u32x4*)(O + (size_t)EPI_ROW(u, ai, m) * DM + col) = pack8f(acc[ai][bj][m][0] + b0, acc[ai][bj][m][1] + b1); }
    }
};
#undef EPI_ROW
#undef EPI_CB
}
namespace att {
constexpr int NW = 8, QBLK = 32, KVBLK = 64, QB = NW * QBLK;
constexpr int SHM_V = KVBLK * 128 * 2, SHM_K = KVBLK * 128 * 2, SHM_KR = KVBLK * 64 * 2;
constexpr int OFF_V = 0, OFF_K = 2 * SHM_V, OFF_KR = OFF_K + 2 * SHM_K, OFF_WS = OFF_KR + 2 * SHM_KR, OFF_QR = OFF_WS + NW * 64 * 4, LDS_BYTES = OFF_QR + NW * 4096;
constexpr float THR = 8.f;
#define KSWZ(row, colB) ((row) * 256 + ((colB) ^ (((row) & 7) << 4)))
__device__ __forceinline__ int v_st(int k, int c) { const int kk = (k & ~0xC) | ((k & 4) << 1) | ((k & 8) >> 1); return ((kk >> 3) * 4 + (c >> 5)) * 512 + ((kk & 7) * 32 + (c & 31)) * 2; }
__device__ __forceinline__ int v_rd_base(int lane) { return ((lane & 3) << 3) | (((lane >> 2) & 3) << 6) | (((lane >> 4) & 1) << 5) | (((lane >> 5) & 1) << 8); }
constexpr int v_rd_off(int d0, int ks, int half) { return d0 * 512 + ks * 4096 + half * 2048; }
__device__ __forceinline__ int crow(int r, int hi) { return (r & 3) + 8 * (r >> 2) + 4 * hi; }

__device__ __forceinline__ void mask_tile(f32x16& p0, f32x16& p1, int dq) {
    const float NEG = -__builtin_inff();
#pragma unroll
    for (int r = 0; r < 16; ++r) {
        const int c = (r & 3) + 8 * (r >> 2);
        if (dq - c < 0) p0[r] = NEG;
        if (dq - c - 32 < 0) p1[r] = NEG;
    }
}
template <bool ROPE>
__device__ __forceinline__ void partialSM(f32x16& p0, f32x16& p1, float& m_reg, float& mn, float& alpha) {
    constexpr float SCALE = ROPE ? 0.07216878364870323f : 0.08838834764831845f;
    float pmax = p0[0];
#pragma unroll
    for (int r = 1; r < 16; ++r) pmax = fmaxf(pmax, p0[r]);
#pragma unroll
    for (int r = 0; r < 16; ++r) pmax = fmaxf(pmax, p1[r]);
    { auto rr = __builtin_amdgcn_permlane32_swap(__float_as_uint(pmax), __float_as_uint(pmax), false, false);
      pmax = fmaxf(__uint_as_float(rr[0]), __uint_as_float(rr[1])); }
    constexpr float C2 = 1.4426950408889634f * SCALE;
    if (__builtin_expect(__all((pmax - m_reg) * SCALE <= THR), 1)) { mn = m_reg; alpha = 1.f; }
    else { mn = fmaxf(m_reg, pmax); alpha = __builtin_amdgcn_exp2f((m_reg - mn) * C2); m_reg = mn; }
    const float mnL = -mn * C2;
#pragma unroll
    for (int r = 0; r < 16; ++r) p0[r] = fmaf(p0[r], C2, mnL);
#pragma unroll
    for (int r = 0; r < 16; ++r) p1[r] = fmaf(p1[r], C2, mnL);
#pragma unroll
    for (int r = 0; r < 16; ++r) p0[r] = __builtin_amdgcn_exp2f(p0[r]);
}
__device__ __forceinline__ void finishSM(f32x16& p0, f32x16& p1, float alpha, float& l_reg, bf16x8& pa0, bf16x8& pa1, bf16x8& pa2, bf16x8& pa3) {
#pragma unroll
    for (int r = 0; r < 16; ++r) p1[r] = __builtin_amdgcn_exp2f(p1[r]);
    float ps = 0;
#pragma unroll
    for (int r = 0; r < 16; ++r) ps += p0[r];
#pragma unroll
    for (int r = 0; r < 16; ++r) ps += p1[r];
    { auto rr = __builtin_amdgcn_permlane32_swap(__float_as_uint(ps), __float_as_uint(ps), false, false);
      ps = __uint_as_float(rr[0]) + __uint_as_float(rr[1]); }
    l_reg = l_reg * alpha + ps;
#define PK4(P, B_, OUT) do { unsigned a0 = cvtpk(P[B_+0], P[B_+1]), a1 = cvtpk(P[B_+2], P[B_+3]);                          \
        unsigned b0 = cvtpk(P[B_+4], P[B_+5]), b1 = cvtpk(P[B_+6], P[B_+7]);                                             \
        auto r0 = __builtin_amdgcn_permlane32_swap(a0, b0, false, false); auto r1 = __builtin_amdgcn_permlane32_swap(a1, b1, false, false); \
        u32x4 w = {r0[0], r1[0], r0[1], r1[1]}; OUT = *reinterpret_cast<bf16x8*>(&w); } while (0)
    PK4(p0, 0, pa0); PK4(p0, 8, pa1); PK4(p1, 0, pa2); PK4(p1, 8, pa3);
#undef PK4
}
template <int KB, bool ROPE>
__device__ __forceinline__ void qkt(f32x16& p0, f32x16& p1, const char* K_lds, int r32, int hi, const bf16x8* qr, const char* qrl) {
    p0 = f32x16{}; p1 = f32x16{};
    const char* kb[4];
#pragma unroll
    for (int dd = 0; dd < 4; ++dd) kb[dd] = K_lds + KB * SHM_K + KSWZ(r32, (dd * 16 + hi * 8) * 2);
#pragma unroll
    for (int d0 = 0; d0 < 8; ++d0) { const char* a = kb[d0 & 3] + (d0 >> 2) * 128;
        bf16x8 b0 = *reinterpret_cast<const bf16x8*>(a);
        bf16x8 b1 = *reinterpret_cast<const bf16x8*>(a + 32 * 256);
        p0 = __builtin_amdgcn_mfma_f32_32x32x16_bf16(b0, qr[d0], p0, 0, 0, 0);
        p1 = __builtin_amdgcn_mfma_f32_32x32x16_bf16(b1, qr[d0], p1, 0, 0, 0); }
    if constexpr (ROPE) {
        constexpr int RO = 2 * SHM_K - KB * SHM_K + KB * SHM_KR;
#pragma unroll
        for (int d0 = 0; d0 < 4; ++d0) { const char* a = kb[d0] + RO;
            bf16x8 b0 = *reinterpret_cast<const bf16x8*>(a);
            bf16x8 b1 = *reinterpret_cast<const bf16x8*>(a + 128);
            const bf16x8 q = *reinterpret_cast<const bf16x8*>(qrl + d0 * 1024);
            p0 = __builtin_amdgcn_mfma_f32_32x32x16_bf16(b0, q, p0, 0, 0, 0);
            p1 = __builtin_amdgcn_mfma_f32_32x32x16_bf16(b1, q, p1, 0, 0, 0); }
    }
}
template <int VB>
__device__ __forceinline__ void pv_tile(f32x16* o, int vb0, bf16x8 pa0, bf16x8 pa1, bf16x8 pa2, bf16x8 pa3) {
#define TRRD(dst, off) asm volatile("ds_read_b64_tr_b16 %0, %1 offset:%2" : "=&v"(dst) : "v"(vb0), "i"(off) : "memory")
#define PV_D0(d0) do { s16x4 l0, l1, l2, l3, h0, h1, h2, h3; constexpr int b_ = VB * SHM_V + v_rd_off(d0, 0, 0);  \
        TRRD(l0, b_); TRRD(h0, b_ + 2048); TRRD(l1, b_ + 4096); TRRD(h1, b_ + 6144); TRRD(l2, b_ + 8192); TRRD(h2, b_ + 10240); TRRD(l3, b_ + 12288); TRRD(h3, b_ + 14336); \
        asm volatile("s_waitcnt lgkmcnt(0)" ::: "memory"); SBAR();   \
        o[d0] = __builtin_amdgcn_mfma_f32_32x32x16_bf16(pa0, (bf16x8){l0[0], l0[1], l0[2], l0[3], h0[0], h0[1], h0[2], h0[3]}, o[d0], 0, 0, 0);   \
        o[d0] = __builtin_amdgcn_mfma_f32_32x32x16_bf16(pa1, (bf16x8){l1[0], l1[1], l1[2], l1[3], h1[0], h1[1], h1[2], h1[3]}, o[d0], 0, 0, 0);   \
        o[d0] = __builtin_amdgcn_mfma_f32_32x32x16_bf16(pa2, (bf16x8){l2[0], l2[1], l2[2], l2[3], h2[0], h2[1], h2[2], h2[3]}, o[d0], 0, 0, 0);   \
        o[d0] = __builtin_amdgcn_mfma_f32_32x32x16_bf16(pa3, (bf16x8){l3[0], l3[1], l3[2], l3[3], h3[0], h3[1], h3[2], h3[3]}, o[d0], 0, 0, 0); } while (0)
    PV_D0(0); PV_D0(1); PV_D0(2); PV_D0(3);
#undef PV_D0
#undef TRRD
}

struct BlockRef { const bf16_t* Q; const bf16_t* QR; const bf16_t* K; const bf16_t* KR; const bf16_t* V; bf16_t* O; int P0; };
struct Strides { int qs, qrs, ks, vs, os, skv; };
template <bool ROPE> struct Seam { bf16x8 qr[ROPE ? 12 : 8];     bf16x8 st_v0, st_v1, st_k0, st_k1, st_kr; };
#define LD8(p) (*reinterpret_cast<const bf16x8*>(p))
#define VMW() asm volatile("s_waitcnt vmcnt(0)" ::: "memory")
#define VMWN(n) asm volatile("s_waitcnt vmcnt(%0)" :: "i"(n) : "memory")
#define SLOAD_H(R, k0) do { const char* vb_ = (const char*)(R).V + (size_t)(k0) * T.vs * 2; const char* kb_ = (const char*)(R).K + (size_t)(k0) * T.ks * 2;   \
                            S.st_v0 = LD8(vb_ + vo_v); S.st_v1 = LD8(vb_ + (size_t)T.vs * 64 + vo_v);              \
                            S.st_k0 = LD8(kb_ + vo_k); S.st_k1 = LD8(kb_ + (size_t)T.ks * 64 + vo_k);              \
                            if constexpr (ROPE) S.st_kr = LD8((const char*)(R).KR + (size_t)(k0) * (DROPE * 2) + vo_kr); } while (0)
#define SWRITE_HK(bf) do { *(bf16x8*)(K_lds + (bf) * SHM_K + kws) = S.st_k0; *(bf16x8*)(K_lds + (bf) * SHM_K + kws + 32 * 256) = S.st_k1;                \
                           if constexpr (ROPE) *(bf16x8*)(K_lds + 2 * SHM_K + (bf) * SHM_KR + krws) = S.st_kr; } while (0)
#define SWRITE_HV(bf) do { *(bf16x8*)(V_lds + (bf) * SHM_V + vst0) = S.st_v0; *(bf16x8*)(V_lds + (bf) * SHM_V + vst1) = S.st_v1; } while (0)
#define SWRITE_H(bf) do { SWRITE_HV(bf); SWRITE_HK(bf); } while (0)
#define QLOAD(R) do { const char* qb_ = (const char*)(R).Q + (size_t)(wid * QBLK) * T.qs * 2; const unsigned qo_ = (unsigned)(r32 * T.qs + hi * 8) * 2u;    \
                      _Pragma("unroll") for (int d0 = 0; d0 < 8; ++d0) S.qr[d0] = LD8(qb_ + qo_ + d0 * 32);    \
                      if constexpr (ROPE) { const char* qrb_ = (const char*)(R).QR + (size_t)(wid * QBLK) * T.qrs * 2; const unsigned qro_ = (unsigned)(r32 * T.qrs + hi * 8) * 2u;   \
                          _Pragma("unroll") for (int d0 = 0; d0 < 4; ++d0) S.qr[8 + d0] = LD8(qrb_ + qro_ + d0 * 32); } } while (0)
#define QPARK() do { if constexpr (ROPE) { _Pragma("unroll") for (int d0 = 0; d0 < 4; ++d0) *(bf16x8*)(qrl + d0 * 1024) = S.qr[8 + d0]; } } while (0)
#define STAGE_IDX() const int sr = tid >> 4, sc = (tid & 15) * 8, kws = KSWZ(sr, sc * 2); \
                    const int rk = tid >> 3, rc = tid & 7, krws = (rk & 31) * 256 + ((((rk >> 5) * 8 + rc) * 16) ^ (((rk & 31) & 7) << 4)); \
                    const unsigned vo_v = (unsigned)(sr * T.vs + sc) * 2u, vo_k = (unsigned)(sr * T.ks + sc) * 2u, vo_kr = (unsigned)(rk * DROPE + rc * 8) * 2u

template <bool ROPE, bool CAUSAL>
__device__ __forceinline__ void attn_prime(const BlockRef& cur, const Strides& T, char* lds, Seam<ROPE>& S) {
    const int tid = threadIdx.x, wid = __builtin_amdgcn_readfirstlane(tid >> 6), lane = tid & 63, r32 = lane & 31, hi = lane >> 5;
    STAGE_IDX(); char* K_lds = lds + OFF_K; char* qrl = lds + OFF_QR + wid * 4096 + lane * 16;
    QLOAD(cur);
    SLOAD_H(cur, 0); VMW(); SWRITE_HK(0); QPARK();
    __syncthreads();
}
template <bool ROPE, bool CAUSAL>
__device__ __forceinline__ void attn_block(const BlockRef& cur, const BlockRef& nxt, const Strides& T, char* lds, Seam<ROPE>& S) {
    const int tid = threadIdx.x, wid = __builtin_amdgcn_readfirstlane(tid >> 6), lane = tid & 63, r32 = lane & 31, hi = lane >> 5;
    int j_hi = CAUSAL ? (cur.P0 + QB - 1) / KVBLK + 1 : T.skv / KVBLK; if (j_hi > T.skv / KVBLK) j_hi = T.skv / KVBLK;
    const int NT = j_hi;
    const int qlo = cur.P0 + wid * QBLK, qm = qlo + r32 - 4 * hi;
    char* V_lds = lds + OFF_V; char* K_lds = lds + OFF_K; char* qrl = lds + OFF_QR + wid * 4096 + lane * 16;
    float* ws = (float*)(lds + OFF_WS) + wid * 64; float* li_l = ws, * al_l = ws + 32;
    float m_reg = -1e30f, l_reg = 0; f32x16 o[4] = {};
    STAGE_IDX(); const int vst0 = v_st(sr, sc), vst1 = v_st(32 + sr, sc);
    const int vb0 = (int)(uintptr_t)V_lds + v_rd_base(lane);
#define RESC(a) do { if (__any((a) < 1.f)) { if (hi == 0) al_l[r32] = (a); asm volatile("s_waitcnt lgkmcnt(0)" ::: "memory");              \
                     for (int d_ = 0; d_ < 4; ++d_) for (int r = 0; r < 16; ++r) o[d_][r] *= al_l[crow(r, hi)]; } } while (0)
#define KBASE(t) ((t) * KVBLK)
#define MASKT(P0_, P1_, t) do { if constexpr (CAUSAL) { const int kb_ = KBASE(t); if (kb_ + KVBLK - 1 > qlo) mask_tile(P0_, P1_, qm - kb_); } } while (0)
    constexpr int NQL = ROPE ? 12 : 8;
#define SEAM_K0() do { VMWN(NQL); SWRITE_HK(0); SBAR(); } while (0)
    f32x16 pA0, pA1, pB0, pB1; float mnA, mnB, alA, alB; bf16x8 pa0, pa1, pa2, pa3;
    SWRITE_HV(0); SBAR();
    if (NT > 1) { SLOAD_H(cur, KBASE(1)); }
    SBAR(); qkt<0, ROPE>(pA0, pA1, K_lds, r32, hi, S.qr, qrl);
    MASKT(pA0, pA1, 0); partialSM<ROPE>(pA0, pA1, m_reg, mnA, alA);
    if (NT > 1) { VMW(); SWRITE_H(1); }
    __syncthreads();
#define HALF_STEP(PX0, PX1, mnX, alX, PY0, PY1, alY, t, KB, VB, SB) do {                                                      \
        SBAR(); qkt<KB, ROPE>(PX0, PX1, K_lds, r32, hi, S.qr, qrl);                                                                \
        finishSM(PY0, PY1, alY, l_reg, pa0, pa1, pa2, pa3); SBAR();                                                           \
        if ((t) + 1 < NT) { SLOAD_H(cur, KBASE((t) + 1)); SBAR(); }                                                           \
        pv_tile<VB>(o, vb0, pa0, pa1, pa2, pa3); MASKT(PX0, PX1, (t)); partialSM<ROPE>(PX0, PX1, m_reg, mnX, alX);            \
        __syncthreads();                                                                                                      \
        if ((t) + 1 < NT) { VMW(); SWRITE_H(SB); }                                                                            \
        RESC(alX); __syncthreads(); } while (0)
    for (int t = 1; t + 1 < NT; t += 2) {
        HALF_STEP(pB0, pB1, mnB, alB, pA0, pA1, alA, t, 1, 0, 0);
        HALF_STEP(pA0, pA1, mnA, alA, pB0, pB1, alB, t + 1, 0, 1, 1);
    }
    const bool even = (NT & 1) == 0;
    if (even) { SBAR(); qkt<1, ROPE>(pB0, pB1, K_lds, r32, hi, S.qr, qrl); SBAR(); }
    SLOAD_H(nxt, 0); SBAR();
    QLOAD(nxt);
    SBAR();
    finishSM(pA0, pA1, alA, l_reg, pa0, pa1, pa2, pa3); SBAR();
    pv_tile<0>(o, vb0, pa0, pa1, pa2, pa3);
    if (even) { MASKT(pB0, pB1, NT - 1); partialSM<ROPE>(pB0, pB1, m_reg, mnB, alB); __syncthreads(); RESC(alB);
        finishSM(pB0, pB1, alB, l_reg, pa0, pa1, pa2, pa3); SBAR(); pv_tile<1>(o, vb0, pa0, pa1, pa2, pa3); }
    SBAR(); SEAM_K0();
    if (hi == 0) li_l[r32] = l_reg; asm volatile("s_waitcnt lgkmcnt(0)" ::: "memory");
    float rli[16];
#pragma unroll
    for (int r = 0; r < 16; ++r) rli[r] = __builtin_amdgcn_rcpf(li_l[crow(r, hi)]);
    bf16_t* Ow = cur.O + (size_t)(wid * QBLK) * T.os;
#pragma unroll
    for (int r = 0; r < 16; ++r) { const int orow = crow(r, hi);
#pragma unroll
        for (int d0 = 0; d0 < 4; ++d0) { const float v = o[d0][r] * rli[r];
            const float vn = __shfl_xor(v, 1);
            if ((r32 & 1) == 0) *(unsigned*)(Ow + (size_t)orow * T.os + d0 * 32 + r32) = cvtpk(v, vn); } }
    QPARK();
    __syncthreads();
#undef RESC
#undef KBASE
#undef MASKT
#undef SEAM_K0
#undef HALF_STEP
}

template <bool ROPE>
__device__ __forceinline__ void qkt_rt(f32x16& p0, f32x16& p1, const char* K_lds, int buf, const int (&koff)[4], const bf16x8* qr, const char* qrl) {
    p0 = f32x16{}; p1 = f32x16{};
    const char* kbase = K_lds + buf * SHM_K;
#pragma unroll
    for (int d0 = 0; d0 < 8; ++d0) { const char* a = kbase + koff[d0 & 3] + (d0 >> 2) * 128;
        bf16x8 b0 = *reinterpret_cast<const bf16x8*>(a);
        bf16x8 b1 = *reinterpret_cast<const bf16x8*>(a + 32 * 256);
        p0 = __builtin_amdgcn_mfma_f32_32x32x16_bf16(b0, qr[d0], p0, 0, 0, 0);
        p1 = __builtin_amdgcn_mfma_f32_32x32x16_bf16(b1, qr[d0], p1, 0, 0, 0); }
    if constexpr (ROPE) {
        const char* rbase = K_lds + 2 * SHM_K + buf * SHM_KR;
#pragma unroll
        for (int d0 = 0; d0 < 4; ++d0) { const char* a = rbase + koff[d0];
            bf16x8 b0 = *reinterpret_cast<const bf16x8*>(a);
            bf16x8 b1 = *reinterpret_cast<const bf16x8*>(a + 128);
            const bf16x8 q = *reinterpret_cast<const bf16x8*>(qrl + d0 * 1024);
            p0 = __builtin_amdgcn_mfma_f32_32x32x16_bf16(b0, q, p0, 0, 0, 0);
            p1 = __builtin_amdgcn_mfma_f32_32x32x16_bf16(b1, q, p1, 0, 0, 0); }
    }
}
template <bool ROPE, bool CAUSAL>
__device__ __forceinline__ void attn_block_simple(const BlockRef& cur, const Strides& T, char* lds) {
    const int tid = threadIdx.x, wid = __builtin_amdgcn_readfirstlane(tid >> 6), lane = tid & 63, r32 = lane & 31, hi = lane >> 5;
    int j_hi = CAUSAL ? (cur.P0 + QB - 1) / KVBLK + 1 : T.skv / KVBLK; if (j_hi > T.skv / KVBLK) j_hi = T.skv / KVBLK;
    const int NT = j_hi;
    const int qlo = cur.P0 + wid * QBLK, qm = qlo + r32 - 4 * hi;
    char* V_lds = lds + OFF_V; char* K_lds = lds + OFF_K;
    float* ws = (float*)(lds + OFF_WS) + wid * 64; float* li_l = ws, * al_l = ws + 32;
    float m_reg = -1e30f, l_reg = 0; f32x16 o[4] = {};
    STAGE_IDX(); const int vst0 = v_st(sr, sc), vst1 = v_st(32 + sr, sc);
    const int vb0 = (int)(uintptr_t)V_lds + v_rd_base(lane);
    int koff[4];
#pragma unroll
    for (int dd = 0; dd < 4; ++dd) koff[dd] = KSWZ(r32, (dd * 16 + hi * 8) * 2);
    Seam<ROPE> S; char* qrl = lds + OFF_QR + wid * 4096 + lane * 16;
    QLOAD(cur);
    SLOAD_H(cur, 0); VMW(); SWRITE_H(0); QPARK();
    __syncthreads();
    for (int t = 0; t < NT; ++t) {
        const int buf = t & 1;
        if (t + 1 < NT) { SLOAD_H(cur, (t + 1) * KVBLK); }
        SBAR();
        f32x16 p0, p1; qkt_rt<ROPE>(p0, p1, K_lds, buf, koff, S.qr, qrl);
        if constexpr (CAUSAL) { const int kb_ = t * KVBLK; if (kb_ + KVBLK - 1 > qlo) mask_tile(p0, p1, qm - kb_); }
        float mn, al; partialSM<ROPE>(p0, p1, m_reg, mn, al);
        if (__any(al < 1.f)) { if (hi == 0) al_l[r32] = al; asm volatile("s_waitcnt lgkmcnt(0)" ::: "memory");
            for (int d_ = 0; d_ < 4; ++d_) for (int r = 0; r < 16; ++r) o[d_][r] *= al_l[crow(r, hi)]; }
        bf16x8 pa0, pa1, pa2, pa3; finishSM(p0, p1, al, l_reg, pa0, pa1, pa2, pa3); SBAR();
        pv_tile<0>(o, vb0 + buf * SHM_V, pa0, pa1, pa2, pa3);
        if (t + 1 < NT) { VMW(); SWRITE_H(buf ^ 1); }
        __syncthreads();
    }
    if (hi == 0) li_l[r32] = l_reg; asm volatile("s_waitcnt lgkmcnt(0)" ::: "memory");
    float rli[16];
#pragma unroll
    for (int r = 0; r < 16; ++r) rli[r] = __builtin_amdgcn_rcpf(li_l[crow(r, hi)]);
    bf16_t* Ow = cur.O + (size_t)(wid * QBLK) * T.os;
#pragma unroll
    for (int r = 0; r < 16; ++r) { const int orow = crow(r, hi);
#pragma unroll
        for (int d0 = 0; d0 < 4; ++d0) { const float v = o[d0][r] * rli[r];
            const float vn = __shfl_xor(v, 1);
            if ((r32 & 1) == 0) *(unsigned*)(Ow + (size_t)orow * T.os + d0 * 32 + r32) = cvtpk(v, vn); } }
    __syncthreads();
}
#undef LD8
#undef VMW
#undef VMWN
#undef SLOAD_H
#undef SWRITE_HK
#undef SWRITE_HV
#undef SWRITE_H
#undef QLOAD
#undef QPARK
#undef STAGE_IDX
}
__device__ __forceinline__ float sq4v(f32x4 v) { return pg8::sq4(v); }
__device__ __forceinline__ float row_rs32g(const float* ss, int row) { return pg8::row_rs32(ss, row, 1.0f / DM); }
struct Params {
    const float *x, *mem; const int* pos; const float *norm_mix, *w_in, *lam_re, *lam_im, *log_step, *b_re, *b_im, *c_re, *c_im, *ssm_d, *w_glu, *b_glu;
    const float *q_norm, *w_uq, *kv_norm, *w_uk, *w_uv, *w_up_ssm, *w_up_mla, *w_out, *norm_xattn, *norm_mem, *xa_wq, *xa_wk, *xa_wv, *xa_wo;
    const float *norm_moe, *router_w, *router_b, *w_gu, *b_gu, *w_dn, *b_dn, *final_norm;
    float* out;
    unsigned* ctl;
    bf16_t *WinT, *WkpeT, *WgluT, *WuqT, *WukvT, *WupsT, *WupmT, *WoutT, *WxqT, *WxkvT, *WxoT, *WguT, *WdnT;
    float* WrT;
    bf16_t *hn, *memn; float *cosT, *sinT; float* abar; bf16_t *bbarT, *cmat;
    bf16_t *ub, *qa, *kva; float *qss, *kvss; bf16_t *sgs, *sgm, *kpe;
    bf16_t *qn, *qr, *kn, *vv, *ymla;
    float* send; bf16_t *zb, *ys, *t1, *mg;
    float* x1; bf16_t* x1b; float* ss1;
    bf16_t *memkv, *qx, *ox;
    float* x2; float* ss2;
    int* topi; float* topw; int* rank; int* slot; int* wgcnt; int* blke;
    bf16_t *xg, *act, *orow;
    int ph_lo, ph_hi;
};

struct Frame { LAS unsigned char* lds; int wave, vcu, G, gw, NGW; };

template <class RowMap>
__device__ __forceinline__ void p0_transpose_item(const float* W, int ldw, int K, bf16_t* WT, const float* gain, LAS float* scr, int kb, int nb, int lane, const RowMap& rowmap) {
    const int k0 = 64 * kb, n0 = 32 * nb;
#pragma unroll 8
    for (int i = 0; i < 32; ++i) { const int kk = 2 * i + (lane >> 5); float v = W[(size_t)(k0 + kk) * ldw + n0 + (lane & 31)]; if (gain) v *= gain[k0 + kk]; scr[kk * 33 + (lane & 31)] = v; }
    LDS_WAIT(); asm volatile("" ::: "memory");
    const int c = lane & 7;
#pragma unroll
    for (int j = 0; j < 4; ++j) { const int n = (lane >> 3) + 8 * j; const LAS float* s = scr + (8 * c) * 33 + n;
        u32x4 o; o.x = cvtpk(s[0 * 33], s[1 * 33]); o.y = cvtpk(s[2 * 33], s[3 * 33]); o.z = cvtpk(s[4 * 33], s[5 * 33]); o.w = cvtpk(s[6 * 33], s[7 * 33]);
        *(u32x4*)(WT + (size_t)rowmap(n0 + n) * K + k0 + 8 * c) = o; }
    LDS_WAIT(); asm volatile("" ::: "memory");
}
struct MapId { int off; __device__ __forceinline__ int operator()(int n) const { return n + off; } };
struct MapUq { __device__ __forceinline__ int operator()(int n) const { const int h = n / 192, d = n % 192; if (d < 128) return h * 128 + d;
    const int dd = d - 128, half = dd >> 5, i = dd & 31; return 2048 + 256 * (h >> 2) + half * 128 + (h & 3) * 32 + i; } };
struct MapGU { __device__ __forceinline__ int operator()(int n) const { const int up = n >= DFF, j = up ? n - DFF : n; return 256 * (j >> 7) + up * 128 + (j & 127); } };

__device__ __forceinline__ void rms_row_bf16(const float* xrow, const float* gain, bf16_t* orow, int lane) {
    f32x4 v[8]; float s = 0.f;
#pragma unroll
    for (int j = 0; j < 8; ++j) { v[j] = *(const f32x4*)(xrow + 256 * j + 4 * lane); s += sq4v(v[j]); }
    const float rs = __builtin_amdgcn_rsqf(wave_sum(s) * (1.0f / DM) + EPS);
#pragma unroll
    for (int j = 0; j < 8; ++j) { const f32x4 g = *(const f32x4*)(gain + 256 * j + 4 * lane); const f32x4 r = v[j] * rs * g;
        u32x2 o = {cvtpk(r[0], r[1]), cvtpk(r[2], r[3])}; *(u32x2*)(orow + 256 * j + 4 * lane) = o; }
}

__device__ __forceinline__ void cmul(float ar, float ai, float br, float bi, float& cr, float& ci) { cr = ar * br - ai * bi; ci = ar * bi + ai * br; }

__device__ __forceinline__ void p0_prologue(const Params& p, Frame& F) {
    LAS float* scr = (LAS float*)(F.lds + F.wave * 16384);
    const int gw = F.gw, NGW = F.NGW, lane = ((int)threadIdx.x & 63);
#define TJOB(W, LDW, COFF, NCOLS, KK, DST, GAIN, MAP) { const int nblk = (NCOLS) / 32, nit = ((KK) / 64) * nblk; \
        for (int it = gw; it < nit; it += NGW) p0_transpose_item((W) + (COFF), (LDW), (KK), (DST), (GAIN), scr, it / nblk, it % nblk, lane, (MAP)); }
    TJOB(p.w_in, IN_COLS, 0, 2048, DM, p.WinT, nullptr, MapId{0});
    TJOB(p.w_in, IN_COLS, 2048, 64, DM, p.WkpeT, nullptr, MapId{0});
    TJOB(p.w_in, IN_COLS, 2112, 4096, DM, p.WinT, nullptr, MapId{2048});
    TJOB(p.w_glu, SSM_W, 0, SSM_W, SSM_W, p.WgluT, nullptr, MapId{0});
    TJOB(p.w_uq, NHEAD * 192, 0, NHEAD * 192, QL, p.WuqT, p.q_norm, MapUq{});
    TJOB(p.w_uk, NHEAD * 128, 0, NHEAD * 128, KVL, p.WukvT, p.kv_norm, MapId{0});
    TJOB(p.w_uv, NHEAD * 128, 0, NHEAD * 128, KVL, p.WukvT, p.kv_norm, MapId{2048});
    TJOB(p.w_up_ssm, DM, 0, DM, SSM_W, p.WupsT, nullptr, MapId{0});
    TJOB(p.w_up_mla, DM, 0, DM, DM, p.WupmT, nullptr, MapId{0});
    TJOB(p.w_out, DM, 0, DM, DM, p.WoutT, nullptr, MapId{0});
    TJOB(p.xa_wq, XW, 0, XW, DM, p.WxqT, p.norm_xattn, MapId{0});
    TJOB(p.xa_wk, XW, 0, XW, DM, p.WxkvT, nullptr, MapId{0});
    TJOB(p.xa_wv, XW, 0, XW, DM, p.WxkvT, nullptr, MapId{512});
    TJOB(p.xa_wo, DM, 0, DM, XW, p.WxoT, nullptr, MapId{0});
    for (int e = 0; e < NEXP; ++e) {
        TJOB(p.w_gu + (size_t)e * DM * 2 * DFF, 2 * DFF, 0, 2 * DFF, DM, p.WguT + (size_t)e * 2 * DFF * DM, nullptr, MapGU{});
        TJOB(p.w_dn + (size_t)e * DFF * DM, DM, 0, DM, DFF, p.WdnT + (size_t)e * DM * DFF, nullptr, MapId{0});
    }
#undef TJOB
    for (int m = gw; m < SEQ; m += NGW) rms_row_bf16(p.x + (size_t)m * DM, p.norm_mix, p.hn + (size_t)m * DM, lane);
    for (int m = gw; m < MEML; m += NGW) rms_row_bf16(p.mem + (size_t)m * DM, p.norm_mem, p.memn + (size_t)m * DM, lane);
    const int gt = gw * 64 + lane, NGT = NGW * 64;
    for (int i = gt; i < SEQ * 32; i += NGT) {
        const int t = i >> 5, f = i & 31;
        const float invf = __builtin_powf(10000.0f, -(float)(2 * f) / 64.0f);
        const float ang = (float)p.pos[t] * invf;
        const double rev = (double)ang * 0.15915494309189535; const float fr = (float)(rev - __builtin_floor(rev));
        p.cosT[i] = __builtin_amdgcn_cosf(fr); p.sinT[i] = __builtin_amdgcn_sinf(fr);
    }
    for (int i = gt; i < DM * NEXP; i += NGT) p.WrT[i] = p.router_w[i] * p.norm_moe[i >> 5];
    for (int i = gt; i < SSM_G * SSM_P; i += NGT) {
        const int g = i >> 6;
        const float dt = __builtin_expf(p.log_step[g]), lr = p.lam_re[i], li = p.lam_im[i];
        const float mag = __builtin_expf(lr * dt); const double rev = (double)(li * dt) * 0.15915494309189535; const float fr = (float)(rev - __builtin_floor(rev));
        const float ar = mag * __builtin_amdgcn_cosf(fr), ai = mag * __builtin_amdgcn_sinf(fr);
        p.abar[2 * i] = ar; p.abar[2 * i + 1] = ai;
        const float den = 1.0f / (lr * lr + li * li); float fr_, fi_; cmul(ar - 1.0f, ai, lr * den, -li * den, fr_, fi_);
        const int pst = i & 63;
#pragma unroll
        for (int h = 0; h < SSM_H; ++h) { const float br = p.b_re[(size_t)i * SSM_H + h], bi = p.b_im[(size_t)i * SSM_H + h]; float cr, ci; cmul(fr_, fi_, br, bi, cr, ci);
            p.bbarT[((size_t)g * 128 + pst) * 16 + h] = f2bf(cr); p.bbarT[((size_t)g * 128 + 64 + pst) * 16 + h] = f2bf(ci); }
    }
    for (int i = gt; i < SSM_G * SSM_H * SSM_P; i += NGT) {
        const int gh = i >> 6, pst = i & 63;
        p.cmat[(size_t)gh * 128 + pst] = f2bf(p.c_re[i]); p.cmat[(size_t)gh * 128 + 64 + pst] = f2bf(-p.c_im[i]);
    }
}

__device__ __forceinline__ void kpe_phase(const Params& p, Frame& F) {
    const int lane = ((int)threadIdx.x & 63), r = lane & 31, hi = lane >> 5;
    for (int tile = F.wave * F.G + F.vcu; tile < SEQ / 32; tile += F.NGW) {
        const int t0 = tile * 32; f32x16 a0 = {}, a1 = {};
        const bf16_t* ap = p.hn + (size_t)(t0 + r) * DM + 8 * hi; const bf16_t* b0p = p.WkpeT + (size_t)r * DM + 8 * hi; const bf16_t* b1p = b0p + (size_t)32 * DM;
#pragma unroll 4
        for (int s = 0; s < DM / 16; ++s) { const bf16x8 a = *(const bf16x8*)(ap + 16 * s), b0 = *(const bf16x8*)(b0p + 16 * s), b1 = *(const bf16x8*)(b1p + 16 * s);
            a0 = __builtin_amdgcn_mfma_f32_32x32x16_bf16(a, b0, a0, 0, 0, 0); a1 = __builtin_amdgcn_mfma_f32_32x32x16_bf16(a, b1, a1, 0, 0, 0); }
#pragma unroll
        for (int i = 0; i < 16; ++i) { const int tok = t0 + (i & 3) + 8 * (i >> 2) + 4 * hi; const float c = p.cosT[(size_t)tok * 32 + r], s = p.sinT[(size_t)tok * 32 + r];
            p.kpe[(size_t)tok * DROPE + r] = f2bf(a0[i] * c - a1[i] * s); p.kpe[(size_t)tok * DROPE + 32 + r] = f2bf(a0[i] * s + a1[i] * c); }
    }
}

constexpr int S5_TC = 256, S5_NCH = SEQ / S5_TC;
struct S5Consts { float a1r[2], a1i[2], a2r[2], a2i[2], a3r[2], a3i[2], a4r[2], a4i[2], a8r[2], a8i[2], a32r[2], a32i[2], a256r[2], a256i[2]; };
__device__ __forceinline__ void s5_consts(const Params& p, int g, int r, S5Consts& c) {
#pragma unroll
    for (int s = 0; s < 2; ++s) { const f32x2 a = *(const f32x2*)(p.abar + 2 * (g * 64 + 32 * s + r)); c.a1r[s] = a[0]; c.a1i[s] = a[1];
        cmul(c.a1r[s], c.a1i[s], c.a1r[s], c.a1i[s], c.a2r[s], c.a2i[s]); cmul(c.a2r[s], c.a2i[s], c.a1r[s], c.a1i[s], c.a3r[s], c.a3i[s]); cmul(c.a2r[s], c.a2i[s], c.a2r[s], c.a2i[s], c.a4r[s], c.a4i[s]);
        cmul(c.a4r[s], c.a4i[s], c.a4r[s], c.a4i[s], c.a8r[s], c.a8i[s]); float tr, ti; cmul(c.a8r[s], c.a8i[s], c.a8r[s], c.a8i[s], tr, ti); cmul(tr, ti, tr, ti, c.a32r[s], c.a32i[s]);
        float ur, ui; cmul(c.a32r[s], c.a32i[s], c.a32r[s], c.a32i[s], tr, ti); cmul(tr, ti, tr, ti, ur, ui); cmul(ur, ui, ur, ui, c.a256r[s], c.a256i[s]); }
}
__device__ __forceinline__ void s5_bu(const Params& p, int g, int t0, int r, int hi, const bf16x8 (&bfr)[4], f32x16 (&acc)[4]) {
    const bf16x8 a = *(const bf16x8*)(p.ub + (size_t)(t0 + r) * SSM_W + g * 16 + 8 * hi);
#pragma unroll
    for (int ct = 0; ct < 4; ++ct) { acc[ct] = f32x16{}; acc[ct] = __builtin_amdgcn_mfma_f32_32x32x16_bf16(a, bfr[ct], acc[ct], 0, 0, 0); }
}
__device__ __forceinline__ void s5_pass_a(const Params& p, Frame& F) {
    const int lane = ((int)threadIdx.x & 63), r = lane & 31, hi = lane >> 5;
    for (int unit = F.gw; unit < S5_NCH * SSM_G; unit += F.NGW) {
        const int g = unit % SSM_G, ch = unit / SSM_G;
        S5Consts c; s5_consts(p, g, r, c);
        bf16x8 bfr[4];
#pragma unroll
        for (int ct = 0; ct < 4; ++ct) bfr[ct] = *(const bf16x8*)(p.bbarT + ((size_t)g * 128 + 32 * ct + r) * 16 + 8 * hi);
        float Sr[2] = {0.f, 0.f}, Si[2] = {0.f, 0.f};
        for (int tl = 0; tl < S5_TC / 32; ++tl) {
            f32x16 acc[4]; s5_bu(p, g, ch * S5_TC + tl * 32, r, hi, bfr, acc);
#pragma unroll
            for (int s = 0; s < 2; ++s) { float Pr = 0.f, Pi = 0.f;
#pragma unroll
                for (int q = 0; q < 4; ++q) { float er = acc[s][4 * q], ei = acc[2 + s][4 * q];
#pragma unroll
                    for (int j = 1; j < 4; ++j) { float tr, ti; cmul(er, ei, c.a1r[s], c.a1i[s], tr, ti); er = tr + acc[s][4 * q + j]; ei = ti + acc[2 + s][4 * q + j]; }
                    float tr, ti; cmul(Pr, Pi, c.a8r[s], c.a8i[s], tr, ti); Pr = tr + er; Pi = ti + ei; }
                if (hi == 0) { float tr, ti; cmul(Pr, Pi, c.a4r[s], c.a4i[s], tr, ti); Pr = tr; Pi = ti; }
                Pr += __shfl_xor(Pr, 32); Pi += __shfl_xor(Pi, 32);
                float tr, ti; cmul(Sr[s], Si[s], c.a32r[s], c.a32i[s], tr, ti); Sr[s] = tr + Pr; Si[s] = ti + Pi; }
        }
        if (hi == 0) {
#pragma unroll
            for (int s = 0; s < 2; ++s) *(f32x2*)(p.send + 2 * ((size_t)(ch * SSM_G + g) * 64 + 32 * s + r)) = (f32x2){Sr[s], Si[s]}; }
    }
}
constexpr int S5_XS = 272;
__device__ __forceinline__ void s5_pass_c(const Params& p, Frame& F) {
    const int lane = ((int)threadIdx.x & 63), r = lane & 31, hi = lane >> 5, l15 = lane & 15, l4 = lane >> 4;
    LAS unsigned char* xl = F.lds + F.wave * (32 * S5_XS);
    for (int unit = F.gw; unit < S5_NCH * SSM_G; unit += F.NGW) {
        const int g = unit % SSM_G, ch = unit / SSM_G;
        S5Consts c; s5_consts(p, g, r, c);
        bf16x8 bfr[4], cfr[4];
#pragma unroll
        for (int ct = 0; ct < 4; ++ct) bfr[ct] = *(const bf16x8*)(p.bbarT + ((size_t)g * 128 + 32 * ct + r) * 16 + 8 * hi);
#pragma unroll
        for (int ks = 0; ks < 4; ++ks) cfr[ks] = *(const bf16x8*)(p.cmat + ((size_t)g * 16 + l15) * 128 + 32 * ks + 8 * l4);
        const f32x4 dsk = *(const f32x4*)(p.ssm_d + g * 16 + 4 * l4);
        float Xr[2] = {0.f, 0.f}, Xi[2] = {0.f, 0.f};
        for (int cp = 0; cp < ch; ++cp) {
#pragma unroll
            for (int s = 0; s < 2; ++s) { const f32x2 e = *(const f32x2*)(p.send + 2 * ((size_t)(cp * SSM_G + g) * 64 + 32 * s + r)); float tr, ti; cmul(Xr[s], Xi[s], c.a256r[s], c.a256i[s], tr, ti); Xr[s] = tr + e[0]; Xi[s] = ti + e[1]; } }
        for (int tl = 0; tl < S5_TC / 32; ++tl) {
            const int t0 = ch * S5_TC + tl * 32;
            f32x16 acc[4]; s5_bu(p, g, t0, r, hi, bfr, acc);
#pragma unroll
            for (int s = 0; s < 2; ++s) {
                float er[4], ei[4];
#pragma unroll
                for (int q = 0; q < 4; ++q) {
#pragma unroll
                    for (int j = 1; j < 4; ++j) { float tr, ti; cmul(acc[s][4 * q + j - 1], acc[2 + s][4 * q + j - 1], c.a1r[s], c.a1i[s], tr, ti); acc[s][4 * q + j] += tr; acc[2 + s][4 * q + j] += ti; }
                    er[q] = acc[s][4 * q + 3]; ei[q] = acc[2 + s][4 * q + 3]; }
                float cr = Xr[s], ci = Xi[s], cinr[4], cini[4];
#pragma unroll
                for (int q = 0; q < 4; ++q) { const float pr = __shfl_xor(er[q], 32), pi = __shfl_xor(ei[q], 32);
                    const float e0r = hi ? pr : er[q], e0i = hi ? pi : ei[q], e1r = hi ? er[q] : pr, e1i = hi ? ei[q] : pi;
                    float tr, ti; const float c0r = cr, c0i = ci; cmul(cr, ci, c.a4r[s], c.a4i[s], tr, ti); cr = tr + e0r; ci = ti + e0i;
                    const float c1r = cr, c1i = ci; cmul(cr, ci, c.a4r[s], c.a4i[s], tr, ti); cr = tr + e1r; ci = ti + e1i;
                    cinr[q] = hi ? c1r : c0r; cini[q] = hi ? c1i : c0i; }
                Xr[s] = cr; Xi[s] = ci;
#pragma unroll
                for (int q = 0; q < 4; ++q) { float tr, ti;
                    cmul(cinr[q], cini[q], c.a1r[s], c.a1i[s], tr, ti); acc[s][4 * q + 0] += tr; acc[2 + s][4 * q + 0] += ti;
                    cmul(cinr[q], cini[q], c.a2r[s], c.a2i[s], tr, ti); acc[s][4 * q + 1] += tr; acc[2 + s][4 * q + 1] += ti;
                    cmul(cinr[q], cini[q], c.a3r[s], c.a3i[s], tr, ti); acc[s][4 * q + 2] += tr; acc[2 + s][4 * q + 2] += ti;
                    cmul(cinr[q], cini[q], c.a4r[s], c.a4i[s], tr, ti); acc[s][4 * q + 3] += tr; acc[2 + s][4 * q + 3] += ti; }
            }
#pragma unroll
            for (int ct = 0; ct < 4; ++ct)
#pragma unroll
                for (int i = 0; i < 16; ++i) *(LAS unsigned short*)(xl + ((i & 3) + 8 * (i >> 2) + 4 * hi) * S5_XS + (32 * ct + r) * 2) = f2bf(acc[ct][i]);
            LDS_WAIT(); asm volatile("" ::: "memory");
#pragma unroll
            for (int nt = 0; nt < 2; ++nt) { f32x4 y = {0.f, 0.f, 0.f, 0.f};
#pragma unroll
                for (int ks = 0; ks < 4; ++ks) { const bf16x8 b = *(const LAS bf16x8*)(xl + (16 * nt + l15) * S5_XS + (32 * ks + 8 * l4) * 2); y = __builtin_amdgcn_mfma_f32_16x16x32_bf16(cfr[ks], b, y, 0, 0, 0); }
                const size_t off = (size_t)(t0 + 16 * nt + l15) * SSM_W + g * 16 + 4 * l4; const u32x2 uw = *(const u32x2*)(p.ub + off);
                const float y0 = y[0] + dsk[0] * bflo(uw.x), y1 = y[1] + dsk[1] * bfhi(uw.x), y2 = y[2] + dsk[2] * bflo(uw.y), y3 = y[3] + dsk[3] * bfhi(uw.y);
                u32x2 o = {cvtpk(gelu_tanh(y0), gelu_tanh(y1)), cvtpk(gelu_tanh(y2), gelu_tanh(y3))}; *(u32x2*)(p.zb + off) = o; }
            LDS_WAIT(); asm volatile("" ::: "memory");
        }
    }
}

__device__ __forceinline__ void router_phase(const Params& p, Frame& F) {
    LAS float* red = (LAS float*)F.lds; LAS float* lg = red + 8 * 32 * 33; LAS int* asg = (LAS int*)(lg + 32 * 33); LAS int* cnt = asg + 256;
    const int lane = ((int)threadIdx.x & 63), i32 = lane & 31, kh = lane >> 5, w = F.wave, tid = (int)threadIdx.x;
    for (int vb = blockIdx.x; vb < SEQ / 64; vb += F.G) {
        if (tid < 32) cnt[tid] = 0;
        for (int tl = 0; tl < 2; ++tl) {
            const int t0 = vb * 64 + tl * 32;
            f32x16 acc = {};
            const float* ap = p.x2 + (size_t)(t0 + i32) * DM + 256 * w + 4 * kh; const float* bp = p.WrT + (size_t)(256 * w + 4 * kh) * NEXP + i32;
#pragma unroll 4
            for (int q = 0; q < 32; ++q) { const f32x4 a = *(const f32x4*)(ap + 8 * q);
#pragma unroll
                for (int e = 0; e < 4; ++e) acc = __builtin_amdgcn_mfma_f32_32x32x2f32(a[e], bp[(size_t)(8 * q + e) * NEXP], acc, 0, 0, 0); }
#pragma unroll
            for (int i = 0; i < 16; ++i) red[(w * 32 + (i & 3) + 8 * (i >> 2) + 4 * kh) * 33 + i32] = acc[i];
            __syncthreads();
            for (int o = tid; o < 1024; o += 512) { const int tok = o >> 5, e = o & 31; float s = 0.f;
#pragma unroll
                for (int ww = 0; ww < 8; ++ww) s += red[(ww * 32 + tok) * 33 + e];
                lg[tok * 33 + e] = s * row_rs32g(p.ss2, t0 + tok) + p.router_b[e]; }
            __syncthreads();
            if (tid < 32) { const int tok = tid; float v[4] = {-__builtin_inff(), -__builtin_inff(), -__builtin_inff(), -__builtin_inff()}; int id[4] = {0, 0, 0, 0};
                for (int e = 0; e < 32; ++e) { float x = lg[tok * 33 + e]; int xi = e;
#pragma unroll
                    for (int k = 0; k < 4; ++k) { const bool gt = x > v[k]; const float tv = gt ? v[k] : x; const int ti = gt ? id[k] : xi; v[k] = gt ? x : v[k]; id[k] = gt ? xi : id[k]; x = tv; xi = ti; } }
                const float e1 = __builtin_expf(v[1] - v[0]), e2 = __builtin_expf(v[2] - v[0]), e3 = __builtin_expf(v[3] - v[0]); const float inv = 1.0f / (1.0f + e1 + e2 + e3);
                const size_t o4 = (size_t)(t0 + tok) * 4;
                *(f32x4*)(p.topw + o4) = (f32x4){inv, e1 * inv, e2 * inv, e3 * inv};
                p.topi[o4] = id[0]; p.topi[o4 + 1] = id[1]; p.topi[o4 + 2] = id[2]; p.topi[o4 + 3] = id[3];
#pragma unroll
                for (int k = 0; k < 4; ++k) asg[(tl * 32 + tok) * 4 + k] = id[k]; }
            __syncthreads();
        }
        if (tid < 256) { const int e = asg[tid]; int rk = 0; for (int j = 0; j < tid; ++j) rk += (asg[j] == e) ? 1 : 0;
            p.rank[(size_t)vb * 256 + tid] = rk; atomicAdd((int*)&cnt[e], 1); }
        __syncthreads();
        if (tid < 32) p.wgcnt[vb * 32 + tid] = cnt[tid];
        __syncthreads();
    }
}
__device__ __forceinline__ void assign_phase(const Params& p, Frame& F) {
    LAS int* part = (LAS int*)F.lds; LAS int* pbef = part + 512; LAS int* base = pbef + 512; LAS int* pst = base + 32; LAS int* slots = pst + 33;
    const int tid = (int)threadIdx.x, lane = ((int)threadIdx.x & 63);
    for (int vb = blockIdx.x; vb < SEQ / 64; vb += F.G) {
        { const int e = tid & 31, pr = tid >> 5; int s = 0, sb = 0;
          for (int b = pr * 16; b < pr * 16 + 16; ++b) { const int c = p.wgcnt[b * 32 + e]; s += c; sb += (b < vb) ? c : 0; }
          part[pr * 32 + e] = s; pbef[pr * 32 + e] = sb; }
        __syncthreads();
        if (tid < 32) { int tot = 0, bef = 0; for (int pr = 0; pr < 16; ++pr) { tot += part[pr * 32 + tid]; bef += pbef[pr * 32 + tid]; } part[tid] = tot; pbef[tid] = bef; }
        __syncthreads();
        if (tid == 0) { int acc = 0; for (int e = 0; e < 32; ++e) { pst[e] = acc; const int nb = (part[e] + 255) >> 8;
                if (vb == 0) for (int b = 0; b < nb; ++b) p.blke[(acc >> 8) + b] = e;
                acc += nb << 8; }
            pst[32] = acc; if (vb == 0) p.blke[MAXBLK] = acc >> 8; }
        __syncthreads();
        if (tid < 32) base[tid] = pst[tid] + pbef[tid];
        __syncthreads();
        if (tid < 256) { const int tok = vb * 64 + (tid >> 2); const int e = p.topi[(size_t)tok * 4 + (tid & 3)]; const int sl = base[e] + p.rank[(size_t)vb * 256 + tid];
            p.slot[(size_t)tok * 4 + (tid & 3)] = sl; slots[tid] = sl; }
        __syncthreads();
        for (int tk = F.wave; tk < 64; tk += NWAVES) { const int tok = vb * 64 + tk; const float* xr = p.x2 + (size_t)tok * DM; const float rs = row_rs32g(p.ss2, tok);
#pragma unroll
            for (int j = 0; j < 4; ++j) { const int c = 512 * j + 8 * lane; const f32x4 g0 = *(const f32x4*)(p.norm_moe + c), g1 = *(const f32x4*)(p.norm_moe + c + 4);
                const u32x4 o = pack8f(*(const f32x4*)(xr + c) * rs * g0, *(const f32x4*)(xr + c + 4) * rs * g1);
#pragma unroll
                for (int k = 0; k < 4; ++k) *(u32x4*)(p.xg + (size_t)slots[tk * 4 + k] * DM + c) = o; } }
        __syncthreads();
    }
}
__device__ __forceinline__ void combine_phase(const Params& p, Frame& F) {
    const int lane = ((int)threadIdx.x & 63);
    for (int tok = F.gw; tok < SEQ; tok += F.NGW) {
        const f32x4 w = *(const f32x4*)(p.topw + (size_t)tok * 4); int sl[4];
#pragma unroll
        for (int k = 0; k < 4; ++k) sl[k] = p.slot[(size_t)tok * 4 + k];
        f32x4 v[4][2]; float s = 0.f;
#pragma unroll
        for (int j = 0; j < 4; ++j) { const int c = 512 * j + 8 * lane; v[j][0] = *(const f32x4*)(p.x2 + (size_t)tok * DM + c); v[j][1] = *(const f32x4*)(p.x2 + (size_t)tok * DM + c + 4);
#pragma unroll
            for (int k = 0; k < 4; ++k) { f32x4 a, b; unpack8(*(const u32x4*)(p.orow + (size_t)sl[k] * DM + c), a, b); v[j][0] += a * w[k]; v[j][1] += b * w[k]; }
            s += sq4v(v[j][0]) + sq4v(v[j][1]); }
        const float rs = __builtin_amdgcn_rsqf(wave_sum(s) * (1.0f / DM) + EPS);
#pragma unroll
        for (int j = 0; j < 4; ++j) { const int c = 512 * j + 8 * lane;
            *(f32x4*)(p.out + (size_t)tok * DM + c) = v[j][0] * rs * *(const f32x4*)(p.final_norm + c); *(f32x4*)(p.out + (size_t)tok * DM + c + 4) = v[j][1] * rs * *(const f32x4*)(p.final_norm + c + 4); }
    }
}
template <bool ROPE, bool CAUSAL, class Refs>
__device__ __forceinline__ void attn_stream(const Refs& R, const att::Strides& T, char* lds) {
    const int n = R.count(); if (n <= 0) return;
    att::Seam<ROPE> S; att::BlockRef cur = R.ref(0);
    att::attn_prime<ROPE, CAUSAL>(cur, T, lds, S);
    for (int i = 0; i < n; ++i) { const att::BlockRef nxt = (i + 1 < n) ? R.ref(i + 1) : cur; att::attn_block<ROPE, CAUSAL>(cur, nxt, T, lds, S); cur = nxt; }
}
struct MlaRefs {
    const Params* p; int b, G; bf16_t* obuf;
    __device__ __forceinline__ int count() const { return b < 512 ? 2 * ((512 - b + G - 1) / G) : 0; }
    __device__ __forceinline__ att::BlockRef ref(int i) const {
        const int L = b + (i >> 1) * G, xcd = L & 7, k = L >> 3, head = (k >> 5) * 8 + xcd, y = k & 31, qb = (i & 1) ? 63 - y : y;
        att::BlockRef r; const size_t row0 = (size_t)qb * 256;
        r.Q = p->qn + row0 * DM + head * DNOPE; r.QR = p->qr + row0 * (NHEAD * DROPE) + head * DROPE; r.K = p->kn + head * DNOPE; r.KR = p->kpe; r.V = p->vv + head * DV;
        r.O = obuf + row0 * DM + head * DV; r.P0 = qb * 256; return r; }
};
struct XaRefs {
    const Params* p; int b, G;
    __device__ __forceinline__ int count() const { return b < 256 ? (256 - b + G - 1) / G : 0; }
    __device__ __forceinline__ att::BlockRef ref(int i) const {
        const int L = b + i * G, head = L & 3, qb = L >> 2; att::BlockRef r; const size_t row0 = (size_t)qb * 256;
        r.Q = p->qx + row0 * XW + head * 128; r.QR = nullptr; r.K = p->memkv + head * 128; r.KR = nullptr; r.V = p->memkv + XW + head * 128; r.O = p->ox + row0 * XW + head * 128; r.P0 = 0; return r; }
};

constexpr int RING_BYTES = 131072, MISC_OFF = RING_BYTES + 320, LDS_BYTES = 147456;
constexpr int NPHASE = 16;
#ifndef MK_ONE_LAUNCH
#define MK_ONE_LAUNCH 1
#endif

__global__ void __launch_bounds__(NWAVES * 64, 2) hybrid_fwd(Params p) {
    extern __shared__ __attribute__((aligned(16))) unsigned char lds[];
    Frame F;
    F.lds = (LAS unsigned char*)lds; F.wave = __builtin_amdgcn_readfirstlane((int)threadIdx.x >> 6);
    F.G = gridDim.x; { const int bx = blockIdx.x; F.vcu = (F.G % 8 == 0) ? (bx % 8) * (F.G / 8) + bx / 8 : bx; }
    F.gw = F.vcu * NWAVES + F.wave; F.NGW = F.G * NWAVES;
    volatile LAS unsigned* MISC = (volatile LAS unsigned*)(F.lds + MISC_OFF);
    for (int u = threadIdx.x; u < (LDS_BYTES - RING_BYTES) / 4; u += NWAVES * 64) ((LAS unsigned*)(F.lds + RING_BYTES))[u] = 0u;
    __syncthreads();
    const int lo = p.ph_lo, hi = p.ph_hi;
    XcdBarrier bar; bar.bar = p.ctl + 4096; bar.x = 0; bar.st = nullptr;
    if (hi - lo > 1) bar = xcd_barrier_post(p.ctl + 4096, MISC + 8);
#ifndef PHMASK
#define PHMASK 0xFFFF
#endif
#define IN(k) ((((PHMASK) >> (k)) & 1) && lo <= (k) && (k) < hi)
#define SEAM(k) do { if (IN(k) && IN((k) + 1)) xcd_barrier(bar); } while (0)
    const int G = F.G, bx = blockIdx.x;
    LAS unsigned char* ring = F.lds;

#ifndef REP3_OBUF
#define REP3_OBUF p.ymla
#endif
#ifndef REPMASK
#define REPMASK 0
#endif
#ifndef REPCOND
#define REPCOND 1
#endif
#define REP(k) ((((REPMASK) >> (k)) & 1) && lo <= ((k) & 15) && ((k) & 15) < hi && (REPCOND))
#define B0 { p0_prologue(p, F); }
#define B1 { kpe_phase(p, F); \
        pg8::Gemm g{p.hn, p.WinT, DM, DM, DM, 0}; pg8::StaticOrder S; S.init(SEQ, 6144, G, bx); \
        pg8::EpiProj E{p.ub, p.qa, p.kva, p.sgs, p.sgm, p.qss, p.kvss}; pg8::gemm_phase(ring, g, S, E); }
#define B2 { s5_pass_a(p, F); \
        { pg8::Gemm g{p.qa, p.WuqT, QL, QL, QL, 0}; pg8::StaticOrder S; S.init(SEQ, 3072, G, bx); pg8::EpiQup E{p.qn, p.qr, p.qss, p.cosT, p.sinT}; pg8::gemm_phase(ring, g, S, E); } \
        { pg8::Gemm g{p.kva, p.WukvT, KVL, KVL, KVL, 0}; pg8::StaticOrder S; S.init(SEQ, 4096, G, bx); pg8::EpiKVup E{p.kn, p.vv, p.kvss}; pg8::gemm_phase(ring, g, S, E); } \
        { pg8::Gemm g{p.memn, p.WxkvT, DM, DM, DM, 0}; pg8::StaticOrder S; S.init(MEML, 2 * XW, G, bx); pg8::EpiPlain E{p.memkv, 2 * XW}; pg8::gemm_phase(ring, g, S, E); } }
#define B3A { s5_pass_c(p, F); __syncthreads(); }
#define B3B_(OB) { const att::Strides T{DM, NHEAD * DROPE, DM, DM, DM, SEQ}; const MlaRefs R{&p, bx, G, OB}; for (int i = 0, n = R.count(); i < n; ++i) att::attn_block_simple<true, true>(R.ref(i), T, (char*)lds); }
#define B4 { pg8::Gemm g{p.zb, p.WgluT, SSM_W, SSM_W, SSM_W, 0}; pg8::StaticOrder S; S.init(SEQ, SSM_W, G, bx); pg8::EpiGlu E{p.zb, p.b_glu, p.ys}; pg8::gemm_phase(ring, g, S, E); }
#define B5 { pg8::Gemm g{p.ys, p.WupsT, SSM_W, SSM_W, SSM_W, 0}; pg8::StaticOrder S; S.init(SEQ, DM, G, bx); pg8::EpiGate E{p.sgs, nullptr, p.t1}; pg8::gemm_phase(ring, g, S, E); }
#define B6 { pg8::Gemm g{p.ymla, p.WupmT, DM, DM, DM, 0}; pg8::StaticOrder S; S.init(SEQ, DM, G, bx); pg8::EpiGate E{p.sgm, p.t1, p.mg}; pg8::gemm_phase(ring, g, S, E); }
#define B7 { pg8::Gemm g{p.mg, p.WoutT, DM, DM, DM, 0}; pg8::StaticOrder S; S.init(SEQ, DM, G, bx); pg8::EpiResid E{p.x, p.x1, p.x1b, p.ss1}; pg8::gemm_phase(ring, g, S, E); }
#define B8 { pg8::Gemm g{p.x1b, p.WxqT, DM, DM, DM, 0}; pg8::StaticOrder S; S.init(SEQ, XW, G, bx); pg8::EpiXq E{p.qx, p.ss1}; pg8::gemm_phase(ring, g, S, E); }
#define B9 { const att::Strides T{XW, 0, 2 * XW, 2 * XW, XW, MEML}; const XaRefs R{&p, bx, G}; attn_stream<false, false>(R, T, (char*)lds); }
#define B10 { pg8::Gemm g{p.ox, p.WxoT, XW, XW, XW, 0}; pg8::StaticOrder S; S.init(SEQ, DM, G, bx); pg8::EpiResid E{p.x1, p.x2, nullptr, p.ss2}; pg8::gemm_phase(ring, g, S, E); }
#define B11 { router_phase(p, F); }
#define B12 { assign_phase(p, F); }
#define B13 { const int nblk = __builtin_amdgcn_readfirstlane(p.blke[MAXBLK]); \
        pg8::Gemm g{p.xg, p.WguT, DM, DM, DM, (size_t)2 * DFF * DM}; pg8::MoeOrder S; S.init(nblk, 2 * DFF, G, bx, p.blke); pg8::EpiMoeGU E{p.b_gu, p.act}; pg8::gemm_phase(ring, g, S, E); }
#define B14 { const int nblk = __builtin_amdgcn_readfirstlane(p.blke[MAXBLK]); \
        pg8::Gemm g{p.act, p.WdnT, DFF, DFF, DFF, (size_t)DM * DFF}; pg8::MoeOrder S; S.init(nblk, DM, G, bx, p.blke); pg8::EpiMoeDown E{p.b_dn, p.orow}; pg8::gemm_phase(ring, g, S, E); }
#define B15 { combine_phase(p, F); }
    if (IN(0)) B0 if (REP(0)) B0 SEAM(0);
    if (IN(1)) B1 if (REP(1)) B1 SEAM(1);
    if (IN(2)) B2 if (REP(2)) B2 SEAM(2);
    if (IN(3)) { B3A if (REP(16)) B3A B3B_(p.ymla) if (REP(3)) B3B_(REP3_OBUF) } SEAM(3);
    if (IN(4)) B4 if (REP(4)) B4 SEAM(4);
    if (IN(5)) B5 if (REP(5)) B5 SEAM(5);
    if (IN(6)) B6 if (REP(6)) B6 SEAM(6);
    if (IN(7)) B7 if (REP(7)) B7 SEAM(7);
    if (IN(8)) B8 if (REP(8)) B8 SEAM(8);
    if (IN(9)) B9 if (REP(9)) B9 SEAM(9);
    if (IN(10)) B10 if (REP(10)) B10 SEAM(10);
    if (IN(11)) B11 if (REP(11)) B11 SEAM(11);
    if (IN(12)) B12 if (REP(12)) B12 SEAM(12);
    if (IN(13)) B13 if (REP(13)) B13 SEAM(13);
    if (IN(14)) B14 if (REP(14)) B14 SEAM(14);
    if (IN(15)) B15 if (REP(15)) B15
#undef IN
#undef SEAM
}

extern "C" void kernel_launch(void* const* d_in, const int* in_sizes, int n_in, void* d_out, int out_size, void* d_ws, size_t ws_size, hipStream_t stream) {
    static int grid = 0;
    if (grid == 0) {
        if (n_in != 37 || in_sizes[0] != SEQ * DM || out_size != SEQ * DM) { fprintf(stderr, "kernel_launch: unexpected shapes (n_in %d)\n", n_in); grid = -1; return; }
        int dev = 0, cus = 0;
        if (hipGetDevice(&dev) != hipSuccess || hipDeviceGetAttribute(&cus, hipDeviceAttributeMultiprocessorCount, dev) != hipSuccess) { grid = -1; return; }
        if (hipFuncSetAttribute((const void*)hybrid_fwd, hipFuncAttributeMaxDynamicSharedMemorySize, LDS_BYTES) != hipSuccess) { fprintf(stderr, "kernel_launch: hipFuncSetAttribute failed\n"); grid = -1; return; }
        int per_cu = 0;
        if (hipOccupancyMaxActiveBlocksPerMultiprocessor(&per_cu, (const void*)hybrid_fwd, NWAVES * 64, LDS_BYTES) != hipSuccess || per_cu < 1) { fprintf(stderr, "kernel_launch: occupancy query says %d\n", per_cu); }
        (void)hipGetLastError();
        grid = cus > 0 ? cus : 256;
    }
    if (grid < 0) return;
    Params p; memset(&p, 0, sizeof(p));
    const float* const* in = (const float* const*)d_in;
    p.x = in[0]; p.mem = in[1]; p.pos = (const int*)d_in[2]; p.norm_mix = in[3]; p.w_in = in[4]; p.lam_re = in[5]; p.lam_im = in[6]; p.log_step = in[7]; p.b_re = in[8]; p.b_im = in[9];
    p.c_re = in[10]; p.c_im = in[11]; p.ssm_d = in[12]; p.w_glu = in[13]; p.b_glu = in[14]; p.q_norm = in[15]; p.w_uq = in[16]; p.kv_norm = in[17]; p.w_uk = in[18]; p.w_uv = in[19];
    p.w_up_ssm = in[20]; p.w_up_mla = in[21]; p.w_out = in[22]; p.norm_xattn = in[23]; p.norm_mem = in[24]; p.xa_wq = in[25]; p.xa_wk = in[26]; p.xa_wv = in[27]; p.xa_wo = in[28];
    p.norm_moe = in[29]; p.router_w = in[30]; p.router_b = in[31]; p.w_gu = in[32]; p.b_gu = in[33]; p.w_dn = in[34]; p.b_dn = in[35]; p.final_norm = in[36];
    p.out = (float*)d_out;
    size_t off = 0; unsigned char* ws = (unsigned char*)d_ws;
    auto take = [&](size_t bytes) { unsigned char* r = ws + off; off += (bytes + 4095) & ~(size_t)4095; return r; };
    p.ctl = (unsigned*)take(1 << 20);
    p.WinT = (bf16_t*)take((size_t)6144 * DM * 2); p.WkpeT = (bf16_t*)take((size_t)64 * DM * 2); p.WgluT = (bf16_t*)take((size_t)SSM_W * SSM_W * 2); p.WuqT = (bf16_t*)take((size_t)3072 * QL * 2);
    p.WukvT = (bf16_t*)take((size_t)4096 * KVL * 2); p.WupsT = (bf16_t*)take((size_t)DM * SSM_W * 2); p.WupmT = (bf16_t*)take((size_t)DM * DM * 2); p.WoutT = (bf16_t*)take((size_t)DM * DM * 2);
    p.WxqT = (bf16_t*)take((size_t)XW * DM * 2); p.WxkvT = (bf16_t*)take((size_t)2 * XW * DM * 2); p.WxoT = (bf16_t*)take((size_t)DM * XW * 2);
    p.WguT = (bf16_t*)take((size_t)NEXP * 2 * DFF * DM * 2); p.WdnT = (bf16_t*)take((size_t)NEXP * DM * DFF * 2); p.WrT = (float*)take((size_t)DM * NEXP * 4);
    p.hn = (bf16_t*)take((size_t)SEQ * DM * 2); p.memn = (bf16_t*)take((size_t)MEML * DM * 2); p.cosT = (float*)take((size_t)SEQ * 32 * 4); p.sinT = (float*)take((size_t)SEQ * 32 * 4);
    p.abar = (float*)take((size_t)SSM_G * SSM_P * 8); p.bbarT = (bf16_t*)take((size_t)SSM_G * 128 * 16 * 2); p.cmat = (bf16_t*)take((size_t)SSM_G * 16 * 128 * 2);
    p.ub = (bf16_t*)take((size_t)SEQ * SSM_W * 2); p.qa = (bf16_t*)take((size_t)SEQ * QL * 2); p.kva = (bf16_t*)take((size_t)SEQ * KVL * 2); p.qss = (float*)take((size_t)SEQ * 8 * 4); p.kvss = (float*)take((size_t)SEQ * 8 * 4);
    p.sgs = (bf16_t*)take((size_t)SEQ * DM * 2); p.sgm = (bf16_t*)take((size_t)SEQ * DM * 2); p.kpe = (bf16_t*)take((size_t)SEQ * DROPE * 2);
    p.qn = (bf16_t*)take((size_t)SEQ * DM * 2); p.qr = (bf16_t*)take((size_t)SEQ * NHEAD * DROPE * 2); p.kn = (bf16_t*)take((size_t)SEQ * DM * 2); p.vv = (bf16_t*)take((size_t)SEQ * DM * 2); p.ymla = (bf16_t*)take((size_t)SEQ * DM * 2);
    p.send = (float*)take((size_t)S5_NCH * SSM_G * 64 * 8); p.zb = (bf16_t*)take((size_t)SEQ * SSM_W * 2); p.ys = (bf16_t*)take((size_t)SEQ * SSM_W * 2); p.t1 = (bf16_t*)take((size_t)SEQ * DM * 2); p.mg = (bf16_t*)take((size_t)SEQ * DM * 2);
    p.x1 = (float*)take((size_t)SEQ * DM * 4); p.x1b = (bf16_t*)take((size_t)SEQ * DM * 2); p.ss1 = (float*)take((size_t)SEQ * 32 * 4);
    p.memkv = (bf16_t*)take((size_t)MEML * 2 * XW * 2); p.qx = (bf16_t*)take((size_t)SEQ * XW * 2); p.ox = (bf16_t*)take((size_t)SEQ * XW * 2);
    p.x2 = (float*)take((size_t)SEQ * DM * 4); p.ss2 = (float*)take((size_t)SEQ * 32 * 4);
    p.topi = (int*)take((size_t)SEQ * 4 * 4); p.topw = (float*)take((size_t)SEQ * 4 * 4); p.rank = (int*)take((size_t)SEQ * 4 * 4); p.slot = (int*)take((size_t)SEQ * 4 * 4); p.wgcnt = (int*)take((size_t)256 * 32 * 4); p.blke = (int*)take((size_t)(MAXBLK + 8) * 4);
    p.xg = (bf16_t*)take((size_t)NSLOT * DM * 2); p.act = (bf16_t*)take((size_t)NSLOT * DFF * 2); p.orow = (bf16_t*)take((size_t)NSLOT * DM * 2);
    if (off > ws_size) { fprintf(stderr, "kernel_launch: workspace too small: need %zu have %zu\n", off, ws_size); return; }
    (void)hipMemsetAsync(p.ctl, 0, 1 << 20, stream);
#if MK_ONE_LAUNCH
    p.ph_lo = 0; p.ph_hi = NPHASE;
    hipLaunchKernelGGL(hybrid_fwd, dim3(grid), dim3(NWAVES * 64), LDS_BYTES, stream, p);
#else
    for (int k = 0; k < NPHASE; ++k) { p.ph_lo = k; p.ph_hi = k + 1; hipLaunchKernelGGL(hybrid_fwd, dim3(grid), dim3(NWAVES * 64), LDS_BYTES, stream, p); }
#endif
}
```

```cpp
#include <hip/hip_runtime.h>
#include <cstdio>
#include <cstdint>
#include <cstring>

#define LAS __attribute__((address_space(3)))
#define GAS __attribute__((address_space(1)))
typedef unsigned short bf16_t;
typedef short bf16x8 __attribute__((ext_vector_type(8)));
typedef short s16x4 __attribute__((ext_vector_type(4)));
typedef float f32x4 __attribute__((ext_vector_type(4)));
typedef float f32x2 __attribute__((ext_vector_type(2)));
typedef float f32x16 __attribute__((ext_vector_type(16)));
typedef unsigned u32x4 __attribute__((ext_vector_type(4)));
typedef unsigned u32x2 __attribute__((ext_vector_type(2)));
typedef GAS unsigned gu32;

constexpr int SEQ = 16384, DM = 2048;
constexpr int SSM_W = 1024, SSM_G = 64, SSM_P = 64, SSM_H = 16;
constexpr int QL = 512, KVL = 512, NHEAD = 16, DNOPE = 128, DROPE = 64, DV = 128;
constexpr int IN_COLS = 6208;
constexpr int MEML = 256, XH = 4, XW = 512;
constexpr int NEXP = 32, TOPK = 4, DFF = 2048;
constexpr int NSLOT = SEQ * TOPK + NEXP * 256;
constexpr int MAXBLK = NSLOT / 256;
constexpr float EPS = 1e-6f;
constexpr int NWAVES = 8;

#define LDS_WAIT() asm volatile("s_waitcnt lgkmcnt(0)" ::: "memory")
#define VM_WAIT() asm volatile("s_waitcnt vmcnt(0)" ::: "memory")
#define SBAR() __builtin_amdgcn_sched_barrier(0)
__device__ __forceinline__ unsigned cvtpk(float lo, float hi) { unsigned r; asm volatile("v_cvt_pk_bf16_f32 %0, %1, %2" : "=v"(r) : "v"(lo), "v"(hi)); return r; }
__device__ __forceinline__ float bf2f(unsigned short b) { return __uint_as_float(((unsigned)b) << 16); }
__device__ __forceinline__ float bflo(unsigned w) { return __uint_as_float(w << 16); }
__device__ __forceinline__ float bfhi(unsigned w) { return __uint_as_float(w & 0xffff0000u); }
__device__ __forceinline__ unsigned short f2bf(float f) { return (unsigned short)(cvtpk(f, f) & 0xffffu); }
__device__ __forceinline__ u32x4 pack8f(f32x4 a, f32x4 b) { u32x4 w = {cvtpk(a[0], a[1]), cvtpk(a[2], a[3]), cvtpk(b[0], b[1]), cvtpk(b[2], b[3])}; return w; }
__device__ __forceinline__ void unpack8(u32x4 w, f32x4& a, f32x4& b) { a = (f32x4){bflo(w.x), bfhi(w.x), bflo(w.y), bfhi(w.y)}; b = (f32x4){bflo(w.z), bfhi(w.z), bflo(w.w), bfhi(w.w)}; }
__device__ __forceinline__ float fsigmoid(float x) { return __builtin_amdgcn_rcpf(1.0f + __builtin_amdgcn_exp2f(-1.4426950408889634f * x)); }
__device__ __forceinline__ float gelu_tanh(float x) {
    const float u = 0.7978845608028654f * (x + 0.044715f * x * x * x);
    return x * fsigmoid(2.0f * u);
}
__device__ __forceinline__ float wave_sum(float v) {
#pragma unroll
    for (int o = 1; o < 64; o <<= 1) v += __shfl_xor(v, o);
    return v;
}

#define XB_TMO      128
#define XB_XCNT(j)  (256  + 64 * (j))
#define XB_XSUB(j)  (1280 + 64 * (j))
#define XB_XGEN(j)  (2304 + 64 * (j))
#define XB_TOP      3328
#define XB_TOPGEN   3392
#define XCD_BAR_WORDS 3456
#define XB_SPIN_CAP (1u << 18)
__device__ __forceinline__ unsigned xb_ld(unsigned* p)              { return __hip_atomic_load(p, __ATOMIC_RELAXED, __HIP_MEMORY_SCOPE_AGENT); }
__device__ __forceinline__ unsigned xb_add(unsigned* p, unsigned v) { return __hip_atomic_fetch_add(p, v, __ATOMIC_RELAXED, __HIP_MEMORY_SCOPE_AGENT); }
__device__ __forceinline__ unsigned xb_xcc_id() { return (unsigned)__builtin_amdgcn_s_getreg((3 << 11) | 20) & 0xFu; }
#define XB_SPIN(cond, bar) do { unsigned _sp = 0; while (cond) { __builtin_amdgcn_s_sleep(1); \
    if ((++_sp & 255u) == 0u) { if (xb_ld(&(bar)[XB_TMO])) break; if (_sp > XB_SPIN_CAP) { atomicAdd(&(bar)[XB_TMO], 1u); break; } } } } while (0)
struct XcdBarrier { unsigned* bar; unsigned x; volatile LAS unsigned* st; };
__device__ __forceinline__ XcdBarrier xcd_barrier_post(unsigned* bar, volatile LAS unsigned* st) {
    XcdBarrier b; b.bar = bar; b.x = xb_xcc_id(); b.st = st;
    if (threadIdx.x == 0) (void)xb_add(&bar[XB_XCNT(b.x)], 1u);
    return b;
}
__device__ __forceinline__ void xcd_barrier_complete(unsigned* bar, unsigned x, unsigned& nloc, unsigned& nx) {
    const unsigned G = gridDim.x * gridDim.y * gridDim.z;
    unsigned sum, cnt, mine, sp = 0u;
    for (;;) {
        sum = 0u; cnt = 0u; mine = 0u;
#pragma unroll
        for (unsigned j = 0; j < 16; ++j) { const unsigned c = xb_ld(&bar[XB_XCNT(j)]); sum += c; cnt += (c > 0u) ? 1u : 0u; mine = (j == x) ? c : mine; }
        if (sum == G) break;
        __builtin_amdgcn_s_sleep(1);
        if ((++sp & 255u) == 0u) { if (xb_ld(&bar[XB_TMO])) break; if (sp > XB_SPIN_CAP) { atomicAdd(&bar[XB_TMO], 1u); break; } }
    }
    nloc = mine > 0u ? mine : 1u; nx = cnt > 0u ? cnt : 1u;
}
__device__ __forceinline__ void xcd_barrier(const XcdBarrier& b) {
    asm volatile("s_waitcnt vmcnt(0)" ::: "memory");
    __syncthreads();
    if (threadIdx.x == 0) {
        unsigned* bar = b.bar;
        __builtin_amdgcn_s_waitcnt(0);
        unsigned nloc = b.st[0], nx = b.st[1];
        if (nloc == 0u) { xcd_barrier_complete(bar, b.x, nloc, nx); b.st[0] = nloc; b.st[1] = nx; }
        const unsigned old = xb_add(&bar[XB_XSUB(b.x)], 1u);
        const unsigned gen = old / nloc;
        if (old + 1u == (gen + 1u) * nloc) {
            __builtin_amdgcn_fence(__ATOMIC_RELEASE, "agent");
            asm volatile("s_waitcnt vmcnt(0)" ::: "memory");
            const unsigned og = xb_add(&bar[XB_TOP], 1u);
            const unsigned tg = og / nx;
            if (og + 1u == (tg + 1u) * nx) xb_add(&bar[XB_TOPGEN], 1u);
            else XB_SPIN(xb_ld(&bar[XB_TOPGEN]) == tg, bar);
            __builtin_amdgcn_fence(__ATOMIC_ACQUIRE, "agent");
            xb_add(&bar[XB_XGEN(b.x)], 1u);
            asm volatile("s_waitcnt vmcnt(0)" ::: "memory");
        } else {
            XB_SPIN(xb_ld(&bar[XB_XGEN(b.x)]) == gen, bar);
            __builtin_amdgcn_fence(__ATOMIC_ACQUIRE, "agent");
            asm volatile("s_waitcnt vmcnt(0)" ::: "memory");
        }
    }
    __syncthreads();
}
namespace pg8 {
constexpr int BM = 256, BK = 64, HALF = 128, HTB = HALF * BK * 2, NXCD = 8, WGM = 8;
__host__ __device__ __forceinline__ int lds_byte(int r, int c) { const int st = (r >> 4) * 2 + (c >> 5), rr = r & 15, cc = c & 31, ob = rr * 64 + cc * 2; return st * 1024 + (ob ^ (((ob >> 9) & 1) << 5)); }
__host__ __device__ __forceinline__ void stage_rc(int b, int& R, int& C) { const int st = b / 1024, sb = b % 1024, swz = sb ^ (((sb >> 9) & 1) << 5); R = (st >> 1) * 16 + swz / 64; C = (st & 1) * 32 + (swz % 64) / 2; }
__host__ __device__ __forceinline__ int perm32(int rho) { const int n = rho >> 4, i = rho & 15; return 8 * (i >> 2) + 4 * n + (i & 3); }

struct Unit { int pm, pn, e; };
struct Gemm { const bf16_t* A; const bf16_t* Bt; int lda, ldb, K; size_t bstride; };

struct StaticOrder {
    int nM, nN, nwg, G, c;
    __device__ void init(int M, int N, int G_, int c_) { nM = M / BM; nN = N / BM; nwg = nM * nN; G = G_; c = c_; }
    __device__ bool next(int i, Unit& u) const {
        const long L = (long)i * G + c; if (L >= nwg) return false;
        int wgid = (int)L; { const int q = nwg / NXCD, r = nwg % NXCD, xcd = wgid % NXCD, off = wgid / NXCD; wgid = (xcd < r ? xcd * (q + 1) : r * (q + 1) + (xcd - r) * q) + off; }
        const int nig = WGM * nN, gid = wgid / nig, fm = gid * WGM, gsz = (nM - fm) < WGM ? (nM - fm) : WGM;
        u.pm = fm + ((wgid % nig) % gsz); u.pn = (wgid % nig) / gsz; u.e = 0; return true;
    }
};
struct MoeOrder {
    StaticOrder so; const int* blk_e;
    __device__ void init(int nblk, int N, int G_, int c_, const int* be) { so.nM = nblk; so.nN = N / BM; so.nwg = so.nM * so.nN; so.G = G_; so.c = c_; blk_e = be; }
    __device__ bool next(int i, Unit& u) const { if (!so.next(i, u)) return false; u.e = __builtin_amdgcn_readfirstlane(blk_e[u.pm]); return true; }
};

typedef int v4i_t __attribute__((ext_vector_type(4)));
typedef int v8i_t __attribute__((ext_vector_type(8)));
#define PG8_CAT8(a, b) __builtin_shufflevector(__builtin_bit_cast(v4i_t, a), __builtin_bit_cast(v4i_t, b), 0, 1, 2, 3, 4, 5, 6, 7)
template <class Epi, class Sched, bool F8 = false>
__device__ __forceinline__ void gemm_phase(LAS unsigned char* lds, const Gemm g, const Sched& S, const Epi& E) {
    constexpr bool ALIGN_EPI = true;
    const int tid = threadIdx.x, wid = __builtin_amdgcn_readfirstlane(tid >> 6), lane = tid & 63, wr = wid >> 2, wc = wid & 3, fr = lane & 15, fq = lane >> 4;
    const int K = g.K, nt = K / BK;
    unsigned voffA[2], voffB[2];
#pragma unroll
    for (int i = 0; i < 2; ++i) { int R, C; stage_rc(tid * 16 + i * 8192, R, C); const int Rb = Epi::PERM ? ((R & ~31) + perm32(R & 31)) : R;
        voffA[i] = (unsigned)(R * g.lda + C) * 2u; voffB[i] = (unsigned)(Rb * g.ldb + C) * 2u; }
    const size_t kstep = (size_t)(BK * 2);
    const size_t hstepA = (size_t)HALF * g.lda * 2, hstepB = (size_t)HALF * g.ldb * 2;
    const unsigned ldsw = (unsigned)wid * 1024u;
    const int aoff = lds_byte(wr * 64 + fr, fq * 8), boff = lds_byte(wc * 32 + fr, fq * 8);
#define PG8_SA(b, h) (((b) * 2 + (h)) * HTB)
#define PG8_SB(b, h) ((4 + (b) * 2 + (h)) * HTB)
#define PG8_STAGE(bufoff, gbase, voff) do { _Pragma("unroll") for (int _i = 0; _i < 2; ++_i) \
        __builtin_amdgcn_global_load_lds((const unsigned*)((const char*)(gbase) + (voff)[_i]), (LAS unsigned*)(lds + (bufoff) + ldsw + _i * 8192), 16, 0, 0); } while (0)
#define PG8_LDA(dst, b, h) do { _Pragma("unroll") for (int m = 0; m < 4; ++m) _Pragma("unroll") for (int k = 0; k < 2; ++k) dst[m][k] = *(const LAS bf16x8*)(lds + PG8_SA(b, h) + aoff + m * 2048 + k * 1024); } while (0)
#define PG8_LDB(dst, b, h) do { _Pragma("unroll") for (int n = 0; n < 2; ++n) _Pragma("unroll") for (int k = 0; k < 2; ++k) dst[n][k] = *(const LAS bf16x8*)(lds + PG8_SB(b, h) + boff + n * 2048 + k * 1024); } while (0)
#define PG8_MMA(ai, bj, At, Bt) do { __builtin_amdgcn_s_setprio(1); _Pragma("unroll") for (int m = 0; m < 4; ++m) _Pragma("unroll") for (int n = 0; n < 2; ++n) { \
        if constexpr (F8) { const v8i_t b8_ = PG8_CAT8(Bt[n][0], Bt[n][1]), a8_ = PG8_CAT8(At[m][0], At[m][1]); asm volatile("v_mfma_f32_16x16x128_f8f6f4 %0, %1, %2, %0" : "+v"(acc[ai][bj][m][n]) : "v"(b8_), "v"(a8_)); }   \
        else { _Pragma("unroll") for (int k = 0; k < 2; ++k) acc[ai][bj][m][n] = __builtin_amdgcn_mfma_f32_16x16x32_bf16(Bt[n][k], At[m][k], acc[ai][bj][m][n], 0, 0, 0); } } __builtin_amdgcn_s_setprio(0); } while (0)
#define PG8_WAIT_V(n) asm volatile("s_waitcnt vmcnt(" #n ")" ::: "memory")
#define PG8_WAIT_L(n) asm volatile("s_waitcnt lgkmcnt(" #n ")" ::: "memory")
#define PG8_BAR __builtin_amdgcn_s_barrier()
#define PG8_SCHED __builtin_amdgcn_sched_barrier(0)
#define PG8_ABASE(u) ((const char*)g.A + (size_t)(u).pm * BM * g.lda * 2)
#define PG8_BBASE(u) ((const char*)g.Bt + ((size_t)(u).e * g.bstride + (size_t)(u).pn * BM * g.ldb) * 2)
    Unit cur, nxt; int ui = 0;
    if (!S.next(0, cur)) return;
    f32x4 acc[2][2][4][2];
#pragma unroll
    for (int a = 0; a < 2; ++a)
#pragma unroll
        for (int b = 0; b < 2; ++b)
#pragma unroll
            for (int m = 0; m < 4; ++m)
#pragma unroll
                for (int n = 0; n < 2; ++n) acc[a][b][m][n] = (f32x4){0.f, 0.f, 0.f, 0.f};
    bf16x8 At[4][2], B0[2][2], B1[2][2];
    const char* cA = PG8_ABASE(cur); const char* cB = PG8_BBASE(cur);
    PG8_STAGE(PG8_SB(0, 0), cB, voffB); PG8_STAGE(PG8_SB(0, 1), cB + hstepB, voffB); PG8_STAGE(PG8_SA(0, 0), cA, voffA); PG8_STAGE(PG8_SA(0, 1), cA + hstepA, voffA);
    if (wr == 1) PG8_BAR;
    PG8_WAIT_V(2); PG8_BAR;
    PG8_STAGE(PG8_SB(1, 0), cB + kstep, voffB); PG8_STAGE(PG8_SA(1, 0), cA + kstep, voffA); PG8_STAGE(PG8_SB(1, 1), cB + hstepB + kstep, voffB);
    PG8_WAIT_V(6); PG8_BAR;
    for (;;) {
        const bool has_next = S.next(ui + 1, nxt);
        const char* nA = has_next ? PG8_ABASE(nxt) : cA; const char* nB = has_next ? PG8_BBASE(nxt) : cB;
        for (int t = 0; t < nt; t += 2) {
            const bool last = (t == nt - 2);
            const char* a1 = cA + (size_t)(t + 1) * kstep;
            const char* a2 = last ? nA : cA + (size_t)(t + 2) * kstep; const char* b2 = last ? nB : cB + (size_t)(t + 2) * kstep;
            const char* a3 = a2 + kstep; const char* b3 = b2 + kstep;
            PG8_LDB(B0, 0, 0); PG8_LDB(B1, 0, 1); PG8_SCHED; PG8_LDA(At, 0, 0); PG8_STAGE(PG8_SA(1, 1), a1 + hstepA, voffA);
            PG8_WAIT_V(8); PG8_WAIT_L(0); PG8_BAR; PG8_MMA(0, 0, At, B0); PG8_MMA(0, 1, At, B1); PG8_BAR; PG8_SCHED;
            PG8_LDA(At, 0, 1); PG8_STAGE(PG8_SB(0, 0), b2, voffB); PG8_STAGE(PG8_SB(0, 1), b2 + hstepB, voffB); PG8_STAGE(PG8_SA(0, 0), a2, voffA);
            PG8_WAIT_V(8); PG8_WAIT_L(0); PG8_BAR; PG8_MMA(1, 0, At, B0); PG8_MMA(1, 1, At, B1); PG8_BAR; PG8_SCHED;
            PG8_LDB(B0, 1, 0); PG8_LDB(B1, 1, 1); PG8_SCHED; PG8_LDA(At, 1, 0); PG8_STAGE(PG8_SA(0, 1), a2 + hstepA, voffA);
            PG8_WAIT_V(8); PG8_WAIT_L(0); PG8_BAR; PG8_MMA(0, 0, At, B0); PG8_MMA(0, 1, At, B1); PG8_BAR; PG8_SCHED;
            PG8_LDA(At, 1, 1); PG8_STAGE(PG8_SB(1, 0), b3, voffB); PG8_STAGE(PG8_SB(1, 1), b3 + hstepB, voffB); PG8_STAGE(PG8_SA(1, 0), a3, voffA);
            PG8_WAIT_V(8); PG8_WAIT_L(0); PG8_BAR; PG8_MMA(1, 0, At, B0); PG8_MMA(1, 1, At, B1); PG8_BAR; PG8_SCHED;
        }
        if constexpr (ALIGN_EPI) { if (wr == 0) PG8_BAR; }
        if constexpr (F8) asm volatile("s_nop 15\n\ts_nop 15\n\ts_nop 15" ::: "memory");
        E(acc, cur, wr, wc, fr, fq);
        if (!has_next) break;
#pragma unroll
        for (int a = 0; a < 2; ++a)
#pragma unroll
            for (int b = 0; b < 2; ++b)
#pragma unroll
                for (int m = 0; m < 4; ++m)
#pragma unroll
                    for (int n = 0; n < 2; ++n) acc[a][b][m][n] = (f32x4){0.f, 0.f, 0.f, 0.f};
        cur = nxt; cA = nA; cB = nB; ++ui;
        if constexpr (ALIGN_EPI) { if (wr == 1) PG8_BAR; }
    }
    PG8_WAIT_V(0);
    if constexpr (!ALIGN_EPI) { if (wr == 0) PG8_BAR; }
    PG8_BAR;
#undef PG8_SA
#undef PG8_SB
#undef PG8_STAGE
#undef PG8_LDA
#undef PG8_LDB
#undef PG8_MMA
#undef PG8_WAIT_V
#undef PG8_WAIT_L
#undef PG8_BAR
#undef PG8_SCHED
#undef PG8_ABASE
#undef PG8_BBASE
}

#define EPI_ROW(u, ai, m) ((u).pm * BM + (ai) * HALF + wr * 64 + (m) * 16 + fr)
#define EPI_CB(bj) ((bj) * HALF + wc * 32 + 8 * fq)
typedef f32x4 AccT[2][2][4][2];

__device__ __forceinline__ f32x4 sig4(f32x4 v) { return (f32x4){fsigmoid(v[0]), fsigmoid(v[1]), fsigmoid(v[2]), fsigmoid(v[3])}; }
__device__ __forceinline__ float sq4(f32x4 v) { return (v[0] * v[0] + v[1] * v[1]) + (v[2] * v[2] + v[3] * v[3]); }

struct EpiProj {
    static constexpr bool PERM = true;
    bf16_t *ub, *qa, *kva, *sgs, *sgm; float *qss, *kvss;
    __device__ __forceinline__ void operator()(const AccT& acc, const Unit& u, int wr, int wc, int fr, int fq) const {
        const int pn = u.pn; bf16_t* dst; int ld, c0; float* ss = nullptr; int ssl = 0; bool sg = false;
        if (pn < 4) { dst = ub; ld = SSM_W; c0 = pn * BM; }
        else if (pn < 6) { dst = qa; ld = QL; c0 = (pn - 4) * BM; ss = qss; ssl = (pn - 4) * 4 + wc; }
        else if (pn < 8) { dst = kva; ld = KVL; c0 = (pn - 6) * BM; ss = kvss; ssl = (pn - 6) * 4 + wc; }
        else if (pn < 16) { dst = sgs; ld = DM; c0 = (pn - 8) * BM; sg = true; }
        else { dst = sgm; ld = DM; c0 = (pn - 16) * BM; sg = true; }
#pragma unroll
        for (int ai = 0; ai < 2; ++ai)
#pragma unroll
            for (int m = 0; m < 4; ++m) { const int row = EPI_ROW(u, ai, m); float s = 0.f;
#pragma unroll
                for (int bj = 0; bj < 2; ++bj) { f32x4 v0 = acc[ai][bj][m][0], v1 = acc[ai][bj][m][1];
                    if (sg) { v0 = sig4(v0); v1 = sig4(v1); }
                    s += sq4(v0) + sq4(v1);
                    *(u32x4*)(dst + (size_t)row * ld + c0 + EPI_CB(bj)) = pack8f(v0, v1); }
                if (ss) { s += __shfl_xor(s, 16); s += __shfl_xor(s, 32); if (fq == 0) ss[((size_t)(ssl >> 2) * SEQ + row) * 4 + (ssl & 3)] = s; } }
    }
};
__device__ __forceinline__ float row_rs8(const float* ss, int row, float invn) { const f32x4 a = *(const f32x4*)(ss + (size_t)row * 4), b = *(const f32x4*)(ss + ((size_t)SEQ + row) * 4);
    return __builtin_amdgcn_rsqf(((a[0] + a[1]) + (a[2] + a[3]) + (b[0] + b[1]) + (b[2] + b[3])) * invn + EPS); }
__device__ __forceinline__ float row_rs32(const float* ss, int row, float invn) { float s = 0.f;
#pragma unroll
    for (int i = 0; i < 8; ++i) { const f32x4 a = *(const f32x4*)(ss + ((size_t)i * SEQ + row) * 4); s += (a[0] + a[1]) + (a[2] + a[3]); }
    return __builtin_amdgcn_rsqf(s * invn + EPS); }

struct EpiQup {
    static constexpr bool PERM = true;
    bf16_t *qn, *qr; const float *ss, *cosT, *sinT;
    __device__ __forceinline__ void operator()(const AccT& acc, const Unit& u, int wr, int wc, int fr, int fq) const {
        const int pn = u.pn;
#pragma unroll
        for (int ai = 0; ai < 2; ++ai)
#pragma unroll
            for (int m = 0; m < 4; ++m) { const int row = EPI_ROW(u, ai, m); const float rs = row_rs8(ss, row, 1.0f / QL);
                if (pn < 8) {
#pragma unroll
                    for (int bj = 0; bj < 2; ++bj) *(u32x4*)(qn + (size_t)row * DM + pn * BM + EPI_CB(bj)) = pack8f(acc[ai][bj][m][0] * rs, acc[ai][bj][m][1] * rs);
                } else {
                    const int head = 4 * (pn - 8) + wc;
                    const f32x4 c0 = *(const f32x4*)(cosT + (size_t)row * 32 + 8 * fq), c1 = *(const f32x4*)(cosT + (size_t)row * 32 + 8 * fq + 4);
                    const f32x4 s0 = *(const f32x4*)(sinT + (size_t)row * 32 + 8 * fq), s1 = *(const f32x4*)(sinT + (size_t)row * 32 + 8 * fq + 4);
                    const f32x4 a0 = acc[ai][0][m][0] * rs, a1 = acc[ai][0][m][1] * rs, b0 = acc[ai][1][m][0] * rs, b1 = acc[ai][1][m][1] * rs;
                    *(u32x4*)(qr + (size_t)row * (NHEAD * DROPE) + head * DROPE + 8 * fq) = pack8f(a0 * c0 - b0 * s0, a1 * c1 - b1 * s1);
                    *(u32x4*)(qr + (size_t)row * (NHEAD * DROPE) + head * DROPE + 32 + 8 * fq) = pack8f(a0 * s0 + b0 * c0, a1 * s1 + b1 * c1);
                } }
    }
};
struct EpiKVup {
    static constexpr bool PERM = true;
    bf16_t *kn, *vv; const float* ss;
    __device__ __forceinline__ void operator()(const AccT& acc, const Unit& u, int wr, int wc, int fr, int fq) const {
        bf16_t* dst = u.pn < 8 ? kn : vv; const int c0 = (u.pn & 7) * BM;
#pragma unroll
        for (int ai = 0; ai < 2; ++ai)
#pragma unroll
            for (int m = 0; m < 4; ++m) { const int row = EPI_ROW(u, ai, m); const float rs = row_rs8(ss, row, 1.0f / KVL);
#pragma unroll
                for (int bj = 0; bj < 2; ++bj) *(u32x4*)(dst + (size_t)row * DM + c0 + EPI_CB(bj)) = pack8f(acc[ai][bj][m][0] * rs, acc[ai][bj][m][1] * rs); }
    }
};
struct EpiPlain {
    static constexpr bool PERM = true;
    bf16_t* O; int ld;
    __device__ __forceinline__ void operator()(const AccT& acc, const Unit& u, int wr, int wc, int fr, int fq) const {
#pragma unroll
        for (int ai = 0; ai < 2; ++ai)
#pragma unroll
            for (int m = 0; m < 4; ++m) { const int row = EPI_ROW(u, ai, m);
#pragma unroll
                for (int bj = 0; bj < 2; ++bj) *(u32x4*)(O + (size_t)row * ld + u.pn * BM + EPI_CB(bj)) = pack8f(acc[ai][bj][m][0], acc[ai][bj][m][1]); }
    }
};
struct EpiGlu {
    static constexpr bool PERM = true;
    const bf16_t* z; const float* bias; bf16_t* ys;
    __device__ __forceinline__ void operator()(const AccT& acc, const Unit& u, int wr, int wc, int fr, int fq) const {
#pragma unroll
        for (int bj = 0; bj < 2; ++bj) { const int col = u.pn * BM + EPI_CB(bj); const f32x4 b0 = *(const f32x4*)(bias + col), b1 = *(const f32x4*)(bias + col + 4);
#pragma unroll
            for (int ai = 0; ai < 2; ++ai)
#pragma unroll
                for (int m = 0; m < 4; ++m) { const size_t off = (size_t)EPI_ROW(u, ai, m) * SSM_W + col; f32x4 z0, z1; unpack8(*(const u32x4*)(z + off), z0, z1);
                    *(u32x4*)(ys + off) = pack8f(z0 * sig4(acc[ai][bj][m][0] + b0), z1 * sig4(acc[ai][bj][m][1] + b1)); } }
    }
};
struct EpiGate {
    static constexpr bool PERM = true;
    const bf16_t* gate; const bf16_t* addend; bf16_t* O;
    __device__ __forceinline__ void operator()(const AccT& acc, const Unit& u, int wr, int wc, int fr, int fq) const {
#pragma unroll
        for (int ai = 0; ai < 2; ++ai)
#pragma unroll
            for (int m = 0; m < 4; ++m)
#pragma unroll
                for (int bj = 0; bj < 2; ++bj) { const size_t off = (size_t)EPI_ROW(u, ai, m) * DM + u.pn * BM + EPI_CB(bj); f32x4 g0, g1; unpack8(*(const u32x4*)(gate + off), g0, g1);
                    f32x4 r0 = g0 * acc[ai][bj][m][0], r1 = g1 * acc[ai][bj][m][1];
                    if (addend) { f32x4 t0, t1; unpack8(*(const u32x4*)(addend + off), t0, t1); r0 += t0; r1 += t1; }
                    *(u32x4*)(O + off) = pack8f(r0, r1); }
    }
};
struct EpiResid {
    static constexpr bool PERM = true;
    const float* xi; float* xo; bf16_t* xb; float* ss;
    __device__ __forceinline__ void operator()(const AccT& acc, const Unit& u, int wr, int wc, int fr, int fq) const {
#pragma unroll
        for (int ai = 0; ai < 2; ++ai)
#pragma unroll
            for (int m = 0; m < 4; ++m) { const int row = EPI_ROW(u, ai, m); float s = 0.f;
#pragma unroll
                for (int bj = 0; bj < 2; ++bj) { const size_t off = (size_t)row * DM + u.pn * BM + EPI_CB(bj);
                    const f32x4 r0 = *(const f32x4*)(xi + off) + acc[ai][bj][m][0], r1 = *(const f32x4*)(xi + off + 4) + acc[ai][bj][m][1];
                    *(f32x4*)(xo + off) = r0; *(f32x4*)(xo + off + 4) = r1; s += sq4(r0) + sq4(r1);
                    if (xb) *(u32x4*)(xb + off) = pack8f(r0, r1); }
                s += __shfl_xor(s, 16); s += __shfl_xor(s, 32); if (fq == 0) ss[((size_t)u.pn * SEQ + row) * 4 + wc] = s; }
    }
};
struct EpiXq {
    static constexpr bool PERM = true;
    bf16_t* O; const float* ss;
    __device__ __forceinline__ void operator()(const AccT& acc, const Unit& u, int wr, int wc, int fr, int fq) const {
#pragma unroll
        for (int ai = 0; ai < 2; ++ai)
#pragma unroll
            for (int m = 0; m < 4; ++m) { const int row = EPI_ROW(u, ai, m); const float rs = row_rs32(ss, row, 1.0f / DM);
#pragma unroll
                for (int bj = 0; bj < 2; ++bj) *(u32x4*)(O + (size_t)row * XW + u.pn * BM + EPI_CB(bj)) = pack8f(acc[ai][bj][m][0] * rs, acc[ai][bj][m][1] * rs); }
    }
};
constexpr float F8_XS = 8.0f, F8_WS = 512.0f, F8_AS = 4.0f;
__device__ __forceinline__ unsigned pk4_fp8(float a, float b, float c, float d) {
    a = fminf(fmaxf(a, -448.f), 448.f); b = fminf(fmaxf(b, -448.f), 448.f); c = fminf(fmaxf(c, -448.f), 448.f); d = fminf(fmaxf(d, -448.f), 448.f);
    int w = __builtin_amdgcn_cvt_pk_fp8_f32(a, b, 0, false); w = __builtin_amdgcn_cvt_pk_fp8_f32(c, d, w, true); return (unsigned)w; }
struct EpiMoeGU {
    static constexpr bool PERM = true;
    const float* bias; unsigned char* act;
    __device__ __forceinline__ void operator()(const AccT& acc, const Unit& u, int wr, int wc, int fr, int fq) const {
        const int j0 = u.pn * HALF + wc * 32 + 8 * fq; const float* bg = bias + (size_t)u.e * (2 * DFF) + j0; constexpr float SC = 1.0f / (F8_XS * F8_WS);
        const f32x4 g0 = *(const f32x4*)bg, g1 = *(const f32x4*)(bg + 4), u0 = *(const f32x4*)(bg + DFF), u1 = *(const f32x4*)(bg + DFF + 4);
#pragma unroll
        for (int ai = 0; ai < 2; ++ai)
#pragma unroll
            for (int m = 0; m < 4; ++m) { const int row = EPI_ROW(u, ai, m); f32x4 r[2];
#pragma unroll
                for (int n = 0; n < 2; ++n) { const f32x4 gt = acc[ai][0][m][n] * SC + (n ? g1 : g0), up = acc[ai][1][m][n] * SC + (n ? u1 : u0);
#pragma unroll
                    for (int j = 0; j < 4; ++j) { const float gc = fminf(gt[j], 7.0f), uc = fminf(fmaxf(up[j], -7.0f), 7.0f); r[n][j] = F8_AS * (uc + 1.0f) * (gc * fsigmoid(1.702f * gc)); } }
                u32x2 o = {pk4_fp8(r[0][0], r[0][1], r[0][2], r[0][3]), pk4_fp8(r[1][0], r[1][1], r[1][2], r[1][3])};
                *(u32x2*)(act + (size_t)row * DFF + j0) = o; }
    }
};
struct EpiMoeDown {
    static constexpr bool PERM = true;
    const float* bias; bf16_t* O;
    __device__ __forceinline__ void operator()(const AccT& acc, const Unit& u, int wr, int wc, int fr, int fq) const {
#pragma unroll
        for (int bj = 0; bj < 2; ++bj) { const int col = u.pn * BM + EPI_CB(bj); const float* bp = bias + (size_t)u.e * DM + col; const f32x4 b0 = *(const f32x4*)bp, b1 = *(const f32x4*)(bp + 4); constexpr float SC = 1.0f / (F8_AS * F8_WS);
#pragma unroll
            for (int ai = 0; ai < 2; ++ai)
#pragma unroll
                for (int m = 0; m < 4; ++m) *(u32x4*)(O + (size_t)EPI_ROW(u, ai, m) * DM + col) = pack8f(acc[ai][bj][m][0] * SC + b0, acc[ai][bj][m][1] * SC + b1); }
    }
};
#undef EPI_ROW
#undef EPI_CB
}
namespace att {
constexpr int NW = 8, QBLK = 32, KVBLK = 64, QB = NW * QBLK;
constexpr int SHM_V = KVBLK * 128 * 2, SHM_K = KVBLK * 128 * 2, SHM_KR = KVBLK * 64 * 2;
constexpr int OFF_V = 0, OFF_K = 2 * SHM_V, OFF_KR = OFF_K + 2 * SHM_K, OFF_WS = OFF_KR + 2 * SHM_KR, OFF_QR = OFF_WS + NW * 64 * 4, LDS_BYTES = OFF_QR + NW * 8192;
constexpr float THR = 8.f;
#define KSWZ(row, colB) ((row) * 256 + ((colB) ^ (((row) & 7) << 4)))
__device__ __forceinline__ int v_st(int k, int c) { const int kk = (k & ~0xC) | ((k & 4) << 1) | ((k & 8) >> 1); return ((kk >> 3) * 4 + (c >> 5)) * 512 + ((kk & 7) * 32 + (c & 31)) * 2; }
__device__ __forceinline__ int v_rd_base(int lane) { return ((lane & 3) << 3) | (((lane >> 2) & 3) << 6) | (((lane >> 4) & 1) << 5) | (((lane >> 5) & 1) << 8); }
constexpr int v_rd_off(int d0, int ks, int half) { return d0 * 512 + ks * 4096 + half * 2048; }
__device__ __forceinline__ int crow(int r, int hi) { return (r & 3) + 8 * (r >> 2) + 4 * hi; }

__device__ __forceinline__ void mask_tile(f32x16& p0, f32x16& p1, int dq) {
    const float NEG = -__builtin_inff();
#pragma unroll
    for (int r = 0; r < 16; ++r) {
        const int c = (r & 3) + 8 * (r >> 2);
        if (dq - c < 0) p0[r] = NEG;
        if (dq - c - 32 < 0) p1[r] = NEG;
    }
}
template <bool ROPE>
__device__ __forceinline__ void partialSM(f32x16& p0, f32x16& p1, float& m_reg, float& mn, float& alpha) {
    constexpr float SCALE = ROPE ? 0.07216878364870323f : 0.08838834764831845f;
    float pmax = p0[0];
#pragma unroll
    for (int r = 1; r < 16; ++r) pmax = fmaxf(pmax, p0[r]);
#pragma unroll
    for (int r = 0; r < 16; ++r) pmax = fmaxf(pmax, p1[r]);
    { auto rr = __builtin_amdgcn_permlane32_swap(__float_as_uint(pmax), __float_as_uint(pmax), false, false);
      pmax = fmaxf(__uint_as_float(rr[0]), __uint_as_float(rr[1])); }
    constexpr float C2 = 1.4426950408889634f * SCALE;
    if (__builtin_expect(__all((pmax - m_reg) * SCALE <= THR), 1)) { mn = m_reg; alpha = 1.f; }
    else { mn = fmaxf(m_reg, pmax); alpha = __builtin_amdgcn_exp2f((m_reg - mn) * C2); m_reg = mn; }
    const float mnL = -mn * C2;
#pragma unroll
    for (int r = 0; r < 16; ++r) p0[r] = fmaf(p0[r], C2, mnL);
#pragma unroll
    for (int r = 0; r < 16; ++r) p1[r] = fmaf(p1[r], C2, mnL);
#pragma unroll
    for (int r = 0; r < 16; ++r) p0[r] = __builtin_amdgcn_exp2f(p0[r]);
}
__device__ __forceinline__ void finishSM(f32x16& p0, f32x16& p1, float alpha, float& l_reg, bf16x8& pa0, bf16x8& pa1, bf16x8& pa2, bf16x8& pa3) {
#pragma unroll
    for (int r = 0; r < 16; ++r) p1[r] = __builtin_amdgcn_exp2f(p1[r]);
    float ps = 0;
#pragma unroll
    for (int r = 0; r < 16; ++r) ps += p0[r];
#pragma unroll
    for (int r = 0; r < 16; ++r) ps += p1[r];
    { auto rr = __builtin_amdgcn_permlane32_swap(__float_as_uint(ps), __float_as_uint(ps), false, false);
      ps = __uint_as_float(rr[0]) + __uint_as_float(rr[1]); }
    l_reg = l_reg * alpha + ps;
#define PK4(P, B_, OUT) do { unsigned a0 = cvtpk(P[B_+0], P[B_+1]), a1 = cvtpk(P[B_+2], P[B_+3]);                          \
        unsigned b0 = cvtpk(P[B_+4], P[B_+5]), b1 = cvtpk(P[B_+6], P[B_+7]);                                             \
        auto r0 = __builtin_amdgcn_permlane32_swap(a0, b0, false, false); auto r1 = __builtin_amdgcn_permlane32_swap(a1, b1, false, false); \
        u32x4 w = {r0[0], r1[0], r0[1], r1[1]}; OUT = *reinterpret_cast<bf16x8*>(&w); } while (0)
    PK4(p0, 0, pa0); PK4(p0, 8, pa1); PK4(p1, 0, pa2); PK4(p1, 8, pa3);
#undef PK4
}
template <int KB, bool ROPE>
__device__ __forceinline__ void qkt(f32x16& p0, f32x16& p1, const char* K_lds, int r32, int hi, const bf16x8* qr, const char* qrl) {
    p0 = f32x16{}; p1 = f32x16{};
    const char* kb[4];
#pragma unroll
    for (int dd = 0; dd < 4; ++dd) kb[dd] = K_lds + KB * SHM_K + KSWZ(r32, (dd * 16 + hi * 8) * 2);
#pragma unroll
    for (int d0 = 0; d0 < 8; ++d0) { const char* a = kb[d0 & 3] + (d0 >> 2) * 128;
        bf16x8 b0 = *reinterpret_cast<const bf16x8*>(a);
        bf16x8 b1 = *reinterpret_cast<const bf16x8*>(a + 32 * 256);
        p0 = __builtin_amdgcn_mfma_f32_32x32x16_bf16(b0, qr[d0], p0, 0, 0, 0);
        p1 = __builtin_amdgcn_mfma_f32_32x32x16_bf16(b1, qr[d0], p1, 0, 0, 0); }
    if constexpr (ROPE) {
        constexpr int RO = 2 * SHM_K - KB * SHM_K + KB * SHM_KR;
#pragma unroll
        for (int d0 = 0; d0 < 4; ++d0) { const char* a = kb[d0] + RO;
            bf16x8 b0 = *reinterpret_cast<const bf16x8*>(a);
            bf16x8 b1 = *reinterpret_cast<const bf16x8*>(a + 128);
            const bf16x8 q = *reinterpret_cast<const bf16x8*>(qrl + d0 * 1024);
            p0 = __builtin_amdgcn_mfma_f32_32x32x16_bf16(b0, q, p0, 0, 0, 0);
            p1 = __builtin_amdgcn_mfma_f32_32x32x16_bf16(b1, q, p1, 0, 0, 0); }
    }
}
template <int VB>
__device__ __forceinline__ void pv_tile(f32x16* o, int vb0, bf16x8 pa0, bf16x8 pa1, bf16x8 pa2, bf16x8 pa3) {
#define TRRD(dst, off) asm volatile("ds_read_b64_tr_b16 %0, %1 offset:%2" : "=&v"(dst) : "v"(vb0), "i"(off) : "memory")
#define PV_D0(d0) do { s16x4 l0, l1, l2, l3, h0, h1, h2, h3; constexpr int b_ = VB * SHM_V + v_rd_off(d0, 0, 0);  \
        TRRD(l0, b_); TRRD(h0, b_ + 2048); TRRD(l1, b_ + 4096); TRRD(h1, b_ + 6144); TRRD(l2, b_ + 8192); TRRD(h2, b_ + 10240); TRRD(l3, b_ + 12288); TRRD(h3, b_ + 14336); \
        asm volatile("s_waitcnt lgkmcnt(0)" ::: "memory"); SBAR();   \
        o[d0] = __builtin_amdgcn_mfma_f32_32x32x16_bf16(pa0, (bf16x8){l0[0], l0[1], l0[2], l0[3], h0[0], h0[1], h0[2], h0[3]}, o[d0], 0, 0, 0);   \
        o[d0] = __builtin_amdgcn_mfma_f32_32x32x16_bf16(pa1, (bf16x8){l1[0], l1[1], l1[2], l1[3], h1[0], h1[1], h1[2], h1[3]}, o[d0], 0, 0, 0);   \
        o[d0] = __builtin_amdgcn_mfma_f32_32x32x16_bf16(pa2, (bf16x8){l2[0], l2[1], l2[2], l2[3], h2[0], h2[1], h2[2], h2[3]}, o[d0], 0, 0, 0);   \
        o[d0] = __builtin_amdgcn_mfma_f32_32x32x16_bf16(pa3, (bf16x8){l3[0], l3[1], l3[2], l3[3], h3[0], h3[1], h3[2], h3[3]}, o[d0], 0, 0, 0); } while (0)
    PV_D0(0); PV_D0(1); PV_D0(2); PV_D0(3);
#undef PV_D0
#undef TRRD
}

struct BlockRef { const bf16_t* Q; const bf16_t* QR; const bf16_t* K; const bf16_t* KR; const bf16_t* V; bf16_t* O; int P0; };
struct Strides { int qs, qrs, ks, vs, os, skv; };
template <bool ROPE> struct Seam { bf16x8 qr[ROPE ? 12 : 8];     bf16x8 st_v0, st_v1, st_k0, st_k1, st_kr; };
#define LD8(p) (*reinterpret_cast<const bf16x8*>(p))
#define VMW() asm volatile("s_waitcnt vmcnt(0)" ::: "memory")
#define VMWN(n) asm volatile("s_waitcnt vmcnt(%0)" :: "i"(n) : "memory")
#define SLOAD_H(R, k0) do { const char* vb_ = (const char*)(R).V + (size_t)(k0) * T.vs * 2; const char* kb_ = (const char*)(R).K + (size_t)(k0) * T.ks * 2;   \
                            S.st_v0 = LD8(vb_ + vo_v); S.st_v1 = LD8(vb_ + (size_t)T.vs * 64 + vo_v);              \
                            S.st_k0 = LD8(kb_ + vo_k); S.st_k1 = LD8(kb_ + (size_t)T.ks * 64 + vo_k);              \
                            if constexpr (ROPE) S.st_kr = LD8((const char*)(R).KR + (size_t)(k0) * (DROPE * 2) + vo_kr); } while (0)
#define SWRITE_HK(bf) do { *(bf16x8*)(K_lds + (bf) * SHM_K + kws) = S.st_k0; *(bf16x8*)(K_lds + (bf) * SHM_K + kws + 32 * 256) = S.st_k1;                \
                           if constexpr (ROPE) *(bf16x8*)(K_lds + 2 * SHM_K + (bf) * SHM_KR + krws) = S.st_kr; } while (0)
#define SWRITE_HV(bf) do { *(bf16x8*)(V_lds + (bf) * SHM_V + vst0) = S.st_v0; *(bf16x8*)(V_lds + (bf) * SHM_V + vst1) = S.st_v1; } while (0)
#define SWRITE_H(bf) do { SWRITE_HV(bf); SWRITE_HK(bf); } while (0)
#define QLOAD(R) do { const char* qb_ = (const char*)(R).Q + (size_t)(wid * QBLK) * T.qs * 2; const unsigned qo_ = (unsigned)(r32 * T.qs + hi * 8) * 2u;    \
                      _Pragma("unroll") for (int d0 = 0; d0 < 8; ++d0) S.qr[d0] = LD8(qb_ + qo_ + d0 * 32);    \
                      if constexpr (ROPE) { const char* qrb_ = (const char*)(R).QR + (size_t)(wid * QBLK) * T.qrs * 2; const unsigned qro_ = (unsigned)(r32 * T.qrs + hi * 8) * 2u;   \
                          _Pragma("unroll") for (int d0 = 0; d0 < 4; ++d0) S.qr[8 + d0] = LD8(qrb_ + qro_ + d0 * 32); } } while (0)
#define QPARK() do { if constexpr (ROPE) { _Pragma("unroll") for (int d0 = 0; d0 < 4; ++d0) *(bf16x8*)(qrl + d0 * 1024) = S.qr[8 + d0]; } } while (0)
#define QPARK8() do { _Pragma("unroll") for (int d0 = 0; d0 < (ROPE ? 8 : 4); ++d0) *(bf16x8*)(qrl + d0 * 1024) = S.qr[4 + d0]; } while (0)
#define STAGE_IDX() const int sr = tid >> 4, sc = (tid & 15) * 8, kws = KSWZ(sr, sc * 2); \
                    const int rk = tid >> 3, rc = tid & 7, krws = (rk & 31) * 256 + ((((rk >> 5) * 8 + rc) * 16) ^ (((rk & 31) & 7) << 4)); \
                    const unsigned vo_v = (unsigned)(sr * T.vs + sc) * 2u, vo_k = (unsigned)(sr * T.ks + sc) * 2u, vo_kr = (unsigned)(rk * DROPE + rc * 8) * 2u

template <bool ROPE, bool CAUSAL>
__device__ __forceinline__ void attn_prime(const BlockRef& cur, const Strides& T, char* lds, Seam<ROPE>& S) {
    const int tid = threadIdx.x, wid = __builtin_amdgcn_readfirstlane(tid >> 6), lane = tid & 63, r32 = lane & 31, hi = lane >> 5;
    STAGE_IDX(); char* K_lds = lds + OFF_K; char* qrl = lds + OFF_QR + wid * 4096 + lane * 16;
    QLOAD(cur);
    SLOAD_H(cur, 0); VMW(); SWRITE_HK(0); QPARK();
    __syncthreads();
}
template <bool ROPE, bool CAUSAL>
__device__ __forceinline__ void attn_block(const BlockRef& cur, const BlockRef& nxt, const Strides& T, char* lds, Seam<ROPE>& S) {
    const int tid = threadIdx.x, wid = __builtin_amdgcn_readfirstlane(tid >> 6), lane = tid & 63, r32 = lane & 31, hi = lane >> 5;
    int j_hi = CAUSAL ? (cur.P0 + QB - 1) / KVBLK + 1 : T.skv / KVBLK; if (j_hi > T.skv / KVBLK) j_hi = T.skv / KVBLK;
    const int NT = j_hi;
    const int qlo = cur.P0 + wid * QBLK, qm = qlo + r32 - 4 * hi;
    char* V_lds = lds + OFF_V; char* K_lds = lds + OFF_K; char* qrl = lds + OFF_QR + wid * 4096 + lane * 16;
    float* ws = (float*)(lds + OFF_WS) + wid * 64; float* li_l = ws, * al_l = ws + 32;
    float m_reg = -1e30f, l_reg = 0; f32x16 o[4] = {};
    STAGE_IDX(); const int vst0 = v_st(sr, sc), vst1 = v_st(32 + sr, sc);
    const int vb0 = (int)(uintptr_t)V_lds + v_rd_base(lane);
#define RESC(a) do { if (__any((a) < 1.f)) { if (hi == 0) al_l[r32] = (a); asm volatile("s_waitcnt lgkmcnt(0)" ::: "memory");              \
                     for (int d_ = 0; d_ < 4; ++d_) for (int r = 0; r < 16; ++r) o[d_][r] *= al_l[crow(r, hi)]; } } while (0)
#define KBASE(t) ((t) * KVBLK)
#define MASKT(P0_, P1_, t) do { if constexpr (CAUSAL) { const int kb_ = KBASE(t); if (kb_ + KVBLK - 1 > qlo) mask_tile(P0_, P1_, qm - kb_); } } while (0)
    constexpr int NQL = ROPE ? 12 : 8;
#define SEAM_K0() do { VMWN(NQL); SWRITE_HK(0); SBAR(); } while (0)
    f32x16 pA0, pA1, pB0, pB1; float mnA, mnB, alA, alB; bf16x8 pa0, pa1, pa2, pa3;
    SWRITE_HV(0); SBAR();
    if (NT > 1) { SLOAD_H(cur, KBASE(1)); }
    SBAR(); qkt<0, ROPE>(pA0, pA1, K_lds, r32, hi, S.qr, qrl);
    MASKT(pA0, pA1, 0); partialSM<ROPE>(pA0, pA1, m_reg, mnA, alA);
    if (NT > 1) { VMW(); SWRITE_H(1); }
    __syncthreads();
#define HALF_STEP(PX0, PX1, mnX, alX, PY0, PY1, alY, t, KB, VB, SB) do {                                                      \
        SBAR(); qkt<KB, ROPE>(PX0, PX1, K_lds, r32, hi, S.qr, qrl);                                                                \
        finishSM(PY0, PY1, alY, l_reg, pa0, pa1, pa2, pa3); SBAR();                                                           \
        if ((t) + 1 < NT) { SLOAD_H(cur, KBASE((t) + 1)); SBAR(); }                                                           \
        pv_tile<VB>(o, vb0, pa0, pa1, pa2, pa3); MASKT(PX0, PX1, (t)); partialSM<ROPE>(PX0, PX1, m_reg, mnX, alX);            \
        __syncthreads();                                                                                                      \
        if ((t) + 1 < NT) { VMW(); SWRITE_H(SB); }                                                                            \
        RESC(alX); __syncthreads(); } while (0)
    for (int t = 1; t + 1 < NT; t += 2) {
        HALF_STEP(pB0, pB1, mnB, alB, pA0, pA1, alA, t, 1, 0, 0);
        HALF_STEP(pA0, pA1, mnA, alA, pB0, pB1, alB, t + 1, 0, 1, 1);
    }
    const bool even = (NT & 1) == 0;
    if (even) { SBAR(); qkt<1, ROPE>(pB0, pB1, K_lds, r32, hi, S.qr, qrl); SBAR(); }
    SLOAD_H(nxt, 0); SBAR();
    QLOAD(nxt);
    SBAR();
    finishSM(pA0, pA1, alA, l_reg, pa0, pa1, pa2, pa3); SBAR();
    pv_tile<0>(o, vb0, pa0, pa1, pa2, pa3);
    if (even) { MASKT(pB0, pB1, NT - 1); partialSM<ROPE>(pB0, pB1, m_reg, mnB, alB); __syncthreads(); RESC(alB);
        finishSM(pB0, pB1, alB, l_reg, pa0, pa1, pa2, pa3); SBAR(); pv_tile<1>(o, vb0, pa0, pa1, pa2, pa3); }
    SBAR(); SEAM_K0();
    if (hi == 0) li_l[r32] = l_reg; asm volatile("s_waitcnt lgkmcnt(0)" ::: "memory");
    float rli[16];
#pragma unroll
    for (int r = 0; r < 16; ++r) rli[r] = __builtin_amdgcn_rcpf(li_l[crow(r, hi)]);
    bf16_t* Ow = cur.O + (size_t)(wid * QBLK) * T.os;
#pragma unroll
    for (int r = 0; r < 16; ++r) { const int orow = crow(r, hi);
#pragma unroll
        for (int d0 = 0; d0 < 4; ++d0) { const float v = o[d0][r] * rli[r];
            const float vn = __shfl_xor(v, 1);
            if ((r32 & 1) == 0) *(unsigned*)(Ow + (size_t)orow * T.os + d0 * 32 + r32) = cvtpk(v, vn); } }
    QPARK();
    __syncthreads();
#undef RESC
#undef KBASE
#undef MASKT
#undef SEAM_K0
#undef HALF_STEP
}

template <bool ROPE>
__device__ __forceinline__ void qkt_rt(f32x16& p0, f32x16& p1, const char* K_lds, int buf, const int (&koff)[4], const bf16x8* qr, const char* qrl) {
    p0 = f32x16{}; p1 = f32x16{};
    const char* kbase = K_lds + buf * SHM_K;
#pragma unroll
    for (int d0 = 0; d0 < 8; ++d0) { const char* a = kbase + koff[d0 & 3] + (d0 >> 2) * 128;
        bf16x8 b0 = *reinterpret_cast<const bf16x8*>(a);
        bf16x8 b1 = *reinterpret_cast<const bf16x8*>(a + 32 * 256);
        p0 = __builtin_amdgcn_mfma_f32_32x32x16_bf16(b0, qr[d0], p0, 0, 0, 0);
        p1 = __builtin_amdgcn_mfma_f32_32x32x16_bf16(b1, qr[d0], p1, 0, 0, 0); }
    if constexpr (ROPE) {
        const char* rbase = K_lds + 2 * SHM_K + buf * SHM_KR;
#pragma unroll
        for (int d0 = 0; d0 < 4; ++d0) { const char* a = rbase + koff[d0];
            bf16x8 b0 = *reinterpret_cast<const bf16x8*>(a);
            bf16x8 b1 = *reinterpret_cast<const bf16x8*>(a + 128);
            const bf16x8 q = *reinterpret_cast<const bf16x8*>(qrl + d0 * 1024);
            p0 = __builtin_amdgcn_mfma_f32_32x32x16_bf16(b0, q, p0, 0, 0, 0);
            p1 = __builtin_amdgcn_mfma_f32_32x32x16_bf16(b1, q, p1, 0, 0, 0); }
    }
}
template <bool ROPE, bool CAUSAL>
__device__ __forceinline__ void attn_block_simple(const BlockRef& cur, const Strides& T, char* lds) {
    const int tid = threadIdx.x, wid = __builtin_amdgcn_readfirstlane(tid >> 6), lane = tid & 63, r32 = lane & 31, hi = lane >> 5;
    int j_hi = CAUSAL ? (cur.P0 + QB - 1) / KVBLK + 1 : T.skv / KVBLK; if (j_hi > T.skv / KVBLK) j_hi = T.skv / KVBLK;
    const int NT = j_hi;
    const int qlo = cur.P0 + wid * QBLK, qm = qlo + r32 - 4 * hi;
    char* V_lds = lds + OFF_V; char* K_lds = lds + OFF_K;
    float* ws = (float*)(lds + OFF_WS) + wid * 64; float* li_l = ws, * al_l = ws + 32;
    float m_reg = -1e30f, l_reg = 0; f32x16 o[4] = {};
    STAGE_IDX(); const int vst0 = v_st(sr, sc), vst1 = v_st(32 + sr, sc);
    const int vb0 = (int)(uintptr_t)V_lds + v_rd_base(lane);
    int koff[4];
#pragma unroll
    for (int dd = 0; dd < 4; ++dd) koff[dd] = KSWZ(r32, (dd * 16 + hi * 8) * 2);
    Seam<ROPE> S; char* qrl = lds + OFF_QR + wid * 4096 + lane * 16;
    QLOAD(cur);
    SLOAD_H(cur, 0); VMW(); SWRITE_H(0); QPARK();
    __syncthreads();
    for (int t = 0; t < NT; ++t) {
        const int buf = t & 1;
        if (t + 1 < NT) { SLOAD_H(cur, (t + 1) * KVBLK); }
        SBAR();
        f32x16 p0, p1; qkt_rt<ROPE>(p0, p1, K_lds, buf, koff, S.qr, qrl);
        if constexpr (CAUSAL) { const int kb_ = t * KVBLK; if (kb_ + KVBLK - 1 > qlo) mask_tile(p0, p1, qm - kb_); }
        float mn, al; partialSM<ROPE>(p0, p1, m_reg, mn, al);
        if (__any(al < 1.f)) { if (hi == 0) al_l[r32] = al; asm volatile("s_waitcnt lgkmcnt(0)" ::: "memory");
            for (int d_ = 0; d_ < 4; ++d_) for (int r = 0; r < 16; ++r) o[d_][r] *= al_l[crow(r, hi)]; }
        bf16x8 pa0, pa1, pa2, pa3; finishSM(p0, p1, al, l_reg, pa0, pa1, pa2, pa3); SBAR();
        pv_tile<0>(o, vb0 + buf * SHM_V, pa0, pa1, pa2, pa3);
        if (t + 1 < NT) { VMW(); SWRITE_H(buf ^ 1); }
        __syncthreads();
    }
    if (hi == 0) li_l[r32] = l_reg; asm volatile("s_waitcnt lgkmcnt(0)" ::: "memory");
    float rli[16];
#pragma unroll
    for (int r = 0; r < 16; ++r) rli[r] = __builtin_amdgcn_rcpf(li_l[crow(r, hi)]);
    bf16_t* Ow = cur.O + (size_t)(wid * QBLK) * T.os;
#pragma unroll
    for (int r = 0; r < 16; ++r) { const int orow = crow(r, hi);
#pragma unroll
        for (int d0 = 0; d0 < 4; ++d0) { const float v = o[d0][r] * rli[r];
            const float vn = __shfl_xor(v, 1);
            if ((r32 & 1) == 0) *(unsigned*)(Ow + (size_t)orow * T.os + d0 * 32 + r32) = cvtpk(v, vn); } }
    __syncthreads();
}


template <bool ROPE>
__device__ __forceinline__ void qkt_rt8(f32x16& p0, f32x16& p1, const char* K_lds, int buf, const int (&koff)[4], const bf16x8* qr, const char* qrl) {
    p0 = f32x16{}; p1 = f32x16{};
    const char* kbase = K_lds + buf * SHM_K;
#pragma unroll
    for (int d0 = 0; d0 < 8; ++d0) { const char* a = kbase + koff[d0 & 3] + (d0 >> 2) * 128;
        bf16x8 b0 = *reinterpret_cast<const bf16x8*>(a);
        bf16x8 b1 = *reinterpret_cast<const bf16x8*>(a + 32 * 256);
        const bf16x8 q = d0 < 4 ? qr[d0] : *reinterpret_cast<const bf16x8*>(qrl + (d0 - 4) * 1024);
        p0 = __builtin_amdgcn_mfma_f32_32x32x16_bf16(b0, q, p0, 0, 0, 0);
        p1 = __builtin_amdgcn_mfma_f32_32x32x16_bf16(b1, q, p1, 0, 0, 0); }
    if constexpr (ROPE) {
        const char* rbase = K_lds + 2 * SHM_K + buf * SHM_KR;
#pragma unroll
        for (int d0 = 0; d0 < 4; ++d0) { const char* a = rbase + koff[d0];
            bf16x8 b0 = *reinterpret_cast<const bf16x8*>(a);
            bf16x8 b1 = *reinterpret_cast<const bf16x8*>(a + 128);
            const bf16x8 q = *reinterpret_cast<const bf16x8*>(qrl + (4 + d0) * 1024);
            p0 = __builtin_amdgcn_mfma_f32_32x32x16_bf16(b0, q, p0, 0, 0, 0);
            p1 = __builtin_amdgcn_mfma_f32_32x32x16_bf16(b1, q, p1, 0, 0, 0); }
    }
}
template <bool ROPE, bool CAUSAL>
__device__ __forceinline__ void attn_block_ap(const BlockRef& cur, const Strides& T, char* lds) {
    const int tid = threadIdx.x, wid = __builtin_amdgcn_readfirstlane(tid >> 6), lane = tid & 63, r32 = lane & 31, hi = lane >> 5, grp = wid >> 2;
    int j_hi = CAUSAL ? (cur.P0 + QB - 1) / KVBLK + 1 : T.skv / KVBLK; if (j_hi > T.skv / KVBLK) j_hi = T.skv / KVBLK;
    const int NT = j_hi;
    const int qlo = cur.P0 + wid * QBLK, qm = qlo + r32 - 4 * hi;
    char* V_lds = lds + OFF_V; char* K_lds = lds + OFF_K;
    float* ws = (float*)(lds + OFF_WS) + wid * 64; float* li_l = ws, * al_l = ws + 32;
    float m_reg = -1e30f, l_reg = 0; f32x16 o[4] = {};
    STAGE_IDX(); const int vst0 = v_st(sr, sc), vst1 = v_st(32 + sr, sc);
    const int vb0 = (int)(uintptr_t)V_lds + v_rd_base(lane);
    int koff[4];
#pragma unroll
    for (int dd = 0; dd < 4; ++dd) koff[dd] = KSWZ(r32, (dd * 16 + hi * 8) * 2);
    Seam<ROPE> S; char* qrl = lds + OFF_QR + wid * 8192 + lane * 16;
    const int dr0 = lane >> 4, dr1 = 4 + (lane >> 4);
    const unsigned kdo0 = (unsigned)((wid * 8 + dr0) * T.ks * 2 + (((lane & 15) ^ dr0) << 4)), kdo1 = (unsigned)((wid * 8 + dr1) * T.ks * 2 + (((lane & 15) ^ dr1) << 4));
    const int kline = 4 * wid + (lane >> 4), kcs = (lane & 15) ^ (kline & 7);
    const unsigned krdo = (unsigned)((kline + 32 * (kcs >> 3)) * (DROPE * 2) + ((kcs & 7) << 4));
    const unsigned klds0 = (unsigned)(uintptr_t)K_lds + wid * 2048, krlds0 = (unsigned)(uintptr_t)K_lds + 2 * SHM_K + wid * 1024;
    QLOAD(cur);
    { const char* kb_ = (const char*)cur.K; S.st_k0 = LD8(kb_ + vo_k); S.st_k1 = LD8(kb_ + (size_t)T.ks * 64 + vo_k); if constexpr (ROPE) S.st_kr = LD8((const char*)cur.KR + vo_kr); }
    VMW(); SWRITE_HK(0); QPARK8();
    __syncthreads();
    f32x16 p0, p1; float mn, al; bf16x8 pa0, pa1, pa2, pa3;
#define AP_BAR() do { asm volatile("s_waitcnt lgkmcnt(0)" ::: "memory"); __builtin_amdgcn_s_barrier(); asm volatile("" ::: "memory"); } while (0)
#define AP_ISSUE(t) do { const char* vb_ = (const char*)cur.V + (size_t)((t) * KVBLK) * T.vs * 2; S.st_v0 = LD8(vb_ + vo_v); S.st_v1 = LD8(vb_ + (size_t)T.vs * 64 + vo_v);        \
        if ((t) + 1 < NT) { const char* kb_ = (const char*)cur.K + (size_t)(((t) + 1) * KVBLK) * T.ks * 2; const unsigned kl_ = klds0 + (((t) + 1) & 1) * SHM_K;                   \
            __builtin_amdgcn_global_load_lds((const unsigned*)(kb_ + kdo0), (LAS unsigned*)(uintptr_t)(kl_), 16, 0, 0);                                                              \
            __builtin_amdgcn_global_load_lds((const unsigned*)(kb_ + kdo1), (LAS unsigned*)(uintptr_t)(kl_ + 1024), 16, 0, 0);                                                       \
            if constexpr (ROPE) __builtin_amdgcn_global_load_lds((const unsigned*)((const char*)cur.KR + (size_t)(((t) + 1) * KVBLK) * (DROPE * 2) + krdo),                          \
                                                                 (LAS unsigned*)(uintptr_t)(krlds0 + (((t) + 1) & 1) * SHM_KR), 16, 0, 0); } SBAR(); } while (0)
#define AP_WRITE(t) do { SBAR(); VMW(); SWRITE_HV((t) & 1); } while (0)
#define AP_QK(t) do { qkt_rt8<ROPE>(p0, p1, K_lds, (t) & 1, koff, S.qr, qrl);                                                      \
        if constexpr (CAUSAL) { const int kb_ = (t) * KVBLK; if (kb_ + KVBLK - 1 > qlo) mask_tile(p0, p1, qm - kb_); } } while (0)
#define AP_SM() do { partialSM<ROPE>(p0, p1, m_reg, mn, al);                                                                      \
        if (__any(al < 1.f)) { if (hi == 0) al_l[r32] = al; asm volatile("s_waitcnt lgkmcnt(0)" ::: "memory");                    \
            for (int d_ = 0; d_ < 4; ++d_) for (int r = 0; r < 16; ++r) o[d_][r] *= al_l[crow(r, hi)]; }                          \
        finishSM(p0, p1, al, l_reg, pa0, pa1, pa2, pa3); } while (0)
#define AP_PV(t) pv_tile<0>(o, vb0 + ((t) & 1) * SHM_V, pa0, pa1, pa2, pa3)
    if (grp == 0) {
        AP_ISSUE(0); AP_QK(0); AP_BAR();
        AP_SM(); AP_WRITE(0); AP_BAR();
        for (int t = 1; t < NT; ++t) {
            AP_ISSUE(t); AP_PV(t - 1); AP_QK(t); AP_BAR();
            AP_SM(); AP_WRITE(t); AP_BAR();
        }
        AP_PV(NT - 1); AP_BAR();
        AP_BAR();
    } else {
        AP_ISSUE(0); AP_BAR();
        AP_QK(0); AP_WRITE(0); AP_BAR();
        for (int t = 1; t < NT; ++t) {
            AP_ISSUE(t); AP_SM(); AP_BAR();
            AP_PV(t - 1); AP_QK(t); AP_WRITE(t); AP_BAR();
        }
        AP_SM(); AP_BAR();
        AP_PV(NT - 1); AP_BAR();
    }
#undef AP_ISSUE
#undef AP_WRITE
#undef AP_BAR
#undef AP_QK
#undef AP_SM
#undef AP_PV
    if (hi == 0) li_l[r32] = l_reg; asm volatile("s_waitcnt lgkmcnt(0)" ::: "memory");
    float rli[16];
#pragma unroll
    for (int r = 0; r < 16; ++r) rli[r] = __builtin_amdgcn_rcpf(li_l[crow(r, hi)]);
    bf16_t* Ow = cur.O + (size_t)(wid * QBLK) * T.os;
#pragma unroll
    for (int r = 0; r < 16; ++r) { const int orow = crow(r, hi);
#pragma unroll
        for (int d0 = 0; d0 < 4; ++d0) { const float v = o[d0][r] * rli[r];
            const float vn = __shfl_xor(v, 1);
            if ((r32 & 1) == 0) *(unsigned*)(Ow + (size_t)orow * T.os + d0 * 32 + r32) = cvtpk(v, vn); } }
    __syncthreads();
}
#undef LD8
#undef VMW
#undef VMWN
#undef SLOAD_H
#undef SWRITE_HK
#undef SWRITE_HV
#undef SWRITE_H
#undef QLOAD
#undef QPARK
#undef QPARK8
#undef STAGE_IDX
}
__device__ __forceinline__ float sq4v(f32x4 v) { return pg8::sq4(v); }
__device__ __forceinline__ float row_rs32g(const float* ss, int row) { return pg8::row_rs32(ss, row, 1.0f / DM); }
struct Params {
    const float *x, *mem; const int* pos; const float *norm_mix, *w_in, *lam_re, *lam_im, *log_step, *b_re, *b_im, *c_re, *c_im, *ssm_d, *w_glu, *b_glu;
    const float *q_norm, *w_uq, *kv_norm, *w_uk, *w_uv, *w_up_ssm, *w_up_mla, *w_out, *norm_xattn, *norm_mem, *xa_wq, *xa_wk, *xa_wv, *xa_wo;
    const float *norm_moe, *router_w, *router_b, *w_gu, *b_gu, *w_dn, *b_dn, *final_norm;
    float* out;
    unsigned* ctl;
    bf16_t *WinT, *WkpeT, *WgluT, *WuqT, *WukvT, *WupsT, *WupmT, *WoutT, *WxqT, *WxkvT, *WxoT; unsigned char *WguT, *WdnT;
    float* WrT;
    bf16_t *hn, *memn; float *cosT, *sinT; float* abar; bf16_t *bbarT, *cmat;
    bf16_t *ub, *qa, *kva; float *qss, *kvss; bf16_t *sgs, *sgm, *kpe;
    bf16_t *qn, *qr, *kn, *vv, *ymla;
    float* send; bf16_t *zb, *ys, *t1, *mg;
    float* x1; bf16_t* x1b; float* ss1;
    bf16_t *memkv, *qx, *ox;
    float* x2; float* ss2;
    int* topi; float* topw; int* rank; int* slot; int* wgcnt; int* blke;
    unsigned char *xg, *act; bf16_t* orow;
    int ph_lo, ph_hi;
};

struct Frame { LAS unsigned char* lds; int wave, vcu, G, gw, NGW; };

template <class RowMap>
__device__ __forceinline__ void p0_transpose_item(const float* W, int ldw, int K, bf16_t* WT, const float* gain, LAS float* scr, int kb, int nb, int lane, const RowMap& rowmap) {
    const int k0 = 64 * kb, n0 = 32 * nb;
#pragma unroll 8
    for (int i = 0; i < 32; ++i) { const int kk = 2 * i + (lane >> 5); float v = W[(size_t)(k0 + kk) * ldw + n0 + (lane & 31)]; if (gain) v *= gain[k0 + kk]; scr[kk * 33 + (lane & 31)] = v; }
    LDS_WAIT(); asm volatile("" ::: "memory");
    const int c = lane & 7;
#pragma unroll
    for (int j = 0; j < 4; ++j) { const int n = (lane >> 3) + 8 * j; const LAS float* s = scr + (8 * c) * 33 + n;
        u32x4 o; o.x = cvtpk(s[0 * 33], s[1 * 33]); o.y = cvtpk(s[2 * 33], s[3 * 33]); o.z = cvtpk(s[4 * 33], s[5 * 33]); o.w = cvtpk(s[6 * 33], s[7 * 33]);
        *(u32x4*)(WT + (size_t)rowmap(n0 + n) * K + k0 + 8 * c) = o; }
    LDS_WAIT(); asm volatile("" ::: "memory");
}
template <class RowMap>
__device__ __forceinline__ void p0_transpose_item_f8(const float* W, int ldw, int K, unsigned char* WT, float scale, LAS float* scr, int kb, int nb, int lane, const RowMap& rowmap) {
    const int k0 = 128 * kb, n0 = 32 * nb;
#pragma unroll 8
    for (int i = 0; i < 64; ++i) { const int kk = 2 * i + (lane >> 5); scr[kk * 33 + (lane & 31)] = W[(size_t)(k0 + kk) * ldw + n0 + (lane & 31)] * scale; }
    LDS_WAIT(); asm volatile("" ::: "memory");
    const int c = lane & 7;
#pragma unroll
    for (int j = 0; j < 4; ++j) { const int n = (lane >> 3) + 8 * j; const LAS float* s = scr + (16 * c) * 33 + n;
        u32x4 o; o.x = pg8::pk4_fp8(s[0 * 33], s[1 * 33], s[2 * 33], s[3 * 33]); o.y = pg8::pk4_fp8(s[4 * 33], s[5 * 33], s[6 * 33], s[7 * 33]);
        o.z = pg8::pk4_fp8(s[8 * 33], s[9 * 33], s[10 * 33], s[11 * 33]); o.w = pg8::pk4_fp8(s[12 * 33], s[13 * 33], s[14 * 33], s[15 * 33]);
        *(u32x4*)(WT + (size_t)rowmap(n0 + n) * K + k0 + 16 * c) = o; }
    LDS_WAIT(); asm volatile("" ::: "memory");
}
struct MapId { int off; __device__ __forceinline__ int operator()(int n) const { return n + off; } };
struct MapUq { __device__ __forceinline__ int operator()(int n) const { const int h = n / 192, d = n % 192; if (d < 128) return h * 128 + d;
    const int dd = d - 128, half = dd >> 5, i = dd & 31; return 2048 + 256 * (h >> 2) + half * 128 + (h & 3) * 32 + i; } };
struct MapGU { __device__ __forceinline__ int operator()(int n) const { const int up = n >= DFF, j = up ? n - DFF : n; return 256 * (j >> 7) + up * 128 + (j & 127); } };

__device__ __forceinline__ void rms_row_bf16(const float* xrow, const float* gain, bf16_t* orow, int lane) {
    f32x4 v[8]; float s = 0.f;
#pragma unroll
    for (int j = 0; j < 8; ++j) { v[j] = *(const f32x4*)(xrow + 256 * j + 4 * lane); s += sq4v(v[j]); }
    const float rs = __builtin_amdgcn_rsqf(wave_sum(s) * (1.0f / DM) + EPS);
#pragma unroll
    for (int j = 0; j < 8; ++j) { const f32x4 g = *(const f32x4*)(gain + 256 * j + 4 * lane); const f32x4 r = v[j] * rs * g;
        u32x2 o = {cvtpk(r[0], r[1]), cvtpk(r[2], r[3])}; *(u32x2*)(orow + 256 * j + 4 * lane) = o; }
}

__device__ __forceinline__ void cmul(float ar, float ai, float br, float bi, float& cr, float& ci) { cr = ar * br - ai * bi; ci = ar * bi + ai * br; }

__device__ __forceinline__ void p0_prologue(const Params& p, Frame& F) {
    LAS float* scr = (LAS float*)(F.lds + F.wave * 17408);
    const int gw = F.gw, NGW = F.NGW, lane = ((int)threadIdx.x & 63);
#define TJOB(W, LDW, COFF, NCOLS, KK, DST, GAIN, MAP) { const int nblk = (NCOLS) / 32, nit = ((KK) / 64) * nblk; \
        for (int it = gw; it < nit; it += NGW) p0_transpose_item((W) + (COFF), (LDW), (KK), (DST), (GAIN), scr, it / nblk, it % nblk, lane, (MAP)); }
    TJOB(p.w_in, IN_COLS, 0, 2048, DM, p.WinT, nullptr, MapId{0});
    TJOB(p.w_in, IN_COLS, 2048, 64, DM, p.WkpeT, nullptr, MapId{0});
    TJOB(p.w_in, IN_COLS, 2112, 4096, DM, p.WinT, nullptr, MapId{2048});
    TJOB(p.w_glu, SSM_W, 0, SSM_W, SSM_W, p.WgluT, nullptr, MapId{0});
    TJOB(p.w_uq, NHEAD * 192, 0, NHEAD * 192, QL, p.WuqT, p.q_norm, MapUq{});
    TJOB(p.w_uk, NHEAD * 128, 0, NHEAD * 128, KVL, p.WukvT, p.kv_norm, MapId{0});
    TJOB(p.w_uv, NHEAD * 128, 0, NHEAD * 128, KVL, p.WukvT, p.kv_norm, MapId{2048});
    TJOB(p.w_up_ssm, DM, 0, DM, SSM_W, p.WupsT, nullptr, MapId{0});
    TJOB(p.w_up_mla, DM, 0, DM, DM, p.WupmT, nullptr, MapId{0});
    TJOB(p.w_out, DM, 0, DM, DM, p.WoutT, nullptr, MapId{0});
    TJOB(p.xa_wq, XW, 0, XW, DM, p.WxqT, p.norm_xattn, MapId{0});
    TJOB(p.xa_wk, XW, 0, XW, DM, p.WxkvT, nullptr, MapId{0});
    TJOB(p.xa_wv, XW, 0, XW, DM, p.WxkvT, nullptr, MapId{512});
    TJOB(p.xa_wo, DM, 0, DM, XW, p.WxoT, nullptr, MapId{0});
#define TJOB8(W, LDW, NCOLS, KK, DST, MAP) { const int nblk = (NCOLS) / 32, nit = ((KK) / 128) * nblk; \
        for (int it = gw; it < nit; it += NGW) p0_transpose_item_f8((W), (LDW), (KK), (DST), pg8::F8_WS, scr, it / nblk, it % nblk, lane, (MAP)); }
    for (int e = 0; e < NEXP; ++e) {
        TJOB8(p.w_gu + (size_t)e * DM * 2 * DFF, 2 * DFF, 2 * DFF, DM, p.WguT + (size_t)e * 2 * DFF * DM, MapGU{});
        TJOB8(p.w_dn + (size_t)e * DFF * DM, DM, DM, DFF, p.WdnT + (size_t)e * DM * DFF, MapId{0});
    }
#undef TJOB8
#undef TJOB
    for (int m = gw; m < SEQ; m += NGW) rms_row_bf16(p.x + (size_t)m * DM, p.norm_mix, p.hn + (size_t)m * DM, lane);
    for (int m = gw; m < MEML; m += NGW) rms_row_bf16(p.mem + (size_t)m * DM, p.norm_mem, p.memn + (size_t)m * DM, lane);
    const int gt = gw * 64 + lane, NGT = NGW * 64;
    for (int i = gt; i < SEQ * 32; i += NGT) {
        const int t = i >> 5, f = i & 31;
        const float invf = __builtin_powf(10000.0f, -(float)(2 * f) / 64.0f);
        const float ang = (float)p.pos[t] * invf;
        const double rev = (double)ang * 0.15915494309189535; const float fr = (float)(rev - __builtin_floor(rev));
        p.cosT[i] = __builtin_amdgcn_cosf(fr); p.sinT[i] = __builtin_amdgcn_sinf(fr);
    }
    for (int i = gt; i < DM * NEXP; i += NGT) p.WrT[i] = p.router_w[i] * p.norm_moe[i >> 5];
    for (int i = gt; i < SSM_G * SSM_P; i += NGT) {
        const int g = i >> 6;
        const float dt = __builtin_expf(p.log_step[g]), lr = p.lam_re[i], li = p.lam_im[i];
        const float mag = __builtin_expf(lr * dt); const double rev = (double)(li * dt) * 0.15915494309189535; const float fr = (float)(rev - __builtin_floor(rev));
        const float ar = mag * __builtin_amdgcn_cosf(fr), ai = mag * __builtin_amdgcn_sinf(fr);
        p.abar[2 * i] = ar; p.abar[2 * i + 1] = ai;
        const float den = 1.0f / (lr * lr + li * li); float fr_, fi_; cmul(ar - 1.0f, ai, lr * den, -li * den, fr_, fi_);
        const int pst = i & 63;
#pragma unroll
        for (int h = 0; h < SSM_H; ++h) { const float br = p.b_re[(size_t)i * SSM_H + h], bi = p.b_im[(size_t)i * SSM_H + h]; float cr, ci; cmul(fr_, fi_, br, bi, cr, ci);
            p.bbarT[((size_t)g * 128 + pst) * 16 + h] = f2bf(cr); p.bbarT[((size_t)g * 128 + 64 + pst) * 16 + h] = f2bf(ci); }
    }
    for (int i = gt; i < SSM_G * SSM_H * SSM_P; i += NGT) {
        const int gh = i >> 6, pst = i & 63;
        p.cmat[(size_t)gh * 128 + pst] = f2bf(p.c_re[i]); p.cmat[(size_t)gh * 128 + 64 + pst] = f2bf(-p.c_im[i]);
    }
}

__device__ __forceinline__ void kpe_phase(const Params& p, Frame& F) {
    const int lane = ((int)threadIdx.x & 63), r = lane & 31, hi = lane >> 5;
    for (int tile = F.wave * F.G + F.vcu; tile < SEQ / 32; tile += F.NGW) {
        const int t0 = tile * 32; f32x16 a0 = {}, a1 = {};
        const bf16_t* ap = p.hn + (size_t)(t0 + r) * DM + 8 * hi; const bf16_t* b0p = p.WkpeT + (size_t)r * DM + 8 * hi; const bf16_t* b1p = b0p + (size_t)32 * DM;
#pragma unroll 4
        for (int s = 0; s < DM / 16; ++s) { const bf16x8 a = *(const bf16x8*)(ap + 16 * s), b0 = *(const bf16x8*)(b0p + 16 * s), b1 = *(const bf16x8*)(b1p + 16 * s);
            a0 = __builtin_amdgcn_mfma_f32_32x32x16_bf16(a, b0, a0, 0, 0, 0); a1 = __builtin_amdgcn_mfma_f32_32x32x16_bf16(a, b1, a1, 0, 0, 0); }
#pragma unroll
        for (int i = 0; i < 16; ++i) { const int tok = t0 + (i & 3) + 8 * (i >> 2) + 4 * hi; const float c = p.cosT[(size_t)tok * 32 + r], s = p.sinT[(size_t)tok * 32 + r];
            p.kpe[(size_t)tok * DROPE + r] = f2bf(a0[i] * c - a1[i] * s); p.kpe[(size_t)tok * DROPE + 32 + r] = f2bf(a0[i] * s + a1[i] * c); }
    }
}

constexpr int S5_TC = 256, S5_NCH = SEQ / S5_TC;
struct S5Consts { float a1r[2], a1i[2], a2r[2], a2i[2], a3r[2], a3i[2], a4r[2], a4i[2], a8r[2], a8i[2], a32r[2], a32i[2], a256r[2], a256i[2]; };
__device__ __forceinline__ void s5_consts(const Params& p, int g, int r, S5Consts& c) {
#pragma unroll
    for (int s = 0; s < 2; ++s) { const f32x2 a = *(const f32x2*)(p.abar + 2 * (g * 64 + 32 * s + r)); c.a1r[s] = a[0]; c.a1i[s] = a[1];
        cmul(c.a1r[s], c.a1i[s], c.a1r[s], c.a1i[s], c.a2r[s], c.a2i[s]); cmul(c.a2r[s], c.a2i[s], c.a1r[s], c.a1i[s], c.a3r[s], c.a3i[s]); cmul(c.a2r[s], c.a2i[s], c.a2r[s], c.a2i[s], c.a4r[s], c.a4i[s]);
        cmul(c.a4r[s], c.a4i[s], c.a4r[s], c.a4i[s], c.a8r[s], c.a8i[s]); float tr, ti; cmul(c.a8r[s], c.a8i[s], c.a8r[s], c.a8i[s], tr, ti); cmul(tr, ti, tr, ti, c.a32r[s], c.a32i[s]);
        float ur, ui; cmul(c.a32r[s], c.a32i[s], c.a32r[s], c.a32i[s], tr, ti); cmul(tr, ti, tr, ti, ur, ui); cmul(ur, ui, ur, ui, c.a256r[s], c.a256i[s]); }
}
__device__ __forceinline__ void s5_bu(const Params& p, int g, int t0, int r, int hi, const bf16x8 (&bfr)[4], f32x16 (&acc)[4]) {
    const bf16x8 a = *(const bf16x8*)(p.ub + (size_t)(t0 + r) * SSM_W + g * 16 + 8 * hi);
#pragma unroll
    for (int ct = 0; ct < 4; ++ct) { acc[ct] = f32x16{}; acc[ct] = __builtin_amdgcn_mfma_f32_32x32x16_bf16(a, bfr[ct], acc[ct], 0, 0, 0); }
}
__device__ __forceinline__ void s5_pass_a(const Params& p, Frame& F) {
    const int lane = ((int)threadIdx.x & 63), r = lane & 31, hi = lane >> 5;
    for (int unit = F.gw; unit < S5_NCH * SSM_G; unit += F.NGW) {
        const int g = unit % SSM_G, ch = unit / SSM_G;
        S5Consts c; s5_consts(p, g, r, c);
        bf16x8 bfr[4];
#pragma unroll
        for (int ct = 0; ct < 4; ++ct) bfr[ct] = *(const bf16x8*)(p.bbarT + ((size_t)g * 128 + 32 * ct + r) * 16 + 8 * hi);
        float Sr[2] = {0.f, 0.f}, Si[2] = {0.f, 0.f};
        for (int tl = 0; tl < S5_TC / 32; ++tl) {
            f32x16 acc[4]; s5_bu(p, g, ch * S5_TC + tl * 32, r, hi, bfr, acc);
#pragma unroll
            for (int s = 0; s < 2; ++s) { float Pr = 0.f, Pi = 0.f;
#pragma unroll
                for (int q = 0; q < 4; ++q) { float er = acc[s][4 * q], ei = acc[2 + s][4 * q];
#pragma unroll
                    for (int j = 1; j < 4; ++j) { float tr, ti; cmul(er, ei, c.a1r[s], c.a1i[s], tr, ti); er = tr + acc[s][4 * q + j]; ei = ti + acc[2 + s][4 * q + j]; }
                    float tr, ti; cmul(Pr, Pi, c.a8r[s], c.a8i[s], tr, ti); Pr = tr + er; Pi = ti + ei; }
                if (hi == 0) { float tr, ti; cmul(Pr, Pi, c.a4r[s], c.a4i[s], tr, ti); Pr = tr; Pi = ti; }
                Pr += __shfl_xor(Pr, 32); Pi += __shfl_xor(Pi, 32);
                float tr, ti; cmul(Sr[s], Si[s], c.a32r[s], c.a32i[s], tr, ti); Sr[s] = tr + Pr; Si[s] = ti + Pi; }
        }
        if (hi == 0) {
#pragma unroll
            for (int s = 0; s < 2; ++s) *(f32x2*)(p.send + 2 * ((size_t)(ch * SSM_G + g) * 64 + 32 * s + r)) = (f32x2){Sr[s], Si[s]}; }
    }
}
constexpr int S5_XS = 272;
__device__ __forceinline__ void s5_pass_c(const Params& p, Frame& F) {
    const int lane = ((int)threadIdx.x & 63), r = lane & 31, hi = lane >> 5, l15 = lane & 15, l4 = lane >> 4;
    LAS unsigned char* xl = F.lds + F.wave * (32 * S5_XS);
    for (int unit = F.gw; unit < S5_NCH * SSM_G; unit += F.NGW) {
        const int g = unit % SSM_G, ch = unit / SSM_G;
        S5Consts c; s5_consts(p, g, r, c);
        bf16x8 bfr[4], cfr[4];
#pragma unroll
        for (int ct = 0; ct < 4; ++ct) bfr[ct] = *(const bf16x8*)(p.bbarT + ((size_t)g * 128 + 32 * ct + r) * 16 + 8 * hi);
#pragma unroll
        for (int ks = 0; ks < 4; ++ks) cfr[ks] = *(const bf16x8*)(p.cmat + ((size_t)g * 16 + l15) * 128 + 32 * ks + 8 * l4);
        const f32x4 dsk = *(const f32x4*)(p.ssm_d + g * 16 + 4 * l4);
        float Xr[2] = {0.f, 0.f}, Xi[2] = {0.f, 0.f};
        for (int cp = 0; cp < ch; ++cp) {
#pragma unroll
            for (int s = 0; s < 2; ++s) { const f32x2 e = *(const f32x2*)(p.send + 2 * ((size_t)(cp * SSM_G + g) * 64 + 32 * s + r)); float tr, ti; cmul(Xr[s], Xi[s], c.a256r[s], c.a256i[s], tr, ti); Xr[s] = tr + e[0]; Xi[s] = ti + e[1]; } }
        for (int tl = 0; tl < S5_TC / 32; ++tl) {
            const int t0 = ch * S5_TC + tl * 32;
            f32x16 acc[4]; s5_bu(p, g, t0, r, hi, bfr, acc);
#pragma unroll
            for (int s = 0; s < 2; ++s) {
                float er[4], ei[4];
#pragma unroll
                for (int q = 0; q < 4; ++q) {
#pragma unroll
                    for (int j = 1; j < 4; ++j) { float tr, ti; cmul(acc[s][4 * q + j - 1], acc[2 + s][4 * q + j - 1], c.a1r[s], c.a1i[s], tr, ti); acc[s][4 * q + j] += tr; acc[2 + s][4 * q + j] += ti; }
                    er[q] = acc[s][4 * q + 3]; ei[q] = acc[2 + s][4 * q + 3]; }
                float cr = Xr[s], ci = Xi[s], cinr[4], cini[4];
#pragma unroll
                for (int q = 0; q < 4; ++q) { const float pr = __shfl_xor(er[q], 32), pi = __shfl_xor(ei[q], 32);
                    const float e0r = hi ? pr : er[q], e0i = hi ? pi : ei[q], e1r = hi ? er[q] : pr, e1i = hi ? ei[q] : pi;
                    float tr, ti; const float c0r = cr, c0i = ci; cmul(cr, ci, c.a4r[s], c.a4i[s], tr, ti); cr = tr + e0r; ci = ti + e0i;
                    const float c1r = cr, c1i = ci; cmul(cr, ci, c.a4r[s], c.a4i[s], tr, ti); cr = tr + e1r; ci = ti + e1i;
                    cinr[q] = hi ? c1r : c0r; cini[q] = hi ? c1i : c0i; }
                Xr[s] = cr; Xi[s] = ci;
#pragma unroll
                for (int q = 0; q < 4; ++q) { float tr, ti;
                    cmul(cinr[q], cini[q], c.a1r[s], c.a1i[s], tr, ti); acc[s][4 * q + 0] += tr; acc[2 + s][4 * q + 0] += ti;
                    cmul(cinr[q], cini[q], c.a2r[s], c.a2i[s], tr, ti); acc[s][4 * q + 1] += tr; acc[2 + s][4 * q + 1] += ti;
                    cmul(cinr[q], cini[q], c.a3r[s], c.a3i[s], tr, ti); acc[s][4 * q + 2] += tr; acc[2 + s][4 * q + 2] += ti;
                    cmul(cinr[q], cini[q], c.a4r[s], c.a4i[s], tr, ti); acc[s][4 * q + 3] += tr; acc[2 + s][4 * q + 3] += ti; }
            }
#pragma unroll
            for (int ct = 0; ct < 4; ++ct)
#pragma unroll
                for (int i = 0; i < 16; ++i) *(LAS unsigned short*)(xl + ((i & 3) + 8 * (i >> 2) + 4 * hi) * S5_XS + (32 * ct + r) * 2) = f2bf(acc[ct][i]);
            LDS_WAIT(); asm volatile("" ::: "memory");
#pragma unroll
            for (int nt = 0; nt < 2; ++nt) { f32x4 y = {0.f, 0.f, 0.f, 0.f};
#pragma unroll
                for (int ks = 0; ks < 4; ++ks) { const bf16x8 b = *(const LAS bf16x8*)(xl + (16 * nt + l15) * S5_XS + (32 * ks + 8 * l4) * 2); y = __builtin_amdgcn_mfma_f32_16x16x32_bf16(cfr[ks], b, y, 0, 0, 0); }
                const size_t off = (size_t)(t0 + 16 * nt + l15) * SSM_W + g * 16 + 4 * l4; const u32x2 uw = *(const u32x2*)(p.ub + off);
                const float y0 = y[0] + dsk[0] * bflo(uw.x), y1 = y[1] + dsk[1] * bfhi(uw.x), y2 = y[2] + dsk[2] * bflo(uw.y), y3 = y[3] + dsk[3] * bfhi(uw.y);
                u32x2 o = {cvtpk(gelu_tanh(y0), gelu_tanh(y1)), cvtpk(gelu_tanh(y2), gelu_tanh(y3))}; *(u32x2*)(p.zb + off) = o; }
            LDS_WAIT(); asm volatile("" ::: "memory");
        }
    }
}

__device__ __forceinline__ void router_phase(const Params& p, Frame& F) {
    LAS float* red = (LAS float*)F.lds; LAS float* lg = red + 8 * 32 * 33; LAS int* asg = (LAS int*)(lg + 32 * 33); LAS int* cnt = asg + 256;
    const int lane = ((int)threadIdx.x & 63), i32 = lane & 31, kh = lane >> 5, w = F.wave, tid = (int)threadIdx.x;
    for (int vb = blockIdx.x; vb < SEQ / 64; vb += F.G) {
        if (tid < 32) cnt[tid] = 0;
        for (int tl = 0; tl < 2; ++tl) {
            const int t0 = vb * 64 + tl * 32;
            f32x16 acc = {};
            const float* ap = p.x2 + (size_t)(t0 + i32) * DM + 256 * w + 4 * kh; const float* bp = p.WrT + (size_t)(256 * w + 4 * kh) * NEXP + i32;
#pragma unroll 4
            for (int q = 0; q < 32; ++q) { const f32x4 a = *(const f32x4*)(ap + 8 * q);
#pragma unroll
                for (int e = 0; e < 4; ++e) acc = __builtin_amdgcn_mfma_f32_32x32x2f32(a[e], bp[(size_t)(8 * q + e) * NEXP], acc, 0, 0, 0); }
#pragma unroll
            for (int i = 0; i < 16; ++i) red[(w * 32 + (i & 3) + 8 * (i >> 2) + 4 * kh) * 33 + i32] = acc[i];
            __syncthreads();
            for (int o = tid; o < 1024; o += 512) { const int tok = o >> 5, e = o & 31; float s = 0.f;
#pragma unroll
                for (int ww = 0; ww < 8; ++ww) s += red[(ww * 32 + tok) * 33 + e];
                lg[tok * 33 + e] = s * row_rs32g(p.ss2, t0 + tok) + p.router_b[e]; }
            __syncthreads();
            if (tid < 32) { const int tok = tid; float v[4] = {-__builtin_inff(), -__builtin_inff(), -__builtin_inff(), -__builtin_inff()}; int id[4] = {0, 0, 0, 0};
                for (int e = 0; e < 32; ++e) { float x = lg[tok * 33 + e]; int xi = e;
#pragma unroll
                    for (int k = 0; k < 4; ++k) { const bool gt = x > v[k]; const float tv = gt ? v[k] : x; const int ti = gt ? id[k] : xi; v[k] = gt ? x : v[k]; id[k] = gt ? xi : id[k]; x = tv; xi = ti; } }
                const float e1 = __builtin_expf(v[1] - v[0]), e2 = __builtin_expf(v[2] - v[0]), e3 = __builtin_expf(v[3] - v[0]); const float inv = 1.0f / (1.0f + e1 + e2 + e3);
                const size_t o4 = (size_t)(t0 + tok) * 4;
                *(f32x4*)(p.topw + o4) = (f32x4){inv, e1 * inv, e2 * inv, e3 * inv};
                p.topi[o4] = id[0]; p.topi[o4 + 1] = id[1]; p.topi[o4 + 2] = id[2]; p.topi[o4 + 3] = id[3];
#pragma unroll
                for (int k = 0; k < 4; ++k) asg[(tl * 32 + tok) * 4 + k] = id[k]; }
            __syncthreads();
        }
        if (tid < 256) { const int e = asg[tid]; int rk = 0; for (int j = 0; j < tid; ++j) rk += (asg[j] == e) ? 1 : 0;
            p.rank[(size_t)vb * 256 + tid] = rk; atomicAdd((int*)&cnt[e], 1); }
        __syncthreads();
        if (tid < 32) p.wgcnt[vb * 32 + tid] = cnt[tid];
        __syncthreads();
    }
}
__device__ __forceinline__ void assign_phase(const Params& p, Frame& F) {
    LAS int* part = (LAS int*)F.lds; LAS int* pbef = part + 512; LAS int* base = pbef + 512; LAS int* pst = base + 32; LAS int* slots = pst + 33;
    const int tid = (int)threadIdx.x, lane = ((int)threadIdx.x & 63);
    for (int vb = blockIdx.x; vb < SEQ / 64; vb += F.G) {
        { const int e = tid & 31, pr = tid >> 5; int s = 0, sb = 0;
          for (int b = pr * 16; b < pr * 16 + 16; ++b) { const int c = p.wgcnt[b * 32 + e]; s += c; sb += (b < vb) ? c : 0; }
          part[pr * 32 + e] = s; pbef[pr * 32 + e] = sb; }
        __syncthreads();
        if (tid < 32) { int tot = 0, bef = 0; for (int pr = 0; pr < 16; ++pr) { tot += part[pr * 32 + tid]; bef += pbef[pr * 32 + tid]; } part[tid] = tot; pbef[tid] = bef; }
        __syncthreads();
        if (tid == 0) { int acc = 0; for (int e = 0; e < 32; ++e) { pst[e] = acc; const int nb = (part[e] + 255) >> 8;
                if (vb == 0) for (int b = 0; b < nb; ++b) p.blke[(acc >> 8) + b] = e;
                acc += nb << 8; }
            pst[32] = acc; if (vb == 0) p.blke[MAXBLK] = acc >> 8; }
        __syncthreads();
        if (tid < 32) base[tid] = pst[tid] + pbef[tid];
        __syncthreads();
        if (tid < 256) { const int tok = vb * 64 + (tid >> 2); const int e = p.topi[(size_t)tok * 4 + (tid & 3)]; const int sl = base[e] + p.rank[(size_t)vb * 256 + tid];
            p.slot[(size_t)tok * 4 + (tid & 3)] = sl; slots[tid] = sl; }
        __syncthreads();
        for (int tk = F.wave; tk < 64; tk += NWAVES) { const int tok = vb * 64 + tk; const float* xr = p.x2 + (size_t)tok * DM; const float rs = row_rs32g(p.ss2, tok);
#pragma unroll
            for (int j = 0; j < 4; ++j) { const int c = 512 * j + 8 * lane; const f32x4 g0 = *(const f32x4*)(p.norm_moe + c), g1 = *(const f32x4*)(p.norm_moe + c + 4);
                const f32x4 a = *(const f32x4*)(xr + c) * (rs * pg8::F8_XS) * g0, b = *(const f32x4*)(xr + c + 4) * (rs * pg8::F8_XS) * g1;
                const u32x2 o = {pg8::pk4_fp8(a[0], a[1], a[2], a[3]), pg8::pk4_fp8(b[0], b[1], b[2], b[3])};
#pragma unroll
                for (int k = 0; k < 4; ++k) *(u32x2*)(p.xg + (size_t)slots[tk * 4 + k] * DM + c) = o; } }
        __syncthreads();
    }
}
__device__ __forceinline__ void combine_phase(const Params& p, Frame& F) {
    const int lane = ((int)threadIdx.x & 63);
    for (int tok = F.gw; tok < SEQ; tok += F.NGW) {
        const f32x4 w = *(const f32x4*)(p.topw + (size_t)tok * 4); int sl[4];
#pragma unroll
        for (int k = 0; k < 4; ++k) sl[k] = p.slot[(size_t)tok * 4 + k];
        f32x4 v[4][2]; float s = 0.f;
#pragma unroll
        for (int j = 0; j < 4; ++j) { const int c = 512 * j + 8 * lane; v[j][0] = *(const f32x4*)(p.x2 + (size_t)tok * DM + c); v[j][1] = *(const f32x4*)(p.x2 + (size_t)tok * DM + c + 4);
#pragma unroll
            for (int k = 0; k < 4; ++k) { f32x4 a, b; unpack8(*(const u32x4*)(p.orow + (size_t)sl[k] * DM + c), a, b); v[j][0] += a * w[k]; v[j][1] += b * w[k]; }
            s += sq4v(v[j][0]) + sq4v(v[j][1]); }
        const float rs = __builtin_amdgcn_rsqf(wave_sum(s) * (1.0f / DM) + EPS);
#pragma unroll
        for (int j = 0; j < 4; ++j) { const int c = 512 * j + 8 * lane;
            *(f32x4*)(p.out + (size_t)tok * DM + c) = v[j][0] * rs * *(const f32x4*)(p.final_norm + c); *(f32x4*)(p.out + (size_t)tok * DM + c + 4) = v[j][1] * rs * *(const f32x4*)(p.final_norm + c + 4); }
    }
}
template <bool ROPE, bool CAUSAL, class Refs>
__device__ __forceinline__ void attn_stream(const Refs& R, const att::Strides& T, char* lds) {
    const int n = R.count(); if (n <= 0) return;
    att::Seam<ROPE> S; att::BlockRef cur = R.ref(0);
    att::attn_prime<ROPE, CAUSAL>(cur, T, lds, S);
    for (int i = 0; i < n; ++i) { const att::BlockRef nxt = (i + 1 < n) ? R.ref(i + 1) : cur; att::attn_block<ROPE, CAUSAL>(cur, nxt, T, lds, S); cur = nxt; }
}
struct MlaRefs {
    const Params* p; int b, G; bf16_t* obuf;
    __device__ __forceinline__ int count() const { return b < 512 ? 2 * ((512 - b + G - 1) / G) : 0; }
    __device__ __forceinline__ att::BlockRef ref(int i) const {
        const int L = b + (i >> 1) * G, xcd = L & 7, k = L >> 3, head = (k >> 5) * 8 + xcd, y = k & 31, qb = (i & 1) ? 63 - y : y;
        att::BlockRef r; const size_t row0 = (size_t)qb * 256;
        r.Q = p->qn + row0 * DM + head * DNOPE; r.QR = p->qr + row0 * (NHEAD * DROPE) + head * DROPE; r.K = p->kn + head * DNOPE; r.KR = p->kpe; r.V = p->vv + head * DV;
        r.O = obuf + row0 * DM + head * DV; r.P0 = qb * 256; return r; }
};
struct XaRefs {
    const Params* p; int b, G;
    __device__ __forceinline__ int count() const { return b < 256 ? (256 - b + G - 1) / G : 0; }
    __device__ __forceinline__ att::BlockRef ref(int i) const {
        const int L = b + i * G, head = L & 3, qb = L >> 2; att::BlockRef r; const size_t row0 = (size_t)qb * 256;
        r.Q = p->qx + row0 * XW + head * 128; r.QR = nullptr; r.K = p->memkv + head * 128; r.KR = nullptr; r.V = p->memkv + XW + head * 128; r.O = p->ox + row0 * XW + head * 128; r.P0 = 0; return r; }
};

constexpr int RING_BYTES = 155648, MISC_OFF = RING_BYTES + 320, LDS_BYTES = 159744;
constexpr int NPHASE = 16;
#ifndef MK_ONE_LAUNCH
#define MK_ONE_LAUNCH 1
#endif

__global__ void __launch_bounds__(NWAVES * 64, 2) hybrid_fwd(Params p) {
    extern __shared__ __attribute__((aligned(16))) unsigned char lds[];
    Frame F;
    F.lds = (LAS unsigned char*)lds; F.wave = __builtin_amdgcn_readfirstlane((int)threadIdx.x >> 6);
    F.G = gridDim.x; { const int bx = blockIdx.x; F.vcu = (F.G % 8 == 0) ? (bx % 8) * (F.G / 8) + bx / 8 : bx; }
    F.gw = F.vcu * NWAVES + F.wave; F.NGW = F.G * NWAVES;
    volatile LAS unsigned* MISC = (volatile LAS unsigned*)(F.lds + MISC_OFF);
    for (int u = threadIdx.x; u < (LDS_BYTES - RING_BYTES) / 4; u += NWAVES * 64) ((LAS unsigned*)(F.lds + RING_BYTES))[u] = 0u;
    __syncthreads();
    const int lo = p.ph_lo, hi = p.ph_hi;
    XcdBarrier bar; bar.bar = p.ctl + 4096; bar.x = 0; bar.st = nullptr;
    if (hi - lo > 1) bar = xcd_barrier_post(p.ctl + 4096, MISC + 8);
#ifndef PHMASK
#define PHMASK 0xFFFF
#endif
#define IN(k) ((((PHMASK) >> (k)) & 1) && lo <= (k) && (k) < hi)
#define SEAM(k) do { if (IN(k) && IN((k) + 1)) xcd_barrier(bar); } while (0)
    const int G = F.G, bx = blockIdx.x;
    LAS unsigned char* ring = F.lds;

#ifndef REP3_OBUF
#define REP3_OBUF p.ymla
#endif
#ifndef REPMASK
#define REPMASK 0
#endif
#ifndef REPCOND
#define REPCOND 1
#endif
#define REP(k) ((((REPMASK) >> (k)) & 1) && lo <= ((k) & 15) && ((k) & 15) < hi && (REPCOND))
#define B0 { p0_prologue(p, F); }
#define B1 { kpe_phase(p, F); \
        pg8::Gemm g{p.hn, p.WinT, DM, DM, DM, 0}; pg8::StaticOrder S; S.init(SEQ, 6144, G, bx); \
        pg8::EpiProj E{p.ub, p.qa, p.kva, p.sgs, p.sgm, p.qss, p.kvss}; pg8::gemm_phase(ring, g, S, E); }
#define B2 { s5_pass_a(p, F); \
        { pg8::Gemm g{p.qa, p.WuqT, QL, QL, QL, 0}; pg8::StaticOrder S; S.init(SEQ, 3072, G, bx); pg8::EpiQup E{p.qn, p.qr, p.qss, p.cosT, p.sinT}; pg8::gemm_phase(ring, g, S, E); } \
        { pg8::Gemm g{p.kva, p.WukvT, KVL, KVL, KVL, 0}; pg8::StaticOrder S; S.init(SEQ, 4096, G, bx); pg8::EpiKVup E{p.kn, p.vv, p.kvss}; pg8::gemm_phase(ring, g, S, E); } \
        { pg8::Gemm g{p.memn, p.WxkvT, DM, DM, DM, 0}; pg8::StaticOrder S; S.init(MEML, 2 * XW, G, bx); pg8::EpiPlain E{p.memkv, 2 * XW}; pg8::gemm_phase(ring, g, S, E); } }
#define B3A { s5_pass_c(p, F); __syncthreads(); }
#define B3B_(OB) { const att::Strides T{DM, NHEAD * DROPE, DM, DM, DM, SEQ}; const MlaRefs R{&p, bx, G, OB}; for (int i = 0, n = R.count(); i < n; ++i) att::attn_block_simple<true, true>(R.ref(i), T, (char*)lds); }
#define B4 { pg8::Gemm g{p.zb, p.WgluT, SSM_W, SSM_W, SSM_W, 0}; pg8::StaticOrder S; S.init(SEQ, SSM_W, G, bx); pg8::EpiGlu E{p.zb, p.b_glu, p.ys}; pg8::gemm_phase(ring, g, S, E); }
#define B5 { pg8::Gemm g{p.ys, p.WupsT, SSM_W, SSM_W, SSM_W, 0}; pg8::StaticOrder S; S.init(SEQ, DM, G, bx); pg8::EpiGate E{p.sgs, nullptr, p.t1}; pg8::gemm_phase(ring, g, S, E); }
#define B6 { pg8::Gemm g{p.ymla, p.WupmT, DM, DM, DM, 0}; pg8::StaticOrder S; S.init(SEQ, DM, G, bx); pg8::EpiGate E{p.sgm, p.t1, p.mg}; pg8::gemm_phase(ring, g, S, E); }
#define B7 { pg8::Gemm g{p.mg, p.WoutT, DM, DM, DM, 0}; pg8::StaticOrder S; S.init(SEQ, DM, G, bx); pg8::EpiResid E{p.x, p.x1, p.x1b, p.ss1}; pg8::gemm_phase(ring, g, S, E); }
#define B8 { pg8::Gemm g{p.x1b, p.WxqT, DM, DM, DM, 0}; pg8::StaticOrder S; S.init(SEQ, XW, G, bx); pg8::EpiXq E{p.qx, p.ss1}; pg8::gemm_phase(ring, g, S, E); }
#define B9 { const att::Strides T{XW, 0, 2 * XW, 2 * XW, XW, MEML}; const XaRefs R{&p, bx, G}; attn_stream<false, false>(R, T, (char*)lds); }
#define B10 { pg8::Gemm g{p.ox, p.WxoT, XW, XW, XW, 0}; pg8::StaticOrder S; S.init(SEQ, DM, G, bx); pg8::EpiResid E{p.x1, p.x2, nullptr, p.ss2}; pg8::gemm_phase(ring, g, S, E); }
#define B11 { router_phase(p, F); }
#define B12 { assign_phase(p, F); }
#define B13 { const int nblk = __builtin_amdgcn_readfirstlane(p.blke[MAXBLK]); \
        pg8::Gemm g{(const bf16_t*)p.xg, (const bf16_t*)p.WguT, DM / 2, DM / 2, DM / 2, (size_t)2 * DFF * DM / 2}; pg8::MoeOrder S; S.init(nblk, 2 * DFF, G, bx, p.blke); pg8::EpiMoeGU E{p.b_gu, p.act}; pg8::gemm_phase<pg8::EpiMoeGU, pg8::MoeOrder, true>(ring, g, S, E); }
#define B14 { const int nblk = __builtin_amdgcn_readfirstlane(p.blke[MAXBLK]); \
        pg8::Gemm g{(const bf16_t*)p.act, (const bf16_t*)p.WdnT, DFF / 2, DFF / 2, DFF / 2, (size_t)DM * DFF / 2}; pg8::MoeOrder S; S.init(nblk, DM, G, bx, p.blke); pg8::EpiMoeDown E{p.b_dn, p.orow}; pg8::gemm_phase<pg8::EpiMoeDown, pg8::MoeOrder, true>(ring, g, S, E); }
#define B15 { combine_phase(p, F); }
    if (IN(0)) B0 if (REP(0)) B0 SEAM(0);
    if (IN(1)) B1 if (REP(1)) B1 SEAM(1);
    if (IN(2)) B2 if (REP(2)) B2 SEAM(2);
    if (IN(3)) { B3A if (REP(16)) B3A B3B_(p.ymla) if (REP(3)) B3B_(REP3_OBUF) } SEAM(3);
    if (IN(4)) B4 if (REP(4)) B4 SEAM(4);
    if (IN(5)) B5 if (REP(5)) B5 SEAM(5);
    if (IN(6)) B6 if (REP(6)) B6 SEAM(6);
    if (IN(7)) B7 if (REP(7)) B7 SEAM(7);
    if (IN(8)) B8 if (REP(8)) B8 SEAM(8);
    if (IN(9)) B9 if (REP(9)) B9 SEAM(9);
    if (IN(10)) B10 if (REP(10)) B10 SEAM(10);
    if (IN(11)) B11 if (REP(11)) B11 SEAM(11);
    if (IN(12)) B12 if (REP(12)) B12 SEAM(12);
    if (IN(13)) B13 if (REP(13)) B13 SEAM(13);
    if (IN(14)) B14 if (REP(14)) B14 SEAM(14);
    if (IN(15)) B15 if (REP(15)) B15
#undef IN
#undef SEAM
}

extern "C" void kernel_launch(void* const* d_in, const int* in_sizes, int n_in, void* d_out, int out_size, void* d_ws, size_t ws_size, hipStream_t stream) {
    static int grid = 0;
    if (grid == 0) {
        if (n_in != 37 || in_sizes[0] != SEQ * DM || out_size != SEQ * DM) { fprintf(stderr, "kernel_launch: unexpected shapes (n_in %d)\n", n_in); grid = -1; return; }
        int dev = 0, cus = 0;
        if (hipGetDevice(&dev) != hipSuccess || hipDeviceGetAttribute(&cus, hipDeviceAttributeMultiprocessorCount, dev) != hipSuccess) { grid = -1; return; }
        if (hipFuncSetAttribute((const void*)hybrid_fwd, hipFuncAttributeMaxDynamicSharedMemorySize, LDS_BYTES) != hipSuccess) { fprintf(stderr, "kernel_launch: hipFuncSetAttribute failed\n"); grid = -1; return; }
        int per_cu = 0;
        if (hipOccupancyMaxActiveBlocksPerMultiprocessor(&per_cu, (const void*)hybrid_fwd, NWAVES * 64, LDS_BYTES) != hipSuccess || per_cu < 1) { fprintf(stderr, "kernel_launch: occupancy query says %d\n", per_cu); }
        (void)hipGetLastError();
        grid = cus > 0 ? cus : 256;
    }
    if (grid < 0) return;
    Params p; memset(&p, 0, sizeof(p));
    const float* const* in = (const float* const*)d_in;
    p.x = in[0]; p.mem = in[1]; p.pos = (const int*)d_in[2]; p.norm_mix = in[3]; p.w_in = in[4]; p.lam_re = in[5]; p.lam_im = in[6]; p.log_step = in[7]; p.b_re = in[8]; p.b_im = in[9];
    p.c_re = in[10]; p.c_im = in[11]; p.ssm_d = in[12]; p.w_glu = in[13]; p.b_glu = in[14]; p.q_norm = in[15]; p.w_uq = in[16]; p.kv_norm = in[17]; p.w_uk = in[18]; p.w_uv = in[19];
    p.w_up_ssm = in[20]; p.w_up_mla = in[21]; p.w_out = in[22]; p.norm_xattn = in[23]; p.norm_mem = in[24]; p.xa_wq = in[25]; p.xa_wk = in[26]; p.xa_wv = in[27]; p.xa_wo = in[28];
    p.norm_moe = in[29]; p.router_w = in[30]; p.router_b = in[31]; p.w_gu = in[32]; p.b_gu = in[33]; p.w_dn = in[34]; p.b_dn = in[35]; p.final_norm = in[36];
    p.out = (float*)d_out;
    size_t off = 0; unsigned char* ws = (unsigned char*)d_ws;
    auto take = [&](size_t bytes) { unsigned char* r = ws + off; off += (bytes + 4095) & ~(size_t)4095; return r; };
    p.ctl = (unsigned*)take(1 << 20);
    p.WinT = (bf16_t*)take((size_t)6144 * DM * 2); p.WkpeT = (bf16_t*)take((size_t)64 * DM * 2); p.WgluT = (bf16_t*)take((size_t)SSM_W * SSM_W * 2); p.WuqT = (bf16_t*)take((size_t)3072 * QL * 2);
    p.WukvT = (bf16_t*)take((size_t)4096 * KVL * 2); p.WupsT = (bf16_t*)take((size_t)DM * SSM_W * 2); p.WupmT = (bf16_t*)take((size_t)DM * DM * 2); p.WoutT = (bf16_t*)take((size_t)DM * DM * 2);
    p.WxqT = (bf16_t*)take((size_t)XW * DM * 2); p.WxkvT = (bf16_t*)take((size_t)2 * XW * DM * 2); p.WxoT = (bf16_t*)take((size_t)DM * XW * 2);
    p.WguT = (unsigned char*)take((size_t)NEXP * 2 * DFF * DM); p.WdnT = (unsigned char*)take((size_t)NEXP * DM * DFF); p.WrT = (float*)take((size_t)DM * NEXP * 4);
    p.hn = (bf16_t*)take((size_t)SEQ * DM * 2); p.memn = (bf16_t*)take((size_t)MEML * DM * 2); p.cosT = (float*)take((size_t)SEQ * 32 * 4); p.sinT = (float*)take((size_t)SEQ * 32 * 4);
    p.abar = (float*)take((size_t)SSM_G * SSM_P * 8); p.bbarT = (bf16_t*)take((size_t)SSM_G * 128 * 16 * 2); p.cmat = (bf16_t*)take((size_t)SSM_G * 16 * 128 * 2);
    p.ub = (bf16_t*)take((size_t)SEQ * SSM_W * 2); p.qa = (bf16_t*)take((size_t)SEQ * QL * 2); p.kva = (bf16_t*)take((size_t)SEQ * KVL * 2); p.qss = (float*)take((size_t)SEQ * 8 * 4); p.kvss = (float*)take((size_t)SEQ * 8 * 4);
    p.sgs = (bf16_t*)take((size_t)SEQ * DM * 2); p.sgm = (bf16_t*)take((size_t)SEQ * DM * 2); p.kpe = (bf16_t*)take((size_t)SEQ * DROPE * 2);
    p.qn = (bf16_t*)take((size_t)SEQ * DM * 2); p.qr = (bf16_t*)take((size_t)SEQ * NHEAD * DROPE * 2); p.kn = (bf16_t*)take((size_t)SEQ * DM * 2); p.vv = (bf16_t*)take((size_t)SEQ * DM * 2); p.ymla = (bf16_t*)take((size_t)SEQ * DM * 2);
    p.send = (float*)take((size_t)S5_NCH * SSM_G * 64 * 8); p.zb = (bf16_t*)take((size_t)SEQ * SSM_W * 2); p.ys = (bf16_t*)take((size_t)SEQ * SSM_W * 2); p.t1 = (bf16_t*)take((size_t)SEQ * DM * 2); p.mg = (bf16_t*)take((size_t)SEQ * DM * 2);
    p.x1 = (float*)take((size_t)SEQ * DM * 4); p.x1b = (bf16_t*)take((size_t)SEQ * DM * 2); p.ss1 = (float*)take((size_t)SEQ * 32 * 4);
    p.memkv = (bf16_t*)take((size_t)MEML * 2 * XW * 2); p.qx = (bf16_t*)take((size_t)SEQ * XW * 2); p.ox = (bf16_t*)take((size_t)SEQ * XW * 2);
    p.x2 = (float*)take((size_t)SEQ * DM * 4); p.ss2 = (float*)take((size_t)SEQ * 32 * 4);
    p.topi = (int*)take((size_t)SEQ * 4 * 4); p.topw = (float*)take((size_t)SEQ * 4 * 4); p.rank = (int*)take((size_t)SEQ * 4 * 4); p.slot = (int*)take((size_t)SEQ * 4 * 4); p.wgcnt = (int*)take((size_t)256 * 32 * 4); p.blke = (int*)take((size_t)(MAXBLK + 8) * 4);
    p.xg = (unsigned char*)take((size_t)NSLOT * DM); p.act = (unsigned char*)take((size_t)NSLOT * DFF); p.orow = (bf16_t*)take((size_t)NSLOT * DM * 2);
    if (off > ws_size) { fprintf(stderr, "kernel_launch: workspace too small: need %zu have %zu\n", off, ws_size); return; }
    (void)hipMemsetAsync(p.ctl, 0, 1 << 20, stream);
#if MK_ONE_LAUNCH
    p.ph_lo = 0; p.ph_hi = NPHASE;
    hipLaunchKernelGGL(hybrid_fwd, dim3(grid), dim3(NWAVES * 64), LDS_BYTES, stream, p);
#else
    for (int k = 0; k < NPHASE; ++k) { p.ph_lo = k; p.ph_hi = k + 1; hipLaunchKernelGGL(hybrid_fwd, dim3(grid), dim3(NWAVES * 64), LDS_BYTES, stream, p); }
#endif
}
```

```cpp
#include <hip/hip_runtime.h>
#include <cstdio>
#include <cstdint>
#include <cstring>

#define LAS __attribute__((address_space(3)))
#define GAS __attribute__((address_space(1)))
typedef unsigned short bf16_t;
typedef short bf16x8 __attribute__((ext_vector_type(8)));
typedef short s16x4 __attribute__((ext_vector_type(4)));
typedef float f32x4 __attribute__((ext_vector_type(4)));
typedef float f32x2 __attribute__((ext_vector_type(2)));
typedef float f32x16 __attribute__((ext_vector_type(16)));
typedef unsigned u32x4 __attribute__((ext_vector_type(4)));
typedef unsigned u32x2 __attribute__((ext_vector_type(2)));
typedef GAS unsigned gu32;

constexpr int SEQ = 16384, DM = 2048;
constexpr int SSM_W = 1024, SSM_G = 64, SSM_P = 64, SSM_H = 16;
constexpr int QL = 512, KVL = 512, NHEAD = 16, DNOPE = 128, DROPE = 64, DV = 128;
constexpr int IN_COLS = 6208;
constexpr int MEML = 256, XH = 4, XW = 512;
constexpr int NEXP = 32, TOPK = 4, DFF = 2048;
constexpr int NSLOT = SEQ * TOPK + NEXP * 256;
constexpr int MAXBLK = NSLOT / 256;
constexpr float EPS = 1e-6f;
constexpr int NWAVES = 8;

#define LDS_WAIT() asm volatile("s_waitcnt lgkmcnt(0)" ::: "memory")
#define VM_WAIT() asm volatile("s_waitcnt vmcnt(0)" ::: "memory")
#define SBAR() __builtin_amdgcn_sched_barrier(0)
__device__ __forceinline__ unsigned cvtpk(float lo, float hi) { unsigned r; asm volatile("v_cvt_pk_bf16_f32 %0, %1, %2" : "=v"(r) : "v"(lo), "v"(hi)); return r; }
__device__ __forceinline__ float bf2f(unsigned short b) { return __uint_as_float(((unsigned)b) << 16); }
__device__ __forceinline__ float bflo(unsigned w) { return __uint_as_float(w << 16); }
__device__ __forceinline__ float bfhi(unsigned w) { return __uint_as_float(w & 0xffff0000u); }
__device__ __forceinline__ unsigned short f2bf(float f) { return (unsigned short)(cvtpk(f, f) & 0xffffu); }
__device__ __forceinline__ u32x4 pack8f(f32x4 a, f32x4 b) { u32x4 w = {cvtpk(a[0], a[1]), cvtpk(a[2], a[3]), cvtpk(b[0], b[1]), cvtpk(b[2], b[3])}; return w; }
__device__ __forceinline__ void unpack8(u32x4 w, f32x4& a, f32x4& b) { a = (f32x4){bflo(w.x), bfhi(w.x), bflo(w.y), bfhi(w.y)}; b = (f32x4){bflo(w.z), bfhi(w.z), bflo(w.w), bfhi(w.w)}; }
__device__ __forceinline__ float fsigmoid(float x) { return __builtin_amdgcn_rcpf(1.0f + __builtin_amdgcn_exp2f(-1.4426950408889634f * x)); }
__device__ __forceinline__ float gelu_tanh(float x) {
    const float u = 0.7978845608028654f * (x + 0.044715f * x * x * x);
    return x * fsigmoid(2.0f * u);
}
__device__ __forceinline__ float wave_sum(float v) {
#pragma unroll
    for (int o = 1; o < 64; o <<= 1) v += __shfl_xor(v, o);
    return v;
}

#define XB_TMO      128
#define XB_XCNT(j)  (256  + 64 * (j))
#define XB_XSUB(j)  (1280 + 64 * (j))
#define XB_XGEN(j)  (2304 + 64 * (j))
#define XB_TOP      3328
#define XB_TOPGEN   3392
#define XCD_BAR_WORDS 3456
#define XB_SPIN_CAP (1u << 18)
__device__ __forceinline__ unsigned xb_ld(unsigned* p)              { return __hip_atomic_load(p, __ATOMIC_RELAXED, __HIP_MEMORY_SCOPE_AGENT); }
__device__ __forceinline__ unsigned xb_add(unsigned* p, unsigned v) { return __hip_atomic_fetch_add(p, v, __ATOMIC_RELAXED, __HIP_MEMORY_SCOPE_AGENT); }
__device__ __forceinline__ unsigned xb_xcc_id() { return (unsigned)__builtin_amdgcn_s_getreg((3 << 11) | 20) & 0xFu; }
#define XB_SPIN(cond, bar) do { unsigned _sp = 0; while (cond) { __builtin_amdgcn_s_sleep(1); \
    if ((++_sp & 255u) == 0u) { if (xb_ld(&(bar)[XB_TMO])) break; if (_sp > XB_SPIN_CAP) { atomicAdd(&(bar)[XB_TMO], 1u); break; } } } } while (0)
struct XcdBarrier { unsigned* bar; unsigned x; volatile LAS unsigned* st; };
__device__ __forceinline__ XcdBarrier xcd_barrier_post(unsigned* bar, volatile LAS unsigned* st) {
    XcdBarrier b; b.bar = bar; b.x = xb_xcc_id(); b.st = st;
    if (threadIdx.x == 0) (void)xb_add(&bar[XB_XCNT(b.x)], 1u);
    return b;
}
__device__ __forceinline__ void xcd_barrier_complete(unsigned* bar, unsigned x, unsigned& nloc, unsigned& nx) {
    const unsigned G = gridDim.x * gridDim.y * gridDim.z;
    unsigned sum, cnt, mine, sp = 0u;
    for (;;) {
        sum = 0u; cnt = 0u; mine = 0u;
#pragma unroll
        for (unsigned j = 0; j < 16; ++j) { const unsigned c = xb_ld(&bar[XB_XCNT(j)]); sum += c; cnt += (c > 0u) ? 1u : 0u; mine = (j == x) ? c : mine; }
        if (sum == G) break;
        __builtin_amdgcn_s_sleep(1);
        if ((++sp & 255u) == 0u) { if (xb_ld(&bar[XB_TMO])) break; if (sp > XB_SPIN_CAP) { atomicAdd(&bar[XB_TMO], 1u); break; } }
    }
    nloc = mine > 0u ? mine : 1u; nx = cnt > 0u ? cnt : 1u;
}
__device__ __forceinline__ void xcd_barrier(const XcdBarrier& b) {
    asm volatile("s_waitcnt vmcnt(0)" ::: "memory");
    __syncthreads();
    if (threadIdx.x == 0) {
        unsigned* bar = b.bar;
        __builtin_amdgcn_s_waitcnt(0);
        unsigned nloc = b.st[0], nx = b.st[1];
        if (nloc == 0u) { xcd_barrier_complete(bar, b.x, nloc, nx); b.st[0] = nloc; b.st[1] = nx; }
        const unsigned old = xb_add(&bar[XB_XSUB(b.x)], 1u);
        const unsigned gen = old / nloc;
        if (old + 1u == (gen + 1u) * nloc) {
            __builtin_amdgcn_fence(__ATOMIC_RELEASE, "agent");
            asm volatile("s_waitcnt vmcnt(0)" ::: "memory");
            const unsigned og = xb_add(&bar[XB_TOP], 1u);
            const unsigned tg = og / nx;
            if (og + 1u == (tg + 1u) * nx) xb_add(&bar[XB_TOPGEN], 1u);
            else XB_SPIN(xb_ld(&bar[XB_TOPGEN]) == tg, bar);
            __builtin_amdgcn_fence(__ATOMIC_ACQUIRE, "agent");
            xb_add(&bar[XB_XGEN(b.x)], 1u);
            asm volatile("s_waitcnt vmcnt(0)" ::: "memory");
        } else {
            XB_SPIN(xb_ld(&bar[XB_XGEN(b.x)]) == gen, bar);
            __builtin_amdgcn_fence(__ATOMIC_ACQUIRE, "agent");
            asm volatile("s_waitcnt vmcnt(0)" ::: "memory");
        }
    }
    __syncthreads();
}
namespace pg8 {
constexpr int BM = 256, BK = 64, HALF = 128, HTB = HALF * BK * 2, NXCD = 8, WGM = 8;
__host__ __device__ __forceinline__ int lds_byte(int r, int c) { const int st = (r >> 4) * 2 + (c >> 5), rr = r & 15, cc = c & 31, ob = rr * 64 + cc * 2; return st * 1024 + (ob ^ (((ob >> 9) & 1) << 5)); }
__host__ __device__ __forceinline__ void stage_rc(int b, int& R, int& C) { const int st = b / 1024, sb = b % 1024, swz = sb ^ (((sb >> 9) & 1) << 5); R = (st >> 1) * 16 + swz / 64; C = (st & 1) * 32 + (swz % 64) / 2; }
__host__ __device__ __forceinline__ int perm32(int rho) { const int n = rho >> 4, i = rho & 15; return 8 * (i >> 2) + 4 * n + (i & 3); }

struct Unit { int pm, pn, e; };
struct Gemm { const bf16_t* A; const bf16_t* Bt; int lda, ldb, K; size_t bstride; };

struct StaticOrder {
    int nM, nN, nwg, G, c;
    __device__ void init(int M, int N, int G_, int c_) { nM = M / BM; nN = N / BM; nwg = nM * nN; G = G_; c = c_; }
    __device__ bool next(int i, Unit& u) const {
        const long L = (long)i * G + c; if (L >= nwg) return false;
        int wgid = (int)L; { const int q = nwg / NXCD, r = nwg % NXCD, xcd = wgid % NXCD, off = wgid / NXCD; wgid = (xcd < r ? xcd * (q + 1) : r * (q + 1) + (xcd - r) * q) + off; }
        const int nig = WGM * nN, gid = wgid / nig, fm = gid * WGM, gsz = (nM - fm) < WGM ? (nM - fm) : WGM;
        u.pm = fm + ((wgid % nig) % gsz); u.pn = (wgid % nig) / gsz; u.e = 0; return true;
    }
};
struct MoeOrder {
    StaticOrder so; const int* blk_e;
    __device__ void init(int nblk, int N, int G_, int c_, const int* be) { so.nM = nblk; so.nN = N / BM; so.nwg = so.nM * so.nN; so.G = G_; so.c = c_; blk_e = be; }
    __device__ bool next(int i, Unit& u) const { if (!so.next(i, u)) return false; u.e = __builtin_amdgcn_readfirstlane(blk_e[u.pm]); return true; }
};

typedef int v4i_t __attribute__((ext_vector_type(4)));
typedef int v8i_t __attribute__((ext_vector_type(8)));
#define PG8_CAT8(a, b) __builtin_shufflevector(__builtin_bit_cast(v4i_t, a), __builtin_bit_cast(v4i_t, b), 0, 1, 2, 3, 4, 5, 6, 7)
template <class Epi, class Sched, bool F8 = false>
__device__ __forceinline__ void gemm_phase(LAS unsigned char* lds, const Gemm g, const Sched& S, const Epi& E) {
    constexpr bool ALIGN_EPI = true;
    const int tid = threadIdx.x, wid = __builtin_amdgcn_readfirstlane(tid >> 6), lane = tid & 63, wr = wid >> 2, wc = wid & 3, fr = lane & 15, fq = lane >> 4;
    const int K = g.K, nt = K / BK;
    unsigned voffA[2], voffB[2];
#pragma unroll
    for (int i = 0; i < 2; ++i) { int R, C; stage_rc(tid * 16 + i * 8192, R, C); const int Rb = Epi::PERM ? ((R & ~31) + perm32(R & 31)) : R;
        voffA[i] = (unsigned)(R * g.lda + C) * 2u; voffB[i] = (unsigned)(Rb * g.ldb + C) * 2u; }
    const size_t kstep = (size_t)(BK * 2);
    const size_t hstepA = (size_t)HALF * g.lda * 2, hstepB = (size_t)HALF * g.ldb * 2;
    const unsigned ldsw = (unsigned)wid * 1024u;
    const int aoff = lds_byte(wr * 64 + fr, fq * 8), boff = lds_byte(wc * 32 + fr, fq * 8);
#define PG8_SA(b, h) (((b) * 2 + (h)) * HTB)
#define PG8_SB(b, h) ((4 + (b) * 2 + (h)) * HTB)
#define PG8_STAGE(bufoff, gbase, voff) do { _Pragma("unroll") for (int _i = 0; _i < 2; ++_i) \
        __builtin_amdgcn_global_load_lds((const unsigned*)((const char*)(gbase) + (voff)[_i]), (LAS unsigned*)(lds + (bufoff) + ldsw + _i * 8192), 16, 0, 0); } while (0)
#define PG8_LDA(dst, b, h) do { _Pragma("unroll") for (int m = 0; m < 4; ++m) _Pragma("unroll") for (int k = 0; k < 2; ++k) dst[m][k] = *(const LAS bf16x8*)(lds + PG8_SA(b, h) + aoff + m * 2048 + k * 1024); } while (0)
#define PG8_LDB(dst, b, h) do { _Pragma("unroll") for (int n = 0; n < 2; ++n) _Pragma("unroll") for (int k = 0; k < 2; ++k) dst[n][k] = *(const LAS bf16x8*)(lds + PG8_SB(b, h) + boff + n * 2048 + k * 1024); } while (0)
#define PG8_MMA(ai, bj, At, Bt) do { __builtin_amdgcn_s_setprio(1); _Pragma("unroll") for (int m = 0; m < 4; ++m) _Pragma("unroll") for (int n = 0; n < 2; ++n) { \
        if constexpr (F8) { const v8i_t b8_ = PG8_CAT8(Bt[n][0], Bt[n][1]), a8_ = PG8_CAT8(At[m][0], At[m][1]); asm volatile("v_mfma_f32_16x16x128_f8f6f4 %0, %1, %2, %0" : "+v"(acc[ai][bj][m][n]) : "v"(b8_), "v"(a8_)); }   \
        else { _Pragma("unroll") for (int k = 0; k < 2; ++k) acc[ai][bj][m][n] = __builtin_amdgcn_mfma_f32_16x16x32_bf16(Bt[n][k], At[m][k], acc[ai][bj][m][n], 0, 0, 0); } } __builtin_amdgcn_s_setprio(0); } while (0)
#define PG8_WAIT_V(n) asm volatile("s_waitcnt vmcnt(" #n ")" ::: "memory")
#define PG8_WAIT_L(n) asm volatile("s_waitcnt lgkmcnt(" #n ")" ::: "memory")
#define PG8_BAR __builtin_amdgcn_s_barrier()
#define PG8_SCHED __builtin_amdgcn_sched_barrier(0)
#define PG8_ABASE(u) ((const char*)g.A + (size_t)(u).pm * BM * g.lda * 2)
#define PG8_BBASE(u) ((const char*)g.Bt + ((size_t)(u).e * g.bstride + (size_t)(u).pn * BM * g.ldb) * 2)
    Unit cur, nxt; int ui = 0;
    if (!S.next(0, cur)) return;
    f32x4 acc[2][2][4][2];
#pragma unroll
    for (int a = 0; a < 2; ++a)
#pragma unroll
        for (int b = 0; b < 2; ++b)
#pragma unroll
            for (int m = 0; m < 4; ++m)
#pragma unroll
                for (int n = 0; n < 2; ++n) acc[a][b][m][n] = (f32x4){0.f, 0.f, 0.f, 0.f};
    bf16x8 At[4][2], B0[2][2], B1[2][2];
    const char* cA = PG8_ABASE(cur); const char* cB = PG8_BBASE(cur);
    PG8_STAGE(PG8_SB(0, 0), cB, voffB); PG8_STAGE(PG8_SB(0, 1), cB + hstepB, voffB); PG8_STAGE(PG8_SA(0, 0), cA, voffA); PG8_STAGE(PG8_SA(0, 1), cA + hstepA, voffA);
    if (wr == 1) PG8_BAR;
    PG8_WAIT_V(2); PG8_BAR;
    PG8_STAGE(PG8_SB(1, 0), cB + kstep, voffB); PG8_STAGE(PG8_SA(1, 0), cA + kstep, voffA); PG8_STAGE(PG8_SB(1, 1), cB + hstepB + kstep, voffB);
    PG8_WAIT_V(6); PG8_BAR;
    for (;;) {
        const bool has_next = S.next(ui + 1, nxt);
        const char* nA = has_next ? PG8_ABASE(nxt) : cA; const char* nB = has_next ? PG8_BBASE(nxt) : cB;
        for (int t = 0; t < nt; t += 2) {
            const bool last = (t == nt - 2);
            const char* a1 = cA + (size_t)(t + 1) * kstep;
            const char* a2 = last ? nA : cA + (size_t)(t + 2) * kstep; const char* b2 = last ? nB : cB + (size_t)(t + 2) * kstep;
            const char* a3 = a2 + kstep; const char* b3 = b2 + kstep;
            PG8_LDB(B0, 0, 0); PG8_LDB(B1, 0, 1); PG8_SCHED; PG8_LDA(At, 0, 0); PG8_STAGE(PG8_SA(1, 1), a1 + hstepA, voffA);
            PG8_WAIT_V(8); PG8_WAIT_L(0); PG8_BAR; PG8_MMA(0, 0, At, B0); PG8_MMA(0, 1, At, B1); PG8_BAR; PG8_SCHED;
            PG8_LDA(At, 0, 1); PG8_STAGE(PG8_SB(0, 0), b2, voffB); PG8_STAGE(PG8_SB(0, 1), b2 + hstepB, voffB); PG8_STAGE(PG8_SA(0, 0), a2, voffA);
            PG8_WAIT_V(8); PG8_WAIT_L(0); PG8_BAR; PG8_MMA(1, 0, At, B0); PG8_MMA(1, 1, At, B1); PG8_BAR; PG8_SCHED;
            PG8_LDB(B0, 1, 0); PG8_LDB(B1, 1, 1); PG8_SCHED; PG8_LDA(At, 1, 0); PG8_STAGE(PG8_SA(0, 1), a2 + hstepA, voffA);
            PG8_WAIT_V(8); PG8_WAIT_L(0); PG8_BAR; PG8_MMA(0, 0, At, B0); PG8_MMA(0, 1, At, B1); PG8_BAR; PG8_SCHED;
            PG8_LDA(At, 1, 1); PG8_STAGE(PG8_SB(1, 0), b3, voffB); PG8_STAGE(PG8_SB(1, 1), b3 + hstepB, voffB); PG8_STAGE(PG8_SA(1, 0), a3, voffA);
            PG8_WAIT_V(8); PG8_WAIT_L(0); PG8_BAR; PG8_MMA(1, 0, At, B0); PG8_MMA(1, 1, At, B1); PG8_BAR; PG8_SCHED;
        }
        if constexpr (ALIGN_EPI) { if (wr == 0) PG8_BAR; }
        if constexpr (F8) asm volatile("s_nop 15\n\ts_nop 15\n\ts_nop 15" ::: "memory");
        E(acc, cur, wr, wc, fr, fq);
        if (!has_next) break;
#pragma unroll
        for (int a = 0; a < 2; ++a)
#pragma unroll
            for (int b = 0; b < 2; ++b)
#pragma unroll
                for (int m = 0; m < 4; ++m)
#pragma unroll
                    for (int n = 0; n < 2; ++n) acc[a][b][m][n] = (f32x4){0.f, 0.f, 0.f, 0.f};
        cur = nxt; cA = nA; cB = nB; ++ui;
        if constexpr (ALIGN_EPI) { if (wr == 1) PG8_BAR; }
    }
    PG8_WAIT_V(0);
    if constexpr (!ALIGN_EPI) { if (wr == 0) PG8_BAR; }
    PG8_BAR;
#undef PG8_SA
#undef PG8_SB
#undef PG8_STAGE
#undef PG8_LDA
#undef PG8_LDB
#undef PG8_MMA
#undef PG8_WAIT_V
#undef PG8_WAIT_L
#undef PG8_BAR
#undef PG8_SCHED
#undef PG8_ABASE
#undef PG8_BBASE
}

#define EPI_ROW(u, ai, m) ((u).pm * BM + (ai) * HALF + wr * 64 + (m) * 16 + fr)
#define EPI_CB(bj) ((bj) * HALF + wc * 32 + 8 * fq)
typedef f32x4 AccT[2][2][4][2];

__device__ __forceinline__ f32x4 sig4(f32x4 v) { return (f32x4){fsigmoid(v[0]), fsigmoid(v[1]), fsigmoid(v[2]), fsigmoid(v[3])}; }
__device__ __forceinline__ float sq4(f32x4 v) { return (v[0] * v[0] + v[1] * v[1]) + (v[2] * v[2] + v[3] * v[3]); }

struct EpiProj {
    static constexpr bool PERM = true;
    bf16_t *ub, *qa, *kva, *sgs, *sgm; float *qss, *kvss;
    __device__ __forceinline__ void operator()(const AccT& acc, const Unit& u, int wr, int wc, int fr, int fq) const {
        const int pn = u.pn; bf16_t* dst; int ld, c0; float* ss = nullptr; int ssl = 0; bool sg = false;
        if (pn < 4) { dst = ub; ld = SSM_W; c0 = pn * BM; }
        else if (pn < 6) { dst = qa; ld = QL; c0 = (pn - 4) * BM; ss = qss; ssl = (pn - 4) * 4 + wc; }
        else if (pn < 8) { dst = kva; ld = KVL; c0 = (pn - 6) * BM; ss = kvss; ssl = (pn - 6) * 4 + wc; }
        else if (pn < 16) { dst = sgs; ld = DM; c0 = (pn - 8) * BM; sg = true; }
        else { dst = sgm; ld = DM; c0 = (pn - 16) * BM; sg = true; }
#pragma unroll
        for (int ai = 0; ai < 2; ++ai)
#pragma unroll
            for (int m = 0; m < 4; ++m) { const int row = EPI_ROW(u, ai, m); float s = 0.f;
#pragma unroll
                for (int bj = 0; bj < 2; ++bj) { f32x4 v0 = acc[ai][bj][m][0], v1 = acc[ai][bj][m][1];
                    if (sg) { v0 = sig4(v0); v1 = sig4(v1); }
                    s += sq4(v0) + sq4(v1);
                    *(u32x4*)(dst + (size_t)row * ld + c0 + EPI_CB(bj)) = pack8f(v0, v1); }
                if (ss) { s += __shfl_xor(s, 16); s += __shfl_xor(s, 32); if (fq == 0) ss[((size_t)(ssl >> 2) * SEQ + row) * 4 + (ssl & 3)] = s; } }
    }
};
__device__ __forceinline__ float row_rs8(const float* ss, int row, float invn) { const f32x4 a = *(const f32x4*)(ss + (size_t)row * 4), b = *(const f32x4*)(ss + ((size_t)SEQ + row) * 4);
    return __builtin_amdgcn_rsqf(((a[0] + a[1]) + (a[2] + a[3]) + (b[0] + b[1]) + (b[2] + b[3])) * invn + EPS); }
__device__ __forceinline__ float row_rs32(const float* ss, int row, float invn) { float s = 0.f;
#pragma unroll
    for (int i = 0; i < 8; ++i) { const f32x4 a = *(const f32x4*)(ss + ((size_t)i * SEQ + row) * 4); s += (a[0] + a[1]) + (a[2] + a[3]); }
    return __builtin_amdgcn_rsqf(s * invn + EPS); }

struct EpiQup {
    static constexpr bool PERM = true;
    bf16_t *qn, *qr; const float *ss, *cosT, *sinT;
    __device__ __forceinline__ void operator()(const AccT& acc, const Unit& u, int wr, int wc, int fr, int fq) const {
        const int pn = u.pn;
#pragma unroll
        for (int ai = 0; ai < 2; ++ai)
#pragma unroll
            for (int m = 0; m < 4; ++m) { const int row = EPI_ROW(u, ai, m); const float rs = row_rs8(ss, row, 1.0f / QL);
                if (pn < 8) {
#pragma unroll
                    for (int bj = 0; bj < 2; ++bj) *(u32x4*)(qn + (size_t)row * DM + pn * BM + EPI_CB(bj)) = pack8f(acc[ai][bj][m][0] * rs, acc[ai][bj][m][1] * rs);
                } else {
                    const int head = 4 * (pn - 8) + wc;
                    const f32x4 c0 = *(const f32x4*)(cosT + (size_t)row * 32 + 8 * fq), c1 = *(const f32x4*)(cosT + (size_t)row * 32 + 8 * fq + 4);
                    const f32x4 s0 = *(const f32x4*)(sinT + (size_t)row * 32 + 8 * fq), s1 = *(const f32x4*)(sinT + (size_t)row * 32 + 8 * fq + 4);
                    const f32x4 a0 = acc[ai][0][m][0] * rs, a1 = acc[ai][0][m][1] * rs, b0 = acc[ai][1][m][0] * rs, b1 = acc[ai][1][m][1] * rs;
                    *(u32x4*)(qr + (size_t)row * (NHEAD * DROPE) + head * DROPE + 8 * fq) = pack8f(a0 * c0 - b0 * s0, a1 * c1 - b1 * s1);
                    *(u32x4*)(qr + (size_t)row * (NHEAD * DROPE) + head * DROPE + 32 + 8 * fq) = pack8f(a0 * s0 + b0 * c0, a1 * s1 + b1 * c1);
                } }
    }
};
struct EpiKVup {
    static constexpr bool PERM = true;
    bf16_t *kn, *vv; const float* ss;
    __device__ __forceinline__ void operator()(const AccT& acc, const Unit& u, int wr, int wc, int fr, int fq) const {
        bf16_t* dst = u.pn < 8 ? kn : vv; const int c0 = (u.pn & 7) * BM;
#pragma unroll
        for (int ai = 0; ai < 2; ++ai)
#pragma unroll
            for (int m = 0; m < 4; ++m) { const int row = EPI_ROW(u, ai, m); const float rs = row_rs8(ss, row, 1.0f / KVL);
#pragma unroll
                for (int bj = 0; bj < 2; ++bj) *(u32x4*)(dst + (size_t)row * DM + c0 + EPI_CB(bj)) = pack8f(acc[ai][bj][m][0] * rs, acc[ai][bj][m][1] * rs); }
    }
};
struct EpiPlain {
    static constexpr bool PERM = true;
    bf16_t* O; int ld;
    __device__ __forceinline__ void operator()(const AccT& acc, const Unit& u, int wr, int wc, int fr, int fq) const {
#pragma unroll
        for (int ai = 0; ai < 2; ++ai)
#pragma unroll
            for (int m = 0; m < 4; ++m) { const int row = EPI_ROW(u, ai, m);
#pragma unroll
                for (int bj = 0; bj < 2; ++bj) *(u32x4*)(O + (size_t)row * ld + u.pn * BM + EPI_CB(bj)) = pack8f(acc[ai][bj][m][0], acc[ai][bj][m][1]); }
    }
};
struct EpiGlu {
    static constexpr bool PERM = true;
    const bf16_t* z; const float* bias; bf16_t* ys;
    __device__ __forceinline__ void operator()(const AccT& acc, const Unit& u, int wr, int wc, int fr, int fq) const {
#pragma unroll
        for (int bj = 0; bj < 2; ++bj) { const int col = u.pn * BM + EPI_CB(bj); const f32x4 b0 = *(const f32x4*)(bias + col), b1 = *(const f32x4*)(bias + col + 4);
#pragma unroll
            for (int ai = 0; ai < 2; ++ai)
#pragma unroll
                for (int m = 0; m < 4; ++m) { const size_t off = (size_t)EPI_ROW(u, ai, m) * SSM_W + col; f32x4 z0, z1; unpack8(*(const u32x4*)(z + off), z0, z1);
                    *(u32x4*)(ys + off) = pack8f(z0 * sig4(acc[ai][bj][m][0] + b0), z1 * sig4(acc[ai][bj][m][1] + b1)); } }
    }
};
struct EpiGate {
    static constexpr bool PERM = true;
    const bf16_t* gate; const bf16_t* addend; bf16_t* O;
    __device__ __forceinline__ void operator()(const AccT& acc, const Unit& u, int wr, int wc, int fr, int fq) const {
#pragma unroll
        for (int ai = 0; ai < 2; ++ai)
#pragma unroll
            for (int m = 0; m < 4; ++m)
#pragma unroll
                for (int bj = 0; bj < 2; ++bj) { const size_t off = (size_t)EPI_ROW(u, ai, m) * DM + u.pn * BM + EPI_CB(bj); f32x4 g0, g1; unpack8(*(const u32x4*)(gate + off), g0, g1);
                    f32x4 r0 = g0 * acc[ai][bj][m][0], r1 = g1 * acc[ai][bj][m][1];
                    if (addend) { f32x4 t0, t1; unpack8(*(const u32x4*)(addend + off), t0, t1); r0 += t0; r1 += t1; }
                    *(u32x4*)(O + off) = pack8f(r0, r1); }
    }
};
template <class TI, bool WF32>
struct EpiResid {
    static constexpr bool PERM = true;
    const TI* xi; float* xo; bf16_t* xb; float* ss;
    __device__ __forceinline__ void operator()(const AccT& acc, const Unit& u, int wr, int wc, int fr, int fq) const {
#pragma unroll
        for (int ai = 0; ai < 2; ++ai)
#pragma unroll
            for (int m = 0; m < 4; ++m) { const int row = EPI_ROW(u, ai, m); float s = 0.f;
#pragma unroll
                for (int bj = 0; bj < 2; ++bj) { const size_t off = (size_t)row * DM + u.pn * BM + EPI_CB(bj); f32x4 r0, r1;
                    if constexpr (sizeof(TI) == 4) { r0 = *(const f32x4*)((const float*)xi + off); r1 = *(const f32x4*)((const float*)xi + off + 4); }
                    else unpack8(*(const u32x4*)((const bf16_t*)xi + off), r0, r1);
                    r0 += acc[ai][bj][m][0]; r1 += acc[ai][bj][m][1];
                    if constexpr (WF32) { *(f32x4*)(xo + off) = r0; *(f32x4*)(xo + off + 4) = r1; }
                    s += sq4(r0) + sq4(r1);
                    if (xb) *(u32x4*)(xb + off) = pack8f(r0, r1); }
                s += __shfl_xor(s, 16); s += __shfl_xor(s, 32); if (fq == 0) ss[((size_t)u.pn * SEQ + row) * 4 + wc] = s; }
    }
};
struct EpiXq {
    static constexpr bool PERM = true;
    bf16_t* O; const float* ss;
    __device__ __forceinline__ void operator()(const AccT& acc, const Unit& u, int wr, int wc, int fr, int fq) const {
#pragma unroll
        for (int ai = 0; ai < 2; ++ai)
#pragma unroll
            for (int m = 0; m < 4; ++m) { const int row = EPI_ROW(u, ai, m); const float rs = row_rs32(ss, row, 1.0f / DM);
#pragma unroll
                for (int bj = 0; bj < 2; ++bj) *(u32x4*)(O + (size_t)row * XW + u.pn * BM + EPI_CB(bj)) = pack8f(acc[ai][bj][m][0] * rs, acc[ai][bj][m][1] * rs); }
    }
};
constexpr float F8_XS = 8.0f, F8_WS = 512.0f, F8_AS = 4.0f;
__device__ __forceinline__ unsigned pk4_fp8(float a, float b, float c, float d) {
    a = fminf(fmaxf(a, -448.f), 448.f); b = fminf(fmaxf(b, -448.f), 448.f); c = fminf(fmaxf(c, -448.f), 448.f); d = fminf(fmaxf(d, -448.f), 448.f);
    int w = __builtin_amdgcn_cvt_pk_fp8_f32(a, b, 0, false); w = __builtin_amdgcn_cvt_pk_fp8_f32(c, d, w, true); return (unsigned)w; }
struct EpiMoeGU {
    static constexpr bool PERM = true;
    const float* bias; unsigned char* act;
    __device__ __forceinline__ void operator()(const AccT& acc, const Unit& u, int wr, int wc, int fr, int fq) const {
        const int j0 = u.pn * HALF + wc * 32 + 8 * fq; const float* bg = bias + (size_t)u.e * (2 * DFF) + j0; constexpr float SC = 1.0f / (F8_XS * F8_WS);
        const f32x4 g0 = *(const f32x4*)bg, g1 = *(const f32x4*)(bg + 4), u0 = *(const f32x4*)(bg + DFF), u1 = *(const f32x4*)(bg + DFF + 4);
#pragma unroll
        for (int ai = 0; ai < 2; ++ai)
#pragma unroll
            for (int m = 0; m < 4; ++m) { const int row = EPI_ROW(u, ai, m); f32x4 r[2];
#pragma unroll
                for (int n = 0; n < 2; ++n) { const f32x4 gt = acc[ai][0][m][n] * SC + (n ? g1 : g0), up = acc[ai][1][m][n] * SC + (n ? u1 : u0);
#pragma unroll
                    for (int j = 0; j < 4; ++j) { const float gc = fminf(gt[j], 7.0f), uc = fminf(fmaxf(up[j], -7.0f), 7.0f); r[n][j] = F8_AS * (uc + 1.0f) * (gc * fsigmoid(1.702f * gc)); } }
                u32x2 o = {pk4_fp8(r[0][0], r[0][1], r[0][2], r[0][3]), pk4_fp8(r[1][0], r[1][1], r[1][2], r[1][3])};
                *(u32x2*)(act + (size_t)row * DFF + j0) = o; }
    }
};
struct EpiMoeDown {
    static constexpr bool PERM = true;
    const float* bias; bf16_t* O;
    __device__ __forceinline__ void operator()(const AccT& acc, const Unit& u, int wr, int wc, int fr, int fq) const {
#pragma unroll
        for (int bj = 0; bj < 2; ++bj) { const int col = u.pn * BM + EPI_CB(bj); const float* bp = bias + (size_t)u.e * DM + col; const f32x4 b0 = *(const f32x4*)bp, b1 = *(const f32x4*)(bp + 4); constexpr float SC = 1.0f / (F8_AS * F8_WS);
#pragma unroll
            for (int ai = 0; ai < 2; ++ai)
#pragma unroll
                for (int m = 0; m < 4; ++m) *(u32x4*)(O + (size_t)EPI_ROW(u, ai, m) * DM + col) = pack8f(acc[ai][bj][m][0] * SC + b0, acc[ai][bj][m][1] * SC + b1); }
    }
};
#undef EPI_ROW
#undef EPI_CB
}
namespace att {
constexpr int NW = 8, QBLK = 32, KVBLK = 64, QB = NW * QBLK;
constexpr int SHM_V = KVBLK * 128 * 2, SHM_K = KVBLK * 128 * 2, SHM_KR = KVBLK * 64 * 2;
constexpr int OFF_V = 0, OFF_K = 2 * SHM_V, OFF_KR = OFF_K + 2 * SHM_K, OFF_WS = OFF_KR + 2 * SHM_KR, OFF_QR = OFF_WS + NW * 64 * 4, LDS_BYTES = OFF_QR + NW * 8192;
constexpr float THR = 8.f;
#define KSWZ(row, colB) ((row) * 256 + ((colB) ^ (((row) & 7) << 4)))
__device__ __forceinline__ int v_st(int k, int c) { const int kk = (k & ~0xC) | ((k & 4) << 1) | ((k & 8) >> 1); return ((kk >> 3) * 4 + (c >> 5)) * 512 + ((kk & 7) * 32 + (c & 31)) * 2; }
__device__ __forceinline__ int v_rd_base(int lane) { return ((lane & 3) << 3) | (((lane >> 2) & 3) << 6) | (((lane >> 4) & 1) << 5) | (((lane >> 5) & 1) << 8); }
constexpr int v_rd_off(int d0, int ks, int half) { return d0 * 512 + ks * 4096 + half * 2048; }
__device__ __forceinline__ int crow(int r, int hi) { return (r & 3) + 8 * (r >> 2) + 4 * hi; }

__device__ __forceinline__ void mask_tile(f32x16& p0, f32x16& p1, int dq) {
    const float NEG = -__builtin_inff();
#pragma unroll
    for (int r = 0; r < 16; ++r) {
        const int c = (r & 3) + 8 * (r >> 2);
        if (dq - c < 0) p0[r] = NEG;
        if (dq - c - 32 < 0) p1[r] = NEG;
    }
}
template <bool ROPE>
__device__ __forceinline__ void partialSM(f32x16& p0, f32x16& p1, float& m_reg, float& mn, float& alpha) {
    constexpr float SCALE = ROPE ? 0.07216878364870323f : 0.08838834764831845f;
    float pmax = p0[0];
#pragma unroll
    for (int r = 1; r < 16; ++r) pmax = fmaxf(pmax, p0[r]);
#pragma unroll
    for (int r = 0; r < 16; ++r) pmax = fmaxf(pmax, p1[r]);
    { auto rr = __builtin_amdgcn_permlane32_swap(__float_as_uint(pmax), __float_as_uint(pmax), false, false);
      pmax = fmaxf(__uint_as_float(rr[0]), __uint_as_float(rr[1])); }
    constexpr float C2 = 1.4426950408889634f * SCALE;
    if (__builtin_expect(__all((pmax - m_reg) * SCALE <= THR), 1)) { mn = m_reg; alpha = 1.f; }
    else { mn = fmaxf(m_reg, pmax); alpha = __builtin_amdgcn_exp2f((m_reg - mn) * C2); m_reg = mn; }
    const float mnL = -mn * C2;
#pragma unroll
    for (int r = 0; r < 16; ++r) p0[r] = fmaf(p0[r], C2, mnL);
#pragma unroll
    for (int r = 0; r < 16; ++r) p1[r] = fmaf(p1[r], C2, mnL);
#pragma unroll
    for (int r = 0; r < 16; ++r) p0[r] = __builtin_amdgcn_exp2f(p0[r]);
}
__device__ __forceinline__ void finishSM(f32x16& p0, f32x16& p1, float alpha, float& l_reg, bf16x8& pa0, bf16x8& pa1, bf16x8& pa2, bf16x8& pa3) {
#pragma unroll
    for (int r = 0; r < 16; ++r) p1[r] = __builtin_amdgcn_exp2f(p1[r]);
    float ps = 0;
#pragma unroll
    for (int r = 0; r < 16; ++r) ps += p0[r];
#pragma unroll
    for (int r = 0; r < 16; ++r) ps += p1[r];
    { auto rr = __builtin_amdgcn_permlane32_swap(__float_as_uint(ps), __float_as_uint(ps), false, false);
      ps = __uint_as_float(rr[0]) + __uint_as_float(rr[1]); }
    l_reg = l_reg * alpha + ps;
#define PK4(P, B_, OUT) do { unsigned a0 = cvtpk(P[B_+0], P[B_+1]), a1 = cvtpk(P[B_+2], P[B_+3]);                          \
        unsigned b0 = cvtpk(P[B_+4], P[B_+5]), b1 = cvtpk(P[B_+6], P[B_+7]);                                             \
        auto r0 = __builtin_amdgcn_permlane32_swap(a0, b0, false, false); auto r1 = __builtin_amdgcn_permlane32_swap(a1, b1, false, false); \
        u32x4 w = {r0[0], r1[0], r0[1], r1[1]}; OUT = *reinterpret_cast<bf16x8*>(&w); } while (0)
    PK4(p0, 0, pa0); PK4(p0, 8, pa1); PK4(p1, 0, pa2); PK4(p1, 8, pa3);
#undef PK4
}
template <int KB, bool ROPE>
__device__ __forceinline__ void qkt(f32x16& p0, f32x16& p1, const char* K_lds, int r32, int hi, const bf16x8* qr, const char* qrl) {
    p0 = f32x16{}; p1 = f32x16{};
    const char* kb[4];
#pragma unroll
    for (int dd = 0; dd < 4; ++dd) kb[dd] = K_lds + KB * SHM_K + KSWZ(r32, (dd * 16 + hi * 8) * 2);
#pragma unroll
    for (int d0 = 0; d0 < 8; ++d0) { const char* a = kb[d0 & 3] + (d0 >> 2) * 128;
        bf16x8 b0 = *reinterpret_cast<const bf16x8*>(a);
        bf16x8 b1 = *reinterpret_cast<const bf16x8*>(a + 32 * 256);
        p0 = __builtin_amdgcn_mfma_f32_32x32x16_bf16(b0, qr[d0], p0, 0, 0, 0);
        p1 = __builtin_amdgcn_mfma_f32_32x32x16_bf16(b1, qr[d0], p1, 0, 0, 0); }
    if constexpr (ROPE) {
        constexpr int RO = 2 * SHM_K - KB * SHM_K + KB * SHM_KR;
#pragma unroll
        for (int d0 = 0; d0 < 4; ++d0) { const char* a = kb[d0] + RO;
            bf16x8 b0 = *reinterpret_cast<const bf16x8*>(a);
            bf16x8 b1 = *reinterpret_cast<const bf16x8*>(a + 128);
            const bf16x8 q = *reinterpret_cast<const bf16x8*>(qrl + d0 * 1024);
            p0 = __builtin_amdgcn_mfma_f32_32x32x16_bf16(b0, q, p0, 0, 0, 0);
            p1 = __builtin_amdgcn_mfma_f32_32x32x16_bf16(b1, q, p1, 0, 0, 0); }
    }
}
template <int VB>
__device__ __forceinline__ void pv_tile(f32x16* o, int vb0, bf16x8 pa0, bf16x8 pa1, bf16x8 pa2, bf16x8 pa3) {
#define TRRD(dst, off) asm volatile("ds_read_b64_tr_b16 %0, %1 offset:%2" : "=&v"(dst) : "v"(vb0), "i"(off) : "memory")
#define PV_D0(d0) do { s16x4 l0, l1, l2, l3, h0, h1, h2, h3; constexpr int b_ = VB * SHM_V + v_rd_off(d0, 0, 0);  \
        TRRD(l0, b_); TRRD(h0, b_ + 2048); TRRD(l1, b_ + 4096); TRRD(h1, b_ + 6144); TRRD(l2, b_ + 8192); TRRD(h2, b_ + 10240); TRRD(l3, b_ + 12288); TRRD(h3, b_ + 14336); \
        asm volatile("s_waitcnt lgkmcnt(0)" ::: "memory"); SBAR();   \
        o[d0] = __builtin_amdgcn_mfma_f32_32x32x16_bf16(pa0, (bf16x8){l0[0], l0[1], l0[2], l0[3], h0[0], h0[1], h0[2], h0[3]}, o[d0], 0, 0, 0);   \
        o[d0] = __builtin_amdgcn_mfma_f32_32x32x16_bf16(pa1, (bf16x8){l1[0], l1[1], l1[2], l1[3], h1[0], h1[1], h1[2], h1[3]}, o[d0], 0, 0, 0);   \
        o[d0] = __builtin_amdgcn_mfma_f32_32x32x16_bf16(pa2, (bf16x8){l2[0], l2[1], l2[2], l2[3], h2[0], h2[1], h2[2], h2[3]}, o[d0], 0, 0, 0);   \
        o[d0] = __builtin_amdgcn_mfma_f32_32x32x16_bf16(pa3, (bf16x8){l3[0], l3[1], l3[2], l3[3], h3[0], h3[1], h3[2], h3[3]}, o[d0], 0, 0, 0); } while (0)
    PV_D0(0); PV_D0(1); PV_D0(2); PV_D0(3);
#undef PV_D0
#undef TRRD
}

struct BlockRef { const bf16_t* Q; const bf16_t* QR; const bf16_t* K; const bf16_t* KR; const bf16_t* V; bf16_t* O; int P0; };
struct Strides { int qs, qrs, ks, vs, os, skv; };
template <bool ROPE> struct Seam { bf16x8 qr[ROPE ? 12 : 8];     bf16x8 st_v0, st_v1, st_k0, st_k1, st_kr; };
#define LD8(p) (*reinterpret_cast<const bf16x8*>(p))
#define VMW() asm volatile("s_waitcnt vmcnt(0)" ::: "memory")
#define VMWN(n) asm volatile("s_waitcnt vmcnt(%0)" :: "i"(n) : "memory")
#define SLOAD_H(R, k0) do { const char* vb_ = (const char*)(R).V + (size_t)(k0) * T.vs * 2; const char* kb_ = (const char*)(R).K + (size_t)(k0) * T.ks * 2;   \
                            S.st_v0 = LD8(vb_ + vo_v); S.st_v1 = LD8(vb_ + (size_t)T.vs * 64 + vo_v);              \
                            S.st_k0 = LD8(kb_ + vo_k); S.st_k1 = LD8(kb_ + (size_t)T.ks * 64 + vo_k);              \
                            if constexpr (ROPE) S.st_kr = LD8((const char*)(R).KR + (size_t)(k0) * (DROPE * 2) + vo_kr); } while (0)
#define SWRITE_HK(bf) do { *(bf16x8*)(K_lds + (bf) * SHM_K + kws) = S.st_k0; *(bf16x8*)(K_lds + (bf) * SHM_K + kws + 32 * 256) = S.st_k1;                \
                           if constexpr (ROPE) *(bf16x8*)(K_lds + 2 * SHM_K + (bf) * SHM_KR + krws) = S.st_kr; } while (0)
#define SWRITE_HV(bf) do { *(bf16x8*)(V_lds + (bf) * SHM_V + vst0) = S.st_v0; *(bf16x8*)(V_lds + (bf) * SHM_V + vst1) = S.st_v1; } while (0)
#define SWRITE_H(bf) do { SWRITE_HV(bf); SWRITE_HK(bf); } while (0)
#define QLOAD(R) do { const char* qb_ = (const char*)(R).Q + (size_t)(wid * QBLK) * T.qs * 2; const unsigned qo_ = (unsigned)(r32 * T.qs + hi * 8) * 2u;    \
                      _Pragma("unroll") for (int d0 = 0; d0 < 8; ++d0) S.qr[d0] = LD8(qb_ + qo_ + d0 * 32);    \
                      if constexpr (ROPE) { const char* qrb_ = (const char*)(R).QR + (size_t)(wid * QBLK) * T.qrs * 2; const unsigned qro_ = (unsigned)(r32 * T.qrs + hi * 8) * 2u;   \
                          _Pragma("unroll") for (int d0 = 0; d0 < 4; ++d0) S.qr[8 + d0] = LD8(qrb_ + qro_ + d0 * 32); } } while (0)
#define QPARK() do { if constexpr (ROPE) { _Pragma("unroll") for (int d0 = 0; d0 < 4; ++d0) *(bf16x8*)(qrl + d0 * 1024) = S.qr[8 + d0]; } } while (0)
#define QPARK8() do { _Pragma("unroll") for (int d0 = 0; d0 < (ROPE ? 8 : 4); ++d0) *(bf16x8*)(qrl + d0 * 1024) = S.qr[4 + d0]; } while (0)
#define STAGE_IDX() const int sr = tid >> 4, sc = (tid & 15) * 8, kws = KSWZ(sr, sc * 2); \
                    const int rk = tid >> 3, rc = tid & 7, krws = (rk & 31) * 256 + ((((rk >> 5) * 8 + rc) * 16) ^ (((rk & 31) & 7) << 4)); \
                    const unsigned vo_v = (unsigned)(sr * T.vs + sc) * 2u, vo_k = (unsigned)(sr * T.ks + sc) * 2u, vo_kr = (unsigned)(rk * DROPE + rc * 8) * 2u

template <bool ROPE, bool CAUSAL>
__device__ __forceinline__ void attn_prime(const BlockRef& cur, const Strides& T, char* lds, Seam<ROPE>& S) {
    const int tid = threadIdx.x, wid = __builtin_amdgcn_readfirstlane(tid >> 6), lane = tid & 63, r32 = lane & 31, hi = lane >> 5;
    STAGE_IDX(); char* K_lds = lds + OFF_K; char* qrl = lds + OFF_QR + wid * 4096 + lane * 16;
    QLOAD(cur);
    SLOAD_H(cur, 0); VMW(); SWRITE_HK(0); QPARK();
    __syncthreads();
}
template <bool ROPE, bool CAUSAL>
__device__ __forceinline__ void attn_block(const BlockRef& cur, const BlockRef& nxt, const Strides& T, char* lds, Seam<ROPE>& S) {
    const int tid = threadIdx.x, wid = __builtin_amdgcn_readfirstlane(tid >> 6), lane = tid & 63, r32 = lane & 31, hi = lane >> 5;
    int j_hi = CAUSAL ? (cur.P0 + QB - 1) / KVBLK + 1 : T.skv / KVBLK; if (j_hi > T.skv / KVBLK) j_hi = T.skv / KVBLK;
    const int NT = j_hi;
    const int qlo = cur.P0 + wid * QBLK, qm = qlo + r32 - 4 * hi;
    char* V_lds = lds + OFF_V; char* K_lds = lds + OFF_K; char* qrl = lds + OFF_QR + wid * 4096 + lane * 16;
    float* ws = (float*)(lds + OFF_WS) + wid * 64; float* li_l = ws, * al_l = ws + 32;
    float m_reg = -1e30f, l_reg = 0; f32x16 o[4] = {};
    STAGE_IDX(); const int vst0 = v_st(sr, sc), vst1 = v_st(32 + sr, sc);
    const int vb0 = (int)(uintptr_t)V_lds + v_rd_base(lane);
#define RESC(a) do { if (__any((a) < 1.f)) { if (hi == 0) al_l[r32] = (a); asm volatile("s_waitcnt lgkmcnt(0)" ::: "memory");              \
                     for (int d_ = 0; d_ < 4; ++d_) for (int r = 0; r < 16; ++r) o[d_][r] *= al_l[crow(r, hi)]; } } while (0)
#define KBASE(t) ((t) * KVBLK)
#define MASKT(P0_, P1_, t) do { if constexpr (CAUSAL) { const int kb_ = KBASE(t); if (kb_ + KVBLK - 1 > qlo) mask_tile(P0_, P1_, qm - kb_); } } while (0)
    constexpr int NQL = ROPE ? 12 : 8;
#define SEAM_K0() do { VMWN(NQL); SWRITE_HK(0); SBAR(); } while (0)
    f32x16 pA0, pA1, pB0, pB1; float mnA, mnB, alA, alB; bf16x8 pa0, pa1, pa2, pa3;
    SWRITE_HV(0); SBAR();
    if (NT > 1) { SLOAD_H(cur, KBASE(1)); }
    SBAR(); qkt<0, ROPE>(pA0, pA1, K_lds, r32, hi, S.qr, qrl);
    MASKT(pA0, pA1, 0); partialSM<ROPE>(pA0, pA1, m_reg, mnA, alA);
    if (NT > 1) { VMW(); SWRITE_H(1); }
    __syncthreads();
#define HALF_STEP(PX0, PX1, mnX, alX, PY0, PY1, alY, t, KB, VB, SB) do {                                                      \
        SBAR(); qkt<KB, ROPE>(PX0, PX1, K_lds, r32, hi, S.qr, qrl);                                                                \
        finishSM(PY0, PY1, alY, l_reg, pa0, pa1, pa2, pa3); SBAR();                                                           \
        if ((t) + 1 < NT) { SLOAD_H(cur, KBASE((t) + 1)); SBAR(); }                                                           \
        pv_tile<VB>(o, vb0, pa0, pa1, pa2, pa3); MASKT(PX0, PX1, (t)); partialSM<ROPE>(PX0, PX1, m_reg, mnX, alX);            \
        __syncthreads();                                                                                                      \
        if ((t) + 1 < NT) { VMW(); SWRITE_H(SB); }                                                                            \
        RESC(alX); __syncthreads(); } while (0)
    for (int t = 1; t + 1 < NT; t += 2) {
        HALF_STEP(pB0, pB1, mnB, alB, pA0, pA1, alA, t, 1, 0, 0);
        HALF_STEP(pA0, pA1, mnA, alA, pB0, pB1, alB, t + 1, 0, 1, 1);
    }
    const bool even = (NT & 1) == 0;
    if (even) { SBAR(); qkt<1, ROPE>(pB0, pB1, K_lds, r32, hi, S.qr, qrl); SBAR(); }
    SLOAD_H(nxt, 0); SBAR();
    QLOAD(nxt);
    SBAR();
    finishSM(pA0, pA1, alA, l_reg, pa0, pa1, pa2, pa3); SBAR();
    pv_tile<0>(o, vb0, pa0, pa1, pa2, pa3);
    if (even) { MASKT(pB0, pB1, NT - 1); partialSM<ROPE>(pB0, pB1, m_reg, mnB, alB); __syncthreads(); RESC(alB);
        finishSM(pB0, pB1, alB, l_reg, pa0, pa1, pa2, pa3); SBAR(); pv_tile<1>(o, vb0, pa0, pa1, pa2, pa3); }
    SBAR(); SEAM_K0();
    if (hi == 0) li_l[r32] = l_reg; asm volatile("s_waitcnt lgkmcnt(0)" ::: "memory");
    float rli[16];
#pragma unroll
    for (int r = 0; r < 16; ++r) rli[r] = __builtin_amdgcn_rcpf(li_l[crow(r, hi)]);
    bf16_t* Ow = cur.O + (size_t)(wid * QBLK) * T.os;
#pragma unroll
    for (int r = 0; r < 16; ++r) { const int orow = crow(r, hi);
#pragma unroll
        for (int d0 = 0; d0 < 4; ++d0) { const float v = o[d0][r] * rli[r];
            const float vn = __shfl_xor(v, 1);
            if ((r32 & 1) == 0) *(unsigned*)(Ow + (size_t)orow * T.os + d0 * 32 + r32) = cvtpk(v, vn); } }
    QPARK();
    __syncthreads();
#undef RESC
#undef KBASE
#undef MASKT
#undef SEAM_K0
#undef HALF_STEP
}

template <bool ROPE>
__device__ __forceinline__ void qkt_rt(f32x16& p0, f32x16& p1, const char* K_lds, int buf, const int (&koff)[4], const bf16x8* qr, const char* qrl) {
    p0 = f32x16{}; p1 = f32x16{};
    const char* kbase = K_lds + buf * SHM_K;
#pragma unroll
    for (int d0 = 0; d0 < 8; ++d0) { const char* a = kbase + koff[d0 & 3] + (d0 >> 2) * 128;
        bf16x8 b0 = *reinterpret_cast<const bf16x8*>(a);
        bf16x8 b1 = *reinterpret_cast<const bf16x8*>(a + 32 * 256);
        p0 = __builtin_amdgcn_mfma_f32_32x32x16_bf16(b0, qr[d0], p0, 0, 0, 0);
        p1 = __builtin_amdgcn_mfma_f32_32x32x16_bf16(b1, qr[d0], p1, 0, 0, 0); }
    if constexpr (ROPE) {
        const char* rbase = K_lds + 2 * SHM_K + buf * SHM_KR;
#pragma unroll
        for (int d0 = 0; d0 < 4; ++d0) { const char* a = rbase + koff[d0];
            bf16x8 b0 = *reinterpret_cast<const bf16x8*>(a);
            bf16x8 b1 = *reinterpret_cast<const bf16x8*>(a + 128);
            const bf16x8 q = *reinterpret_cast<const bf16x8*>(qrl + d0 * 1024);
            p0 = __builtin_amdgcn_mfma_f32_32x32x16_bf16(b0, q, p0, 0, 0, 0);
            p1 = __builtin_amdgcn_mfma_f32_32x32x16_bf16(b1, q, p1, 0, 0, 0); }
    }
}
template <bool ROPE, bool CAUSAL>
__device__ __forceinline__ void attn_block_simple(const BlockRef& cur, const Strides& T, char* lds) {
    const int tid = threadIdx.x, wid = __builtin_amdgcn_readfirstlane(tid >> 6), lane = tid & 63, r32 = lane & 31, hi = lane >> 5;
    int j_hi = CAUSAL ? (cur.P0 + QB - 1) / KVBLK + 1 : T.skv / KVBLK; if (j_hi > T.skv / KVBLK) j_hi = T.skv / KVBLK;
    const int NT = j_hi;
    const int qlo = cur.P0 + wid * QBLK, qm = qlo + r32 - 4 * hi;
    char* V_lds = lds + OFF_V; char* K_lds = lds + OFF_K;
    float* ws = (float*)(lds + OFF_WS) + wid * 64; float* li_l = ws, * al_l = ws + 32;
    float m_reg = -1e30f, l_reg = 0; f32x16 o[4] = {};
    STAGE_IDX(); const int vst0 = v_st(sr, sc), vst1 = v_st(32 + sr, sc);
    const int vb0 = (int)(uintptr_t)V_lds + v_rd_base(lane);
    int koff[4];
#pragma unroll
    for (int dd = 0; dd < 4; ++dd) koff[dd] = KSWZ(r32, (dd * 16 + hi * 8) * 2);
    Seam<ROPE> S; char* qrl = lds + OFF_QR + wid * 4096 + lane * 16;
    QLOAD(cur);
    SLOAD_H(cur, 0); VMW(); SWRITE_H(0); QPARK();
    __syncthreads();
    for (int t = 0; t < NT; ++t) {
        const int buf = t & 1;
        if (t + 1 < NT) { SLOAD_H(cur, (t + 1) * KVBLK); }
        SBAR();
        f32x16 p0, p1; qkt_rt<ROPE>(p0, p1, K_lds, buf, koff, S.qr, qrl);
        if constexpr (CAUSAL) { const int kb_ = t * KVBLK; if (kb_ + KVBLK - 1 > qlo) mask_tile(p0, p1, qm - kb_); }
        float mn, al; partialSM<ROPE>(p0, p1, m_reg, mn, al);
        if (__any(al < 1.f)) { if (hi == 0) al_l[r32] = al; asm volatile("s_waitcnt lgkmcnt(0)" ::: "memory");
            for (int d_ = 0; d_ < 4; ++d_) for (int r = 0; r < 16; ++r) o[d_][r] *= al_l[crow(r, hi)]; }
        bf16x8 pa0, pa1, pa2, pa3; finishSM(p0, p1, al, l_reg, pa0, pa1, pa2, pa3); SBAR();
        pv_tile<0>(o, vb0 + buf * SHM_V, pa0, pa1, pa2, pa3);
        if (t + 1 < NT) { VMW(); SWRITE_H(buf ^ 1); }
        __syncthreads();
    }
    if (hi == 0) li_l[r32] = l_reg; asm volatile("s_waitcnt lgkmcnt(0)" ::: "memory");
    float rli[16];
#pragma unroll
    for (int r = 0; r < 16; ++r) rli[r] = __builtin_amdgcn_rcpf(li_l[crow(r, hi)]);
    bf16_t* Ow = cur.O + (size_t)(wid * QBLK) * T.os;
#pragma unroll
    for (int r = 0; r < 16; ++r) { const int orow = crow(r, hi);
#pragma unroll
        for (int d0 = 0; d0 < 4; ++d0) { const float v = o[d0][r] * rli[r];
            const float vn = __shfl_xor(v, 1);
            if ((r32 & 1) == 0) *(unsigned*)(Ow + (size_t)orow * T.os + d0 * 32 + r32) = cvtpk(v, vn); } }
    __syncthreads();
}


template <bool ROPE>
__device__ __forceinline__ void qkt_rt8(f32x16& p0, f32x16& p1, const char* K_lds, int buf, const int (&koff)[4], const bf16x8* qr, const char* qrl) {
    p0 = f32x16{}; p1 = f32x16{};
    const char* kbase = K_lds + buf * SHM_K;
#pragma unroll
    for (int d0 = 0; d0 < 8; ++d0) { const char* a = kbase + koff[d0 & 3] + (d0 >> 2) * 128;
        bf16x8 b0 = *reinterpret_cast<const bf16x8*>(a);
        bf16x8 b1 = *reinterpret_cast<const bf16x8*>(a + 32 * 256);
        const bf16x8 q = d0 < 4 ? qr[d0] : *reinterpret_cast<const bf16x8*>(qrl + (d0 - 4) * 1024);
        p0 = __builtin_amdgcn_mfma_f32_32x32x16_bf16(b0, q, p0, 0, 0, 0);
        p1 = __builtin_amdgcn_mfma_f32_32x32x16_bf16(b1, q, p1, 0, 0, 0); }
    if constexpr (ROPE) {
        const char* rbase = K_lds + 2 * SHM_K + buf * SHM_KR;
#pragma unroll
        for (int d0 = 0; d0 < 4; ++d0) { const char* a = rbase + koff[d0];
            bf16x8 b0 = *reinterpret_cast<const bf16x8*>(a);
            bf16x8 b1 = *reinterpret_cast<const bf16x8*>(a + 128);
            const bf16x8 q = *reinterpret_cast<const bf16x8*>(qrl + (4 + d0) * 1024);
            p0 = __builtin_amdgcn_mfma_f32_32x32x16_bf16(b0, q, p0, 0, 0, 0);
            p1 = __builtin_amdgcn_mfma_f32_32x32x16_bf16(b1, q, p1, 0, 0, 0); }
    }
}
template <bool ROPE, bool CAUSAL>
__device__ __forceinline__ void attn_block_ap(const BlockRef& cur, const Strides& T, char* lds) {
    const int tid = threadIdx.x, wid = __builtin_amdgcn_readfirstlane(tid >> 6), lane = tid & 63, r32 = lane & 31, hi = lane >> 5, grp = wid >> 2;
    int j_hi = CAUSAL ? (cur.P0 + QB - 1) / KVBLK + 1 : T.skv / KVBLK; if (j_hi > T.skv / KVBLK) j_hi = T.skv / KVBLK;
    const int NT = j_hi;
    const int qlo = cur.P0 + wid * QBLK, qm = qlo + r32 - 4 * hi;
    char* V_lds = lds + OFF_V; char* K_lds = lds + OFF_K;
    float* ws = (float*)(lds + OFF_WS) + wid * 64; float* li_l = ws, * al_l = ws + 32;
    float m_reg = -1e30f, l_reg = 0; f32x16 o[4] = {};
    STAGE_IDX(); const int vst0 = v_st(sr, sc), vst1 = v_st(32 + sr, sc);
    const int vb0 = (int)(uintptr_t)V_lds + v_rd_base(lane);
    int koff[4];
#pragma unroll
    for (int dd = 0; dd < 4; ++dd) koff[dd] = KSWZ(r32, (dd * 16 + hi * 8) * 2);
    Seam<ROPE> S; char* qrl = lds + OFF_QR + wid * 8192 + lane * 16;
    const int dr0 = lane >> 4, dr1 = 4 + (lane >> 4);
    const unsigned kdo0 = (unsigned)((wid * 8 + dr0) * T.ks * 2 + (((lane & 15) ^ dr0) << 4)), kdo1 = (unsigned)((wid * 8 + dr1) * T.ks * 2 + (((lane & 15) ^ dr1) << 4));
    const int kline = 4 * wid + (lane >> 4), kcs = (lane & 15) ^ (kline & 7);
    const unsigned krdo = (unsigned)((kline + 32 * (kcs >> 3)) * (DROPE * 2) + ((kcs & 7) << 4));
    const unsigned klds0 = (unsigned)(uintptr_t)K_lds + wid * 2048, krlds0 = (unsigned)(uintptr_t)K_lds + 2 * SHM_K + wid * 1024;
    QLOAD(cur);
    { const char* kb_ = (const char*)cur.K; S.st_k0 = LD8(kb_ + vo_k); S.st_k1 = LD8(kb_ + (size_t)T.ks * 64 + vo_k); if constexpr (ROPE) S.st_kr = LD8((const char*)cur.KR + vo_kr); }
    VMW(); SWRITE_HK(0); QPARK8();
    __syncthreads();
    f32x16 p0, p1; float mn, al; bf16x8 pa0, pa1, pa2, pa3;
#define AP_BAR() do { asm volatile("s_waitcnt lgkmcnt(0)" ::: "memory"); __builtin_amdgcn_s_barrier(); asm volatile("" ::: "memory"); } while (0)
#define AP_ISSUE(t) do { const char* vb_ = (const char*)cur.V + (size_t)((t) * KVBLK) * T.vs * 2; S.st_v0 = LD8(vb_ + vo_v); S.st_v1 = LD8(vb_ + (size_t)T.vs * 64 + vo_v);        \
        if ((t) + 1 < NT) { const char* kb_ = (const char*)cur.K + (size_t)(((t) + 1) * KVBLK) * T.ks * 2; const unsigned kl_ = klds0 + (((t) + 1) & 1) * SHM_K;                   \
            __builtin_amdgcn_global_load_lds((const unsigned*)(kb_ + kdo0), (LAS unsigned*)(uintptr_t)(kl_), 16, 0, 0);                                                              \
            __builtin_amdgcn_global_load_lds((const unsigned*)(kb_ + kdo1), (LAS unsigned*)(uintptr_t)(kl_ + 1024), 16, 0, 0);                                                       \
            if constexpr (ROPE) __builtin_amdgcn_global_load_lds((const unsigned*)((const char*)cur.KR + (size_t)(((t) + 1) * KVBLK) * (DROPE * 2) + krdo),                          \
                                                                 (LAS unsigned*)(uintptr_t)(krlds0 + (((t) + 1) & 1) * SHM_KR), 16, 0, 0); } SBAR(); } while (0)
#define AP_WRITE(t) do { SBAR(); VMW(); SWRITE_HV((t) & 1); } while (0)
#define AP_QK(t) do { qkt_rt8<ROPE>(p0, p1, K_lds, (t) & 1, koff, S.qr, qrl);                                                      \
        if constexpr (CAUSAL) { const int kb_ = (t) * KVBLK; if (kb_ + KVBLK - 1 > qlo) mask_tile(p0, p1, qm - kb_); } } while (0)
#define AP_SM() do { partialSM<ROPE>(p0, p1, m_reg, mn, al);                                                                      \
        if (__any(al < 1.f)) { if (hi == 0) al_l[r32] = al; asm volatile("s_waitcnt lgkmcnt(0)" ::: "memory");                    \
            for (int d_ = 0; d_ < 4; ++d_) for (int r = 0; r < 16; ++r) o[d_][r] *= al_l[crow(r, hi)]; }                          \
        finishSM(p0, p1, al, l_reg, pa0, pa1, pa2, pa3); } while (0)
#define AP_PV(t) pv_tile<0>(o, vb0 + ((t) & 1) * SHM_V, pa0, pa1, pa2, pa3)
    if (grp == 0) {
        AP_ISSUE(0); AP_QK(0); AP_BAR();
        AP_SM(); AP_WRITE(0); AP_BAR();
        for (int t = 1; t < NT; ++t) {
            AP_ISSUE(t); AP_PV(t - 1); AP_QK(t); AP_BAR();
            AP_SM(); AP_WRITE(t); AP_BAR();
        }
        AP_PV(NT - 1); AP_BAR();
        AP_BAR();
    } else {
        AP_ISSUE(0); AP_BAR();
        AP_QK(0); AP_WRITE(0); AP_BAR();
        for (int t = 1; t < NT; ++t) {
            AP_ISSUE(t); AP_SM(); AP_BAR();
            AP_PV(t - 1); AP_QK(t); AP_WRITE(t); AP_BAR();
        }
        AP_SM(); AP_BAR();
        AP_PV(NT - 1); AP_BAR();
    }
#undef AP_ISSUE
#undef AP_WRITE
#undef AP_BAR
#undef AP_QK
#undef AP_SM
#undef AP_PV
    if (hi == 0) li_l[r32] = l_reg; asm volatile("s_waitcnt lgkmcnt(0)" ::: "memory");
    float rli[16];
#pragma unroll
    for (int r = 0; r < 16; ++r) rli[r] = __builtin_amdgcn_rcpf(li_l[crow(r, hi)]);
    bf16_t* Ow = cur.O + (size_t)(wid * QBLK) * T.os;
#pragma unroll
    for (int r = 0; r < 16; ++r) { const int orow = crow(r, hi);
#pragma unroll
        for (int d0 = 0; d0 < 4; ++d0) { const float v = o[d0][r] * rli[r];
            const float vn = __shfl_xor(v, 1);
            if ((r32 & 1) == 0) *(unsigned*)(Ow + (size_t)orow * T.os + d0 * 32 + r32) = cvtpk(v, vn); } }
    __syncthreads();
}

template <bool ROPE, bool CAUSAL>
__device__ __forceinline__ void attn_block_dma(const BlockRef& cur, const Strides& T, char* lds) {
    const int tid = threadIdx.x, wid = __builtin_amdgcn_readfirstlane(tid >> 6), lane = tid & 63, r32 = lane & 31, hi = lane >> 5;
    int j_hi = CAUSAL ? (cur.P0 + QB - 1) / KVBLK + 1 : T.skv / KVBLK; if (j_hi > T.skv / KVBLK) j_hi = T.skv / KVBLK;
    const int NT = j_hi;
    const int qlo = cur.P0 + wid * QBLK, qm = qlo + r32 - 4 * hi;
    char* V_lds = lds + OFF_V; char* K_lds = lds + OFF_K;
    float* ws = (float*)(lds + OFF_WS) + wid * 64; float* li_l = ws, * al_l = ws + 32;
    float m_reg = -1e30f, l_reg = 0; f32x16 o[4] = {};
    const int vb0 = (int)(uintptr_t)V_lds + v_rd_base(lane);
    int koff[4];
#pragma unroll
    for (int dd = 0; dd < 4; ++dd) koff[dd] = KSWZ(r32, (dd * 16 + hi * 8) * 2);
    const int dr0 = lane >> 4, dr1 = 4 + (lane >> 4);
    const unsigned kdo0 = (unsigned)((wid * 8 + dr0) * T.ks * 2 + (((lane & 15) ^ dr0) << 4)), kdo1 = (unsigned)((wid * 8 + dr1) * T.ks * 2 + (((lane & 15) ^ dr1) << 4));
    const int kline = 4 * wid + (lane >> 4), kcs = (lane & 15) ^ (kline & 7);
    const unsigned krdo = (unsigned)((kline + 32 * (kcs >> 3)) * (DROPE * 2) + ((kcs & 7) << 4));
    const int vkk = 8 * wid + ((lane >> 2) & 7), vk = (vkk & ~0xC) | ((vkk & 4) << 1) | ((vkk & 8) >> 1);
    const unsigned vdo0 = (unsigned)(vk * T.vs * 2 + (((lane >> 5)) * 32 + (lane & 3) * 8) * 2), vdo1 = vdo0 + 128;
    const unsigned klds0 = (unsigned)(uintptr_t)K_lds + wid * 2048, krlds0 = (unsigned)(uintptr_t)K_lds + 2 * SHM_K + wid * 1024, vlds0 = (unsigned)(uintptr_t)V_lds + wid * 2048;
#define DMA_TILE(t, bf) do { const char* kb_ = (const char*)cur.K + (size_t)((t) * KVBLK) * T.ks * 2; const char* vb_ = (const char*)cur.V + (size_t)((t) * KVBLK) * T.vs * 2;       \
        __builtin_amdgcn_global_load_lds((const unsigned*)(kb_ + kdo0), (LAS unsigned*)(uintptr_t)(klds0 + (bf) * SHM_K), 16, 0, 0);                                       \
        __builtin_amdgcn_global_load_lds((const unsigned*)(kb_ + kdo1), (LAS unsigned*)(uintptr_t)(klds0 + (bf) * SHM_K + 1024), 16, 0, 0);                                \
        if constexpr (ROPE) __builtin_amdgcn_global_load_lds((const unsigned*)((const char*)cur.KR + (size_t)((t) * KVBLK) * (DROPE * 2) + krdo), (LAS unsigned*)(uintptr_t)(krlds0 + (bf) * SHM_KR), 16, 0, 0); \
        __builtin_amdgcn_global_load_lds((const unsigned*)(vb_ + vdo0), (LAS unsigned*)(uintptr_t)(vlds0 + (bf) * SHM_V), 16, 0, 0);                                       \
        __builtin_amdgcn_global_load_lds((const unsigned*)(vb_ + vdo1), (LAS unsigned*)(uintptr_t)(vlds0 + (bf) * SHM_V + 1024), 16, 0, 0); } while (0)
#define DMA_BAR() do { asm volatile("s_waitcnt vmcnt(0) lgkmcnt(0)" ::: "memory"); __builtin_amdgcn_s_barrier(); asm volatile("" ::: "memory"); } while (0)
    Seam<ROPE> S; char* qrl = lds + OFF_QR + wid * 4096 + lane * 16;
    QLOAD(cur);
    DMA_TILE(0, 0); QPARK();
    DMA_BAR();
    for (int t = 0; t < NT; ++t) {
        const int buf = t & 1;
        if (t + 1 < NT) { DMA_TILE(t + 1, buf ^ 1); }
        SBAR();
        f32x16 p0, p1; qkt_rt<ROPE>(p0, p1, K_lds, buf, koff, S.qr, qrl);
        if constexpr (CAUSAL) { const int kb_ = t * KVBLK; if (kb_ + KVBLK - 1 > qlo) mask_tile(p0, p1, qm - kb_); }
        float mn, al; partialSM<ROPE>(p0, p1, m_reg, mn, al);
        if (__any(al < 1.f)) { if (hi == 0) al_l[r32] = al; asm volatile("s_waitcnt lgkmcnt(0)" ::: "memory");
            for (int d_ = 0; d_ < 4; ++d_) for (int r = 0; r < 16; ++r) o[d_][r] *= al_l[crow(r, hi)]; }
        bf16x8 pa0, pa1, pa2, pa3; finishSM(p0, p1, al, l_reg, pa0, pa1, pa2, pa3); SBAR();
        pv_tile<0>(o, vb0 + buf * SHM_V, pa0, pa1, pa2, pa3);
        DMA_BAR();
    }
#undef DMA_TILE
#undef DMA_BAR
    if (hi == 0) li_l[r32] = l_reg; asm volatile("s_waitcnt lgkmcnt(0)" ::: "memory");
    float rli[16];
#pragma unroll
    for (int r = 0; r < 16; ++r) rli[r] = __builtin_amdgcn_rcpf(li_l[crow(r, hi)]);
    bf16_t* Ow = cur.O + (size_t)(wid * QBLK) * T.os;
#pragma unroll
    for (int r = 0; r < 16; ++r) { const int orow = crow(r, hi);
#pragma unroll
        for (int d0 = 0; d0 < 4; ++d0) { const float v = o[d0][r] * rli[r];
            const float vn = __shfl_xor(v, 1);
            if ((r32 & 1) == 0) *(unsigned*)(Ow + (size_t)orow * T.os + d0 * 32 + r32) = cvtpk(v, vn); } }
    __syncthreads();
}
#undef LD8
#undef VMW
#undef VMWN
#undef SLOAD_H
#undef SWRITE_HK
#undef SWRITE_HV
#undef SWRITE_H
#undef QLOAD
#undef QPARK
#undef QPARK8
#undef STAGE_IDX
}
__device__ __forceinline__ float sq4v(f32x4 v) { return pg8::sq4(v); }
__device__ __forceinline__ float row_rs32g(const float* ss, int row) { return pg8::row_rs32(ss, row, 1.0f / DM); }
struct Params {
    const float *x, *mem; const int* pos; const float *norm_mix, *w_in, *lam_re, *lam_im, *log_step, *b_re, *b_im, *c_re, *c_im, *ssm_d, *w_glu, *b_glu;
    const float *q_norm, *w_uq, *kv_norm, *w_uk, *w_uv, *w_up_ssm, *w_up_mla, *w_out, *norm_xattn, *norm_mem, *xa_wq, *xa_wk, *xa_wv, *xa_wo;
    const float *norm_moe, *router_w, *router_b, *w_gu, *b_gu, *w_dn, *b_dn, *final_norm;
    float* out;
    unsigned* ctl;
    bf16_t *WinT, *WkpeT, *WgluT, *WuqT, *WukvT, *WupsT, *WupmT, *WoutT, *WxqT, *WxkvT, *WxoT; unsigned char *WguT, *WdnT;
    float* WrT;
    bf16_t *hn, *memn; float *cosT, *sinT; float* abar; bf16_t *bbarT, *cmat;
    bf16_t *ub, *qa, *kva; float *qss, *kvss; bf16_t *sgs, *sgm, *kpe;
    bf16_t *qn, *qr, *kn, *vv, *ymla;
    float* send; bf16_t *zb, *ys, *t1, *mg;
    float* x1; bf16_t* x1b; float* ss1;
    bf16_t *memkv, *qx, *ox;
    bf16_t* x2; float* ss2;
    int* topi; float* topw; int* rank; int* slot; int* wgcnt; int* blke;
    unsigned char *xg, *act; bf16_t* orow;
    int ph_lo, ph_hi;
};

struct Frame { LAS unsigned char* lds; int wave, vcu, G, gw, NGW; };

template <class RowMap>
__device__ __forceinline__ void p0_transpose_item(const float* W, int ldw, int K, bf16_t* WT, const float* gain, LAS float* scr, int kb, int nb, int lane, const RowMap& rowmap) {
    const int k0 = 64 * kb, n0 = 32 * nb;
#pragma unroll 8
    for (int i = 0; i < 32; ++i) { const int kk = 2 * i + (lane >> 5); float v = W[(size_t)(k0 + kk) * ldw + n0 + (lane & 31)]; if (gain) v *= gain[k0 + kk]; scr[kk * 33 + (lane & 31)] = v; }
    LDS_WAIT(); asm volatile("" ::: "memory");
    const int c = lane & 7;
#pragma unroll
    for (int j = 0; j < 4; ++j) { const int n = (lane >> 3) + 8 * j; const LAS float* s = scr + (8 * c) * 33 + n;
        u32x4 o; o.x = cvtpk(s[0 * 33], s[1 * 33]); o.y = cvtpk(s[2 * 33], s[3 * 33]); o.z = cvtpk(s[4 * 33], s[5 * 33]); o.w = cvtpk(s[6 * 33], s[7 * 33]);
        *(u32x4*)(WT + (size_t)rowmap(n0 + n) * K + k0 + 8 * c) = o; }
    LDS_WAIT(); asm volatile("" ::: "memory");
}
template <class RowMap>
__device__ __forceinline__ void p0_transpose_item_f8(const float* W, int ldw, int K, unsigned char* WT, float scale, LAS float* scr, int kb, int nb, int lane, const RowMap& rowmap) {
    const int k0 = 128 * kb, n0 = 32 * nb;
#pragma unroll 8
    for (int i = 0; i < 64; ++i) { const int kk = 2 * i + (lane >> 5); scr[kk * 33 + (lane & 31)] = W[(size_t)(k0 + kk) * ldw + n0 + (lane & 31)] * scale; }
    LDS_WAIT(); asm volatile("" ::: "memory");
    const int c = lane & 7;
#pragma unroll
    for (int j = 0; j < 4; ++j) { const int n = (lane >> 3) + 8 * j; const LAS float* s = scr + (16 * c) * 33 + n;
        u32x4 o; o.x = pg8::pk4_fp8(s[0 * 33], s[1 * 33], s[2 * 33], s[3 * 33]); o.y = pg8::pk4_fp8(s[4 * 33], s[5 * 33], s[6 * 33], s[7 * 33]);
        o.z = pg8::pk4_fp8(s[8 * 33], s[9 * 33], s[10 * 33], s[11 * 33]); o.w = pg8::pk4_fp8(s[12 * 33], s[13 * 33], s[14 * 33], s[15 * 33]);
        *(u32x4*)(WT + (size_t)rowmap(n0 + n) * K + k0 + 16 * c) = o; }
    LDS_WAIT(); asm volatile("" ::: "memory");
}
struct MapId { int off; __device__ __forceinline__ int operator()(int n) const { return n + off; } };
struct MapUq { __device__ __forceinline__ int operator()(int n) const { const int h = n / 192, d = n % 192; if (d < 128) return h * 128 + d;
    const int dd = d - 128, half = dd >> 5, i = dd & 31; return 2048 + 256 * (h >> 2) + half * 128 + (h & 3) * 32 + i; } };
struct MapGU { __device__ __forceinline__ int operator()(int n) const { const int up = n >= DFF, j = up ? n - DFF : n; return 256 * (j >> 7) + up * 128 + (j & 127); } };

__device__ __forceinline__ void rms_row_bf16(const float* xrow, const float* gain, bf16_t* orow, int lane) {
    f32x4 v[8]; float s = 0.f;
#pragma unroll
    for (int j = 0; j < 8; ++j) { v[j] = *(const f32x4*)(xrow + 256 * j + 4 * lane); s += sq4v(v[j]); }
    const float rs = __builtin_amdgcn_rsqf(wave_sum(s) * (1.0f / DM) + EPS);
#pragma unroll
    for (int j = 0; j < 8; ++j) { const f32x4 g = *(const f32x4*)(gain + 256 * j + 4 * lane); const f32x4 r = v[j] * rs * g;
        u32x2 o = {cvtpk(r[0], r[1]), cvtpk(r[2], r[3])}; *(u32x2*)(orow + 256 * j + 4 * lane) = o; }
}

__device__ __forceinline__ void cmul(float ar, float ai, float br, float bi, float& cr, float& ci) { cr = ar * br - ai * bi; ci = ar * bi + ai * br; }

__device__ __forceinline__ void p0_prologue(const Params& p, Frame& F) {
    LAS float* scr = (LAS float*)(F.lds + F.wave * 17408);
    const int gw = F.gw, NGW = F.NGW, lane = ((int)threadIdx.x & 63);
#define TJOB(W, LDW, COFF, NCOLS, KK, DST, GAIN, MAP) { const int nblk = (NCOLS) / 32, nit = ((KK) / 64) * nblk; \
        for (int it = gw; it < nit; it += NGW) p0_transpose_item((W) + (COFF), (LDW), (KK), (DST), (GAIN), scr, it / nblk, it % nblk, lane, (MAP)); }
    TJOB(p.w_in, IN_COLS, 0, 2048, DM, p.WinT, nullptr, MapId{0});
    TJOB(p.w_in, IN_COLS, 2048, 64, DM, p.WkpeT, nullptr, MapId{0});
    TJOB(p.w_in, IN_COLS, 2112, 4096, DM, p.WinT, nullptr, MapId{2048});
    TJOB(p.w_glu, SSM_W, 0, SSM_W, SSM_W, p.WgluT, nullptr, MapId{0});
    TJOB(p.w_uq, NHEAD * 192, 0, NHEAD * 192, QL, p.WuqT, p.q_norm, MapUq{});
    TJOB(p.w_uk, NHEAD * 128, 0, NHEAD * 128, KVL, p.WukvT, p.kv_norm, MapId{0});
    TJOB(p.w_uv, NHEAD * 128, 0, NHEAD * 128, KVL, p.WukvT, p.kv_norm, MapId{2048});
    TJOB(p.w_up_ssm, DM, 0, DM, SSM_W, p.WupsT, nullptr, MapId{0});
    TJOB(p.w_up_mla, DM, 0, DM, DM, p.WupmT, nullptr, MapId{0});
    TJOB(p.w_out, DM, 0, DM, DM, p.WoutT, nullptr, MapId{0});
    TJOB(p.xa_wq, XW, 0, XW, DM, p.WxqT, p.norm_xattn, MapId{0});
    TJOB(p.xa_wk, XW, 0, XW, DM, p.WxkvT, nullptr, MapId{0});
    TJOB(p.xa_wv, XW, 0, XW, DM, p.WxkvT, nullptr, MapId{512});
    TJOB(p.xa_wo, DM, 0, DM, XW, p.WxoT, nullptr, MapId{0});
#define TJOB8(W, LDW, NCOLS, KK, DST, MAP) { const int nblk = (NCOLS) / 32, nit = ((KK) / 128) * nblk; \
        for (int it = gw; it < nit; it += NGW) p0_transpose_item_f8((W), (LDW), (KK), (DST), pg8::F8_WS, scr, it / nblk, it % nblk, lane, (MAP)); }
    for (int e = 0; e < NEXP; ++e) {
        TJOB8(p.w_gu + (size_t)e * DM * 2 * DFF, 2 * DFF, 2 * DFF, DM, p.WguT + (size_t)e * 2 * DFF * DM, MapGU{});
        TJOB8(p.w_dn + (size_t)e * DFF * DM, DM, DM, DFF, p.WdnT + (size_t)e * DM * DFF, MapId{0});
    }
#undef TJOB8
#undef TJOB
    for (int m = gw; m < SEQ; m += NGW) rms_row_bf16(p.x + (size_t)m * DM, p.norm_mix, p.hn + (size_t)m * DM, lane);
    for (int m = gw; m < MEML; m += NGW) rms_row_bf16(p.mem + (size_t)m * DM, p.norm_mem, p.memn + (size_t)m * DM, lane);
    const int gt = gw * 64 + lane, NGT = NGW * 64;
    for (int i = gt; i < SEQ * 32; i += NGT) {
        const int t = i >> 5, f = i & 31;
        const float invf = __builtin_powf(10000.0f, -(float)(2 * f) / 64.0f);
        const float ang = (float)p.pos[t] * invf;
        const double rev = (double)ang * 0.15915494309189535; const float fr = (float)(rev - __builtin_floor(rev));
        p.cosT[i] = __builtin_amdgcn_cosf(fr); p.sinT[i] = __builtin_amdgcn_sinf(fr);
    }
    for (int i = gt; i < DM * NEXP; i += NGT) p.WrT[i] = p.router_w[i] * p.norm_moe[i >> 5];
    for (int i = gt; i < SSM_G * SSM_P; i += NGT) {
        const int g = i >> 6;
        const float dt = __builtin_expf(p.log_step[g]), lr = p.lam_re[i], li = p.lam_im[i];
        const float mag = __builtin_expf(lr * dt); const double rev = (double)(li * dt) * 0.15915494309189535; const float fr = (float)(rev - __builtin_floor(rev));
        const float ar = mag * __builtin_amdgcn_cosf(fr), ai = mag * __builtin_amdgcn_sinf(fr);
        p.abar[2 * i] = ar; p.abar[2 * i + 1] = ai;
        const float den = 1.0f / (lr * lr + li * li); float fr_, fi_; cmul(ar - 1.0f, ai, lr * den, -li * den, fr_, fi_);
        const int pst = i & 63;
#pragma unroll
        for (int h = 0; h < SSM_H; ++h) { const float br = p.b_re[(size_t)i * SSM_H + h], bi = p.b_im[(size_t)i * SSM_H + h]; float cr, ci; cmul(fr_, fi_, br, bi, cr, ci);
            p.bbarT[((size_t)g * 128 + pst) * 16 + h] = f2bf(cr); p.bbarT[((size_t)g * 128 + 64 + pst) * 16 + h] = f2bf(ci); }
    }
    for (int i = gt; i < SSM_G * SSM_H * SSM_P; i += NGT) {
        const int gh = i >> 6, pst = i & 63;
        p.cmat[(size_t)gh * 128 + pst] = f2bf(p.c_re[i]); p.cmat[(size_t)gh * 128 + 64 + pst] = f2bf(-p.c_im[i]);
    }
}

__device__ __forceinline__ void kpe_phase(const Params& p, Frame& F) {
    const int lane = ((int)threadIdx.x & 63), r = lane & 31, hi = lane >> 5;
    for (int tile = F.wave * F.G + F.vcu; tile < SEQ / 32; tile += F.NGW) {
        const int t0 = tile * 32; f32x16 a0 = {}, a1 = {};
        const bf16_t* ap = p.hn + (size_t)(t0 + r) * DM + 8 * hi; const bf16_t* b0p = p.WkpeT + (size_t)r * DM + 8 * hi; const bf16_t* b1p = b0p + (size_t)32 * DM;
#pragma unroll 4
        for (int s = 0; s < DM / 16; ++s) { const bf16x8 a = *(const bf16x8*)(ap + 16 * s), b0 = *(const bf16x8*)(b0p + 16 * s), b1 = *(const bf16x8*)(b1p + 16 * s);
            a0 = __builtin_amdgcn_mfma_f32_32x32x16_bf16(a, b0, a0, 0, 0, 0); a1 = __builtin_amdgcn_mfma_f32_32x32x16_bf16(a, b1, a1, 0, 0, 0); }
#pragma unroll
        for (int i = 0; i < 16; ++i) { const int tok = t0 + (i & 3) + 8 * (i >> 2) + 4 * hi; const float c = p.cosT[(size_t)tok * 32 + r], s = p.sinT[(size_t)tok * 32 + r];
            p.kpe[(size_t)tok * DROPE + r] = f2bf(a0[i] * c - a1[i] * s); p.kpe[(size_t)tok * DROPE + 32 + r] = f2bf(a0[i] * s + a1[i] * c); }
    }
}

constexpr int S5_TC = 256, S5_NCH = SEQ / S5_TC;
struct S5Consts { float a1r[2], a1i[2], a2r[2], a2i[2], a3r[2], a3i[2], a4r[2], a4i[2], a8r[2], a8i[2], a32r[2], a32i[2], a256r[2], a256i[2]; };
__device__ __forceinline__ void s5_consts(const Params& p, int g, int r, S5Consts& c) {
#pragma unroll
    for (int s = 0; s < 2; ++s) { const f32x2 a = *(const f32x2*)(p.abar + 2 * (g * 64 + 32 * s + r)); c.a1r[s] = a[0]; c.a1i[s] = a[1];
        cmul(c.a1r[s], c.a1i[s], c.a1r[s], c.a1i[s], c.a2r[s], c.a2i[s]); cmul(c.a2r[s], c.a2i[s], c.a1r[s], c.a1i[s], c.a3r[s], c.a3i[s]); cmul(c.a2r[s], c.a2i[s], c.a2r[s], c.a2i[s], c.a4r[s], c.a4i[s]);
        cmul(c.a4r[s], c.a4i[s], c.a4r[s], c.a4i[s], c.a8r[s], c.a8i[s]); float tr, ti; cmul(c.a8r[s], c.a8i[s], c.a8r[s], c.a8i[s], tr, ti); cmul(tr, ti, tr, ti, c.a32r[s], c.a32i[s]);
        float ur, ui; cmul(c.a32r[s], c.a32i[s], c.a32r[s], c.a32i[s], tr, ti); cmul(tr, ti, tr, ti, ur, ui); cmul(ur, ui, ur, ui, c.a256r[s], c.a256i[s]); }
}
__device__ __forceinline__ void s5_bu(const Params& p, int g, int t0, int r, int hi, const bf16x8 (&bfr)[4], f32x16 (&acc)[4]) {
    const bf16x8 a = *(const bf16x8*)(p.ub + (size_t)(t0 + r) * SSM_W + g * 16 + 8 * hi);
#pragma unroll
    for (int ct = 0; ct < 4; ++ct) { acc[ct] = f32x16{}; acc[ct] = __builtin_amdgcn_mfma_f32_32x32x16_bf16(a, bfr[ct], acc[ct], 0, 0, 0); }
}
__device__ __forceinline__ void s5_pass_a(const Params& p, Frame& F) {
    const int lane = ((int)threadIdx.x & 63), r = lane & 31, hi = lane >> 5;
    for (int unit = F.gw; unit < S5_NCH * SSM_G; unit += F.NGW) {
        const int g = unit % SSM_G, ch = unit / SSM_G;
        S5Consts c; s5_consts(p, g, r, c);
        bf16x8 bfr[4];
#pragma unroll
        for (int ct = 0; ct < 4; ++ct) bfr[ct] = *(const bf16x8*)(p.bbarT + ((size_t)g * 128 + 32 * ct + r) * 16 + 8 * hi);
        float Sr[2] = {0.f, 0.f}, Si[2] = {0.f, 0.f};
        for (int tl = 0; tl < S5_TC / 32; ++tl) {
            f32x16 acc[4]; s5_bu(p, g, ch * S5_TC + tl * 32, r, hi, bfr, acc);
#pragma unroll
            for (int s = 0; s < 2; ++s) { float Pr = 0.f, Pi = 0.f;
#pragma unroll
                for (int q = 0; q < 4; ++q) { float er = acc[s][4 * q], ei = acc[2 + s][4 * q];
#pragma unroll
                    for (int j = 1; j < 4; ++j) { float tr, ti; cmul(er, ei, c.a1r[s], c.a1i[s], tr, ti); er = tr + acc[s][4 * q + j]; ei = ti + acc[2 + s][4 * q + j]; }
                    float tr, ti; cmul(Pr, Pi, c.a8r[s], c.a8i[s], tr, ti); Pr = tr + er; Pi = ti + ei; }
                if (hi == 0) { float tr, ti; cmul(Pr, Pi, c.a4r[s], c.a4i[s], tr, ti); Pr = tr; Pi = ti; }
                Pr += __shfl_xor(Pr, 32); Pi += __shfl_xor(Pi, 32);
                float tr, ti; cmul(Sr[s], Si[s], c.a32r[s], c.a32i[s], tr, ti); Sr[s] = tr + Pr; Si[s] = ti + Pi; }
        }
        if (hi == 0) {
#pragma unroll
            for (int s = 0; s < 2; ++s) *(f32x2*)(p.send + 2 * ((size_t)(ch * SSM_G + g) * 64 + 32 * s + r)) = (f32x2){Sr[s], Si[s]}; }
    }
}
constexpr int S5_XS = 272;
__device__ __forceinline__ void s5_pass_c(const Params& p, Frame& F) {
    const int lane = ((int)threadIdx.x & 63), r = lane & 31, hi = lane >> 5, l15 = lane & 15, l4 = lane >> 4;
    LAS unsigned char* xl = F.lds + F.wave * (32 * S5_XS);
    for (int unit = F.gw; unit < S5_NCH * SSM_G; unit += F.NGW) {
        const int g = unit % SSM_G, ch = unit / SSM_G;
        S5Consts c; s5_consts(p, g, r, c);
        bf16x8 bfr[4], cfr[4];
#pragma unroll
        for (int ct = 0; ct < 4; ++ct) bfr[ct] = *(const bf16x8*)(p.bbarT + ((size_t)g * 128 + 32 * ct + r) * 16 + 8 * hi);
#pragma unroll
        for (int ks = 0; ks < 4; ++ks) cfr[ks] = *(const bf16x8*)(p.cmat + ((size_t)g * 16 + l15) * 128 + 32 * ks + 8 * l4);
        const f32x4 dsk = *(const f32x4*)(p.ssm_d + g * 16 + 4 * l4);
        float Xr[2] = {0.f, 0.f}, Xi[2] = {0.f, 0.f};
        for (int cp = 0; cp < ch; ++cp) {
#pragma unroll
            for (int s = 0; s < 2; ++s) { const f32x2 e = *(const f32x2*)(p.send + 2 * ((size_t)(cp * SSM_G + g) * 64 + 32 * s + r)); float tr, ti; cmul(Xr[s], Xi[s], c.a256r[s], c.a256i[s], tr, ti); Xr[s] = tr + e[0]; Xi[s] = ti + e[1]; } }
        for (int tl = 0; tl < S5_TC / 32; ++tl) {
            const int t0 = ch * S5_TC + tl * 32;
            f32x16 acc[4]; s5_bu(p, g, t0, r, hi, bfr, acc);
#pragma unroll
            for (int s = 0; s < 2; ++s) {
                float er[4], ei[4];
#pragma unroll
                for (int q = 0; q < 4; ++q) {
#pragma unroll
                    for (int j = 1; j < 4; ++j) { float tr, ti; cmul(acc[s][4 * q + j - 1], acc[2 + s][4 * q + j - 1], c.a1r[s], c.a1i[s], tr, ti); acc[s][4 * q + j] += tr; acc[2 + s][4 * q + j] += ti; }
                    er[q] = acc[s][4 * q + 3]; ei[q] = acc[2 + s][4 * q + 3]; }
                float cr = Xr[s], ci = Xi[s], cinr[4], cini[4];
#pragma unroll
                for (int q = 0; q < 4; ++q) { const float pr = __shfl_xor(er[q], 32), pi = __shfl_xor(ei[q], 32);
                    const float e0r = hi ? pr : er[q], e0i = hi ? pi : ei[q], e1r = hi ? er[q] : pr, e1i = hi ? ei[q] : pi;
                    float tr, ti; const float c0r = cr, c0i = ci; cmul(cr, ci, c.a4r[s], c.a4i[s], tr, ti); cr = tr + e0r; ci = ti + e0i;
                    const float c1r = cr, c1i = ci; cmul(cr, ci, c.a4r[s], c.a4i[s], tr, ti); cr = tr + e1r; ci = ti + e1i;
                    cinr[q] = hi ? c1r : c0r; cini[q] = hi ? c1i : c0i; }
                Xr[s] = cr; Xi[s] = ci;
#pragma unroll
                for (int q = 0; q < 4; ++q) { float tr, ti;
                    cmul(cinr[q], cini[q], c.a1r[s], c.a1i[s], tr, ti); acc[s][4 * q + 0] += tr; acc[2 + s][4 * q + 0] += ti;
                    cmul(cinr[q], cini[q], c.a2r[s], c.a2i[s], tr, ti); acc[s][4 * q + 1] += tr; acc[2 + s][4 * q + 1] += ti;
                    cmul(cinr[q], cini[q], c.a3r[s], c.a3i[s], tr, ti); acc[s][4 * q + 2] += tr; acc[2 + s][4 * q + 2] += ti;
                    cmul(cinr[q], cini[q], c.a4r[s], c.a4i[s], tr, ti); acc[s][4 * q + 3] += tr; acc[2 + s][4 * q + 3] += ti; }
            }
#pragma unroll
            for (int ct = 0; ct < 4; ++ct)
#pragma unroll
                for (int i = 0; i < 16; ++i) *(LAS unsigned short*)(xl + ((i & 3) + 8 * (i >> 2) + 4 * hi) * S5_XS + (32 * ct + r) * 2) = f2bf(acc[ct][i]);
            LDS_WAIT(); asm volatile("" ::: "memory");
#pragma unroll
            for (int nt = 0; nt < 2; ++nt) { f32x4 y = {0.f, 0.f, 0.f, 0.f};
#pragma unroll
                for (int ks = 0; ks < 4; ++ks) { const bf16x8 b = *(const LAS bf16x8*)(xl + (16 * nt + l15) * S5_XS + (32 * ks + 8 * l4) * 2); y = __builtin_amdgcn_mfma_f32_16x16x32_bf16(cfr[ks], b, y, 0, 0, 0); }
                const size_t off = (size_t)(t0 + 16 * nt + l15) * SSM_W + g * 16 + 4 * l4; const u32x2 uw = *(const u32x2*)(p.ub + off);
                const float y0 = y[0] + dsk[0] * bflo(uw.x), y1 = y[1] + dsk[1] * bfhi(uw.x), y2 = y[2] + dsk[2] * bflo(uw.y), y3 = y[3] + dsk[3] * bfhi(uw.y);
                u32x2 o = {cvtpk(gelu_tanh(y0), gelu_tanh(y1)), cvtpk(gelu_tanh(y2), gelu_tanh(y3))}; *(u32x2*)(p.zb + off) = o; }
            LDS_WAIT(); asm volatile("" ::: "memory");
        }
    }
}

__device__ __forceinline__ void router_phase(const Params& p, Frame& F) {
    LAS float* red = (LAS float*)F.lds; LAS float* lg = red + 8 * 32 * 33; LAS int* asg = (LAS int*)(lg + 32 * 33); LAS int* cnt = asg + 256;
    const int lane = ((int)threadIdx.x & 63), i32 = lane & 31, kh = lane >> 5, w = F.wave, tid = (int)threadIdx.x;
    for (int vb = blockIdx.x; vb < SEQ / 64; vb += F.G) {
        if (tid < 32) cnt[tid] = 0;
        for (int tl = 0; tl < 2; ++tl) {
            const int t0 = vb * 64 + tl * 32;
            f32x16 acc = {};
            const bf16_t* ap = p.x2 + (size_t)(t0 + i32) * DM + 256 * w + 4 * kh; const float* bp = p.WrT + (size_t)(256 * w + 4 * kh) * NEXP + i32;
#pragma unroll 4
            for (int q = 0; q < 32; ++q) { const u32x2 aw = *(const u32x2*)(ap + 8 * q); const f32x4 a = {bflo(aw.x), bfhi(aw.x), bflo(aw.y), bfhi(aw.y)};
#pragma unroll
                for (int e = 0; e < 4; ++e) acc = __builtin_amdgcn_mfma_f32_32x32x2f32(a[e], bp[(size_t)(8 * q + e) * NEXP], acc, 0, 0, 0); }
#pragma unroll
            for (int i = 0; i < 16; ++i) red[(w * 32 + (i & 3) + 8 * (i >> 2) + 4 * kh) * 33 + i32] = acc[i];
            __syncthreads();
            for (int o = tid; o < 1024; o += 512) { const int tok = o >> 5, e = o & 31; float s = 0.f;
#pragma unroll
                for (int ww = 0; ww < 8; ++ww) s += red[(ww * 32 + tok) * 33 + e];
                lg[tok * 33 + e] = s * row_rs32g(p.ss2, t0 + tok) + p.router_b[e]; }
            __syncthreads();
            if (tid < 32) { const int tok = tid; float v[4] = {-__builtin_inff(), -__builtin_inff(), -__builtin_inff(), -__builtin_inff()}; int id[4] = {0, 0, 0, 0};
                for (int e = 0; e < 32; ++e) { float x = lg[tok * 33 + e]; int xi = e;
#pragma unroll
                    for (int k = 0; k < 4; ++k) { const bool gt = x > v[k]; const float tv = gt ? v[k] : x; const int ti = gt ? id[k] : xi; v[k] = gt ? x : v[k]; id[k] = gt ? xi : id[k]; x = tv; xi = ti; } }
                const float e1 = __builtin_expf(v[1] - v[0]), e2 = __builtin_expf(v[2] - v[0]), e3 = __builtin_expf(v[3] - v[0]); const float inv = 1.0f / (1.0f + e1 + e2 + e3);
                const size_t o4 = (size_t)(t0 + tok) * 4;
                *(f32x4*)(p.topw + o4) = (f32x4){inv, e1 * inv, e2 * inv, e3 * inv};
                p.topi[o4] = id[0]; p.topi[o4 + 1] = id[1]; p.topi[o4 + 2] = id[2]; p.topi[o4 + 3] = id[3];
#pragma unroll
                for (int k = 0; k < 4; ++k) asg[(tl * 32 + tok) * 4 + k] = id[k]; }
            __syncthreads();
        }
        if (tid < 256) { const int e = asg[tid]; int rk = 0; for (int j = 0; j < tid; ++j) rk += (asg[j] == e) ? 1 : 0;
            p.rank[(size_t)vb * 256 + tid] = rk; atomicAdd((int*)&cnt[e], 1); }
        __syncthreads();
        if (tid < 32) p.wgcnt[vb * 32 + tid] = cnt[tid];
        __syncthreads();
    }
}
__device__ __forceinline__ void assign_phase(const Params& p, Frame& F) {
    LAS int* part = (LAS int*)F.lds; LAS int* pbef = part + 512; LAS int* base = pbef + 512; LAS int* pst = base + 32; LAS int* slots = pst + 33;
    const int tid = (int)threadIdx.x, lane = ((int)threadIdx.x & 63);
    for (int vb = blockIdx.x; vb < SEQ / 64; vb += F.G) {
        { const int e = tid & 31, pr = tid >> 5; int s = 0, sb = 0;
          for (int b = pr * 16; b < pr * 16 + 16; ++b) { const int c = p.wgcnt[b * 32 + e]; s += c; sb += (b < vb) ? c : 0; }
          part[pr * 32 + e] = s; pbef[pr * 32 + e] = sb; }
        __syncthreads();
        if (tid < 32) { int tot = 0, bef = 0; for (int pr = 0; pr < 16; ++pr) { tot += part[pr * 32 + tid]; bef += pbef[pr * 32 + tid]; } part[tid] = tot; pbef[tid] = bef; }
        __syncthreads();
        if (tid == 0) { int acc = 0; for (int e = 0; e < 32; ++e) { pst[e] = acc; const int nb = (part[e] + 255) >> 8;
                if (vb == 0) for (int b = 0; b < nb; ++b) p.blke[(acc >> 8) + b] = e;
                acc += nb << 8; }
            pst[32] = acc; if (vb == 0) p.blke[MAXBLK] = acc >> 8; }
        __syncthreads();
        if (tid < 32) base[tid] = pst[tid] + pbef[tid];
        __syncthreads();
        if (tid < 256) { const int tok = vb * 64 + (tid >> 2); const int e = p.topi[(size_t)tok * 4 + (tid & 3)]; const int sl = base[e] + p.rank[(size_t)vb * 256 + tid];
            p.slot[(size_t)tok * 4 + (tid & 3)] = sl; slots[tid] = sl; }
        __syncthreads();
        for (int tk = F.wave; tk < 64; tk += NWAVES) { const int tok = vb * 64 + tk; const bf16_t* xr = p.x2 + (size_t)tok * DM; const float rs = row_rs32g(p.ss2, tok);
#pragma unroll
            for (int j = 0; j < 4; ++j) { const int c = 512 * j + 8 * lane; const f32x4 g0 = *(const f32x4*)(p.norm_moe + c), g1 = *(const f32x4*)(p.norm_moe + c + 4);
                f32x4 xa, xb2; unpack8(*(const u32x4*)(xr + c), xa, xb2);
                const f32x4 a = xa * (rs * pg8::F8_XS) * g0, b = xb2 * (rs * pg8::F8_XS) * g1;
                const u32x2 o = {pg8::pk4_fp8(a[0], a[1], a[2], a[3]), pg8::pk4_fp8(b[0], b[1], b[2], b[3])};
#pragma unroll
                for (int k = 0; k < 4; ++k) *(u32x2*)(p.xg + (size_t)slots[tk * 4 + k] * DM + c) = o; } }
        __syncthreads();
    }
}
__device__ __forceinline__ void combine_phase(const Params& p, Frame& F) {
    const int lane = ((int)threadIdx.x & 63);
    for (int tok = F.gw; tok < SEQ; tok += F.NGW) {
        const f32x4 w = *(const f32x4*)(p.topw + (size_t)tok * 4); int sl[4];
#pragma unroll
        for (int k = 0; k < 4; ++k) sl[k] = p.slot[(size_t)tok * 4 + k];
        f32x4 v[4][2]; float s = 0.f;
#pragma unroll
        for (int j = 0; j < 4; ++j) { const int c = 512 * j + 8 * lane; unpack8(*(const u32x4*)(p.x2 + (size_t)tok * DM + c), v[j][0], v[j][1]);
#pragma unroll
            for (int k = 0; k < 4; ++k) { f32x4 a, b; unpack8(*(const u32x4*)(p.orow + (size_t)sl[k] * DM + c), a, b); v[j][0] += a * w[k]; v[j][1] += b * w[k]; }
            s += sq4v(v[j][0]) + sq4v(v[j][1]); }
        const float rs = __builtin_amdgcn_rsqf(wave_sum(s) * (1.0f / DM) + EPS);
#pragma unroll
        for (int j = 0; j < 4; ++j) { const int c = 512 * j + 8 * lane;
            *(f32x4*)(p.out + (size_t)tok * DM + c) = v[j][0] * rs * *(const f32x4*)(p.final_norm + c); *(f32x4*)(p.out + (size_t)tok * DM + c + 4) = v[j][1] * rs * *(const f32x4*)(p.final_norm + c + 4); }
    }
}
template <bool ROPE, bool CAUSAL, class Refs>
__device__ __forceinline__ void attn_stream(const Refs& R, const att::Strides& T, char* lds) {
    const int n = R.count(); if (n <= 0) return;
    att::Seam<ROPE> S; att::BlockRef cur = R.ref(0);
    att::attn_prime<ROPE, CAUSAL>(cur, T, lds, S);
    for (int i = 0; i < n; ++i) { const att::BlockRef nxt = (i + 1 < n) ? R.ref(i + 1) : cur; att::attn_block<ROPE, CAUSAL>(cur, nxt, T, lds, S); cur = nxt; }
}
struct MlaRefs {
    const Params* p; int b, G; bf16_t* obuf;
    __device__ __forceinline__ int count() const { return b < 512 ? 2 * ((512 - b + G - 1) / G) : 0; }
    __device__ __forceinline__ att::BlockRef ref(int i) const {
        const int L = b + (i >> 1) * G, xcd = L & 7, k = L >> 3, head = (k >> 5) * 8 + xcd, y = k & 31, qb = (i & 1) ? 63 - y : y;
        att::BlockRef r; const size_t row0 = (size_t)qb * 256;
        r.Q = p->qn + row0 * DM + head * DNOPE; r.QR = p->qr + row0 * (NHEAD * DROPE) + head * DROPE; r.K = p->kn + head * DNOPE; r.KR = p->kpe; r.V = p->vv + head * DV;
        r.O = obuf + row0 * DM + head * DV; r.P0 = qb * 256; return r; }
};
struct XaRefs {
    const Params* p; int b, G;
    __device__ __forceinline__ int count() const { return b < 256 ? (256 - b + G - 1) / G : 0; }
    __device__ __forceinline__ att::BlockRef ref(int i) const {
        const int L = b + i * G, head = L & 3, qb = L >> 2; att::BlockRef r; const size_t row0 = (size_t)qb * 256;
        r.Q = p->qx + row0 * XW + head * 128; r.QR = nullptr; r.K = p->memkv + head * 128; r.KR = nullptr; r.V = p->memkv + XW + head * 128; r.O = p->ox + row0 * XW + head * 128; r.P0 = 0; return r; }
};

constexpr int RING_BYTES = 155648, MISC_OFF = RING_BYTES + 320, LDS_BYTES = 159744;
constexpr int NPHASE = 16;
#ifndef MK_ONE_LAUNCH
#define MK_ONE_LAUNCH 1
#endif

__global__ void __launch_bounds__(NWAVES * 64, 2) hybrid_fwd(Params p) {
    extern __shared__ __attribute__((aligned(16))) unsigned char lds[];
    Frame F;
    F.lds = (LAS unsigned char*)lds; F.wave = __builtin_amdgcn_readfirstlane((int)threadIdx.x >> 6);
    F.G = gridDim.x; { const int bx = blockIdx.x; F.vcu = (F.G % 8 == 0) ? (bx % 8) * (F.G / 8) + bx / 8 : bx; }
    F.gw = F.vcu * NWAVES + F.wave; F.NGW = F.G * NWAVES;
    volatile LAS unsigned* MISC = (volatile LAS unsigned*)(F.lds + MISC_OFF);
    for (int u = threadIdx.x; u < (LDS_BYTES - RING_BYTES) / 4; u += NWAVES * 64) ((LAS unsigned*)(F.lds + RING_BYTES))[u] = 0u;
    __syncthreads();
    const int lo = p.ph_lo, hi = p.ph_hi;
    XcdBarrier bar; bar.bar = p.ctl + 4096; bar.x = 0; bar.st = nullptr;
    if (hi - lo > 1) bar = xcd_barrier_post(p.ctl + 4096, MISC + 8);
#ifndef PHMASK
#define PHMASK 0xFFFF
#endif
#define IN(k) ((((PHMASK) >> (k)) & 1) && lo <= (k) && (k) < hi)
#define SEAM(k) do { if (IN(k) && IN((k) + 1)) xcd_barrier(bar); } while (0)
    const int G = F.G, bx = blockIdx.x;
    LAS unsigned char* ring = F.lds;

#ifndef REP3_OBUF
#define REP3_OBUF p.ymla
#endif
#ifndef REPMASK
#define REPMASK 0
#endif
#ifndef REPCOND
#define REPCOND 1
#endif
#define REP(k) ((((REPMASK) >> (k)) & 1) && lo <= ((k) & 15) && ((k) & 15) < hi && (REPCOND))
#define B0 { p0_prologue(p, F); }
#define B1 { kpe_phase(p, F); \
        pg8::Gemm g{p.hn, p.WinT, DM, DM, DM, 0}; pg8::StaticOrder S; S.init(SEQ, 6144, G, bx); \
        pg8::EpiProj E{p.ub, p.qa, p.kva, p.sgs, p.sgm, p.qss, p.kvss}; pg8::gemm_phase(ring, g, S, E); }
#define B2 { s5_pass_a(p, F); \
        { pg8::Gemm g{p.qa, p.WuqT, QL, QL, QL, 0}; pg8::StaticOrder S; S.init(SEQ, 3072, G, bx); pg8::EpiQup E{p.qn, p.qr, p.qss, p.cosT, p.sinT}; pg8::gemm_phase(ring, g, S, E); } \
        { pg8::Gemm g{p.kva, p.WukvT, KVL, KVL, KVL, 0}; pg8::StaticOrder S; S.init(SEQ, 4096, G, bx); pg8::EpiKVup E{p.kn, p.vv, p.kvss}; pg8::gemm_phase(ring, g, S, E); } \
        { pg8::Gemm g{p.memn, p.WxkvT, DM, DM, DM, 0}; pg8::StaticOrder S; S.init(MEML, 2 * XW, G, bx); pg8::EpiPlain E{p.memkv, 2 * XW}; pg8::gemm_phase(ring, g, S, E); } }
#define B3A { s5_pass_c(p, F); __syncthreads(); }
#define B3B_(OB) { const att::Strides T{DM, NHEAD * DROPE, DM, DM, DM, SEQ}; const MlaRefs R{&p, bx, G, OB}; for (int i = 0, n = R.count(); i < n; ++i) att::attn_block_simple<true, true>(R.ref(i), T, (char*)lds); }
#define B4 { pg8::Gemm g{p.zb, p.WgluT, SSM_W, SSM_W, SSM_W, 0}; pg8::StaticOrder S; S.init(SEQ, SSM_W, G, bx); pg8::EpiGlu E{p.zb, p.b_glu, p.ys}; pg8::gemm_phase(ring, g, S, E); }
#define B5 { pg8::Gemm g{p.ys, p.WupsT, SSM_W, SSM_W, SSM_W, 0}; pg8::StaticOrder S; S.init(SEQ, DM, G, bx); pg8::EpiGate E{p.sgs, nullptr, p.t1}; pg8::gemm_phase(ring, g, S, E); }
#define B6 { pg8::Gemm g{p.ymla, p.WupmT, DM, DM, DM, 0}; pg8::StaticOrder S; S.init(SEQ, DM, G, bx); pg8::EpiGate E{p.sgm, p.t1, p.mg}; pg8::gemm_phase(ring, g, S, E); }
#define B7 { pg8::Gemm g{p.mg, p.WoutT, DM, DM, DM, 0}; pg8::StaticOrder S; S.init(SEQ, DM, G, bx); pg8::EpiResid<float, false> E{p.x, nullptr, p.x1b, p.ss1}; pg8::gemm_phase(ring, g, S, E); }
#define B8 { pg8::Gemm g{p.x1b, p.WxqT, DM, DM, DM, 0}; pg8::StaticOrder S; S.init(SEQ, XW, G, bx); pg8::EpiXq E{p.qx, p.ss1}; pg8::gemm_phase(ring, g, S, E); }
#define B9 { const att::Strides T{XW, 0, 2 * XW, 2 * XW, XW, MEML}; const XaRefs R{&p, bx, G}; attn_stream<false, false>(R, T, (char*)lds); }
#define B10 { pg8::Gemm g{p.ox, p.WxoT, XW, XW, XW, 0}; pg8::StaticOrder S; S.init(SEQ, DM, G, bx); pg8::EpiResid<bf16_t, false> E{p.x1b, nullptr, p.x2, p.ss2}; pg8::gemm_phase(ring, g, S, E); }
#define B11 { router_phase(p, F); }
#define B12 { assign_phase(p, F); }
#define B13 { const int nblk = __builtin_amdgcn_readfirstlane(p.blke[MAXBLK]); \
        pg8::Gemm g{(const bf16_t*)p.xg, (const bf16_t*)p.WguT, DM / 2, DM / 2, DM / 2, (size_t)2 * DFF * DM / 2}; pg8::MoeOrder S; S.init(nblk, 2 * DFF, G, bx, p.blke); pg8::EpiMoeGU E{p.b_gu, p.act}; pg8::gemm_phase<pg8::EpiMoeGU, pg8::MoeOrder, true>(ring, g, S, E); }
#define B14 { const int nblk = __builtin_amdgcn_readfirstlane(p.blke[MAXBLK]); \
        pg8::Gemm g{(const bf16_t*)p.act, (const bf16_t*)p.WdnT, DFF / 2, DFF / 2, DFF / 2, (size_t)DM * DFF / 2}; pg8::MoeOrder S; S.init(nblk, DM, G, bx, p.blke); pg8::EpiMoeDown E{p.b_dn, p.orow}; pg8::gemm_phase<pg8::EpiMoeDown, pg8::MoeOrder, true>(ring, g, S, E); }
#define B15 { combine_phase(p, F); }
    if (IN(0)) B0 if (REP(0)) B0 SEAM(0);
    if (IN(1)) B1 if (REP(1)) B1 SEAM(1);
    if (IN(2)) B2 if (REP(2)) B2 SEAM(2);
    if (IN(3)) { B3A if (REP(16)) B3A B3B_(p.ymla) if (REP(3)) B3B_(REP3_OBUF) } SEAM(3);
    if (IN(4)) B4 if (REP(4)) B4 SEAM(4);
    if (IN(5)) B5 if (REP(5)) B5 SEAM(5);
    if (IN(6)) B6 if (REP(6)) B6 SEAM(6);
    if (IN(7)) B7 if (REP(7)) B7 SEAM(7);
    if (IN(8)) B8 if (REP(8)) B8 SEAM(8);
    if (IN(9)) B9 if (REP(9)) B9 SEAM(9);
    if (IN(10)) B10 if (REP(10)) B10 SEAM(10);
    if (IN(11)) B11 if (REP(11)) B11 SEAM(11);
    if (IN(12)) B12 if (REP(12)) B12 SEAM(12);
    if (IN(13)) B13 if (REP(13)) B13 SEAM(13);
    if (IN(14)) B14 if (REP(14)) B14 SEAM(14);
    if (IN(15)) B15 if (REP(15)) B15
#undef IN
#undef SEAM
}

extern "C" void kernel_launch(void* const* d_in, const int* in_sizes, int n_in, void* d_out, int out_size, void* d_ws, size_t ws_size, hipStream_t stream) {
    static int grid = 0;
    if (grid == 0) {
        if (n_in != 37 || in_sizes[0] != SEQ * DM || out_size != SEQ * DM) { fprintf(stderr, "kernel_launch: unexpected shapes (n_in %d)\n", n_in); grid = -1; return; }
        int dev = 0, cus = 0;
        if (hipGetDevice(&dev) != hipSuccess || hipDeviceGetAttribute(&cus, hipDeviceAttributeMultiprocessorCount, dev) != hipSuccess) { grid = -1; return; }
        if (hipFuncSetAttribute((const void*)hybrid_fwd, hipFuncAttributeMaxDynamicSharedMemorySize, LDS_BYTES) != hipSuccess) { fprintf(stderr, "kernel_launch: hipFuncSetAttribute failed\n"); grid = -1; return; }
        int per_cu = 0;
        if (hipOccupancyMaxActiveBlocksPerMultiprocessor(&per_cu, (const void*)hybrid_fwd, NWAVES * 64, LDS_BYTES) != hipSuccess || per_cu < 1) { fprintf(stderr, "kernel_launch: occupancy query says %d\n", per_cu); }
        (void)hipGetLastError();
        grid = cus > 0 ? cus : 256;
    }
    if (grid < 0) return;
    Params p; memset(&p, 0, sizeof(p));
    const float* const* in = (const float* const*)d_in;
    p.x = in[0]; p.mem = in[1]; p.pos = (const int*)d_in[2]; p.norm_mix = in[3]; p.w_in = in[4]; p.lam_re = in[5]; p.lam_im = in[6]; p.log_step = in[7]; p.b_re = in[8]; p.b_im = in[9];
    p.c_re = in[10]; p.c_im = in[11]; p.ssm_d = in[12]; p.w_glu = in[13]; p.b_glu = in[14]; p.q_norm = in[15]; p.w_uq = in[16]; p.kv_norm = in[17]; p.w_uk = in[18]; p.w_uv = in[19];
    p.w_up_ssm = in[20]; p.w_up_mla = in[21]; p.w_out = in[22]; p.norm_xattn = in[23]; p.norm_mem = in[24]; p.xa_wq = in[25]; p.xa_wk = in[26]; p.xa_wv = in[27]; p.xa_wo = in[28];
    p.norm_moe = in[29]; p.router_w = in[30]; p.router_b = in[31]; p.w_gu = in[32]; p.b_gu = in[33]; p.w_dn = in[34]; p.b_dn = in[35]; p.final_norm = in[36];
    p.out = (float*)d_out;
    size_t off = 0; unsigned char* ws = (unsigned char*)d_ws;
    auto take = [&](size_t bytes) { unsigned char* r = ws + off; off += (bytes + 4095) & ~(size_t)4095; return r; };
    p.ctl = (unsigned*)take(1 << 20);
    p.WinT = (bf16_t*)take((size_t)6144 * DM * 2); p.WkpeT = (bf16_t*)take((size_t)64 * DM * 2); p.WgluT = (bf16_t*)take((size_t)SSM_W * SSM_W * 2); p.WuqT = (bf16_t*)take((size_t)3072 * QL * 2);
    p.WukvT = (bf16_t*)take((size_t)4096 * KVL * 2); p.WupsT = (bf16_t*)take((size_t)DM * SSM_W * 2); p.WupmT = (bf16_t*)take((size_t)DM * DM * 2); p.WoutT = (bf16_t*)take((size_t)DM * DM * 2);
    p.WxqT = (bf16_t*)take((size_t)XW * DM * 2); p.WxkvT = (bf16_t*)take((size_t)2 * XW * DM * 2); p.WxoT = (bf16_t*)take((size_t)DM * XW * 2);
    p.WguT = (unsigned char*)take((size_t)NEXP * 2 * DFF * DM); p.WdnT = (unsigned char*)take((size_t)NEXP * DM * DFF); p.WrT = (float*)take((size_t)DM * NEXP * 4);
    p.hn = (bf16_t*)take((size_t)SEQ * DM * 2); p.memn = (bf16_t*)take((size_t)MEML * DM * 2); p.cosT = (float*)take((size_t)SEQ * 32 * 4); p.sinT = (float*)take((size_t)SEQ * 32 * 4);
    p.abar = (float*)take((size_t)SSM_G * SSM_P * 8); p.bbarT = (bf16_t*)take((size_t)SSM_G * 128 * 16 * 2); p.cmat = (bf16_t*)take((size_t)SSM_G * 16 * 128 * 2);
    p.ub = (bf16_t*)take((size_t)SEQ * SSM_W * 2); p.qa = (bf16_t*)take((size_t)SEQ * QL * 2); p.kva = (bf16_t*)take((size_t)SEQ * KVL * 2); p.qss = (float*)take((size_t)SEQ * 8 * 4); p.kvss = (float*)take((size_t)SEQ * 8 * 4);
    p.sgs = (bf16_t*)take((size_t)SEQ * DM * 2); p.sgm = (bf16_t*)take((size_t)SEQ * DM * 2); p.kpe = (bf16_t*)take((size_t)SEQ * DROPE * 2);
    p.qn = (bf16_t*)take((size_t)SEQ * DM * 2); p.qr = (bf16_t*)take((size_t)SEQ * NHEAD * DROPE * 2); p.kn = (bf16_t*)take((size_t)SEQ * DM * 2); p.vv = (bf16_t*)take((size_t)SEQ * DM * 2); p.ymla = (bf16_t*)take((size_t)SEQ * DM * 2);
    p.send = (float*)take((size_t)S5_NCH * SSM_G * 64 * 8); p.zb = (bf16_t*)take((size_t)SEQ * SSM_W * 2); p.ys = (bf16_t*)take((size_t)SEQ * SSM_W * 2); p.t1 = (bf16_t*)take((size_t)SEQ * DM * 2); p.mg = (bf16_t*)take((size_t)SEQ * DM * 2);
    p.x1 = nullptr; p.x1b = (bf16_t*)take((size_t)SEQ * DM * 2); p.ss1 = (float*)take((size_t)SEQ * 32 * 4);
    p.memkv = (bf16_t*)take((size_t)MEML * 2 * XW * 2); p.qx = (bf16_t*)take((size_t)SEQ * XW * 2); p.ox = (bf16_t*)take((size_t)SEQ * XW * 2);
    p.x2 = (bf16_t*)take((size_t)SEQ * DM * 2); p.ss2 = (float*)take((size_t)SEQ * 32 * 4);
    p.topi = (int*)take((size_t)SEQ * 4 * 4); p.topw = (float*)take((size_t)SEQ * 4 * 4); p.rank = (int*)take((size_t)SEQ * 4 * 4); p.slot = (int*)take((size_t)SEQ * 4 * 4); p.wgcnt = (int*)take((size_t)256 * 32 * 4); p.blke = (int*)take((size_t)(MAXBLK + 8) * 4);
    p.xg = (unsigned char*)take((size_t)NSLOT * DM); p.act = (unsigned char*)take((size_t)NSLOT * DFF); p.orow = (bf16_t*)take((size_t)NSLOT * DM * 2);
    if (off > ws_size) { fprintf(stderr, "kernel_launch: workspace too small: need %zu have %zu\n", off, ws_size); return; }
    (void)hipMemsetAsync(p.ctl, 0, 1 << 20, stream);
#if MK_ONE_LAUNCH
    p.ph_lo = 0; p.ph_hi = NPHASE;
    hipLaunchKernelGGL(hybrid_fwd, dim3(grid), dim3(NWAVES * 64), LDS_BYTES, stream, p);
#else
    for (int k = 0; k < NPHASE; ++k) { p.ph_lo = k; p.ph_hi = k + 1; hipLaunchKernelGGL(hybrid_fwd, dim3(grid), dim3(NWAVES * 64), LDS_BYTES, stream, p); }
#endif
}
```

```cpp
#include <hip/hip_runtime.h>
#include <cstdio>
#include <cstdint>
#include <cstring>

#define LAS __attribute__((address_space(3)))
#define GAS __attribute__((address_space(1)))
typedef unsigned short bf16_t;
typedef short bf16x8 __attribute__((ext_vector_type(8)));
typedef short s16x4 __attribute__((ext_vector_type(4)));
typedef float f32x4 __attribute__((ext_vector_type(4)));
typedef float f32x2 __attribute__((ext_vector_type(2)));
typedef float f32x16 __attribute__((ext_vector_type(16)));
typedef unsigned u32x4 __attribute__((ext_vector_type(4)));
typedef unsigned u32x2 __attribute__((ext_vector_type(2)));
typedef GAS unsigned gu32;

constexpr int SEQ = 16384, DM = 2048;
constexpr int SSM_W = 1024, SSM_G = 64, SSM_P = 64, SSM_H = 16;
constexpr int QL = 512, KVL = 512, NHEAD = 16, DNOPE = 128, DROPE = 64, DV = 128;
constexpr int IN_COLS = 6208;
constexpr int MEML = 256, XH = 4, XW = 512;
constexpr int NEXP = 32, TOPK = 4, DFF = 2048;
constexpr int NSLOT = SEQ * TOPK + NEXP * 256;
constexpr int MAXBLK = NSLOT / 256;
constexpr float EPS = 1e-6f;
constexpr int NWAVES = 8;

#define LDS_WAIT() asm volatile("s_waitcnt lgkmcnt(0)" ::: "memory")
#define VM_WAIT() asm volatile("s_waitcnt vmcnt(0)" ::: "memory")
#define SBAR() __builtin_amdgcn_sched_barrier(0)
__device__ __forceinline__ unsigned cvtpk(float lo, float hi) { unsigned r; asm volatile("v_cvt_pk_bf16_f32 %0, %1, %2" : "=v"(r) : "v"(lo), "v"(hi)); return r; }
__device__ __forceinline__ float bf2f(unsigned short b) { return __uint_as_float(((unsigned)b) << 16); }
__device__ __forceinline__ float bflo(unsigned w) { return __uint_as_float(w << 16); }
__device__ __forceinline__ float bfhi(unsigned w) { return __uint_as_float(w & 0xffff0000u); }
__device__ __forceinline__ unsigned short f2bf(float f) { return (unsigned short)(cvtpk(f, f) & 0xffffu); }
__device__ __forceinline__ u32x4 pack8f(f32x4 a, f32x4 b) { u32x4 w = {cvtpk(a[0], a[1]), cvtpk(a[2], a[3]), cvtpk(b[0], b[1]), cvtpk(b[2], b[3])}; return w; }
__device__ __forceinline__ void unpack8(u32x4 w, f32x4& a, f32x4& b) { a = (f32x4){bflo(w.x), bfhi(w.x), bflo(w.y), bfhi(w.y)}; b = (f32x4){bflo(w.z), bfhi(w.z), bflo(w.w), bfhi(w.w)}; }
__device__ __forceinline__ float fsigmoid(float x) { return __builtin_amdgcn_rcpf(1.0f + __builtin_amdgcn_exp2f(-1.4426950408889634f * x)); }
__device__ __forceinline__ float gelu_tanh(float x) {
    const float u = 0.7978845608028654f * (x + 0.044715f * x * x * x);
    return x * fsigmoid(2.0f * u);
}
__device__ __forceinline__ float wave_sum(float v) {
#pragma unroll
    for (int o = 1; o < 64; o <<= 1) v += __shfl_xor(v, o);
    return v;
}

#define XB_TMO      128
#define XB_XCNT(j)  (256  + 64 * (j))
#define XB_XSUB(j)  (1280 + 64 * (j))
#define XB_XGEN(j)  (2304 + 64 * (j))
#define XB_TOP      3328
#define XB_TOPGEN   3392
#define XCD_BAR_WORDS 3456
#define XB_SPIN_CAP (1u << 18)
__device__ __forceinline__ unsigned xb_ld(unsigned* p)              { return __hip_atomic_load(p, __ATOMIC_RELAXED, __HIP_MEMORY_SCOPE_AGENT); }
__device__ __forceinline__ unsigned xb_add(unsigned* p, unsigned v) { return __hip_atomic_fetch_add(p, v, __ATOMIC_RELAXED, __HIP_MEMORY_SCOPE_AGENT); }
__device__ __forceinline__ unsigned xb_xcc_id() { return (unsigned)__builtin_amdgcn_s_getreg((3 << 11) | 20) & 0xFu; }
#define XB_SPIN(cond, bar) do { unsigned _sp = 0; while (cond) { __builtin_amdgcn_s_sleep(1); \
    if ((++_sp & 255u) == 0u) { if (xb_ld(&(bar)[XB_TMO])) break; if (_sp > XB_SPIN_CAP) { atomicAdd(&(bar)[XB_TMO], 1u); break; } } } } while (0)
struct XcdBarrier { unsigned* bar; unsigned x; volatile LAS unsigned* st; };
__device__ __forceinline__ XcdBarrier xcd_barrier_post(unsigned* bar, volatile LAS unsigned* st) {
    XcdBarrier b; b.bar = bar; b.x = xb_xcc_id(); b.st = st;
    if (threadIdx.x == 0) (void)xb_add(&bar[XB_XCNT(b.x)], 1u);
    return b;
}
__device__ __forceinline__ void xcd_barrier_complete(unsigned* bar, unsigned x, unsigned& nloc, unsigned& nx) {
    const unsigned G = gridDim.x * gridDim.y * gridDim.z;
    unsigned sum, cnt, mine, sp = 0u;
    for (;;) {
        sum = 0u; cnt = 0u; mine = 0u;
#pragma unroll
        for (unsigned j = 0; j < 16; ++j) { const unsigned c = xb_ld(&bar[XB_XCNT(j)]); sum += c; cnt += (c > 0u) ? 1u : 0u; mine = (j == x) ? c : mine; }
        if (sum == G) break;
        __builtin_amdgcn_s_sleep(1);
        if ((++sp & 255u) == 0u) { if (xb_ld(&bar[XB_TMO])) break; if (sp > XB_SPIN_CAP) { atomicAdd(&bar[XB_TMO], 1u); break; } }
    }
    nloc = mine > 0u ? mine : 1u; nx = cnt > 0u ? cnt : 1u;
}
__device__ __forceinline__ void xcd_barrier(const XcdBarrier& b) {
    asm volatile("s_waitcnt vmcnt(0)" ::: "memory");
    __syncthreads();
    if (threadIdx.x == 0) {
        unsigned* bar = b.bar;
        __builtin_amdgcn_s_waitcnt(0);
        unsigned nloc = b.st[0], nx = b.st[1];
        if (nloc == 0u) { xcd_barrier_complete(bar, b.x, nloc, nx); b.st[0] = nloc; b.st[1] = nx; }
        const unsigned old = xb_add(&bar[XB_XSUB(b.x)], 1u);
        const unsigned gen = old / nloc;
        if (old + 1u == (gen + 1u) * nloc) {
            __builtin_amdgcn_fence(__ATOMIC_RELEASE, "agent");
            asm volatile("s_waitcnt vmcnt(0)" ::: "memory");
            const unsigned og = xb_add(&bar[XB_TOP], 1u);
            const unsigned tg = og / nx;
            if (og + 1u == (tg + 1u) * nx) xb_add(&bar[XB_TOPGEN], 1u);
            else XB_SPIN(xb_ld(&bar[XB_TOPGEN]) == tg, bar);
            __builtin_amdgcn_fence(__ATOMIC_ACQUIRE, "agent");
            xb_add(&bar[XB_XGEN(b.x)], 1u);
            asm volatile("s_waitcnt vmcnt(0)" ::: "memory");
        } else {
            XB_SPIN(xb_ld(&bar[XB_XGEN(b.x)]) == gen, bar);
            __builtin_amdgcn_fence(__ATOMIC_ACQUIRE, "agent");
            asm volatile("s_waitcnt vmcnt(0)" ::: "memory");
        }
    }
    __syncthreads();
}
namespace pg8 {
constexpr int BM = 256, BK = 64, HALF = 128, HTB = HALF * BK * 2, NXCD = 8, WGM = 8;
__host__ __device__ __forceinline__ int lds_byte(int r, int c) { const int st = (r >> 4) * 2 + (c >> 5), rr = r & 15, cc = c & 31, ob = rr * 64 + cc * 2; return st * 1024 + (ob ^ (((ob >> 9) & 1) << 5)); }
__host__ __device__ __forceinline__ void stage_rc(int b, int& R, int& C) { const int st = b / 1024, sb = b % 1024, swz = sb ^ (((sb >> 9) & 1) << 5); R = (st >> 1) * 16 + swz / 64; C = (st & 1) * 32 + (swz % 64) / 2; }
__host__ __device__ __forceinline__ int perm32(int rho) { const int n = rho >> 4, i = rho & 15; return 8 * (i >> 2) + 4 * n + (i & 3); }

struct Unit { int pm, pn, e; };
struct Gemm { const bf16_t* A; const bf16_t* Bt; int lda, ldb, K; size_t bstride; };

struct StaticOrder {
    int nM, nN, nwg, G, c;
    __device__ void init(int M, int N, int G_, int c_) { nM = M / BM; nN = N / BM; nwg = nM * nN; G = G_; c = c_; }
    __device__ bool next(int i, Unit& u) const {
        const long L = (long)i * G + c; if (L >= nwg) return false;
        int wgid = (int)L; { const int q = nwg / NXCD, r = nwg % NXCD, xcd = wgid % NXCD, off = wgid / NXCD; wgid = (xcd < r ? xcd * (q + 1) : r * (q + 1) + (xcd - r) * q) + off; }
        const int nig = WGM * nN, gid = wgid / nig, fm = gid * WGM, gsz = (nM - fm) < WGM ? (nM - fm) : WGM;
        u.pm = fm + ((wgid % nig) % gsz); u.pn = (wgid % nig) / gsz; u.e = 0; return true;
    }
};
struct MoeOrder {
    StaticOrder so; const int* blk_e;
    __device__ void init(int nblk, int N, int G_, int c_, const int* be) { so.nM = nblk; so.nN = N / BM; so.nwg = so.nM * so.nN; so.G = G_; so.c = c_; blk_e = be; }
    __device__ bool next(int i, Unit& u) const { if (!so.next(i, u)) return false; u.e = __builtin_amdgcn_readfirstlane(blk_e[u.pm]); return true; }
};

typedef int v4i_t __attribute__((ext_vector_type(4)));
typedef int v8i_t __attribute__((ext_vector_type(8)));
#define PG8_CAT8(a, b) __builtin_shufflevector(__builtin_bit_cast(v4i_t, a), __builtin_bit_cast(v4i_t, b), 0, 1, 2, 3, 4, 5, 6, 7)
template <class Epi, class Sched, bool F8 = false>
__device__ __forceinline__ void gemm_phase(LAS unsigned char* lds, const Gemm g, const Sched& S, const Epi& E) {
    constexpr bool ALIGN_EPI = true;
    const int tid = threadIdx.x, wid = __builtin_amdgcn_readfirstlane(tid >> 6), lane = tid & 63, wr = wid >> 2, wc = wid & 3, fr = lane & 15, fq = lane >> 4;
    const int K = g.K, nt = K / BK;
    unsigned voffA[2], voffB[2];
#pragma unroll
    for (int i = 0; i < 2; ++i) { int R, C; stage_rc(tid * 16 + i * 8192, R, C); const int Rb = Epi::PERM ? ((R & ~31) + perm32(R & 31)) : R;
        voffA[i] = (unsigned)(R * g.lda + C) * 2u; voffB[i] = (unsigned)(Rb * g.ldb + C) * 2u; }
    const size_t kstep = (size_t)(BK * 2);
    const size_t hstepA = (size_t)HALF * g.lda * 2, hstepB = (size_t)HALF * g.ldb * 2;
    const unsigned ldsw = (unsigned)wid * 1024u;
    const int aoff = lds_byte(wr * 64 + fr, fq * 8), boff = lds_byte(wc * 32 + fr, fq * 8);
#define PG8_SA(b, h) (((b) * 2 + (h)) * HTB)
#define PG8_SB(b, h) ((4 + (b) * 2 + (h)) * HTB)
#define PG8_STAGE(bufoff, gbase, voff) do { _Pragma("unroll") for (int _i = 0; _i < 2; ++_i) \
        __builtin_amdgcn_global_load_lds((const unsigned*)((const char*)(gbase) + (voff)[_i]), (LAS unsigned*)(lds + (bufoff) + ldsw + _i * 8192), 16, 0, 0); } while (0)
#define PG8_LDA(dst, b, h) do { _Pragma("unroll") for (int m = 0; m < 4; ++m) _Pragma("unroll") for (int k = 0; k < 2; ++k) dst[m][k] = *(const LAS bf16x8*)(lds + PG8_SA(b, h) + aoff + m * 2048 + k * 1024); } while (0)
#define PG8_LDB(dst, b, h) do { _Pragma("unroll") for (int n = 0; n < 2; ++n) _Pragma("unroll") for (int k = 0; k < 2; ++k) dst[n][k] = *(const LAS bf16x8*)(lds + PG8_SB(b, h) + boff + n * 2048 + k * 1024); } while (0)
#define PG8_MMA(ai, bj, At, Bt) do { __builtin_amdgcn_s_setprio(1); _Pragma("unroll") for (int m = 0; m < 4; ++m) _Pragma("unroll") for (int n = 0; n < 2; ++n) { \
        if constexpr (F8) { const v8i_t b8_ = PG8_CAT8(Bt[n][0], Bt[n][1]), a8_ = PG8_CAT8(At[m][0], At[m][1]); asm volatile("v_mfma_f32_16x16x128_f8f6f4 %0, %1, %2, %0" : "+v"(acc[ai][bj][m][n]) : "v"(b8_), "v"(a8_)); }   \
        else { _Pragma("unroll") for (int k = 0; k < 2; ++k) acc[ai][bj][m][n] = __builtin_amdgcn_mfma_f32_16x16x32_bf16(Bt[n][k], At[m][k], acc[ai][bj][m][n], 0, 0, 0); } } __builtin_amdgcn_s_setprio(0); } while (0)
#define PG8_WAIT_V(n) asm volatile("s_waitcnt vmcnt(" #n ")" ::: "memory")
#define PG8_WAIT_L(n) asm volatile("s_waitcnt lgkmcnt(" #n ")" ::: "memory")
#define PG8_BAR __builtin_amdgcn_s_barrier()
#define PG8_SCHED __builtin_amdgcn_sched_barrier(0)
#define PG8_ABASE(u) ((const char*)g.A + (size_t)(u).pm * BM * g.lda * 2)
#define PG8_BBASE(u) ((const char*)g.Bt + ((size_t)(u).e * g.bstride + (size_t)(u).pn * BM * g.ldb) * 2)
    Unit cur, nxt; int ui = 0;
    if (!S.next(0, cur)) return;
    f32x4 acc[2][2][4][2];
#pragma unroll
    for (int a = 0; a < 2; ++a)
#pragma unroll
        for (int b = 0; b < 2; ++b)
#pragma unroll
            for (int m = 0; m < 4; ++m)
#pragma unroll
                for (int n = 0; n < 2; ++n) acc[a][b][m][n] = (f32x4){0.f, 0.f, 0.f, 0.f};
    bf16x8 At[4][2], B0[2][2], B1[2][2];
    const char* cA = PG8_ABASE(cur); const char* cB = PG8_BBASE(cur);
    PG8_STAGE(PG8_SB(0, 0), cB, voffB); PG8_STAGE(PG8_SB(0, 1), cB + hstepB, voffB); PG8_STAGE(PG8_SA(0, 0), cA, voffA); PG8_STAGE(PG8_SA(0, 1), cA + hstepA, voffA);
    if (wr == 1) PG8_BAR;
    PG8_WAIT_V(2); PG8_BAR;
    PG8_STAGE(PG8_SB(1, 0), cB + kstep, voffB); PG8_STAGE(PG8_SA(1, 0), cA + kstep, voffA); PG8_STAGE(PG8_SB(1, 1), cB + hstepB + kstep, voffB);
    PG8_WAIT_V(6); PG8_BAR;
    for (;;) {
        const bool has_next = S.next(ui + 1, nxt);
        const char* nA = has_next ? PG8_ABASE(nxt) : cA; const char* nB = has_next ? PG8_BBASE(nxt) : cB;
        for (int t = 0; t < nt; t += 2) {
            const bool last = (t == nt - 2);
            const char* a1 = cA + (size_t)(t + 1) * kstep;
            const char* a2 = last ? nA : cA + (size_t)(t + 2) * kstep; const char* b2 = last ? nB : cB + (size_t)(t + 2) * kstep;
            const char* a3 = a2 + kstep; const char* b3 = b2 + kstep;
            PG8_LDB(B0, 0, 0); PG8_LDB(B1, 0, 1); PG8_SCHED; PG8_LDA(At, 0, 0); PG8_STAGE(PG8_SA(1, 1), a1 + hstepA, voffA);
            PG8_WAIT_V(8); PG8_WAIT_L(0); PG8_BAR; PG8_MMA(0, 0, At, B0); PG8_MMA(0, 1, At, B1); PG8_BAR; PG8_SCHED;
            PG8_LDA(At, 0, 1); PG8_STAGE(PG8_SB(0, 0), b2, voffB); PG8_STAGE(PG8_SB(0, 1), b2 + hstepB, voffB); PG8_STAGE(PG8_SA(0, 0), a2, voffA);
            PG8_WAIT_V(8); PG8_WAIT_L(0); PG8_BAR; PG8_MMA(1, 0, At, B0); PG8_MMA(1, 1, At, B1); PG8_BAR; PG8_SCHED;
            PG8_LDB(B0, 1, 0); PG8_LDB(B1, 1, 1); PG8_SCHED; PG8_LDA(At, 1, 0); PG8_STAGE(PG8_SA(0, 1), a2 + hstepA, voffA);
            PG8_WAIT_V(8); PG8_WAIT_L(0); PG8_BAR; PG8_MMA(0, 0, At, B0); PG8_MMA(0, 1, At, B1); PG8_BAR; PG8_SCHED;
            PG8_LDA(At, 1, 1); PG8_STAGE(PG8_SB(1, 0), b3, voffB); PG8_STAGE(PG8_SB(1, 1), b3 + hstepB, voffB); PG8_STAGE(PG8_SA(1, 0), a3, voffA);
            PG8_WAIT_V(8); PG8_WAIT_L(0); PG8_BAR; PG8_MMA(1, 0, At, B0); PG8_MMA(1, 1, At, B1); PG8_BAR; PG8_SCHED;
        }
        if constexpr (ALIGN_EPI) { if (wr == 0) PG8_BAR; }
        if constexpr (F8) asm volatile("s_nop 15\n\ts_nop 15\n\ts_nop 15" ::: "memory");
        E(acc, cur, wr, wc, fr, fq);
        if (!has_next) break;
#pragma unroll
        for (int a = 0; a < 2; ++a)
#pragma unroll
            for (int b = 0; b < 2; ++b)
#pragma unroll
                for (int m = 0; m < 4; ++m)
#pragma unroll
                    for (int n = 0; n < 2; ++n) acc[a][b][m][n] = (f32x4){0.f, 0.f, 0.f, 0.f};
        cur = nxt; cA = nA; cB = nB; ++ui;
        if constexpr (ALIGN_EPI) { if (wr == 1) PG8_BAR; }
    }
    PG8_WAIT_V(0);
    if constexpr (!ALIGN_EPI) { if (wr == 0) PG8_BAR; }
    PG8_BAR;
#undef PG8_SA
#undef PG8_SB
#undef PG8_STAGE
#undef PG8_LDA
#undef PG8_LDB
#undef PG8_MMA
#undef PG8_WAIT_V
#undef PG8_WAIT_L
#undef PG8_BAR
#undef PG8_SCHED
#undef PG8_ABASE
#undef PG8_BBASE
}

#define EPI_ROW(u, ai, m) ((u).pm * BM + (ai) * HALF + wr * 64 + (m) * 16 + fr)
#define EPI_CB(bj) ((bj) * HALF + wc * 32 + 8 * fq)
typedef f32x4 AccT[2][2][4][2];

__device__ __forceinline__ f32x4 sig4(f32x4 v) { return (f32x4){fsigmoid(v[0]), fsigmoid(v[1]), fsigmoid(v[2]), fsigmoid(v[3])}; }
__device__ __forceinline__ float sq4(f32x4 v) { return (v[0] * v[0] + v[1] * v[1]) + (v[2] * v[2] + v[3] * v[3]); }

struct EpiProj {
    static constexpr bool PERM = true;
    bf16_t *ub, *qa, *kva, *sgs, *sgm; float *qss, *kvss;
    __device__ __forceinline__ void operator()(const AccT& acc, const Unit& u, int wr, int wc, int fr, int fq) const {
        const int pn = u.pn; bf16_t* dst; int ld, c0; float* ss = nullptr; int ssl = 0; bool sg = false;
        if (pn < 4) { dst = ub; ld = SSM_W; c0 = pn * BM; }
        else if (pn < 6) { dst = qa; ld = QL; c0 = (pn - 4) * BM; ss = qss; ssl = (pn - 4) * 4 + wc; }
        else if (pn < 8) { dst = kva; ld = KVL; c0 = (pn - 6) * BM; ss = kvss; ssl = (pn - 6) * 4 + wc; }
        else if (pn < 16) { dst = sgs; ld = DM; c0 = (pn - 8) * BM; sg = true; }
        else { dst = sgm; ld = DM; c0 = (pn - 16) * BM; sg = true; }
#pragma unroll
        for (int ai = 0; ai < 2; ++ai)
#pragma unroll
            for (int m = 0; m < 4; ++m) { const int row = EPI_ROW(u, ai, m); float s = 0.f;
#pragma unroll
                for (int bj = 0; bj < 2; ++bj) { f32x4 v0 = acc[ai][bj][m][0], v1 = acc[ai][bj][m][1];
                    if (sg) { v0 = sig4(v0); v1 = sig4(v1); }
                    s += sq4(v0) + sq4(v1);
                    *(u32x4*)(dst + (size_t)row * ld + c0 + EPI_CB(bj)) = pack8f(v0, v1); }
                if (ss) { s += __shfl_xor(s, 16); s += __shfl_xor(s, 32); if (fq == 0) ss[((size_t)(ssl >> 2) * SEQ + row) * 4 + (ssl & 3)] = s; } }
    }
};
__device__ __forceinline__ float row_rs8(const float* ss, int row, float invn) { const f32x4 a = *(const f32x4*)(ss + (size_t)row * 4), b = *(const f32x4*)(ss + ((size_t)SEQ + row) * 4);
    return __builtin_amdgcn_rsqf(((a[0] + a[1]) + (a[2] + a[3]) + (b[0] + b[1]) + (b[2] + b[3])) * invn + EPS); }
__device__ __forceinline__ float row_rs32(const float* ss, int row, float invn) { float s = 0.f;
#pragma unroll
    for (int i = 0; i < 8; ++i) { const f32x4 a = *(const f32x4*)(ss + ((size_t)i * SEQ + row) * 4); s += (a[0] + a[1]) + (a[2] + a[3]); }
    return __builtin_amdgcn_rsqf(s * invn + EPS); }

struct EpiQup {
    static constexpr bool PERM = true;
    bf16_t *qn, *qr; const float *ss, *cosT, *sinT;
    __device__ __forceinline__ void operator()(const AccT& acc, const Unit& u, int wr, int wc, int fr, int fq) const {
        const int pn = u.pn;
#pragma unroll
        for (int ai = 0; ai < 2; ++ai)
#pragma unroll
            for (int m = 0; m < 4; ++m) { const int row = EPI_ROW(u, ai, m); const float rs = row_rs8(ss, row, 1.0f / QL);
                if (pn < 8) {
#pragma unroll
                    for (int bj = 0; bj < 2; ++bj) *(u32x4*)(qn + (size_t)row * DM + pn * BM + EPI_CB(bj)) = pack8f(acc[ai][bj][m][0] * rs, acc[ai][bj][m][1] * rs);
                } else {
                    const int head = 4 * (pn - 8) + wc;
                    const f32x4 c0 = *(const f32x4*)(cosT + (size_t)row * 32 + 8 * fq), c1 = *(const f32x4*)(cosT + (size_t)row * 32 + 8 * fq + 4);
                    const f32x4 s0 = *(const f32x4*)(sinT + (size_t)row * 32 + 8 * fq), s1 = *(const f32x4*)(sinT + (size_t)row * 32 + 8 * fq + 4);
                    const f32x4 a0 = acc[ai][0][m][0] * rs, a1 = acc[ai][0][m][1] * rs, b0 = acc[ai][1][m][0] * rs, b1 = acc[ai][1][m][1] * rs;
                    *(u32x4*)(qr + (size_t)row * (NHEAD * DROPE) + head * DROPE + 8 * fq) = pack8f(a0 * c0 - b0 * s0, a1 * c1 - b1 * s1);
                    *(u32x4*)(qr + (size_t)row * (NHEAD * DROPE) + head * DROPE + 32 + 8 * fq) = pack8f(a0 * s0 + b0 * c0, a1 * s1 + b1 * c1);
                } }
    }
};
struct EpiKVup {
    static constexpr bool PERM = true;
    bf16_t *kn, *vv; const float* ss;
    __device__ __forceinline__ void operator()(const AccT& acc, const Unit& u, int wr, int wc, int fr, int fq) const {
        bf16_t* dst = u.pn < 8 ? kn : vv; const int c0 = (u.pn & 7) * BM;
#pragma unroll
        for (int ai = 0; ai < 2; ++ai)
#pragma unroll
            for (int m = 0; m < 4; ++m) { const int row = EPI_ROW(u, ai, m); const float rs = row_rs8(ss, row, 1.0f / KVL);
#pragma unroll
                for (int bj = 0; bj < 2; ++bj) *(u32x4*)(dst + (size_t)row * DM + c0 + EPI_CB(bj)) = pack8f(acc[ai][bj][m][0] * rs, acc[ai][bj][m][1] * rs); }
    }
};
struct EpiPlain {
    static constexpr bool PERM = true;
    bf16_t* O; int ld;
    __device__ __forceinline__ void operator()(const AccT& acc, const Unit& u, int wr, int wc, int fr, int fq) const {
#pragma unroll
        for (int ai = 0; ai < 2; ++ai)
#pragma unroll
            for (int m = 0; m < 4; ++m) { const int row = EPI_ROW(u, ai, m);
#pragma unroll
                for (int bj = 0; bj < 2; ++bj) *(u32x4*)(O + (size_t)row * ld + u.pn * BM + EPI_CB(bj)) = pack8f(acc[ai][bj][m][0], acc[ai][bj][m][1]); }
    }
};
struct EpiGlu {
    static constexpr bool PERM = true;
    const bf16_t* z; const float* bias; bf16_t* ys;
    __device__ __forceinline__ void operator()(const AccT& acc, const Unit& u, int wr, int wc, int fr, int fq) const {
#pragma unroll
        for (int bj = 0; bj < 2; ++bj) { const int col = u.pn * BM + EPI_CB(bj); const f32x4 b0 = *(const f32x4*)(bias + col), b1 = *(const f32x4*)(bias + col + 4);
#pragma unroll
            for (int ai = 0; ai < 2; ++ai)
#pragma unroll
                for (int m = 0; m < 4; ++m) { const size_t off = (size_t)EPI_ROW(u, ai, m) * SSM_W + col; f32x4 z0, z1; unpack8(*(const u32x4*)(z + off), z0, z1);
                    *(u32x4*)(ys + off) = pack8f(z0 * sig4(acc[ai][bj][m][0] + b0), z1 * sig4(acc[ai][bj][m][1] + b1)); } }
    }
};
struct EpiGate {
    static constexpr bool PERM = true;
    const bf16_t* gate; const bf16_t* addend; bf16_t* O;
    __device__ __forceinline__ void operator()(const AccT& acc, const Unit& u, int wr, int wc, int fr, int fq) const {
#pragma unroll
        for (int ai = 0; ai < 2; ++ai)
#pragma unroll
            for (int m = 0; m < 4; ++m)
#pragma unroll
                for (int bj = 0; bj < 2; ++bj) { const size_t off = (size_t)EPI_ROW(u, ai, m) * DM + u.pn * BM + EPI_CB(bj); f32x4 g0, g1; unpack8(*(const u32x4*)(gate + off), g0, g1);
                    f32x4 r0 = g0 * acc[ai][bj][m][0], r1 = g1 * acc[ai][bj][m][1];
                    if (addend) { f32x4 t0, t1; unpack8(*(const u32x4*)(addend + off), t0, t1); r0 += t0; r1 += t1; }
                    *(u32x4*)(O + off) = pack8f(r0, r1); }
    }
};
template <class TI, bool WF32>
struct EpiResid {
    static constexpr bool PERM = true;
    const TI* xi; float* xo; bf16_t* xb; float* ss;
    __device__ __forceinline__ void operator()(const AccT& acc, const Unit& u, int wr, int wc, int fr, int fq) const {
#pragma unroll
        for (int ai = 0; ai < 2; ++ai)
#pragma unroll
            for (int m = 0; m < 4; ++m) { const int row = EPI_ROW(u, ai, m); float s = 0.f;
#pragma unroll
                for (int bj = 0; bj < 2; ++bj) { const size_t off = (size_t)row * DM + u.pn * BM + EPI_CB(bj); f32x4 r0, r1;
                    if constexpr (sizeof(TI) == 4) { r0 = *(const f32x4*)((const float*)xi + off); r1 = *(const f32x4*)((const float*)xi + off + 4); }
                    else unpack8(*(const u32x4*)((const bf16_t*)xi + off), r0, r1);
                    r0 += acc[ai][bj][m][0]; r1 += acc[ai][bj][m][1];
                    if constexpr (WF32) { *(f32x4*)(xo + off) = r0; *(f32x4*)(xo + off + 4) = r1; }
                    s += sq4(r0) + sq4(r1);
                    if (xb) *(u32x4*)(xb + off) = pack8f(r0, r1); }
                s += __shfl_xor(s, 16); s += __shfl_xor(s, 32); if (fq == 0) ss[((size_t)u.pn * SEQ + row) * 4 + wc] = s; }
    }
};
struct EpiXq {
    static constexpr bool PERM = true;
    bf16_t* O; const float* ss;
    __device__ __forceinline__ void operator()(const AccT& acc, const Unit& u, int wr, int wc, int fr, int fq) const {
#pragma unroll
        for (int ai = 0; ai < 2; ++ai)
#pragma unroll
            for (int m = 0; m < 4; ++m) { const int row = EPI_ROW(u, ai, m); const float rs = row_rs32(ss, row, 1.0f / DM);
#pragma unroll
                for (int bj = 0; bj < 2; ++bj) *(u32x4*)(O + (size_t)row * XW + u.pn * BM + EPI_CB(bj)) = pack8f(acc[ai][bj][m][0] * rs, acc[ai][bj][m][1] * rs); }
    }
};
constexpr float F8_XS = 8.0f, F8_WS = 512.0f, F8_AS = 4.0f;
__device__ __forceinline__ unsigned pk4_fp8(float a, float b, float c, float d) {
    a = fminf(fmaxf(a, -448.f), 448.f); b = fminf(fmaxf(b, -448.f), 448.f); c = fminf(fmaxf(c, -448.f), 448.f); d = fminf(fmaxf(d, -448.f), 448.f);
    int w = __builtin_amdgcn_cvt_pk_fp8_f32(a, b, 0, false); w = __builtin_amdgcn_cvt_pk_fp8_f32(c, d, w, true); return (unsigned)w; }
struct EpiMoeGU {
    static constexpr bool PERM = true;
    const float* bias; unsigned char* act;
    __device__ __forceinline__ void operator()(const AccT& acc, const Unit& u, int wr, int wc, int fr, int fq) const {
        const int j0 = u.pn * HALF + wc * 32 + 8 * fq; const float* bg = bias + (size_t)u.e * (2 * DFF) + j0; constexpr float SC = 1.0f / (F8_XS * F8_WS);
        const f32x4 g0 = *(const f32x4*)bg, g1 = *(const f32x4*)(bg + 4), u0 = *(const f32x4*)(bg + DFF), u1 = *(const f32x4*)(bg + DFF + 4);
#pragma unroll
        for (int ai = 0; ai < 2; ++ai)
#pragma unroll
            for (int m = 0; m < 4; ++m) { const int row = EPI_ROW(u, ai, m); f32x4 r[2];
#pragma unroll
                for (int n = 0; n < 2; ++n) { const f32x4 gt = acc[ai][0][m][n] * SC + (n ? g1 : g0), up = acc[ai][1][m][n] * SC + (n ? u1 : u0);
#pragma unroll
                    for (int j = 0; j < 4; ++j) { const float gc = fminf(gt[j], 7.0f), uc = fminf(fmaxf(up[j], -7.0f), 7.0f); r[n][j] = F8_AS * (uc + 1.0f) * (gc * fsigmoid(1.702f * gc)); } }
                u32x2 o = {pk4_fp8(r[0][0], r[0][1], r[0][2], r[0][3]), pk4_fp8(r[1][0], r[1][1], r[1][2], r[1][3])};
                *(u32x2*)(act + (size_t)row * DFF + j0) = o; }
    }
};
struct EpiMoeDown {
    static constexpr bool PERM = true;
    const float* bias; bf16_t* O;
    __device__ __forceinline__ void operator()(const AccT& acc, const Unit& u, int wr, int wc, int fr, int fq) const {
#pragma unroll
        for (int bj = 0; bj < 2; ++bj) { const int col = u.pn * BM + EPI_CB(bj); const float* bp = bias + (size_t)u.e * DM + col; const f32x4 b0 = *(const f32x4*)bp, b1 = *(const f32x4*)(bp + 4); constexpr float SC = 1.0f / (F8_AS * F8_WS);
#pragma unroll
            for (int ai = 0; ai < 2; ++ai)
#pragma unroll
                for (int m = 0; m < 4; ++m) *(u32x4*)(O + (size_t)EPI_ROW(u, ai, m) * DM + col) = pack8f(acc[ai][bj][m][0] * SC + b0, acc[ai][bj][m][1] * SC + b1); }
    }
};
#undef EPI_ROW
#undef EPI_CB
}
namespace att {
constexpr int NW = 8, QBLK = 32, KVBLK = 64, QB = NW * QBLK;
constexpr int SHM_V = KVBLK * 128 * 2, SHM_K = KVBLK * 128 * 2, SHM_KR = KVBLK * 64 * 2;
constexpr int OFF_V = 0, OFF_K = 2 * SHM_V, OFF_KR = OFF_K + 2 * SHM_K, OFF_WS = OFF_KR + 2 * SHM_KR, OFF_QR = OFF_WS + NW * 64 * 4, LDS_BYTES = OFF_QR + NW * 8192;
constexpr float THR = 8.f;
#define KSWZ(row, colB) ((row) * 256 + ((colB) ^ (((row) & 7) << 4)))
__device__ __forceinline__ int v_st(int k, int c) { const int kk = (k & ~0xC) | ((k & 4) << 1) | ((k & 8) >> 1); return ((kk >> 3) * 4 + (c >> 5)) * 512 + ((kk & 7) * 32 + (c & 31)) * 2; }
__device__ __forceinline__ int v_rd_base(int lane) { return ((lane & 3) << 3) | (((lane >> 2) & 3) << 6) | (((lane >> 4) & 1) << 5) | (((lane >> 5) & 1) << 8); }
constexpr int v_rd_off(int d0, int ks, int half) { return d0 * 512 + ks * 4096 + half * 2048; }
__device__ __forceinline__ int crow(int r, int hi) { return (r & 3) + 8 * (r >> 2) + 4 * hi; }

__device__ __forceinline__ void mask_tile(f32x16& p0, f32x16& p1, int dq) {
    const float NEG = -__builtin_inff();
#pragma unroll
    for (int r = 0; r < 16; ++r) {
        const int c = (r & 3) + 8 * (r >> 2);
        if (dq - c < 0) p0[r] = NEG;
        if (dq - c - 32 < 0) p1[r] = NEG;
    }
}
template <bool ROPE>
__device__ __forceinline__ void partialSM(f32x16& p0, f32x16& p1, float& m_reg, float& mn, float& alpha) {
    constexpr float SCALE = ROPE ? 0.07216878364870323f : 0.08838834764831845f;
    float pmax = p0[0];
#pragma unroll
    for (int r = 1; r < 16; ++r) pmax = fmaxf(pmax, p0[r]);
#pragma unroll
    for (int r = 0; r < 16; ++r) pmax = fmaxf(pmax, p1[r]);
    { auto rr = __builtin_amdgcn_permlane32_swap(__float_as_uint(pmax), __float_as_uint(pmax), false, false);
      pmax = fmaxf(__uint_as_float(rr[0]), __uint_as_float(rr[1])); }
    constexpr float C2 = 1.4426950408889634f * SCALE;
    if (__builtin_expect(__all((pmax - m_reg) * SCALE <= THR), 1)) { mn = m_reg; alpha = 1.f; }
    else { mn = fmaxf(m_reg, pmax); alpha = __builtin_amdgcn_exp2f((m_reg - mn) * C2); m_reg = mn; }
    const float mnL = -mn * C2;
#pragma unroll
    for (int r = 0; r < 16; ++r) p0[r] = fmaf(p0[r], C2, mnL);
#pragma unroll
    for (int r = 0; r < 16; ++r) p1[r] = fmaf(p1[r], C2, mnL);
#pragma unroll
    for (int r = 0; r < 16; ++r) p0[r] = __builtin_amdgcn_exp2f(p0[r]);
}
__device__ __forceinline__ void finishSM(f32x16& p0, f32x16& p1, float alpha, float& l_reg, bf16x8& pa0, bf16x8& pa1, bf16x8& pa2, bf16x8& pa3) {
#pragma unroll
    for (int r = 0; r < 16; ++r) p1[r] = __builtin_amdgcn_exp2f(p1[r]);
    float ps = 0;
#pragma unroll
    for (int r = 0; r < 16; ++r) ps += p0[r];
#pragma unroll
    for (int r = 0; r < 16; ++r) ps += p1[r];
    { auto rr = __builtin_amdgcn_permlane32_swap(__float_as_uint(ps), __float_as_uint(ps), false, false);
      ps = __uint_as_float(rr[0]) + __uint_as_float(rr[1]); }
    l_reg = l_reg * alpha + ps;
#define PK4(P, B_, OUT) do { unsigned a0 = cvtpk(P[B_+0], P[B_+1]), a1 = cvtpk(P[B_+2], P[B_+3]);                          \
        unsigned b0 = cvtpk(P[B_+4], P[B_+5]), b1 = cvtpk(P[B_+6], P[B_+7]);                                             \
        auto r0 = __builtin_amdgcn_permlane32_swap(a0, b0, false, false); auto r1 = __builtin_amdgcn_permlane32_swap(a1, b1, false, false); \
        u32x4 w = {r0[0], r1[0], r0[1], r1[1]}; OUT = *reinterpret_cast<bf16x8*>(&w); } while (0)
    PK4(p0, 0, pa0); PK4(p0, 8, pa1); PK4(p1, 0, pa2); PK4(p1, 8, pa3);
#undef PK4
}
template <int KB, bool ROPE>
__device__ __forceinline__ void qkt(f32x16& p0, f32x16& p1, const char* K_lds, int r32, int hi, const bf16x8* qr, const char* qrl) {
    p0 = f32x16{}; p1 = f32x16{};
    const char* kb[4];
#pragma unroll
    for (int dd = 0; dd < 4; ++dd) kb[dd] = K_lds + KB * SHM_K + KSWZ(r32, (dd * 16 + hi * 8) * 2);
#pragma unroll
    for (int d0 = 0; d0 < 8; ++d0) { const char* a = kb[d0 & 3] + (d0 >> 2) * 128;
        bf16x8 b0 = *reinterpret_cast<const bf16x8*>(a);
        bf16x8 b1 = *reinterpret_cast<const bf16x8*>(a + 32 * 256);
        p0 = __builtin_amdgcn_mfma_f32_32x32x16_bf16(b0, qr[d0], p0, 0, 0, 0);
        p1 = __builtin_amdgcn_mfma_f32_32x32x16_bf16(b1, qr[d0], p1, 0, 0, 0); }
    if constexpr (ROPE) {
        constexpr int RO = 2 * SHM_K - KB * SHM_K + KB * SHM_KR;
#pragma unroll
        for (int d0 = 0; d0 < 4; ++d0) { const char* a = kb[d0] + RO;
            bf16x8 b0 = *reinterpret_cast<const bf16x8*>(a);
            bf16x8 b1 = *reinterpret_cast<const bf16x8*>(a + 128);
            const bf16x8 q = *reinterpret_cast<const bf16x8*>(qrl + d0 * 1024);
            p0 = __builtin_amdgcn_mfma_f32_32x32x16_bf16(b0, q, p0, 0, 0, 0);
            p1 = __builtin_amdgcn_mfma_f32_32x32x16_bf16(b1, q, p1, 0, 0, 0); }
    }
}
template <int VB>
__device__ __forceinline__ void pv_tile(f32x16* o, int vb0, bf16x8 pa0, bf16x8 pa1, bf16x8 pa2, bf16x8 pa3) {
#define TRRD(dst, off) asm volatile("ds_read_b64_tr_b16 %0, %1 offset:%2" : "=&v"(dst) : "v"(vb0), "i"(off) : "memory")
#define PV_D0(d0) do { s16x4 l0, l1, l2, l3, h0, h1, h2, h3; constexpr int b_ = VB * SHM_V + v_rd_off(d0, 0, 0);  \
        TRRD(l0, b_); TRRD(h0, b_ + 2048); TRRD(l1, b_ + 4096); TRRD(h1, b_ + 6144); TRRD(l2, b_ + 8192); TRRD(h2, b_ + 10240); TRRD(l3, b_ + 12288); TRRD(h3, b_ + 14336); \
        asm volatile("s_waitcnt lgkmcnt(0)" ::: "memory"); SBAR();   \
        o[d0] = __builtin_amdgcn_mfma_f32_32x32x16_bf16(pa0, (bf16x8){l0[0], l0[1], l0[2], l0[3], h0[0], h0[1], h0[2], h0[3]}, o[d0], 0, 0, 0);   \
        o[d0] = __builtin_amdgcn_mfma_f32_32x32x16_bf16(pa1, (bf16x8){l1[0], l1[1], l1[2], l1[3], h1[0], h1[1], h1[2], h1[3]}, o[d0], 0, 0, 0);   \
        o[d0] = __builtin_amdgcn_mfma_f32_32x32x16_bf16(pa2, (bf16x8){l2[0], l2[1], l2[2], l2[3], h2[0], h2[1], h2[2], h2[3]}, o[d0], 0, 0, 0);   \
        o[d0] = __builtin_amdgcn_mfma_f32_32x32x16_bf16(pa3, (bf16x8){l3[0], l3[1], l3[2], l3[3], h3[0], h3[1], h3[2], h3[3]}, o[d0], 0, 0, 0); } while (0)
    PV_D0(0); PV_D0(1); PV_D0(2); PV_D0(3);
#undef PV_D0
#undef TRRD
}

struct BlockRef { const bf16_t* Q; const bf16_t* QR; const bf16_t* K; const bf16_t* KR; const bf16_t* V; bf16_t* O; int P0; };
struct Strides { int qs, qrs, ks, vs, os, skv; };
template <bool ROPE> struct Seam { bf16x8 qr[ROPE ? 12 : 8];     bf16x8 st_v0, st_v1, st_k0, st_k1, st_kr; };
#define LD8(p) (*reinterpret_cast<const bf16x8*>(p))
#define VMW() asm volatile("s_waitcnt vmcnt(0)" ::: "memory")
#define VMWN(n) asm volatile("s_waitcnt vmcnt(%0)" :: "i"(n) : "memory")
#define SLOAD_H(R, k0) do { const char* vb_ = (const char*)(R).V + (size_t)(k0) * T.vs * 2; const char* kb_ = (const char*)(R).K + (size_t)(k0) * T.ks * 2;   \
                            S.st_v0 = LD8(vb_ + vo_v); S.st_v1 = LD8(vb_ + (size_t)T.vs * 64 + vo_v);              \
                            S.st_k0 = LD8(kb_ + vo_k); S.st_k1 = LD8(kb_ + (size_t)T.ks * 64 + vo_k);              \
                            if constexpr (ROPE) S.st_kr = LD8((const char*)(R).KR + (size_t)(k0) * (DROPE * 2) + vo_kr); } while (0)
#define SWRITE_HK(bf) do { *(bf16x8*)(K_lds + (bf) * SHM_K + kws) = S.st_k0; *(bf16x8*)(K_lds + (bf) * SHM_K + kws + 32 * 256) = S.st_k1;                \
                           if constexpr (ROPE) *(bf16x8*)(K_lds + 2 * SHM_K + (bf) * SHM_KR + krws) = S.st_kr; } while (0)
#define SWRITE_HV(bf) do { *(bf16x8*)(V_lds + (bf) * SHM_V + vst0) = S.st_v0; *(bf16x8*)(V_lds + (bf) * SHM_V + vst1) = S.st_v1; } while (0)
#define SWRITE_H(bf) do { SWRITE_HV(bf); SWRITE_HK(bf); } while (0)
#define QLOAD(R) do { const char* qb_ = (const char*)(R).Q + (size_t)(wid * QBLK) * T.qs * 2; const unsigned qo_ = (unsigned)(r32 * T.qs + hi * 8) * 2u;    \
                      _Pragma("unroll") for (int d0 = 0; d0 < 8; ++d0) S.qr[d0] = LD8(qb_ + qo_ + d0 * 32);    \
                      if constexpr (ROPE) { const char* qrb_ = (const char*)(R).QR + (size_t)(wid * QBLK) * T.qrs * 2; const unsigned qro_ = (unsigned)(r32 * T.qrs + hi * 8) * 2u;   \
                          _Pragma("unroll") for (int d0 = 0; d0 < 4; ++d0) S.qr[8 + d0] = LD8(qrb_ + qro_ + d0 * 32); } } while (0)
#define QPARK() do { if constexpr (ROPE) { _Pragma("unroll") for (int d0 = 0; d0 < 4; ++d0) *(bf16x8*)(qrl + d0 * 1024) = S.qr[8 + d0]; } } while (0)
#define QPARK8() do { _Pragma("unroll") for (int d0 = 0; d0 < (ROPE ? 8 : 4); ++d0) *(bf16x8*)(qrl + d0 * 1024) = S.qr[4 + d0]; } while (0)
#define STAGE_IDX() const int sr = tid >> 4, sc = (tid & 15) * 8, kws = KSWZ(sr, sc * 2); \
                    const int rk = tid >> 3, rc = tid & 7, krws = (rk & 31) * 256 + ((((rk >> 5) * 8 + rc) * 16) ^ (((rk & 31) & 7) << 4)); \
                    const unsigned vo_v = (unsigned)(sr * T.vs + sc) * 2u, vo_k = (unsigned)(sr * T.ks + sc) * 2u, vo_kr = (unsigned)(rk * DROPE + rc * 8) * 2u

template <bool ROPE, bool CAUSAL>
__device__ __forceinline__ void attn_prime(const BlockRef& cur, const Strides& T, char* lds, Seam<ROPE>& S) {
    const int tid = threadIdx.x, wid = __builtin_amdgcn_readfirstlane(tid >> 6), lane = tid & 63, r32 = lane & 31, hi = lane >> 5;
    STAGE_IDX(); char* K_lds = lds + OFF_K; char* qrl = lds + OFF_QR + wid * 4096 + lane * 16;
    QLOAD(cur);
    SLOAD_H(cur, 0); VMW(); SWRITE_HK(0); QPARK();
    __syncthreads();
}
template <bool ROPE, bool CAUSAL>
__device__ __forceinline__ void attn_block(const BlockRef& cur, const BlockRef& nxt, const Strides& T, char* lds, Seam<ROPE>& S) {
    const int tid = threadIdx.x, wid = __builtin_amdgcn_readfirstlane(tid >> 6), lane = tid & 63, r32 = lane & 31, hi = lane >> 5;
    int j_hi = CAUSAL ? (cur.P0 + QB - 1) / KVBLK + 1 : T.skv / KVBLK; if (j_hi > T.skv / KVBLK) j_hi = T.skv / KVBLK;
    const int NT = j_hi;
    const int qlo = cur.P0 + wid * QBLK, qm = qlo + r32 - 4 * hi;
    char* V_lds = lds + OFF_V; char* K_lds = lds + OFF_K; char* qrl = lds + OFF_QR + wid * 4096 + lane * 16;
    float* ws = (float*)(lds + OFF_WS) + wid * 64; float* li_l = ws, * al_l = ws + 32;
    float m_reg = -1e30f, l_reg = 0; f32x16 o[4] = {};
    STAGE_IDX(); const int vst0 = v_st(sr, sc), vst1 = v_st(32 + sr, sc);
    const int vb0 = (int)(uintptr_t)V_lds + v_rd_base(lane);
#define RESC(a) do { if (__any((a) < 1.f)) { if (hi == 0) al_l[r32] = (a); asm volatile("s_waitcnt lgkmcnt(0)" ::: "memory");              \
                     for (int d_ = 0; d_ < 4; ++d_) for (int r = 0; r < 16; ++r) o[d_][r] *= al_l[crow(r, hi)]; } } while (0)
#define KBASE(t) ((t) * KVBLK)
#define MASKT(P0_, P1_, t) do { if constexpr (CAUSAL) { const int kb_ = KBASE(t); if (kb_ + KVBLK - 1 > qlo) mask_tile(P0_, P1_, qm - kb_); } } while (0)
    constexpr int NQL = ROPE ? 12 : 8;
#define SEAM_K0() do { VMWN(NQL); SWRITE_HK(0); SBAR(); } while (0)
    f32x16 pA0, pA1, pB0, pB1; float mnA, mnB, alA, alB; bf16x8 pa0, pa1, pa2, pa3;
    SWRITE_HV(0); SBAR();
    if (NT > 1) { SLOAD_H(cur, KBASE(1)); }
    SBAR(); qkt<0, ROPE>(pA0, pA1, K_lds, r32, hi, S.qr, qrl);
    MASKT(pA0, pA1, 0); partialSM<ROPE>(pA0, pA1, m_reg, mnA, alA);
    if (NT > 1) { VMW(); SWRITE_H(1); }
    __syncthreads();
#define HALF_STEP(PX0, PX1, mnX, alX, PY0, PY1, alY, t, KB, VB, SB) do {                                                      \
        SBAR(); qkt<KB, ROPE>(PX0, PX1, K_lds, r32, hi, S.qr, qrl);                                                                \
        finishSM(PY0, PY1, alY, l_reg, pa0, pa1, pa2, pa3); SBAR();                                                           \
        if ((t) + 1 < NT) { SLOAD_H(cur, KBASE((t) + 1)); SBAR(); }                                                           \
        pv_tile<VB>(o, vb0, pa0, pa1, pa2, pa3); MASKT(PX0, PX1, (t)); partialSM<ROPE>(PX0, PX1, m_reg, mnX, alX);            \
        __syncthreads();                                                                                                      \
        if ((t) + 1 < NT) { VMW(); SWRITE_H(SB); }                                                                            \
        RESC(alX); __syncthreads(); } while (0)
    for (int t = 1; t + 1 < NT; t += 2) {
        HALF_STEP(pB0, pB1, mnB, alB, pA0, pA1, alA, t, 1, 0, 0);
        HALF_STEP(pA0, pA1, mnA, alA, pB0, pB1, alB, t + 1, 0, 1, 1);
    }
    const bool even = (NT & 1) == 0;
    if (even) { SBAR(); qkt<1, ROPE>(pB0, pB1, K_lds, r32, hi, S.qr, qrl); SBAR(); }
    SLOAD_H(nxt, 0); SBAR();
    QLOAD(nxt);
    SBAR();
    finishSM(pA0, pA1, alA, l_reg, pa0, pa1, pa2, pa3); SBAR();
    pv_tile<0>(o, vb0, pa0, pa1, pa2, pa3);
    if (even) { MASKT(pB0, pB1, NT - 1); partialSM<ROPE>(pB0, pB1, m_reg, mnB, alB); __syncthreads(); RESC(alB);
        finishSM(pB0, pB1, alB, l_reg, pa0, pa1, pa2, pa3); SBAR(); pv_tile<1>(o, vb0, pa0, pa1, pa2, pa3); }
    SBAR(); SEAM_K0();
    if (hi == 0) li_l[r32] = l_reg; asm volatile("s_waitcnt lgkmcnt(0)" ::: "memory");
    float rli[16];
#pragma unroll
    for (int r = 0; r < 16; ++r) rli[r] = __builtin_amdgcn_rcpf(li_l[crow(r, hi)]);
    bf16_t* Ow = cur.O + (size_t)(wid * QBLK) * T.os;
#pragma unroll
    for (int r = 0; r < 16; ++r) { const int orow = crow(r, hi);
#pragma unroll
        for (int d0 = 0; d0 < 4; ++d0) { const float v = o[d0][r] * rli[r];
            const float vn = __shfl_xor(v, 1);
            if ((r32 & 1) == 0) *(unsigned*)(Ow + (size_t)orow * T.os + d0 * 32 + r32) = cvtpk(v, vn); } }
    QPARK();
    __syncthreads();
#undef RESC
#undef KBASE
#undef MASKT
#undef SEAM_K0
#undef HALF_STEP
}

template <bool ROPE>
__device__ __forceinline__ void qkt_rt(f32x16& p0, f32x16& p1, const char* K_lds, int buf, const int (&koff)[4], const bf16x8* qr, const char* qrl) {
    p0 = f32x16{}; p1 = f32x16{};
    const char* kbase = K_lds + buf * SHM_K;
#pragma unroll
    for (int d0 = 0; d0 < 8; ++d0) { const char* a = kbase + koff[d0 & 3] + (d0 >> 2) * 128;
        bf16x8 b0 = *reinterpret_cast<const bf16x8*>(a);
        bf16x8 b1 = *reinterpret_cast<const bf16x8*>(a + 32 * 256);
        p0 = __builtin_amdgcn_mfma_f32_32x32x16_bf16(b0, qr[d0], p0, 0, 0, 0);
        p1 = __builtin_amdgcn_mfma_f32_32x32x16_bf16(b1, qr[d0], p1, 0, 0, 0); }
    if constexpr (ROPE) {
        const char* rbase = K_lds + 2 * SHM_K + buf * SHM_KR;
#pragma unroll
        for (int d0 = 0; d0 < 4; ++d0) { const char* a = rbase + koff[d0];
            bf16x8 b0 = *reinterpret_cast<const bf16x8*>(a);
            bf16x8 b1 = *reinterpret_cast<const bf16x8*>(a + 128);
            const bf16x8 q = *reinterpret_cast<const bf16x8*>(qrl + d0 * 1024);
            p0 = __builtin_amdgcn_mfma_f32_32x32x16_bf16(b0, q, p0, 0, 0, 0);
            p1 = __builtin_amdgcn_mfma_f32_32x32x16_bf16(b1, q, p1, 0, 0, 0); }
    }
}
template <bool ROPE, bool CAUSAL>
__device__ __forceinline__ void attn_block_simple(const BlockRef& cur, const Strides& T, char* lds) {
    const int tid = threadIdx.x, wid = __builtin_amdgcn_readfirstlane(tid >> 6), lane = tid & 63, r32 = lane & 31, hi = lane >> 5;
    int j_hi = CAUSAL ? (cur.P0 + QB - 1) / KVBLK + 1 : T.skv / KVBLK; if (j_hi > T.skv / KVBLK) j_hi = T.skv / KVBLK;
    const int NT = j_hi;
    const int qlo = cur.P0 + wid * QBLK, qm = qlo + r32 - 4 * hi;
    char* V_lds = lds + OFF_V; char* K_lds = lds + OFF_K;
    float* ws = (float*)(lds + OFF_WS) + wid * 64; float* li_l = ws, * al_l = ws + 32;
    float m_reg = -1e30f, l_reg = 0; f32x16 o[4] = {};
    STAGE_IDX(); const int vst0 = v_st(sr, sc), vst1 = v_st(32 + sr, sc);
    const int vb0 = (int)(uintptr_t)V_lds + v_rd_base(lane);
    int koff[4];
#pragma unroll
    for (int dd = 0; dd < 4; ++dd) koff[dd] = KSWZ(r32, (dd * 16 + hi * 8) * 2);
    Seam<ROPE> S; char* qrl = lds + OFF_QR + wid * 4096 + lane * 16;
    QLOAD(cur);
    SLOAD_H(cur, 0); VMW(); SWRITE_H(0); QPARK();
    __syncthreads();
    for (int t = 0; t < NT; ++t) {
        const int buf = t & 1;
        if (t + 1 < NT) { SLOAD_H(cur, (t + 1) * KVBLK); }
        SBAR();
        f32x16 p0, p1; qkt_rt<ROPE>(p0, p1, K_lds, buf, koff, S.qr, qrl);
        if constexpr (CAUSAL) { const int kb_ = t * KVBLK; if (kb_ + KVBLK - 1 > qlo) mask_tile(p0, p1, qm - kb_); }
        float mn, al; partialSM<ROPE>(p0, p1, m_reg, mn, al);
        if (__any(al < 1.f)) { if (hi == 0) al_l[r32] = al; asm volatile("s_waitcnt lgkmcnt(0)" ::: "memory");
            for (int d_ = 0; d_ < 4; ++d_) for (int r = 0; r < 16; ++r) o[d_][r] *= al_l[crow(r, hi)]; }
        bf16x8 pa0, pa1, pa2, pa3; finishSM(p0, p1, al, l_reg, pa0, pa1, pa2, pa3); SBAR();
        pv_tile<0>(o, vb0 + buf * SHM_V, pa0, pa1, pa2, pa3);
        if (t + 1 < NT) { VMW(); SWRITE_H(buf ^ 1); }
        __syncthreads();
    }
    if (hi == 0) li_l[r32] = l_reg; asm volatile("s_waitcnt lgkmcnt(0)" ::: "memory");
    float rli[16];
#pragma unroll
    for (int r = 0; r < 16; ++r) rli[r] = __builtin_amdgcn_rcpf(li_l[crow(r, hi)]);
    bf16_t* Ow = cur.O + (size_t)(wid * QBLK) * T.os;
#pragma unroll
    for (int r = 0; r < 16; ++r) { const int orow = crow(r, hi);
#pragma unroll
        for (int d0 = 0; d0 < 4; ++d0) { const float v = o[d0][r] * rli[r];
            const float vn = __shfl_xor(v, 1);
            if ((r32 & 1) == 0) *(unsigned*)(Ow + (size_t)orow * T.os + d0 * 32 + r32) = cvtpk(v, vn); } }
    __syncthreads();
}


template <bool ROPE>
__device__ __forceinline__ void qkt_rt8(f32x16& p0, f32x16& p1, const char* K_lds, int buf, const int (&koff)[4], const bf16x8* qr, const char* qrl) {
    p0 = f32x16{}; p1 = f32x16{};
    const char* kbase = K_lds + buf * SHM_K;
#pragma unroll
    for (int d0 = 0; d0 < 8; ++d0) { const char* a = kbase + koff[d0 & 3] + (d0 >> 2) * 128;
        bf16x8 b0 = *reinterpret_cast<const bf16x8*>(a);
        bf16x8 b1 = *reinterpret_cast<const bf16x8*>(a + 32 * 256);
        const bf16x8 q = d0 < 4 ? qr[d0] : *reinterpret_cast<const bf16x8*>(qrl + (d0 - 4) * 1024);
        p0 = __builtin_amdgcn_mfma_f32_32x32x16_bf16(b0, q, p0, 0, 0, 0);
        p1 = __builtin_amdgcn_mfma_f32_32x32x16_bf16(b1, q, p1, 0, 0, 0); }
    if constexpr (ROPE) {
        const char* rbase = K_lds + 2 * SHM_K + buf * SHM_KR;
#pragma unroll
        for (int d0 = 0; d0 < 4; ++d0) { const char* a = rbase + koff[d0];
            bf16x8 b0 = *reinterpret_cast<const bf16x8*>(a);
            bf16x8 b1 = *reinterpret_cast<const bf16x8*>(a + 128);
            const bf16x8 q = *reinterpret_cast<const bf16x8*>(qrl + (4 + d0) * 1024);
            p0 = __builtin_amdgcn_mfma_f32_32x32x16_bf16(b0, q, p0, 0, 0, 0);
            p1 = __builtin_amdgcn_mfma_f32_32x32x16_bf16(b1, q, p1, 0, 0, 0); }
    }
}
template <bool ROPE, bool CAUSAL>
__device__ __forceinline__ void attn_block_ap(const BlockRef& cur, const Strides& T, char* lds) {
    const int tid = threadIdx.x, wid = __builtin_amdgcn_readfirstlane(tid >> 6), lane = tid & 63, r32 = lane & 31, hi = lane >> 5, grp = wid >> 2;
    int j_hi = CAUSAL ? (cur.P0 + QB - 1) / KVBLK + 1 : T.skv / KVBLK; if (j_hi > T.skv / KVBLK) j_hi = T.skv / KVBLK;
    const int NT = j_hi;
    const int qlo = cur.P0 + wid * QBLK, qm = qlo + r32 - 4 * hi;
    char* V_lds = lds + OFF_V; char* K_lds = lds + OFF_K;
    float* ws = (float*)(lds + OFF_WS) + wid * 64; float* li_l = ws, * al_l = ws + 32;
    float m_reg = -1e30f, l_reg = 0; f32x16 o[4] = {};
    STAGE_IDX(); const int vst0 = v_st(sr, sc), vst1 = v_st(32 + sr, sc);
    const int vb0 = (int)(uintptr_t)V_lds + v_rd_base(lane);
    int koff[4];
#pragma unroll
    for (int dd = 0; dd < 4; ++dd) koff[dd] = KSWZ(r32, (dd * 16 + hi * 8) * 2);
    Seam<ROPE> S; char* qrl = lds + OFF_QR + wid * 8192 + lane * 16;
    const int dr0 = lane >> 4, dr1 = 4 + (lane >> 4);
    const unsigned kdo0 = (unsigned)((wid * 8 + dr0) * T.ks * 2 + (((lane & 15) ^ dr0) << 4)), kdo1 = (unsigned)((wid * 8 + dr1) * T.ks * 2 + (((lane & 15) ^ dr1) << 4));
    const int kline = 4 * wid + (lane >> 4), kcs = (lane & 15) ^ (kline & 7);
    const unsigned krdo = (unsigned)((kline + 32 * (kcs >> 3)) * (DROPE * 2) + ((kcs & 7) << 4));
    const unsigned klds0 = (unsigned)(uintptr_t)K_lds + wid * 2048, krlds0 = (unsigned)(uintptr_t)K_lds + 2 * SHM_K + wid * 1024;
    QLOAD(cur);
    { const char* kb_ = (const char*)cur.K; S.st_k0 = LD8(kb_ + vo_k); S.st_k1 = LD8(kb_ + (size_t)T.ks * 64 + vo_k); if constexpr (ROPE) S.st_kr = LD8((const char*)cur.KR + vo_kr); }
    VMW(); SWRITE_HK(0); QPARK8();
    __syncthreads();
    f32x16 p0, p1; float mn, al; bf16x8 pa0, pa1, pa2, pa3;
#define AP_BAR() do { asm volatile("s_waitcnt lgkmcnt(0)" ::: "memory"); __builtin_amdgcn_s_barrier(); asm volatile("" ::: "memory"); } while (0)
#define AP_ISSUE(t) do { const char* vb_ = (const char*)cur.V + (size_t)((t) * KVBLK) * T.vs * 2; S.st_v0 = LD8(vb_ + vo_v); S.st_v1 = LD8(vb_ + (size_t)T.vs * 64 + vo_v);        \
        if ((t) + 1 < NT) { const char* kb_ = (const char*)cur.K + (size_t)(((t) + 1) * KVBLK) * T.ks * 2; const unsigned kl_ = klds0 + (((t) + 1) & 1) * SHM_K;                   \
            __builtin_amdgcn_global_load_lds((const unsigned*)(kb_ + kdo0), (LAS unsigned*)(uintptr_t)(kl_), 16, 0, 0);                                                              \
            __builtin_amdgcn_global_load_lds((const unsigned*)(kb_ + kdo1), (LAS unsigned*)(uintptr_t)(kl_ + 1024), 16, 0, 0);                                                       \
            if constexpr (ROPE) __builtin_amdgcn_global_load_lds((const unsigned*)((const char*)cur.KR + (size_t)(((t) + 1) * KVBLK) * (DROPE * 2) + krdo),                          \
                                                                 (LAS unsigned*)(uintptr_t)(krlds0 + (((t) + 1) & 1) * SHM_KR), 16, 0, 0); } SBAR(); } while (0)
#define AP_WRITE(t) do { SBAR(); VMW(); SWRITE_HV((t) & 1); } while (0)
#define AP_QK(t) do { qkt_rt8<ROPE>(p0, p1, K_lds, (t) & 1, koff, S.qr, qrl);                                                      \
        if constexpr (CAUSAL) { const int kb_ = (t) * KVBLK; if (kb_ + KVBLK - 1 > qlo) mask_tile(p0, p1, qm - kb_); } } while (0)
#define AP_SM() do { partialSM<ROPE>(p0, p1, m_reg, mn, al);                                                                      \
        if (__any(al < 1.f)) { if (hi == 0) al_l[r32] = al; asm volatile("s_waitcnt lgkmcnt(0)" ::: "memory");                    \
            for (int d_ = 0; d_ < 4; ++d_) for (int r = 0; r < 16; ++r) o[d_][r] *= al_l[crow(r, hi)]; }                          \
        finishSM(p0, p1, al, l_reg, pa0, pa1, pa2, pa3); } while (0)
#define AP_PV(t) pv_tile<0>(o, vb0 + ((t) & 1) * SHM_V, pa0, pa1, pa2, pa3)
    if (grp == 0) {
        AP_ISSUE(0); AP_QK(0); AP_BAR();
        AP_SM(); AP_WRITE(0); AP_BAR();
        for (int t = 1; t < NT; ++t) {
            AP_ISSUE(t); AP_PV(t - 1); AP_QK(t); AP_BAR();
            AP_SM(); AP_WRITE(t); AP_BAR();
        }
        AP_PV(NT - 1); AP_BAR();
        AP_BAR();
    } else {
        AP_ISSUE(0); AP_BAR();
        AP_QK(0); AP_WRITE(0); AP_BAR();
        for (int t = 1; t < NT; ++t) {
            AP_ISSUE(t); AP_SM(); AP_BAR();
            AP_PV(t - 1); AP_QK(t); AP_WRITE(t); AP_BAR();
        }
        AP_SM(); AP_BAR();
        AP_PV(NT - 1); AP_BAR();
    }
#undef AP_ISSUE
#undef AP_WRITE
#undef AP_BAR
#undef AP_QK
#undef AP_SM
#undef AP_PV
    if (hi == 0) li_l[r32] = l_reg; asm volatile("s_waitcnt lgkmcnt(0)" ::: "memory");
    float rli[16];
#pragma unroll
    for (int r = 0; r < 16; ++r) rli[r] = __builtin_amdgcn_rcpf(li_l[crow(r, hi)]);
    bf16_t* Ow = cur.O + (size_t)(wid * QBLK) * T.os;
#pragma unroll
    for (int r = 0; r < 16; ++r) { const int orow = crow(r, hi);
#pragma unroll
        for (int d0 = 0; d0 < 4; ++d0) { const float v = o[d0][r] * rli[r];
            const float vn = __shfl_xor(v, 1);
            if ((r32 & 1) == 0) *(unsigned*)(Ow + (size_t)orow * T.os + d0 * 32 + r32) = cvtpk(v, vn); } }
    __syncthreads();
}

template <bool ROPE, bool CAUSAL>
__device__ __forceinline__ void attn_block_dma(const BlockRef& cur, const Strides& T, char* lds) {
    const int tid = threadIdx.x, wid = __builtin_amdgcn_readfirstlane(tid >> 6), lane = tid & 63, r32 = lane & 31, hi = lane >> 5;
    int j_hi = CAUSAL ? (cur.P0 + QB - 1) / KVBLK + 1 : T.skv / KVBLK; if (j_hi > T.skv / KVBLK) j_hi = T.skv / KVBLK;
    const int NT = j_hi;
    const int qlo = cur.P0 + wid * QBLK, qm = qlo + r32 - 4 * hi;
    char* V_lds = lds + OFF_V; char* K_lds = lds + OFF_K;
    float* ws = (float*)(lds + OFF_WS) + wid * 64; float* li_l = ws, * al_l = ws + 32;
    float m_reg = -1e30f, l_reg = 0; f32x16 o[4] = {};
    const int vb0 = (int)(uintptr_t)V_lds + v_rd_base(lane);
    int koff[4];
#pragma unroll
    for (int dd = 0; dd < 4; ++dd) koff[dd] = KSWZ(r32, (dd * 16 + hi * 8) * 2);
    const int dr0 = lane >> 4, dr1 = 4 + (lane >> 4);
    const unsigned kdo0 = (unsigned)((wid * 8 + dr0) * T.ks * 2 + (((lane & 15) ^ dr0) << 4)), kdo1 = (unsigned)((wid * 8 + dr1) * T.ks * 2 + (((lane & 15) ^ dr1) << 4));
    const int kline = 4 * wid + (lane >> 4), kcs = (lane & 15) ^ (kline & 7);
    const unsigned krdo = (unsigned)((kline + 32 * (kcs >> 3)) * (DROPE * 2) + ((kcs & 7) << 4));
    const int vkk = 8 * wid + ((lane >> 2) & 7), vk = (vkk & ~0xC) | ((vkk & 4) << 1) | ((vkk & 8) >> 1);
    const unsigned vdo0 = (unsigned)(vk * T.vs * 2 + (((lane >> 5)) * 32 + (lane & 3) * 8) * 2), vdo1 = vdo0 + 128;
    const unsigned klds0 = (unsigned)(uintptr_t)K_lds + wid * 2048, krlds0 = (unsigned)(uintptr_t)K_lds + 2 * SHM_K + wid * 1024, vlds0 = (unsigned)(uintptr_t)V_lds + wid * 2048;
#define DMA_TILE(t, bf) do { const char* kb_ = (const char*)cur.K + (size_t)((t) * KVBLK) * T.ks * 2; const char* vb_ = (const char*)cur.V + (size_t)((t) * KVBLK) * T.vs * 2;       \
        __builtin_amdgcn_global_load_lds((const unsigned*)(kb_ + kdo0), (LAS unsigned*)(uintptr_t)(klds0 + (bf) * SHM_K), 16, 0, 0);                                       \
        __builtin_amdgcn_global_load_lds((const unsigned*)(kb_ + kdo1), (LAS unsigned*)(uintptr_t)(klds0 + (bf) * SHM_K + 1024), 16, 0, 0);                                \
        if constexpr (ROPE) __builtin_amdgcn_global_load_lds((const unsigned*)((const char*)cur.KR + (size_t)((t) * KVBLK) * (DROPE * 2) + krdo), (LAS unsigned*)(uintptr_t)(krlds0 + (bf) * SHM_KR), 16, 0, 0); \
        __builtin_amdgcn_global_load_lds((const unsigned*)(vb_ + vdo0), (LAS unsigned*)(uintptr_t)(vlds0 + (bf) * SHM_V), 16, 0, 0);                                       \
        __builtin_amdgcn_global_load_lds((const unsigned*)(vb_ + vdo1), (LAS unsigned*)(uintptr_t)(vlds0 + (bf) * SHM_V + 1024), 16, 0, 0); } while (0)
#define DMA_BAR() do { asm volatile("s_waitcnt vmcnt(0) lgkmcnt(0)" ::: "memory"); __builtin_amdgcn_s_barrier(); asm volatile("" ::: "memory"); } while (0)
    Seam<ROPE> S; char* qrl = lds + OFF_QR + wid * 4096 + lane * 16;
    QLOAD(cur);
    DMA_TILE(0, 0); QPARK();
    DMA_BAR();
    for (int t = 0; t < NT; ++t) {
        const int buf = t & 1;
        if (t + 1 < NT) { DMA_TILE(t + 1, buf ^ 1); }
        SBAR();
        f32x16 p0, p1; qkt_rt<ROPE>(p0, p1, K_lds, buf, koff, S.qr, qrl);
        if constexpr (CAUSAL) { const int kb_ = t * KVBLK; if (kb_ + KVBLK - 1 > qlo) mask_tile(p0, p1, qm - kb_); }
        float mn, al; partialSM<ROPE>(p0, p1, m_reg, mn, al);
        if (__any(al < 1.f)) { if (hi == 0) al_l[r32] = al; asm volatile("s_waitcnt lgkmcnt(0)" ::: "memory");
            for (int d_ = 0; d_ < 4; ++d_) for (int r = 0; r < 16; ++r) o[d_][r] *= al_l[crow(r, hi)]; }
        bf16x8 pa0, pa1, pa2, pa3; finishSM(p0, p1, al, l_reg, pa0, pa1, pa2, pa3); SBAR();
        pv_tile<0>(o, vb0 + buf * SHM_V, pa0, pa1, pa2, pa3);
        DMA_BAR();
    }
#undef DMA_TILE
#undef DMA_BAR
    if (hi == 0) li_l[r32] = l_reg; asm volatile("s_waitcnt lgkmcnt(0)" ::: "memory");
    float rli[16];
#pragma unroll
    for (int r = 0; r < 16; ++r) rli[r] = __builtin_amdgcn_rcpf(li_l[crow(r, hi)]);
    bf16_t* Ow = cur.O + (size_t)(wid * QBLK) * T.os;
#pragma unroll
    for (int r = 0; r < 16; ++r) { const int orow = crow(r, hi);
#pragma unroll
        for (int d0 = 0; d0 < 4; ++d0) { const float v = o[d0][r] * rli[r];
            const float vn = __shfl_xor(v, 1);
            if ((r32 & 1) == 0) *(unsigned*)(Ow + (size_t)orow * T.os + d0 * 32 + r32) = cvtpk(v, vn); } }
    __syncthreads();
}
#undef LD8
#undef VMW
#undef VMWN
#undef SLOAD_H
#undef SWRITE_HK
#undef SWRITE_HV
#undef SWRITE_H
#undef QLOAD
#undef QPARK
#undef QPARK8
#undef STAGE_IDX
}
__device__ __forceinline__ float sq4v(f32x4 v) { return pg8::sq4(v); }
__device__ __forceinline__ float row_rs32g(const float* ss, int row) { return pg8::row_rs32(ss, row, 1.0f / DM); }
struct Params {
    const float *x, *mem; const int* pos; const float *norm_mix, *w_in, *lam_re, *lam_im, *log_step, *b_re, *b_im, *c_re, *c_im, *ssm_d, *w_glu, *b_glu;
    const float *q_norm, *w_uq, *kv_norm, *w_uk, *w_uv, *w_up_ssm, *w_up_mla, *w_out, *norm_xattn, *norm_mem, *xa_wq, *xa_wk, *xa_wv, *xa_wo;
    const float *norm_moe, *router_w, *router_b, *w_gu, *b_gu, *w_dn, *b_dn, *final_norm;
    float* out;
    unsigned* ctl;
    bf16_t *WinT, *WkpeT, *WgluT, *WuqT, *WukvT, *WupsT, *WupmT, *WoutT, *WxqT, *WxkvT, *WxoT; unsigned char *WguT, *WdnT;
    float* WrT;
    bf16_t *hn, *memn; float *cosT, *sinT; float* abar; bf16_t *bbarT, *cmat;
    bf16_t *ub, *qa, *kva; float *qss, *kvss; bf16_t *sgs, *sgm, *kpe;
    bf16_t *qn, *qr, *kn, *vv, *ymla;
    float* send; bf16_t *zb, *ys, *t1, *mg;
    float* x1; bf16_t* x1b; float* ss1;
    bf16_t *memkv, *qx, *ox;
    bf16_t* x2; float* ss2;
    unsigned* csprev; int* topi; float* topw; int* rank; int* slot; int* wgcnt; int* blke;
    unsigned char *xg, *act; bf16_t* orow;
    int ph_lo, ph_hi;
};

struct Frame { LAS unsigned char* lds; int wave, vcu, G, gw, NGW; };

template <class RowMap>
__device__ __forceinline__ void p0_transpose_item(const float* W, int ldw, int K, bf16_t* WT, const float* gain, LAS float* scr, int kb, int nb, int lane, const RowMap& rowmap) {
    const int k0 = 64 * kb, n0 = 32 * nb;
#pragma unroll 8
    for (int i = 0; i < 32; ++i) { const int kk = 2 * i + (lane >> 5); float v = W[(size_t)(k0 + kk) * ldw + n0 + (lane & 31)]; if (gain) v *= gain[k0 + kk]; scr[kk * 33 + (lane & 31)] = v; }
    LDS_WAIT(); asm volatile("" ::: "memory");
    const int c = lane & 7;
#pragma unroll
    for (int j = 0; j < 4; ++j) { const int n = (lane >> 3) + 8 * j; const LAS float* s = scr + (8 * c) * 33 + n;
        u32x4 o; o.x = cvtpk(s[0 * 33], s[1 * 33]); o.y = cvtpk(s[2 * 33], s[3 * 33]); o.z = cvtpk(s[4 * 33], s[5 * 33]); o.w = cvtpk(s[6 * 33], s[7 * 33]);
        *(u32x4*)(WT + (size_t)rowmap(n0 + n) * K + k0 + 8 * c) = o; }
    LDS_WAIT(); asm volatile("" ::: "memory");
}
template <class RowMap>
__device__ __forceinline__ void p0_transpose_item_f8(const float* W, int ldw, int K, unsigned char* WT, float scale, LAS float* scr, int kb, int nb, int lane, const RowMap& rowmap) {
    const int k0 = 128 * kb, n0 = 32 * nb;
#pragma unroll 8
    for (int i = 0; i < 64; ++i) { const int kk = 2 * i + (lane >> 5); scr[kk * 33 + (lane & 31)] = W[(size_t)(k0 + kk) * ldw + n0 + (lane & 31)] * scale; }
    LDS_WAIT(); asm volatile("" ::: "memory");
    const int c = lane & 7;
#pragma unroll
    for (int j = 0; j < 4; ++j) { const int n = (lane >> 3) + 8 * j; const LAS float* s = scr + (16 * c) * 33 + n;
        u32x4 o; o.x = pg8::pk4_fp8(s[0 * 33], s[1 * 33], s[2 * 33], s[3 * 33]); o.y = pg8::pk4_fp8(s[4 * 33], s[5 * 33], s[6 * 33], s[7 * 33]);
        o.z = pg8::pk4_fp8(s[8 * 33], s[9 * 33], s[10 * 33], s[11 * 33]); o.w = pg8::pk4_fp8(s[12 * 33], s[13 * 33], s[14 * 33], s[15 * 33]);
        *(u32x4*)(WT + (size_t)rowmap(n0 + n) * K + k0 + 16 * c) = o; }
    LDS_WAIT(); asm volatile("" ::: "memory");
}
struct MapId { int off; __device__ __forceinline__ int operator()(int n) const { return n + off; } };
struct MapUq { __device__ __forceinline__ int operator()(int n) const { const int h = n / 192, d = n % 192; if (d < 128) return h * 128 + d;
    const int dd = d - 128, half = dd >> 5, i = dd & 31; return 2048 + 256 * (h >> 2) + half * 128 + (h & 3) * 32 + i; } };
struct MapGU { __device__ __forceinline__ int operator()(int n) const { const int up = n >= DFF, j = up ? n - DFF : n; return 256 * (j >> 7) + up * 128 + (j & 127); } };

__device__ __forceinline__ void rms_row_bf16(const float* xrow, const float* gain, bf16_t* orow, int lane) {
    f32x4 v[8]; float s = 0.f;
#pragma unroll
    for (int j = 0; j < 8; ++j) { v[j] = *(const f32x4*)(xrow + 256 * j + 4 * lane); s += sq4v(v[j]); }
    const float rs = __builtin_amdgcn_rsqf(wave_sum(s) * (1.0f / DM) + EPS);
#pragma unroll
    for (int j = 0; j < 8; ++j) { const f32x4 g = *(const f32x4*)(gain + 256 * j + 4 * lane); const f32x4 r = v[j] * rs * g;
        u32x2 o = {cvtpk(r[0], r[1]), cvtpk(r[2], r[3])}; *(u32x2*)(orow + 256 * j + 4 * lane) = o; }
}

__device__ __forceinline__ void cmul(float ar, float ai, float br, float bi, float& cr, float& ci) { cr = ar * br - ai * bi; ci = ar * bi + ai * br; }


__device__ __forceinline__ void p0_moe_f8(const Params& p, Frame& F) {
    LAS float* tile = (LAS float*)F.lds; const int tid = threadIdx.x, lane = tid & 63, w = F.wave;
    constexpr int TS = 260;
    for (int it = F.vcu; it < NEXP * 384; it += F.G) {
        const int e = it / 384, r = it % 384; const bool gu = r < 256; const int rr = gu ? r : r - 256, nbn = gu ? 16 : 8, kb = rr / nbn, nb = rr % nbn;
        const float* W = gu ? p.w_gu + (size_t)e * DM * 2 * DFF : p.w_dn + (size_t)e * DFF * DM; const int ldw = gu ? 2 * DFF : DM;
        unsigned char* WT = gu ? p.WguT + (size_t)e * 2 * DFF * DM : p.WdnT + (size_t)e * DM * DFF;
        const int k0 = 128 * kb, n0 = 256 * nb;
        f32x4 v[16];
#pragma unroll
        for (int i = 0; i < 16; ++i) v[i] = *(const f32x4*)(W + (size_t)(k0 + 16 * w + i) * ldw + n0 + 4 * lane);
#pragma unroll
        for (int i = 0; i < 16; ++i) *(LAS f32x4*)(tile + (16 * w + i) * TS + 4 * lane) = v[i] * pg8::F8_WS;
        __syncthreads();
#pragma unroll
        for (int j = 0; j < 4; ++j) { const int nl = tid & 255, c = (tid >> 8) + 2 * j; const LAS float* s = tile + (16 * c) * TS + nl;
            u32x4 o; o.x = pg8::pk4_fp8(s[0 * TS], s[1 * TS], s[2 * TS], s[3 * TS]); o.y = pg8::pk4_fp8(s[4 * TS], s[5 * TS], s[6 * TS], s[7 * TS]);
            o.z = pg8::pk4_fp8(s[8 * TS], s[9 * TS], s[10 * TS], s[11 * TS]); o.w = pg8::pk4_fp8(s[12 * TS], s[13 * TS], s[14 * TS], s[15 * TS]);
            const int n = n0 + nl; const int row = gu ? MapGU{}(n) : n;
            *(u32x4*)(WT + (size_t)row * DM + k0 + 16 * c) = o; }
        __syncthreads();
    }
}
__device__ __forceinline__ void p0_prologue(const Params& p, Frame& F) {
    LAS float* scr = (LAS float*)(F.lds + F.wave * 17408);
    const int gw = F.gw, NGW = F.NGW, lane = ((int)threadIdx.x & 63);
#define TJOB(W, LDW, COFF, NCOLS, KK, DST, GAIN, MAP) { const int nblk = (NCOLS) / 32, nit = ((KK) / 64) * nblk; \
        for (int it = gw; it < nit; it += NGW) p0_transpose_item((W) + (COFF), (LDW), (KK), (DST), (GAIN), scr, it / nblk, it % nblk, lane, (MAP)); }
    TJOB(p.w_in, IN_COLS, 0, 2048, DM, p.WinT, nullptr, MapId{0});
    TJOB(p.w_in, IN_COLS, 2048, 64, DM, p.WkpeT, nullptr, MapId{0});
    TJOB(p.w_in, IN_COLS, 2112, 4096, DM, p.WinT, nullptr, MapId{2048});
    TJOB(p.w_glu, SSM_W, 0, SSM_W, SSM_W, p.WgluT, nullptr, MapId{0});
    TJOB(p.w_uq, NHEAD * 192, 0, NHEAD * 192, QL, p.WuqT, p.q_norm, MapUq{});
    TJOB(p.w_uk, NHEAD * 128, 0, NHEAD * 128, KVL, p.WukvT, p.kv_norm, MapId{0});
    TJOB(p.w_uv, NHEAD * 128, 0, NHEAD * 128, KVL, p.WukvT, p.kv_norm, MapId{2048});
    TJOB(p.w_up_ssm, DM, 0, DM, SSM_W, p.WupsT, nullptr, MapId{0});
    TJOB(p.w_up_mla, DM, 0, DM, DM, p.WupmT, nullptr, MapId{0});
    TJOB(p.w_out, DM, 0, DM, DM, p.WoutT, nullptr, MapId{0});
    TJOB(p.xa_wq, XW, 0, XW, DM, p.WxqT, p.norm_xattn, MapId{0});
    TJOB(p.xa_wk, XW, 0, XW, DM, p.WxkvT, nullptr, MapId{0});
    TJOB(p.xa_wv, XW, 0, XW, DM, p.WxkvT, nullptr, MapId{512});
    TJOB(p.xa_wo, DM, 0, DM, XW, p.WxoT, nullptr, MapId{0});
    p0_moe_f8(p, F);
#undef TJOB
    for (int m = gw; m < SEQ; m += NGW) rms_row_bf16(p.x + (size_t)m * DM, p.norm_mix, p.hn + (size_t)m * DM, lane);
    for (int m = gw; m < MEML; m += NGW) rms_row_bf16(p.mem + (size_t)m * DM, p.norm_mem, p.memn + (size_t)m * DM, lane);
    const int gt = gw * 64 + lane, NGT = NGW * 64;
    for (int i = gt; i < SEQ * 32; i += NGT) {
        const int t = i >> 5, f = i & 31;
        const float invf = __builtin_powf(10000.0f, -(float)(2 * f) / 64.0f);
        const float ang = (float)p.pos[t] * invf;
        const double rev = (double)ang * 0.15915494309189535; const float fr = (float)(rev - __builtin_floor(rev));
        p.cosT[i] = __builtin_amdgcn_cosf(fr); p.sinT[i] = __builtin_amdgcn_sinf(fr);
    }
    for (int i = gt; i < DM * NEXP; i += NGT) p.WrT[i] = p.router_w[i] * p.norm_moe[i >> 5];
    for (int i = gt; i < SSM_G * SSM_P; i += NGT) {
        const int g = i >> 6;
        const float dt = __builtin_expf(p.log_step[g]), lr = p.lam_re[i], li = p.lam_im[i];
        const float mag = __builtin_expf(lr * dt); const double rev = (double)(li * dt) * 0.15915494309189535; const float fr = (float)(rev - __builtin_floor(rev));
        const float ar = mag * __builtin_amdgcn_cosf(fr), ai = mag * __builtin_amdgcn_sinf(fr);
        p.abar[2 * i] = ar; p.abar[2 * i + 1] = ai;
        const float den = 1.0f / (lr * lr + li * li); float fr_, fi_; cmul(ar - 1.0f, ai, lr * den, -li * den, fr_, fi_);
        const int pst = i & 63;
#pragma unroll
        for (int h = 0; h < SSM_H; ++h) { const float br = p.b_re[(size_t)i * SSM_H + h], bi = p.b_im[(size_t)i * SSM_H + h]; float cr, ci; cmul(fr_, fi_, br, bi, cr, ci);
            p.bbarT[((size_t)g * 128 + pst) * 16 + h] = f2bf(cr); p.bbarT[((size_t)g * 128 + 64 + pst) * 16 + h] = f2bf(ci); }
    }
    for (int i = gt; i < SSM_G * SSM_H * SSM_P; i += NGT) {
        const int gh = i >> 6, pst = i & 63;
        p.cmat[(size_t)gh * 128 + pst] = f2bf(p.c_re[i]); p.cmat[(size_t)gh * 128 + 64 + pst] = f2bf(-p.c_im[i]);
    }
}

__device__ __forceinline__ void kpe_phase(const Params& p, Frame& F) {
    const int lane = ((int)threadIdx.x & 63), r = lane & 31, hi = lane >> 5;
    for (int tile = F.wave * F.G + F.vcu; tile < SEQ / 32; tile += F.NGW) {
        const int t0 = tile * 32; f32x16 a0 = {}, a1 = {};
        const bf16_t* ap = p.hn + (size_t)(t0 + r) * DM + 8 * hi; const bf16_t* b0p = p.WkpeT + (size_t)r * DM + 8 * hi; const bf16_t* b1p = b0p + (size_t)32 * DM;
#pragma unroll 4
        for (int s = 0; s < DM / 16; ++s) { const bf16x8 a = *(const bf16x8*)(ap + 16 * s), b0 = *(const bf16x8*)(b0p + 16 * s), b1 = *(const bf16x8*)(b1p + 16 * s);
            a0 = __builtin_amdgcn_mfma_f32_32x32x16_bf16(a, b0, a0, 0, 0, 0); a1 = __builtin_amdgcn_mfma_f32_32x32x16_bf16(a, b1, a1, 0, 0, 0); }
#pragma unroll
        for (int i = 0; i < 16; ++i) { const int tok = t0 + (i & 3) + 8 * (i >> 2) + 4 * hi; const float c = p.cosT[(size_t)tok * 32 + r], s = p.sinT[(size_t)tok * 32 + r];
            p.kpe[(size_t)tok * DROPE + r] = f2bf(a0[i] * c - a1[i] * s); p.kpe[(size_t)tok * DROPE + 32 + r] = f2bf(a0[i] * s + a1[i] * c); }
    }
}

constexpr int S5_TC = 256, S5_NCH = SEQ / S5_TC;
struct S5Consts { float a1r[2], a1i[2], a2r[2], a2i[2], a3r[2], a3i[2], a4r[2], a4i[2], a8r[2], a8i[2], a32r[2], a32i[2], a256r[2], a256i[2]; };
__device__ __forceinline__ void s5_consts(const Params& p, int g, int r, S5Consts& c) {
#pragma unroll
    for (int s = 0; s < 2; ++s) { const f32x2 a = *(const f32x2*)(p.abar + 2 * (g * 64 + 32 * s + r)); c.a1r[s] = a[0]; c.a1i[s] = a[1];
        cmul(c.a1r[s], c.a1i[s], c.a1r[s], c.a1i[s], c.a2r[s], c.a2i[s]); cmul(c.a2r[s], c.a2i[s], c.a1r[s], c.a1i[s], c.a3r[s], c.a3i[s]); cmul(c.a2r[s], c.a2i[s], c.a2r[s], c.a2i[s], c.a4r[s], c.a4i[s]);
        cmul(c.a4r[s], c.a4i[s], c.a4r[s], c.a4i[s], c.a8r[s], c.a8i[s]); float tr, ti; cmul(c.a8r[s], c.a8i[s], c.a8r[s], c.a8i[s], tr, ti); cmul(tr, ti, tr, ti, c.a32r[s], c.a32i[s]);
        float ur, ui; cmul(c.a32r[s], c.a32i[s], c.a32r[s], c.a32i[s], tr, ti); cmul(tr, ti, tr, ti, ur, ui); cmul(ur, ui, ur, ui, c.a256r[s], c.a256i[s]); }
}
__device__ __forceinline__ void s5_bu(const Params& p, int g, int t0, int r, int hi, const bf16x8 (&bfr)[4], f32x16 (&acc)[4]) {
    const bf16x8 a = *(const bf16x8*)(p.ub + (size_t)(t0 + r) * SSM_W + g * 16 + 8 * hi);
#pragma unroll
    for (int ct = 0; ct < 4; ++ct) { acc[ct] = f32x16{}; acc[ct] = __builtin_amdgcn_mfma_f32_32x32x16_bf16(a, bfr[ct], acc[ct], 0, 0, 0); }
}
__device__ __forceinline__ void s5_pass_a(const Params& p, Frame& F) {
    const int lane = ((int)threadIdx.x & 63), r = lane & 31, hi = lane >> 5;
    for (int unit = F.gw; unit < S5_NCH * SSM_G; unit += F.NGW) {
        const int g = unit % SSM_G, ch = unit / SSM_G;
        S5Consts c; s5_consts(p, g, r, c);
        bf16x8 bfr[4];
#pragma unroll
        for (int ct = 0; ct < 4; ++ct) bfr[ct] = *(const bf16x8*)(p.bbarT + ((size_t)g * 128 + 32 * ct + r) * 16 + 8 * hi);
        float Sr[2] = {0.f, 0.f}, Si[2] = {0.f, 0.f};
        for (int tl = 0; tl < S5_TC / 32; ++tl) {
            f32x16 acc[4]; s5_bu(p, g, ch * S5_TC + tl * 32, r, hi, bfr, acc);
#pragma unroll
            for (int s = 0; s < 2; ++s) { float Pr = 0.f, Pi = 0.f;
#pragma unroll
                for (int q = 0; q < 4; ++q) { float er = acc[s][4 * q], ei = acc[2 + s][4 * q];
#pragma unroll
                    for (int j = 1; j < 4; ++j) { float tr, ti; cmul(er, ei, c.a1r[s], c.a1i[s], tr, ti); er = tr + acc[s][4 * q + j]; ei = ti + acc[2 + s][4 * q + j]; }
                    float tr, ti; cmul(Pr, Pi, c.a8r[s], c.a8i[s], tr, ti); Pr = tr + er; Pi = ti + ei; }
                if (hi == 0) { float tr, ti; cmul(Pr, Pi, c.a4r[s], c.a4i[s], tr, ti); Pr = tr; Pi = ti; }
                Pr += __shfl_xor(Pr, 32); Pi += __shfl_xor(Pi, 32);
                float tr, ti; cmul(Sr[s], Si[s], c.a32r[s], c.a32i[s], tr, ti); Sr[s] = tr + Pr; Si[s] = ti + Pi; }
        }
        if (hi == 0) {
#pragma unroll
            for (int s = 0; s < 2; ++s) *(f32x2*)(p.send + 2 * ((size_t)(ch * SSM_G + g) * 64 + 32 * s + r)) = (f32x2){Sr[s], Si[s]}; }
    }
}
constexpr int S5_XS = 272;
__device__ __forceinline__ void s5_pass_c(const Params& p, Frame& F) {
    const int lane = ((int)threadIdx.x & 63), r = lane & 31, hi = lane >> 5, l15 = lane & 15, l4 = lane >> 4;
    LAS unsigned char* xl = F.lds + F.wave * (32 * S5_XS);
    for (int unit = F.gw; unit < S5_NCH * SSM_G; unit += F.NGW) {
        const int g = unit % SSM_G, ch = unit / SSM_G;
        S5Consts c; s5_consts(p, g, r, c);
        bf16x8 bfr[4], cfr[4];
#pragma unroll
        for (int ct = 0; ct < 4; ++ct) bfr[ct] = *(const bf16x8*)(p.bbarT + ((size_t)g * 128 + 32 * ct + r) * 16 + 8 * hi);
#pragma unroll
        for (int ks = 0; ks < 4; ++ks) cfr[ks] = *(const bf16x8*)(p.cmat + ((size_t)g * 16 + l15) * 128 + 32 * ks + 8 * l4);
        const f32x4 dsk = *(const f32x4*)(p.ssm_d + g * 16 + 4 * l4);
        float Xr[2] = {0.f, 0.f}, Xi[2] = {0.f, 0.f};
        for (int cp = 0; cp < ch; ++cp) {
#pragma unroll
            for (int s = 0; s < 2; ++s) { const f32x2 e = *(const f32x2*)(p.send + 2 * ((size_t)(cp * SSM_G + g) * 64 + 32 * s + r)); float tr, ti; cmul(Xr[s], Xi[s], c.a256r[s], c.a256i[s], tr, ti); Xr[s] = tr + e[0]; Xi[s] = ti + e[1]; } }
        for (int tl = 0; tl < S5_TC / 32; ++tl) {
            const int t0 = ch * S5_TC + tl * 32;
            f32x16 acc[4]; s5_bu(p, g, t0, r, hi, bfr, acc);
#pragma unroll
            for (int s = 0; s < 2; ++s) {
                float er[4], ei[4];
#pragma unroll
                for (int q = 0; q < 4; ++q) {
#pragma unroll
                    for (int j = 1; j < 4; ++j) { float tr, ti; cmul(acc[s][4 * q + j - 1], acc[2 + s][4 * q + j - 1], c.a1r[s], c.a1i[s], tr, ti); acc[s][4 * q + j] += tr; acc[2 + s][4 * q + j] += ti; }
                    er[q] = acc[s][4 * q + 3]; ei[q] = acc[2 + s][4 * q + 3]; }
                float cr = Xr[s], ci = Xi[s], cinr[4], cini[4];
#pragma unroll
                for (int q = 0; q < 4; ++q) { const float pr = __shfl_xor(er[q], 32), pi = __shfl_xor(ei[q], 32);
                    const float e0r = hi ? pr : er[q], e0i = hi ? pi : ei[q], e1r = hi ? er[q] : pr, e1i = hi ? ei[q] : pi;
                    float tr, ti; const float c0r = cr, c0i = ci; cmul(cr, ci, c.a4r[s], c.a4i[s], tr, ti); cr = tr + e0r; ci = ti + e0i;
                    const float c1r = cr, c1i = ci; cmul(cr, ci, c.a4r[s], c.a4i[s], tr, ti); cr = tr + e1r; ci = ti + e1i;
                    cinr[q] = hi ? c1r : c0r; cini[q] = hi ? c1i : c0i; }
                Xr[s] = cr; Xi[s] = ci;
#pragma unroll
                for (int q = 0; q < 4; ++q) { float tr, ti;
                    cmul(cinr[q], cini[q], c.a1r[s], c.a1i[s], tr, ti); acc[s][4 * q + 0] += tr; acc[2 + s][4 * q + 0] += ti;
                    cmul(cinr[q], cini[q], c.a2r[s], c.a2i[s], tr, ti); acc[s][4 * q + 1] += tr; acc[2 + s][4 * q + 1] += ti;
                    cmul(cinr[q], cini[q], c.a3r[s], c.a3i[s], tr, ti); acc[s][4 * q + 2] += tr; acc[2 + s][4 * q + 2] += ti;
                    cmul(cinr[q], cini[q], c.a4r[s], c.a4i[s], tr, ti); acc[s][4 * q + 3] += tr; acc[2 + s][4 * q + 3] += ti; }
            }
#pragma unroll
            for (int ct = 0; ct < 4; ++ct)
#pragma unroll
                for (int i = 0; i < 16; ++i) *(LAS unsigned short*)(xl + ((i & 3) + 8 * (i >> 2) + 4 * hi) * S5_XS + (32 * ct + r) * 2) = f2bf(acc[ct][i]);
            LDS_WAIT(); asm volatile("" ::: "memory");
#pragma unroll
            for (int nt = 0; nt < 2; ++nt) { f32x4 y = {0.f, 0.f, 0.f, 0.f};
#pragma unroll
                for (int ks = 0; ks < 4; ++ks) { const bf16x8 b = *(const LAS bf16x8*)(xl + (16 * nt + l15) * S5_XS + (32 * ks + 8 * l4) * 2); y = __builtin_amdgcn_mfma_f32_16x16x32_bf16(cfr[ks], b, y, 0, 0, 0); }
                const size_t off = (size_t)(t0 + 16 * nt + l15) * SSM_W + g * 16 + 4 * l4; const u32x2 uw = *(const u32x2*)(p.ub + off);
                const float y0 = y[0] + dsk[0] * bflo(uw.x), y1 = y[1] + dsk[1] * bfhi(uw.x), y2 = y[2] + dsk[2] * bflo(uw.y), y3 = y[3] + dsk[3] * bfhi(uw.y);
                u32x2 o = {cvtpk(gelu_tanh(y0), gelu_tanh(y1)), cvtpk(gelu_tanh(y2), gelu_tanh(y3))}; *(u32x2*)(p.zb + off) = o; }
            LDS_WAIT(); asm volatile("" ::: "memory");
        }
    }
}

__device__ __forceinline__ void router_phase(const Params& p, Frame& F) {
    LAS float* red = (LAS float*)F.lds; LAS float* lg = red + 8 * 32 * 33; LAS int* asg = (LAS int*)(lg + 32 * 33); LAS int* cnt = asg + 256;
    const int lane = ((int)threadIdx.x & 63), i32 = lane & 31, kh = lane >> 5, w = F.wave, tid = (int)threadIdx.x;
    for (int vb = blockIdx.x; vb < SEQ / 64; vb += F.G) {
        if (tid < 32) cnt[tid] = 0;
        for (int tl = 0; tl < 2; ++tl) {
            const int t0 = vb * 64 + tl * 32;
            f32x16 acc = {};
            const bf16_t* ap = p.x2 + (size_t)(t0 + i32) * DM + 256 * w + 4 * kh; const float* bp = p.WrT + (size_t)(256 * w + 4 * kh) * NEXP + i32;
#pragma unroll 4
            for (int q = 0; q < 32; ++q) { const u32x2 aw = *(const u32x2*)(ap + 8 * q); const f32x4 a = {bflo(aw.x), bfhi(aw.x), bflo(aw.y), bfhi(aw.y)};
#pragma unroll
                for (int e = 0; e < 4; ++e) acc = __builtin_amdgcn_mfma_f32_32x32x2f32(a[e], bp[(size_t)(8 * q + e) * NEXP], acc, 0, 0, 0); }
#pragma unroll
            for (int i = 0; i < 16; ++i) red[(w * 32 + (i & 3) + 8 * (i >> 2) + 4 * kh) * 33 + i32] = acc[i];
            __syncthreads();
            for (int o = tid; o < 1024; o += 512) { const int tok = o >> 5, e = o & 31; float s = 0.f;
#pragma unroll
                for (int ww = 0; ww < 8; ++ww) s += red[(ww * 32 + tok) * 33 + e];
                lg[tok * 33 + e] = s * row_rs32g(p.ss2, t0 + tok) + p.router_b[e]; }
            __syncthreads();
            if (tid < 32) { const int tok = tid; float v[4] = {-__builtin_inff(), -__builtin_inff(), -__builtin_inff(), -__builtin_inff()}; int id[4] = {0, 0, 0, 0};
                for (int e = 0; e < 32; ++e) { float x = lg[tok * 33 + e]; int xi = e;
#pragma unroll
                    for (int k = 0; k < 4; ++k) { const bool gt = x > v[k]; const float tv = gt ? v[k] : x; const int ti = gt ? id[k] : xi; v[k] = gt ? x : v[k]; id[k] = gt ? xi : id[k]; x = tv; xi = ti; } }
                const float e1 = __builtin_expf(v[1] - v[0]), e2 = __builtin_expf(v[2] - v[0]), e3 = __builtin_expf(v[3] - v[0]); const float inv = 1.0f / (1.0f + e1 + e2 + e3);
                const size_t o4 = (size_t)(t0 + tok) * 4;
                *(f32x4*)(p.topw + o4) = (f32x4){inv, e1 * inv, e2 * inv, e3 * inv};
                p.topi[o4] = id[0]; p.topi[o4 + 1] = id[1]; p.topi[o4 + 2] = id[2]; p.topi[o4 + 3] = id[3];
#pragma unroll
                for (int k = 0; k < 4; ++k) asg[(tl * 32 + tok) * 4 + k] = id[k]; }
            __syncthreads();
        }
        if (tid < 256) { const int e = asg[tid]; int rk = 0; for (int j = 0; j < tid; ++j) rk += (asg[j] == e) ? 1 : 0;
            p.rank[(size_t)vb * 256 + tid] = rk; atomicAdd((int*)&cnt[e], 1); }
        __syncthreads();
        if (tid < 32) p.wgcnt[vb * 32 + tid] = cnt[tid];
        __syncthreads();
    }
}
__device__ __forceinline__ void assign_phase(const Params& p, Frame& F) {
    LAS int* part = (LAS int*)F.lds; LAS int* pbef = part + 512; LAS int* base = pbef + 512; LAS int* pst = base + 32; LAS int* slots = pst + 33;
    const int tid = (int)threadIdx.x, lane = ((int)threadIdx.x & 63);
    for (int vb = blockIdx.x; vb < SEQ / 64; vb += F.G) {
        { const int e = tid & 31, pr = tid >> 5; int s = 0, sb = 0;
          for (int b = pr * 16; b < pr * 16 + 16; ++b) { const int c = p.wgcnt[b * 32 + e]; s += c; sb += (b < vb) ? c : 0; }
          part[pr * 32 + e] = s; pbef[pr * 32 + e] = sb; }
        __syncthreads();
        if (tid < 32) { int tot = 0, bef = 0; for (int pr = 0; pr < 16; ++pr) { tot += part[pr * 32 + tid]; bef += pbef[pr * 32 + tid]; } part[tid] = tot; pbef[tid] = bef; }
        __syncthreads();
        if (tid == 0) { int acc = 0; for (int e = 0; e < 32; ++e) { pst[e] = acc; const int nb = (part[e] + 255) >> 8;
                if (vb == 0) for (int b = 0; b < nb; ++b) p.blke[(acc >> 8) + b] = e;
                acc += nb << 8; }
            pst[32] = acc; if (vb == 0) p.blke[MAXBLK] = acc >> 8; }
        __syncthreads();
        if (tid < 32) base[tid] = pst[tid] + pbef[tid];
        __syncthreads();
        if (tid < 256) { const int tok = vb * 64 + (tid >> 2); const int e = p.topi[(size_t)tok * 4 + (tid & 3)]; const int sl = base[e] + p.rank[(size_t)vb * 256 + tid];
            p.slot[(size_t)tok * 4 + (tid & 3)] = sl; slots[tid] = sl; }
        __syncthreads();
        for (int tk = F.wave; tk < 64; tk += NWAVES) { const int tok = vb * 64 + tk; const bf16_t* xr = p.x2 + (size_t)tok * DM; const float rs = row_rs32g(p.ss2, tok);
#pragma unroll
            for (int j = 0; j < 4; ++j) { const int c = 512 * j + 8 * lane; const f32x4 g0 = *(const f32x4*)(p.norm_moe + c), g1 = *(const f32x4*)(p.norm_moe + c + 4);
                f32x4 xa, xb2; unpack8(*(const u32x4*)(xr + c), xa, xb2);
                const f32x4 a = xa * (rs * pg8::F8_XS) * g0, b = xb2 * (rs * pg8::F8_XS) * g1;
                const u32x2 o = {pg8::pk4_fp8(a[0], a[1], a[2], a[3]), pg8::pk4_fp8(b[0], b[1], b[2], b[3])};
#pragma unroll
                for (int k = 0; k < 4; ++k) *(u32x2*)(p.xg + (size_t)slots[tk * 4 + k] * DM + c) = o; } }
        __syncthreads();
    }
}
#ifdef CSPROBE
#define CSPOISON + (badph >= 0 ? __builtin_exp2f(20.0f + 4.0f * badph) : 0.0f)
#else
#define CSPOISON
#endif
__device__ __forceinline__ void combine_phase(const Params& p, Frame& F) {
    const int lane = ((int)threadIdx.x & 63);
    const bool tmo = __hip_atomic_load(p.ctl + 4096 + XB_TMO, __ATOMIC_RELAXED, __HIP_MEMORY_SCOPE_AGENT) != 0u;
#ifdef CSPROBE
    int badph = -1; { unsigned* prev = p.csprev; for (int i = 15; i >= 0; --i) { const unsigned c = __hip_atomic_load(p.ctl + 65536 + i, __ATOMIC_RELAXED, __HIP_MEMORY_SCOPE_AGENT), o = prev[i]; if (o != 0xAAAAAAAAu && o != c) badph = i; }
      for (int i = 13; i >= 0; --i) if (__hip_atomic_load(p.ctl + 65536 + 32 + i, __ATOMIC_RELAXED, __HIP_MEMORY_SCOPE_AGENT) != 0u) badph = 16 + i; }
#endif
    for (int tok = F.gw; tok < SEQ; tok += F.NGW) {
        const f32x4 w = *(const f32x4*)(p.topw + (size_t)tok * 4); int sl[4];
#pragma unroll
        for (int k = 0; k < 4; ++k) sl[k] = p.slot[(size_t)tok * 4 + k];
        f32x4 v[4][2]; float s = 0.f;
#pragma unroll
        for (int j = 0; j < 4; ++j) { const int c = 512 * j + 8 * lane; unpack8(*(const u32x4*)(p.x2 + (size_t)tok * DM + c), v[j][0], v[j][1]);
#pragma unroll
            for (int k = 0; k < 4; ++k) { f32x4 a, b; unpack8(*(const u32x4*)(p.orow + (size_t)sl[k] * DM + c), a, b); v[j][0] += a * w[k]; v[j][1] += b * w[k]; }
            s += sq4v(v[j][0]) + sq4v(v[j][1]); }
        const float rs = tmo ? __builtin_nanf("") : __builtin_amdgcn_rsqf(wave_sum(s) * (1.0f / DM) + EPS);
#pragma unroll
        for (int j = 0; j < 4; ++j) { const int c = 512 * j + 8 * lane;
            *(f32x4*)(p.out + (size_t)tok * DM + c) = v[j][0] * rs * *(const f32x4*)(p.final_norm + c) CSPOISON; *(f32x4*)(p.out + (size_t)tok * DM + c + 4) = v[j][1] * rs * *(const f32x4*)(p.final_norm + c + 4); }
    }
#ifdef CSPROBE
    __syncthreads();
    if (threadIdx.x == 0) { const unsigned old = atomicAdd(p.ctl + 65536 + 64, 1u); if (old == (unsigned)F.G - 1u) { for (int i = 0; i < 16; ++i) p.csprev[i] = __hip_atomic_load(p.ctl + 65536 + i, __ATOMIC_RELAXED, __HIP_MEMORY_SCOPE_AGENT); } }
#endif
}
template <bool ROPE, bool CAUSAL, class Refs>
__device__ __forceinline__ void attn_stream(const Refs& R, const att::Strides& T, char* lds) {
    const int n = R.count(); if (n <= 0) return;
    att::Seam<ROPE> S; att::BlockRef cur = R.ref(0);
    att::attn_prime<ROPE, CAUSAL>(cur, T, lds, S);
    for (int i = 0; i < n; ++i) { const att::BlockRef nxt = (i + 1 < n) ? R.ref(i + 1) : cur; att::attn_block<ROPE, CAUSAL>(cur, nxt, T, lds, S); cur = nxt; }
}
struct MlaRefs {
    const Params* p; int b, G; bf16_t* obuf;
    __device__ __forceinline__ int count() const { return b < 512 ? 2 * ((512 - b + G - 1) / G) : 0; }
    __device__ __forceinline__ att::BlockRef ref(int i) const {
        const int L = b + (i >> 1) * G, xcd = L & 7, k = L >> 3, head = (k >> 5) * 8 + xcd, y = k & 31, qb = (i & 1) ? 63 - y : y;
        att::BlockRef r; const size_t row0 = (size_t)qb * 256;
        r.Q = p->qn + row0 * DM + head * DNOPE; r.QR = p->qr + row0 * (NHEAD * DROPE) + head * DROPE; r.K = p->kn + head * DNOPE; r.KR = p->kpe; r.V = p->vv + head * DV;
        r.O = obuf + row0 * DM + head * DV; r.P0 = qb * 256; return r; }
};
struct XaRefs {
    const Params* p; int b, G;
    __device__ __forceinline__ int count() const { return b < 256 ? (256 - b + G - 1) / G : 0; }
    __device__ __forceinline__ att::BlockRef ref(int i) const {
        const int L = b + i * G, head = L & 3, qb = L >> 2; att::BlockRef r; const size_t row0 = (size_t)qb * 256;
        r.Q = p->qx + row0 * XW + head * 128; r.QR = nullptr; r.K = p->memkv + head * 128; r.KR = nullptr; r.V = p->memkv + XW + head * 128; r.O = p->ox + row0 * XW + head * 128; r.P0 = 0; return r; }
};


#ifdef CSPROBE
__device__ __forceinline__ void cs_buf(const Params& p, Frame& F, int slot, const void* buf, size_t bytes) {
    const u32x4* q = (const u32x4*)buf; const size_t n = bytes / 16; unsigned x = 0;
    unsigned np = 0;
    for (size_t i = (size_t)F.gw * 64 + (threadIdx.x & 63); i < n; i += (size_t)F.NGW * 64) { const u32x4 v = q[i]; x ^= v.x ^ (v.y * 3u) ^ (v.z * 5u) ^ (v.w * 7u);
        np += (v.x == 0xAAAAAAAAu) + (v.y == 0xAAAAAAAAu) + (v.z == 0xAAAAAAAAu) + (v.w == 0xAAAAAAAAu); }
    if (__any(np != 0)) { if (np) atomicAdd(p.ctl + 65536 + 32 + slot, np); }
#pragma unroll
    for (int o = 1; o < 64; o <<= 1) x ^= __shfl_xor((int)x, o);
    if ((threadIdx.x & 63) == 0) atomicXor(p.ctl + 65536 + slot, x);
}

__device__ __forceinline__ void cs_rows(const Params& p, Frame& F) {
    const int lane = threadIdx.x & 63; unsigned xa = 0, xo = 0;
    for (int tok = F.gw; tok < SEQ; tok += F.NGW) {
#pragma unroll
        for (int k = 0; k < 4; ++k) { const int sl = p.slot[(size_t)tok * 4 + k];
            const u32x4* a = (const u32x4*)(p.act + (size_t)sl * DFF); const u32x4* o = (const u32x4*)(p.orow + (size_t)sl * DM);
            for (int i = lane; i < DFF / 16; i += 64) { const u32x4 v = a[i]; xa ^= (v.x ^ (v.y * 3u) ^ (v.z * 5u) ^ (v.w * 7u)) * (unsigned)(2 * k + 1); }
            for (int i = lane; i < DM * 2 / 16; i += 64) { const u32x4 v = o[i]; xo ^= (v.x ^ (v.y * 3u) ^ (v.z * 5u) ^ (v.w * 7u)) * (unsigned)(2 * k + 1); } } }
#pragma unroll
    for (int o = 1; o < 64; o <<= 1) { xa ^= __shfl_xor((int)xa, o); xo ^= __shfl_xor((int)xo, o); }
    if (lane == 0) { atomicXor(p.ctl + 65536 + 14, xa); atomicXor(p.ctl + 65536 + 15, xo); }
}
#define CS(slot, buf, bytes) cs_buf(p, F, slot, buf, bytes)
#else
#define CS(slot, buf, bytes) do {} while (0)
#endif
constexpr int RING_BYTES = 155648, MISC_OFF = RING_BYTES + 320, LDS_BYTES = 159744;
constexpr int NPHASE = 16;
#ifndef MK_ONE_LAUNCH
#define MK_ONE_LAUNCH 1
#endif

__global__ void __launch_bounds__(NWAVES * 64, 2) hybrid_fwd(Params p) {
    extern __shared__ __attribute__((aligned(16))) unsigned char lds[];
    Frame F;
    F.lds = (LAS unsigned char*)lds; F.wave = __builtin_amdgcn_readfirstlane((int)threadIdx.x >> 6);
    F.G = gridDim.x; { const int bx = blockIdx.x; F.vcu = (F.G % 8 == 0) ? (bx % 8) * (F.G / 8) + bx / 8 : bx; }
    F.gw = F.vcu * NWAVES + F.wave; F.NGW = F.G * NWAVES;
    volatile LAS unsigned* MISC = (volatile LAS unsigned*)(F.lds + MISC_OFF);
    for (int u = threadIdx.x; u < (LDS_BYTES - RING_BYTES) / 4; u += NWAVES * 64) ((LAS unsigned*)(F.lds + RING_BYTES))[u] = 0u;
    __syncthreads();
    const int lo = p.ph_lo, hi = p.ph_hi;
    XcdBarrier bar; bar.bar = p.ctl + 4096; bar.x = 0; bar.st = nullptr;
    if (hi - lo > 1) bar = xcd_barrier_post(p.ctl + 4096, MISC + 8);
#ifndef PHMASK
#define PHMASK 0xFFFF
#endif
#define IN(k) ((((PHMASK) >> (k)) & 1) && lo <= (k) && (k) < hi)
#ifndef NBAR
#define NBAR 1
#endif
#define SEAM(k) do { if (IN(k) && IN((k) + 1)) { xcd_barrier(bar); if (NBAR > 1) xcd_barrier(bar); } } while (0)
    const int G = F.G, bx = blockIdx.x;
    LAS unsigned char* ring = F.lds;

#ifndef REP3_OBUF
#define REP3_OBUF p.ymla
#endif
#ifndef REPMASK
#define REPMASK 0
#endif
#ifndef REPCOND
#define REPCOND 1
#endif
#define REP(k) ((((REPMASK) >> (k)) & 1) && lo <= ((k) & 15) && ((k) & 15) < hi && (REPCOND))
#define B0 { p0_prologue(p, F); }
#define B1 { kpe_phase(p, F); \
        pg8::Gemm g{p.hn, p.WinT, DM, DM, DM, 0}; pg8::StaticOrder S; S.init(SEQ, 6144, G, bx); \
        pg8::EpiProj E{p.ub, p.qa, p.kva, p.sgs, p.sgm, p.qss, p.kvss}; pg8::gemm_phase(ring, g, S, E); }
#define B2 { s5_pass_a(p, F); \
        { pg8::Gemm g{p.qa, p.WuqT, QL, QL, QL, 0}; pg8::StaticOrder S; S.init(SEQ, 3072, G, bx); pg8::EpiQup E{p.qn, p.qr, p.qss, p.cosT, p.sinT}; pg8::gemm_phase(ring, g, S, E); } \
        { pg8::Gemm g{p.kva, p.WukvT, KVL, KVL, KVL, 0}; pg8::StaticOrder S; S.init(SEQ, 4096, G, bx); pg8::EpiKVup E{p.kn, p.vv, p.kvss}; pg8::gemm_phase(ring, g, S, E); } \
        { pg8::Gemm g{p.memn, p.WxkvT, DM, DM, DM, 0}; pg8::StaticOrder S; S.init(MEML, 2 * XW, G, bx); pg8::EpiPlain E{p.memkv, 2 * XW}; pg8::gemm_phase(ring, g, S, E); } }
#define B3A { s5_pass_c(p, F); __syncthreads(); }
#define B3B_(OB) { const att::Strides T{DM, NHEAD * DROPE, DM, DM, DM, SEQ}; const MlaRefs R{&p, bx, G, OB}; for (int i = 0, n = R.count(); i < n; ++i) att::attn_block_simple<true, true>(R.ref(i), T, (char*)lds); }
#define B4 { pg8::Gemm g{p.zb, p.WgluT, SSM_W, SSM_W, SSM_W, 0}; pg8::StaticOrder S; S.init(SEQ, SSM_W, G, bx); pg8::EpiGlu E{p.zb, p.b_glu, p.ys}; pg8::gemm_phase(ring, g, S, E); }
#define B5 { pg8::Gemm g{p.ys, p.WupsT, SSM_W, SSM_W, SSM_W, 0}; pg8::StaticOrder S; S.init(SEQ, DM, G, bx); pg8::EpiGate E{p.sgs, nullptr, p.t1}; pg8::gemm_phase(ring, g, S, E); }
#define B6 { pg8::Gemm g{p.ymla, p.WupmT, DM, DM, DM, 0}; pg8::StaticOrder S; S.init(SEQ, DM, G, bx); pg8::EpiGate E{p.sgm, p.t1, p.mg}; pg8::gemm_phase(ring, g, S, E); }
#define B7 { pg8::Gemm g{p.mg, p.WoutT, DM, DM, DM, 0}; pg8::StaticOrder S; S.init(SEQ, DM, G, bx); pg8::EpiResid<float, false> E{p.x, nullptr, p.x1b, p.ss1}; pg8::gemm_phase(ring, g, S, E); }
#define B8 { pg8::Gemm g{p.x1b, p.WxqT, DM, DM, DM, 0}; pg8::StaticOrder S; S.init(SEQ, XW, G, bx); pg8::EpiXq E{p.qx, p.ss1}; pg8::gemm_phase(ring, g, S, E); }
#define B9 { const att::Strides T{XW, 0, 2 * XW, 2 * XW, XW, MEML}; const XaRefs R{&p, bx, G}; attn_stream<false, false>(R, T, (char*)lds); }
#define B10 { pg8::Gemm g{p.ox, p.WxoT, XW, XW, XW, 0}; pg8::StaticOrder S; S.init(SEQ, DM, G, bx); pg8::EpiResid<bf16_t, false> E{p.x1b, nullptr, p.x2, p.ss2}; pg8::gemm_phase(ring, g, S, E); }
#define B11 { router_phase(p, F); }
#define B12 { assign_phase(p, F); }
#define B13 { const int nblk = __builtin_amdgcn_readfirstlane(p.blke[MAXBLK]); \
        pg8::Gemm g{(const bf16_t*)p.xg, (const bf16_t*)p.WguT, DM / 2, DM / 2, DM / 2, (size_t)2 * DFF * DM / 2}; pg8::MoeOrder S; S.init(nblk, 2 * DFF, G, bx, p.blke); pg8::EpiMoeGU E{p.b_gu, p.act}; pg8::gemm_phase<pg8::EpiMoeGU, pg8::MoeOrder, true>(ring, g, S, E); }
#define B14 { const int nblk = __builtin_amdgcn_readfirstlane(p.blke[MAXBLK]); \
        pg8::Gemm g{(const bf16_t*)p.act, (const bf16_t*)p.WdnT, DFF / 2, DFF / 2, DFF / 2, (size_t)DM * DFF / 2}; pg8::MoeOrder S; S.init(nblk, DM, G, bx, p.blke); pg8::EpiMoeDown E{p.b_dn, p.orow}; pg8::gemm_phase<pg8::EpiMoeDown, pg8::MoeOrder, true>(ring, g, S, E); }
#define B15 { combine_phase(p, F); }
    if (IN(0)) B0 if (REP(0)) B0 SEAM(0);
    if (IN(1)) B1 if (REP(1)) B1 SEAM(1);
    if (IN(2)) B2 if (REP(2)) B2 SEAM(2);
    if (IN(3)) { B3A if (REP(16)) B3A B3B_(p.ymla) if (REP(3)) B3B_(REP3_OBUF) } SEAM(3);
    if (IN(4)) B4 if (REP(4)) B4 SEAM(4);
    if (IN(5)) B5 if (REP(5)) B5 SEAM(5);
    if (IN(6)) B6 if (REP(6)) B6 SEAM(6);
    if (IN(7)) B7 if (REP(7)) B7 SEAM(7);
    if (IN(8)) B8 if (REP(8)) B8 SEAM(8);
    if (IN(9)) B9 if (REP(9)) B9 SEAM(9);
    if (IN(10)) B10 if (REP(10)) B10 SEAM(10);
    if (IN(11)) B11 if (REP(11)) B11 SEAM(11);
    if (IN(12)) B12 if (REP(12)) B12 SEAM(12);
    if (IN(13)) B13 if (REP(13)) B13 SEAM(13);
    if (IN(14)) B14 if (REP(14)) B14 SEAM(14);
#ifdef CSPROBE
    if (IN(15)) { CS(0, p.hn, (size_t)SEQ*DM*2); CS(0, p.WinT, (size_t)6144*DM*2); CS(0, p.WguT, (size_t)NEXP*2*DFF*DM); CS(0, p.WdnT, (size_t)NEXP*DM*DFF); CS(0, p.WuqT, (size_t)3072*QL*2); CS(0, p.WukvT, (size_t)4096*KVL*2); CS(0, p.cosT, (size_t)SEQ*32*4); CS(0, p.sinT, (size_t)SEQ*32*4); CS(0, p.bbarT, (size_t)SSM_G*128*16*2); CS(0, p.cmat, (size_t)SSM_G*16*128*2); CS(0, p.abar, (size_t)SSM_G*SSM_P*8); CS(0, p.WrT, (size_t)DM*NEXP*4); CS(0, p.WkpeT, (size_t)64*DM*2); CS(0, p.WgluT, (size_t)SSM_W*SSM_W*2); CS(0, p.WupsT, (size_t)DM*SSM_W*2); CS(0, p.WupmT, (size_t)DM*DM*2); CS(0, p.WoutT, (size_t)DM*DM*2); CS(0, p.WxqT, (size_t)XW*DM*2); CS(0, p.WxkvT, (size_t)2*XW*DM*2); CS(0, p.WxoT, (size_t)DM*XW*2); CS(0, p.memn, (size_t)MEML*DM*2); CS(1, p.ub, (size_t)SEQ*SSM_W*2); CS(1, p.qa, (size_t)SEQ*QL*2); CS(1, p.kva, (size_t)SEQ*KVL*2); CS(1, p.qss, (size_t)SEQ*8*4); CS(1, p.kvss, (size_t)SEQ*8*4); CS(1, p.sgs, (size_t)SEQ*DM*2); CS(1, p.sgm, (size_t)SEQ*DM*2); CS(1, p.kpe, (size_t)SEQ*DROPE*2); CS(2, p.send, (size_t)S5_NCH*SSM_G*64*8); CS(2, p.qn, (size_t)SEQ*DM*2); CS(2, p.qr, (size_t)SEQ*NHEAD*DROPE*2); CS(2, p.kn, (size_t)SEQ*DM*2); CS(2, p.vv, (size_t)SEQ*DM*2); CS(2, p.memkv, (size_t)MEML*2*XW*2); CS(3, p.zb, (size_t)SEQ*SSM_W*2); CS(4, p.ymla, (size_t)SEQ*DM*2); CS(5, p.ys, (size_t)SEQ*SSM_W*2); CS(6, p.t1, (size_t)SEQ*DM*2); CS(7, p.mg, (size_t)SEQ*DM*2); CS(8, p.x1b, (size_t)SEQ*DM*2); CS(8, p.ss1, (size_t)SEQ*32*4); CS(9, p.qx, (size_t)SEQ*XW*2); CS(10, p.ox, (size_t)SEQ*XW*2); CS(11, p.x2, (size_t)SEQ*DM*2); CS(11, p.ss2, (size_t)SEQ*32*4); CS(12, p.topi, (size_t)SEQ*16); CS(12, p.topw, (size_t)SEQ*16); CS(12, p.rank, (size_t)SEQ*16); CS(12, p.wgcnt, (size_t)256*32*4); CS(13, p.slot, (size_t)SEQ*16); cs_rows(p, F); xcd_barrier(bar); }
#endif
    if (IN(15)) B15 if (REP(15)) B15
#undef IN
#undef SEAM
}

extern "C" void kernel_launch(void* const* d_in, const int* in_sizes, int n_in, void* d_out, int out_size, void* d_ws, size_t ws_size, hipStream_t stream) {
    static int grid = 0;
    if (grid == 0) {
        if (n_in != 37 || in_sizes[0] != SEQ * DM || out_size != SEQ * DM) { fprintf(stderr, "kernel_launch: unexpected shapes (n_in %d)\n", n_in); grid = -1; return; }
        int dev = 0, cus = 0;
        if (hipGetDevice(&dev) != hipSuccess || hipDeviceGetAttribute(&cus, hipDeviceAttributeMultiprocessorCount, dev) != hipSuccess) { grid = -1; return; }
        if (hipFuncSetAttribute((const void*)hybrid_fwd, hipFuncAttributeMaxDynamicSharedMemorySize, LDS_BYTES) != hipSuccess) { fprintf(stderr, "kernel_launch: hipFuncSetAttribute failed\n"); grid = -1; return; }
        int per_cu = 0;
        if (hipOccupancyMaxActiveBlocksPerMultiprocessor(&per_cu, (const void*)hybrid_fwd, NWAVES * 64, LDS_BYTES) != hipSuccess || per_cu < 1) { fprintf(stderr, "kernel_launch: occupancy query says %d\n", per_cu); }
        (void)hipGetLastError();
        grid = cus > 0 ? cus : 256;
    }
    if (grid < 0) return;
    Params p; memset(&p, 0, sizeof(p));
    const float* const* in = (const float* const*)d_in;
    p.x = in[0]; p.mem = in[1]; p.pos = (const int*)d_in[2]; p.norm_mix = in[3]; p.w_in = in[4]; p.lam_re = in[5]; p.lam_im = in[6]; p.log_step = in[7]; p.b_re = in[8]; p.b_im = in[9];
    p.c_re = in[10]; p.c_im = in[11]; p.ssm_d = in[12]; p.w_glu = in[13]; p.b_glu = in[14]; p.q_norm = in[15]; p.w_uq = in[16]; p.kv_norm = in[17]; p.w_uk = in[18]; p.w_uv = in[19];
    p.w_up_ssm = in[20]; p.w_up_mla = in[21]; p.w_out = in[22]; p.norm_xattn = in[23]; p.norm_mem = in[24]; p.xa_wq = in[25]; p.xa_wk = in[26]; p.xa_wv = in[27]; p.xa_wo = in[28];
    p.norm_moe = in[29]; p.router_w = in[30]; p.router_b = in[31]; p.w_gu = in[32]; p.b_gu = in[33]; p.w_dn = in[34]; p.b_dn = in[35]; p.final_norm = in[36];
    p.out = (float*)d_out;
    size_t off = 0; unsigned char* ws = (unsigned char*)d_ws;
    auto take = [&](size_t bytes) { unsigned char* r = ws + off; off += (bytes + 4095) & ~(size_t)4095; return r; };
    p.ctl = (unsigned*)take(1 << 20);
    p.WinT = (bf16_t*)take((size_t)6144 * DM * 2); p.WkpeT = (bf16_t*)take((size_t)64 * DM * 2); p.WgluT = (bf16_t*)take((size_t)SSM_W * SSM_W * 2); p.WuqT = (bf16_t*)take((size_t)3072 * QL * 2);
    p.WukvT = (bf16_t*)take((size_t)4096 * KVL * 2); p.WupsT = (bf16_t*)take((size_t)DM * SSM_W * 2); p.WupmT = (bf16_t*)take((size_t)DM * DM * 2); p.WoutT = (bf16_t*)take((size_t)DM * DM * 2);
    p.WxqT = (bf16_t*)take((size_t)XW * DM * 2); p.WxkvT = (bf16_t*)take((size_t)2 * XW * DM * 2); p.WxoT = (bf16_t*)take((size_t)DM * XW * 2);
    p.WguT = (unsigned char*)take((size_t)NEXP * 2 * DFF * DM); p.WdnT = (unsigned char*)take((size_t)NEXP * DM * DFF); p.WrT = (float*)take((size_t)DM * NEXP * 4);
    p.hn = (bf16_t*)take((size_t)SEQ * DM * 2); p.memn = (bf16_t*)take((size_t)MEML * DM * 2); p.cosT = (float*)take((size_t)SEQ * 32 * 4); p.sinT = (float*)take((size_t)SEQ * 32 * 4);
    p.abar = (float*)take((size_t)SSM_G * SSM_P * 8); p.bbarT = (bf16_t*)take((size_t)SSM_G * 128 * 16 * 2); p.cmat = (bf16_t*)take((size_t)SSM_G * 16 * 128 * 2);
    p.ub = (bf16_t*)take((size_t)SEQ * SSM_W * 2); p.qa = (bf16_t*)take((size_t)SEQ * QL * 2); p.kva = (bf16_t*)take((size_t)SEQ * KVL * 2); p.qss = (float*)take((size_t)SEQ * 8 * 4); p.kvss = (float*)take((size_t)SEQ * 8 * 4);
    p.sgs = (bf16_t*)take((size_t)SEQ * DM * 2); p.sgm = (bf16_t*)take((size_t)SEQ * DM * 2); p.kpe = (bf16_t*)take((size_t)SEQ * DROPE * 2);
    p.qn = (bf16_t*)take((size_t)SEQ * DM * 2); p.qr = (bf16_t*)take((size_t)SEQ * NHEAD * DROPE * 2); p.kn = (bf16_t*)take((size_t)SEQ * DM * 2); p.vv = (bf16_t*)take((size_t)SEQ * DM * 2); p.ymla = (bf16_t*)take((size_t)SEQ * DM * 2);
    p.send = (float*)take((size_t)S5_NCH * SSM_G * 64 * 8); p.zb = (bf16_t*)take((size_t)SEQ * SSM_W * 2); p.ys = (bf16_t*)take((size_t)SEQ * SSM_W * 2); p.t1 = (bf16_t*)take((size_t)SEQ * DM * 2); p.mg = (bf16_t*)take((size_t)SEQ * DM * 2);
    p.x1 = nullptr; p.x1b = (bf16_t*)take((size_t)SEQ * DM * 2); p.ss1 = (float*)take((size_t)SEQ * 32 * 4);
    p.memkv = (bf16_t*)take((size_t)MEML * 2 * XW * 2); p.qx = (bf16_t*)take((size_t)SEQ * XW * 2); p.ox = (bf16_t*)take((size_t)SEQ * XW * 2);
    p.x2 = (bf16_t*)take((size_t)SEQ * DM * 2); p.ss2 = (float*)take((size_t)SEQ * 32 * 4);
    p.csprev = (unsigned*)take(4096); p.topi = (int*)take((size_t)SEQ * 4 * 4); p.topw = (float*)take((size_t)SEQ * 4 * 4); p.rank = (int*)take((size_t)SEQ * 4 * 4); p.slot = (int*)take((size_t)SEQ * 4 * 4); p.wgcnt = (int*)take((size_t)256 * 32 * 4); p.blke = (int*)take((size_t)(MAXBLK + 8) * 4);
    p.xg = (unsigned char*)take((size_t)NSLOT * DM); p.act = (unsigned char*)take((size_t)NSLOT * DFF); p.orow = (bf16_t*)take((size_t)NSLOT * DM * 2);
    if (off > ws_size) { fprintf(stderr, "kernel_launch: workspace too small: need %zu have %zu\n", off, ws_size); return; }
    (void)hipMemsetAsync(p.ctl, 0, 1 << 20, stream);
#if MK_ONE_LAUNCH
    p.ph_lo = 0; p.ph_hi = NPHASE;
    hipLaunchKernelGGL(hybrid_fwd, dim3(grid), dim3(NWAVES * 64), LDS_BYTES, stream, p);
#else
    for (int k = 0; k < NPHASE; ++k) { p.ph_lo = k; p.ph_hi = k + 1; hipLaunchKernelGGL(hybrid_fwd, dim3(grid), dim3(NWAVES * 64), LDS_BYTES, stream, p); }
#endif
}
```

```cpp
#include <hip/hip_runtime.h>
#ifdef USE_CG
#include <hip/hip_cooperative_groups.h>
#endif
#include <cstdio>
#include <cstdint>
#include <cstring>

#ifndef PROJ_F8
#define PROJ_F8 2
#endif
#ifndef OUT_F8
#define OUT_F8 1
#endif
#ifndef MUP_F8
#define MUP_F8 1
#endif
#ifndef QK_F8
#define QK_F8 1
#endif
#ifndef PV_F8
#define PV_F8 1
#endif
#ifndef LAT_F8
#define LAT_F8 1
#endif
#ifndef LAT_P2
#define LAT_P2 1
#endif
#ifndef MLA_X2
#define MLA_X2 0
#endif
#ifndef MOE_IN_MLA
#define MOE_IN_MLA 0
#endif
#ifndef MOE_REG
#define MOE_REG 0
#endif
#ifndef SGM_F8
#define SGM_F8 1
#endif
#ifndef MLA_SEAM
#define MLA_SEAM 0
#endif
#ifndef P56_MERGE
#define P56_MERGE 0
#endif
#ifndef XQ_HALF
#define XQ_HALF 1
#endif
#ifndef XQ_F8
#define XQ_F8 0
#endif
#ifndef P0_PIPE
#define P0_PIPE 0
#endif

#define LAS __attribute__((address_space(3)))
#define GAS __attribute__((address_space(1)))
typedef unsigned short bf16_t;
typedef short bf16x8 __attribute__((ext_vector_type(8)));
typedef short s16x4 __attribute__((ext_vector_type(4)));
typedef float f32x4 __attribute__((ext_vector_type(4)));
typedef float f32x2 __attribute__((ext_vector_type(2)));
typedef float f32x16 __attribute__((ext_vector_type(16)));
typedef unsigned u32x4 __attribute__((ext_vector_type(4)));
typedef unsigned u32x2 __attribute__((ext_vector_type(2)));
typedef GAS unsigned gu32;

constexpr int SEQ = 16384, DM = 2048;
constexpr int SSM_W = 1024, SSM_G = 64, SSM_P = 64, SSM_H = 16;
constexpr int QL = 512, KVL = 512, NHEAD = 16, DNOPE = 128, DROPE = 64, DV = 128;
constexpr int IN_COLS = 6208;
constexpr int MEML = 256, XH = 4, XW = 512;
constexpr int NEXP = 32, TOPK = 4, DFF = 2048;
constexpr int NSLOT = SEQ * TOPK + NEXP * 256;
constexpr int MAXBLK = NSLOT / 256;
constexpr float EPS = 1e-6f;
constexpr int NWAVES = 8;

#define LDS_WAIT() asm volatile("s_waitcnt lgkmcnt(0)" ::: "memory")
#define VM_WAIT() asm volatile("s_waitcnt vmcnt(0)" ::: "memory")
#define SBAR() __builtin_amdgcn_sched_barrier(0)
__device__ __forceinline__ unsigned cvtpk(float lo, float hi) { unsigned r; asm volatile("v_cvt_pk_bf16_f32 %0, %1, %2" : "=v"(r) : "v"(lo), "v"(hi)); return r; }
__device__ __forceinline__ float bf2f(unsigned short b) { return __uint_as_float(((unsigned)b) << 16); }
__device__ __forceinline__ float bflo(unsigned w) { return __uint_as_float(w << 16); }
__device__ __forceinline__ float bfhi(unsigned w) { return __uint_as_float(w & 0xffff0000u); }
__device__ __forceinline__ unsigned short f2bf(float f) { return (unsigned short)(cvtpk(f, f) & 0xffffu); }
__device__ __forceinline__ u32x4 pack8f(f32x4 a, f32x4 b) { u32x4 w = {cvtpk(a[0], a[1]), cvtpk(a[2], a[3]), cvtpk(b[0], b[1]), cvtpk(b[2], b[3])}; return w; }
__device__ __forceinline__ void unpack8(u32x4 w, f32x4& a, f32x4& b) { a = (f32x4){bflo(w.x), bfhi(w.x), bflo(w.y), bfhi(w.y)}; b = (f32x4){bflo(w.z), bfhi(w.z), bflo(w.w), bfhi(w.w)}; }
__device__ __forceinline__ float fsigmoid(float x) { return __builtin_amdgcn_rcpf(1.0f + __builtin_amdgcn_exp2f(-1.4426950408889634f * x)); }
__device__ __forceinline__ float gelu_tanh(float x) {
    const float u = 0.7978845608028654f * (x + 0.044715f * x * x * x);
    return x * fsigmoid(2.0f * u);
}
template <int CTRL> __device__ __forceinline__ float dppf(float v) { return __uint_as_float((unsigned)__builtin_amdgcn_update_dpp(0, (int)__float_as_uint(v), CTRL, 0xF, 0xF, false)); }
__device__ __forceinline__ float sum_x32(float v) { auto r = __builtin_amdgcn_permlane32_swap(__float_as_uint(v), __float_as_uint(v), false, false); return __uint_as_float(r[0]) + __uint_as_float(r[1]); }
__device__ __forceinline__ float sum_x16(float v) { auto r = __builtin_amdgcn_permlane16_swap(__float_as_uint(v), __float_as_uint(v), false, false); return __uint_as_float(r[0]) + __uint_as_float(r[1]); }
__device__ __forceinline__ float other_half(float v, int hi) { auto r = __builtin_amdgcn_permlane32_swap(__float_as_uint(v), __float_as_uint(v), false, false); return __uint_as_float(hi ? r[0] : r[1]); }
__device__ __forceinline__ float lane_x1(float v) { return dppf<0xB1>(v); }
__device__ __forceinline__ float wave_sum(float v) {
    v += dppf<0x128>(v); v += dppf<0x124>(v); v += dppf<0x122>(v); v += dppf<0x121>(v);
    return sum_x32(sum_x16(v));
}

#define XB_TMO      128
#define XB_XCNT(j)  (256  + 64 * (j))
#define XB_XSUB(j)  (1280 + 64 * (j))
#define XB_XGEN(j)  (2304 + 64 * (j))
#define XB_TOP      3328
#define XB_TOPGEN   3392
#define XCD_BAR_WORDS 3456
#define XB_SPIN_CAP (1u << 18)
__device__ __forceinline__ unsigned xb_ld(unsigned* p)              { return __hip_atomic_load(p, __ATOMIC_RELAXED, __HIP_MEMORY_SCOPE_AGENT); }
__device__ __forceinline__ unsigned xb_add(unsigned* p, unsigned v) { return __hip_atomic_fetch_add(p, v, __ATOMIC_RELAXED, __HIP_MEMORY_SCOPE_AGENT); }
__device__ __forceinline__ unsigned xb_xcc_id() { return (unsigned)__builtin_amdgcn_s_getreg((3 << 11) | 20) & 0xFu; }
#define XB_SPIN(cond, bar) do { unsigned _sp = 0; while (cond) { __builtin_amdgcn_s_sleep(1); \
    if ((++_sp & 255u) == 0u) { if (xb_ld(&(bar)[XB_TMO])) break; if (_sp > XB_SPIN_CAP) { atomicAdd(&(bar)[XB_TMO], 1u); break; } } } } while (0)
#ifndef XB_ACQ_SYS
#define XB_ACQ_SYS 0
#endif
#define XB_ACQUIRE() do { if (XB_ACQ_SYS) __builtin_amdgcn_fence(__ATOMIC_ACQUIRE, ""); else __builtin_amdgcn_fence(__ATOMIC_ACQUIRE, "agent"); } while (0)
struct XcdBarrier { unsigned* bar; unsigned x; volatile LAS unsigned* st; };
__device__ __forceinline__ XcdBarrier xcd_barrier_post(unsigned* bar, volatile LAS unsigned* st) {
    XcdBarrier b; b.bar = bar; b.x = xb_xcc_id(); b.st = st;
    if (threadIdx.x == 0) (void)xb_add(&bar[XB_XCNT(b.x)], 1u);
    return b;
}
__device__ __forceinline__ void xcd_barrier_complete(unsigned* bar, unsigned x, unsigned& nloc, unsigned& nx) {
    const unsigned G = gridDim.x * gridDim.y * gridDim.z;
    unsigned sum, cnt, mine, sp = 0u;
    for (;;) {
        sum = 0u; cnt = 0u; mine = 0u;
#pragma unroll
        for (unsigned j = 0; j < 16; ++j) { const unsigned c = xb_ld(&bar[XB_XCNT(j)]); sum += c; cnt += (c > 0u) ? 1u : 0u; mine = (j == x) ? c : mine; }
        if (sum == G) break;
        __builtin_amdgcn_s_sleep(1);
        if ((++sp & 255u) == 0u) { if (xb_ld(&bar[XB_TMO])) break; if (sp > XB_SPIN_CAP) { atomicAdd(&bar[XB_TMO], 1u); break; } }
    }
    nloc = mine > 0u ? mine : 1u; nx = cnt > 0u ? cnt : 1u;
}
__device__ __forceinline__ void xcd_barrier(const XcdBarrier& b) {
    asm volatile("s_waitcnt vmcnt(0)" ::: "memory");
    __syncthreads();
    if (threadIdx.x == 0) {
        unsigned* bar = b.bar;
        __builtin_amdgcn_s_waitcnt(0);
        unsigned nloc = b.st[0], nx = b.st[1];
        if (nloc == 0u) { xcd_barrier_complete(bar, b.x, nloc, nx); b.st[0] = nloc; b.st[1] = nx; }
        const unsigned old = xb_add(&bar[XB_XSUB(b.x)], 1u);
        const unsigned gen = old / nloc;
        if (old + 1u == (gen + 1u) * nloc) {
            __builtin_amdgcn_fence(__ATOMIC_RELEASE, "agent");
            asm volatile("s_waitcnt vmcnt(0)" ::: "memory");
            const unsigned og = xb_add(&bar[XB_TOP], 1u);
            const unsigned tg = og / nx;
            if (og + 1u == (tg + 1u) * nx) xb_add(&bar[XB_TOPGEN], 1u);
            else XB_SPIN(xb_ld(&bar[XB_TOPGEN]) == tg, bar);
            XB_ACQUIRE();
            xb_add(&bar[XB_XGEN(b.x)], 1u);
            asm volatile("s_waitcnt vmcnt(0)" ::: "memory");
        } else {
            XB_SPIN(xb_ld(&bar[XB_XGEN(b.x)]) == gen, bar);
            XB_ACQUIRE();
            asm volatile("s_waitcnt vmcnt(0)" ::: "memory");
        }
    }
    __syncthreads();
}
namespace pg8 {
constexpr int BM = 256, BK = 64, HALF = 128, HTB = HALF * BK * 2, NXCD = 8, WGM = 8;
__host__ __device__ __forceinline__ int lds_byte(int r, int c) { const int st = (r >> 4) * 2 + (c >> 5), rr = r & 15, cc = c & 31, ob = rr * 64 + cc * 2; return st * 1024 + (ob ^ (((ob >> 9) & 1) << 5)); }
__host__ __device__ __forceinline__ void stage_rc(int b, int& R, int& C) { const int st = b / 1024, sb = b % 1024, swz = sb ^ (((sb >> 9) & 1) << 5); R = (st >> 1) * 16 + swz / 64; C = (st & 1) * 32 + (swz % 64) / 2; }
__host__ __device__ __forceinline__ int perm32(int rho) { const int n = rho >> 4, i = rho & 15; return 8 * (i >> 2) + 4 * n + (i & 3); }

struct Unit { int pm, pn, e; };
struct Gemm { const bf16_t* A; const bf16_t* Bt; int lda, ldb, K; size_t bstride; };

struct StaticOrder {
    static constexpr int RB = BM; static constexpr bool HM = false;
    int nM, nN, nwg, G, c;
    __device__ void init(int M, int N, int G_, int c_) { nM = M / BM; nN = N / BM; nwg = nM * nN; G = G_; c = c_; }
    __device__ bool next(int i, Unit& u) const {
        const long L = (long)i * G + c; if (L >= nwg) return false;
        int wgid = (int)L; { const int q = nwg / NXCD, r = nwg % NXCD, xcd = wgid % NXCD, off = wgid / NXCD; wgid = (xcd < r ? xcd * (q + 1) : r * (q + 1) + (xcd - r) * q) + off; }
        const int nig = WGM * nN, gid = wgid / nig, fm = gid * WGM, gsz = (nM - fm) < WGM ? (nM - fm) : WGM;
        u.pm = fm + ((wgid % nig) % gsz); u.pn = (wgid % nig) / gsz; u.e = 0; return true;
    }
};
struct HalfOrder {
    static constexpr int RB = HALF; static constexpr bool HM = true;
    StaticOrder so;
    __device__ void init(int M, int N, int G_, int c_) { so.nM = M / HALF; so.nN = N / BM; so.nwg = so.nM * so.nN; so.G = G_; so.c = c_; }
    __device__ bool next(int i, Unit& u) const { return so.next(i, u); }
};
struct MoeOrder {
    static constexpr int RB = BM; static constexpr bool HM = false;
    StaticOrder so; const LAS int* blk_e;
    __device__ void init(int nblk, int N, int G_, int c_, const LAS int* be) { so.nM = nblk; so.nN = N / BM; so.nwg = so.nM * so.nN; so.G = G_; so.c = c_; blk_e = be; }
    __device__ bool next(int i, Unit& u) const { if (!so.next(i, u)) return false; u.e = __builtin_amdgcn_readfirstlane(blk_e[u.pm]); return true; }
};

typedef int v4i_t __attribute__((ext_vector_type(4)));
typedef int v8i_t __attribute__((ext_vector_type(8)));
#define PG8_CAT8(a, b) __builtin_shufflevector(__builtin_bit_cast(v4i_t, a), __builtin_bit_cast(v4i_t, b), 0, 1, 2, 3, 4, 5, 6, 7)
template <class Epi, class Sched, bool F8 = false>
__device__ __forceinline__ void gemm_phase(LAS unsigned char* lds, const Gemm g, const Sched& S, const Epi& E) {
    constexpr bool ALIGN_EPI = true;
    int tid = threadIdx.x; asm volatile("" : "+v"(tid));
    const int wid = __builtin_amdgcn_readfirstlane(tid >> 6), lane = tid & 63, wr = wid >> 2, wc = wid & 3, fr = lane & 15, fq = lane >> 4;
    const int K = g.K, nt = K / BK;
    unsigned voffA[2], voffB[2];
#pragma unroll
    for (int i = 0; i < 2; ++i) { int R, C; stage_rc(tid * 16 + i * 8192, R, C); const int Rb = Epi::PERM ? ((R & ~31) + perm32(R & 31)) : R;
        voffA[i] = (unsigned)(R * g.lda + C) * 2u; voffB[i] = (unsigned)(Rb * g.ldb + C) * 2u; }
    const size_t kstep = (size_t)(BK * 2);
    const size_t hstepA = (size_t)HALF * g.lda * 2, hstepB = (size_t)HALF * g.ldb * 2;
    const unsigned ldsw = (unsigned)wid * 1024u;
    const int aoff = lds_byte(wr * 64 + fr, fq * 8), boff = lds_byte(wc * 32 + fr, fq * 8);
#define PG8_SA(b, h) (((b) * 2 + (h)) * HTB)
#define PG8_SB(b, h) ((4 + (b) * 2 + (h)) * HTB)
#define PG8_STAGE(bufoff, gbase, voff) do { _Pragma("unroll") for (int _i = 0; _i < 2; ++_i) \
        __builtin_amdgcn_global_load_lds((const unsigned*)((const char*)(gbase) + (voff)[_i]), (LAS unsigned*)(lds + (bufoff) + ldsw + _i * 8192), 16, 0, 0); } while (0)
#define PG8_LDA(dst, b, h) do { _Pragma("unroll") for (int m = 0; m < 4; ++m) _Pragma("unroll") for (int k = 0; k < 2; ++k) dst[m][k] = *(const LAS bf16x8*)(lds + PG8_SA(b, h) + aoff + m * 2048 + k * 1024); } while (0)
#define PG8_LDB(dst, b, h) do { _Pragma("unroll") for (int n = 0; n < 2; ++n) _Pragma("unroll") for (int k = 0; k < 2; ++k) dst[n][k] = *(const LAS bf16x8*)(lds + PG8_SB(b, h) + boff + n * 2048 + k * 1024); } while (0)
#define PG8_MMA(ai, bj, At, Bt) do { __builtin_amdgcn_s_setprio(1); _Pragma("unroll") for (int m = 0; m < 4; ++m) _Pragma("unroll") for (int n = 0; n < 2; ++n) { \
        if constexpr (F8) { const v8i_t b8_ = PG8_CAT8(Bt[n][0], Bt[n][1]), a8_ = PG8_CAT8(At[m][0], At[m][1]); asm volatile("v_mfma_f32_16x16x128_f8f6f4 %0, %1, %2, %0" : "+v"(acc[ai][bj][m][n]) : "v"(b8_), "v"(a8_)); }   \
        else { _Pragma("unroll") for (int k = 0; k < 2; ++k) acc[ai][bj][m][n] = __builtin_amdgcn_mfma_f32_16x16x32_bf16(Bt[n][k], At[m][k], acc[ai][bj][m][n], 0, 0, 0); } } __builtin_amdgcn_s_setprio(0); } while (0)
#define PG8_WAIT_V(n) asm volatile("s_waitcnt vmcnt(" #n ")" ::: "memory")
#define PG8_WAIT_L(n) asm volatile("s_waitcnt lgkmcnt(" #n ")" ::: "memory")
#define PG8_BAR __builtin_amdgcn_s_barrier()
#define PG8_SCHED __builtin_amdgcn_sched_barrier(0)
#define PG8_ABASE(u) ((const char*)g.A + (size_t)(u).pm * Sched::RB * g.lda * 2)
#define PG8_BBASE(u) ((const char*)g.Bt + ((size_t)(u).e * g.bstride + (size_t)(u).pn * BM * g.ldb) * 2)
    Unit cur, nxt; int ui = 0;
    if (!S.next(0, cur)) return;
    f32x4 acc[2][2][4][2];
#pragma unroll
    for (int a = 0; a < 2; ++a)
#pragma unroll
        for (int b = 0; b < 2; ++b)
#pragma unroll
            for (int m = 0; m < 4; ++m)
#pragma unroll
                for (int n = 0; n < 2; ++n) acc[a][b][m][n] = (f32x4){0.f, 0.f, 0.f, 0.f};
    if constexpr (F8) {
#pragma unroll
        for (int a = 0; a < 2; ++a)
#pragma unroll
            for (int b = 0; b < 2; ++b)
#pragma unroll
                for (int m = 0; m < 4; ++m)
#pragma unroll
                    for (int n = 0; n < 2; ++n) asm volatile("" : "+v"(acc[a][b][m][n])); }
    bf16x8 At[4][2], B0[2][2], B1[2][2];
    const char* cA = PG8_ABASE(cur); const char* cB = PG8_BBASE(cur);
    PG8_STAGE(PG8_SB(0, 0), cB, voffB); PG8_STAGE(PG8_SB(0, 1), cB + hstepB, voffB); PG8_STAGE(PG8_SA(0, 0), cA, voffA); PG8_STAGE(PG8_SA(0, 1), cA + hstepA, voffA);
    if (wr == 1) PG8_BAR;
    PG8_WAIT_V(2); PG8_BAR;
    PG8_STAGE(PG8_SB(1, 0), cB + kstep, voffB); PG8_STAGE(PG8_SA(1, 0), cA + kstep, voffA); PG8_STAGE(PG8_SB(1, 1), cB + hstepB + kstep, voffB);
    PG8_WAIT_V(6); PG8_BAR;
    for (;;) {
        const bool has_next = S.next(ui + 1, nxt);
        const char* nA = has_next ? PG8_ABASE(nxt) : cA; const char* nB = has_next ? PG8_BBASE(nxt) : cB;
        for (int t = 0; t < nt; t += 2) {
            const bool last = (t == nt - 2);
            const char* a1 = cA + (size_t)(t + 1) * kstep;
            const char* a2 = last ? nA : cA + (size_t)(t + 2) * kstep; const char* b2 = last ? nB : cB + (size_t)(t + 2) * kstep;
            const char* a3 = a2 + kstep; const char* b3 = b2 + kstep;
            PG8_LDB(B0, 0, 0); PG8_LDB(B1, 0, 1); PG8_SCHED; PG8_LDA(At, 0, 0); PG8_STAGE(PG8_SA(1, 1), a1 + hstepA, voffA);
            PG8_WAIT_V(8); PG8_WAIT_L(0); PG8_BAR; PG8_MMA(0, 0, At, B0); PG8_MMA(0, 1, At, B1); PG8_BAR; PG8_SCHED;
            if constexpr (!Sched::HM) { PG8_LDA(At, 0, 1); } PG8_STAGE(PG8_SB(0, 0), b2, voffB); PG8_STAGE(PG8_SB(0, 1), b2 + hstepB, voffB); PG8_STAGE(PG8_SA(0, 0), a2, voffA);
            PG8_WAIT_V(8); PG8_WAIT_L(0); PG8_BAR; if constexpr (!Sched::HM) { PG8_MMA(1, 0, At, B0); PG8_MMA(1, 1, At, B1); } PG8_BAR; PG8_SCHED;
            PG8_LDB(B0, 1, 0); PG8_LDB(B1, 1, 1); PG8_SCHED; PG8_LDA(At, 1, 0); PG8_STAGE(PG8_SA(0, 1), a2 + hstepA, voffA);
            PG8_WAIT_V(8); PG8_WAIT_L(0); PG8_BAR; PG8_MMA(0, 0, At, B0); PG8_MMA(0, 1, At, B1); PG8_BAR; PG8_SCHED;
            if constexpr (!Sched::HM) { PG8_LDA(At, 1, 1); } PG8_STAGE(PG8_SB(1, 0), b3, voffB); PG8_STAGE(PG8_SB(1, 1), b3 + hstepB, voffB); PG8_STAGE(PG8_SA(1, 0), a3, voffA);
            PG8_WAIT_V(8); PG8_WAIT_L(0); PG8_BAR; if constexpr (!Sched::HM) { PG8_MMA(1, 0, At, B0); PG8_MMA(1, 1, At, B1); } PG8_BAR; PG8_SCHED;
        }
        if constexpr (ALIGN_EPI) { if (wr == 0) PG8_BAR; }
        if constexpr (F8) asm volatile("s_nop 15\n\ts_nop 15\n\ts_nop 15" ::: "memory");
        E(acc, cur, wr, wc, fr, fq);
        if (!has_next) break;
#pragma unroll
        for (int a = 0; a < 2; ++a)
#pragma unroll
            for (int b = 0; b < 2; ++b)
#pragma unroll
                for (int m = 0; m < 4; ++m)
#pragma unroll
                    for (int n = 0; n < 2; ++n) acc[a][b][m][n] = (f32x4){0.f, 0.f, 0.f, 0.f};
    if constexpr (F8) {
#pragma unroll
        for (int a = 0; a < 2; ++a)
#pragma unroll
            for (int b = 0; b < 2; ++b)
#pragma unroll
                for (int m = 0; m < 4; ++m)
#pragma unroll
                    for (int n = 0; n < 2; ++n) asm volatile("" : "+v"(acc[a][b][m][n])); }
        cur = nxt; cA = nA; cB = nB; ++ui;
        if constexpr (ALIGN_EPI) { if (wr == 1) PG8_BAR; }
    }
    PG8_WAIT_V(0);
    if constexpr (!ALIGN_EPI) { if (wr == 0) PG8_BAR; }
    PG8_BAR;
#undef PG8_SA
#undef PG8_SB
#undef PG8_STAGE
#undef PG8_LDA
#undef PG8_LDB
#undef PG8_MMA
#undef PG8_WAIT_V
#undef PG8_WAIT_L
#undef PG8_BAR
#undef PG8_SCHED
#undef PG8_ABASE
#undef PG8_BBASE
}

#define EPI_ROW(u, ai, m) ((u).pm * BM + (ai) * HALF + wr * 64 + (m) * 16 + fr)
#define EPI_CB(bj) ((bj) * HALF + wc * 32 + 8 * fq)
typedef f32x4 AccT[2][2][4][2];

__device__ __forceinline__ f32x4 sig4(f32x4 v) { return (f32x4){fsigmoid(v[0]), fsigmoid(v[1]), fsigmoid(v[2]), fsigmoid(v[3])}; }
__device__ __forceinline__ float sq4(f32x4 v) { return (v[0] * v[0] + v[1] * v[1]) + (v[2] * v[2] + v[3] * v[3]); }

constexpr float F8_XS = 8.0f, F8_WS = 512.0f, F8_AS = 4.0f;
__device__ __forceinline__ unsigned pk4_fp8(float a, float b, float c, float d) {
    a = fminf(fmaxf(a, -448.f), 448.f); b = fminf(fmaxf(b, -448.f), 448.f); c = fminf(fmaxf(c, -448.f), 448.f); d = fminf(fmaxf(d, -448.f), 448.f);
    int w = __builtin_amdgcn_cvt_pk_fp8_f32(a, b, 0, false); w = __builtin_amdgcn_cvt_pk_fp8_f32(c, d, w, true); return (unsigned)w; }
struct EpiProj {
    static constexpr bool PERM = true;
    bf16_t *ub, *qa, *kva, *sgs, *sgm; float *qss, *kvss; float sc; int pn_off; static constexpr bool l8 = (LAT_P2 != 0);
    __device__ __forceinline__ void operator()(const AccT& acc, const Unit& u, int wr, int wc, int fr, int fq) const {
        const int pn = u.pn + pn_off; bf16_t* dst; int ld, c0; float* ss = nullptr; int ssl = 0; bool sg = false;
        if (pn < 4) { dst = ub; ld = SSM_W; c0 = pn * BM; }
        else if (pn < 6) { dst = qa; ld = QL; c0 = (pn - 4) * BM; ss = qss; ssl = (pn - 4) * 4 + wc; }
        else if (pn < 8) { dst = kva; ld = KVL; c0 = (pn - 6) * BM; ss = kvss; ssl = (pn - 6) * 4 + wc; }
        else if (pn < 16) { dst = sgs; ld = DM; c0 = (pn - 8) * BM; sg = true; }
        else { dst = sgm; ld = DM; c0 = (pn - 16) * BM; sg = true; }
#pragma unroll
        for (int ai = 0; ai < 2; ++ai)
#pragma unroll
            for (int m = 0; m < 4; ++m) { const int row = EPI_ROW(u, ai, m); float s = 0.f;
#pragma unroll
                for (int bj = 0; bj < 2; ++bj) { f32x4 v0 = acc[ai][bj][m][0] * sc, v1 = acc[ai][bj][m][1] * sc;
                    if (sg) { v0 = sig4(v0); v1 = sig4(v1); }
                    s += sq4(v0) + sq4(v1);
                    if (SGM_F8 && pn >= 16) { const f32x4 w0 = v0 * 256.0f, w1 = v1 * 256.0f; const u32x2 o8 = {pk4_fp8(w0[0], w0[1], w0[2], w0[3]), pk4_fp8(w1[0], w1[1], w1[2], w1[3])}; *(u32x2*)((unsigned char*)dst + (size_t)row * ld + c0 + EPI_CB(bj)) = o8; }
                    else if (l8 && ss) { const f32x4 w0 = v0 * F8_XS, w1 = v1 * F8_XS; const u32x2 o8 = {pk4_fp8(w0[0], w0[1], w0[2], w0[3]), pk4_fp8(w1[0], w1[1], w1[2], w1[3])}; *(u32x2*)((unsigned char*)dst + (size_t)row * ld + c0 + EPI_CB(bj)) = o8; }
                    else *(u32x4*)(dst + (size_t)row * ld + c0 + EPI_CB(bj)) = pack8f(v0, v1); }
                if (ss) { s = sum_x32(sum_x16(s)); if (fq == 0) ss[((size_t)(ssl >> 2) * SEQ + row) * 4 + (ssl & 3)] = s; } }
    }
};
__device__ __forceinline__ float row_rs8(const float* ss, int row, float invn) { const f32x4 a = *(const f32x4*)(ss + (size_t)row * 4), b = *(const f32x4*)(ss + ((size_t)SEQ + row) * 4);
    return __builtin_amdgcn_rsqf(((a[0] + a[1]) + (a[2] + a[3]) + (b[0] + b[1]) + (b[2] + b[3])) * invn + EPS); }
__device__ __forceinline__ float row_rs32(const float* ss, int row, float invn) { float s = 0.f;
#pragma unroll
    for (int i = 0; i < 8; ++i) { const f32x4 a = *(const f32x4*)(ss + ((size_t)i * SEQ + row) * 4); s += (a[0] + a[1]) + (a[2] + a[3]); }
    return __builtin_amdgcn_rsqf(s * invn + EPS); }

struct EpiQup {
    static constexpr bool PERM = true;
    bf16_t *qn, *qr; const float *ss, *cosT, *sinT; float sc; static constexpr bool f8 = (QK_F8 != 0);
    __device__ __forceinline__ void operator()(const AccT& acc, const Unit& u, int wr, int wc, int fr, int fq) const {
        const int pn = u.pn;
#pragma unroll
        for (int ai = 0; ai < 2; ++ai)
#pragma unroll
            for (int m = 0; m < 4; ++m) { const int row = EPI_ROW(u, ai, m); const float rs = row_rs8(ss, row, 1.0f / QL) * sc;
                if (pn < 8) {
#pragma unroll
                    for (int bj = 0; bj < 2; ++bj) { const f32x4 v0 = acc[ai][bj][m][0] * rs, v1 = acc[ai][bj][m][1] * rs;
                        if (f8) { const f32x4 w0 = v0 * F8_XS, w1 = v1 * F8_XS; const u32x2 o8 = {pk4_fp8(w0[0], w0[1], w0[2], w0[3]), pk4_fp8(w1[0], w1[1], w1[2], w1[3])}; *(u32x2*)((unsigned char*)qn + (size_t)row * DM + pn * BM + EPI_CB(bj)) = o8; }
                        else *(u32x4*)(qn + (size_t)row * DM + pn * BM + EPI_CB(bj)) = pack8f(v0, v1); }
                } else {
                    const int head = 4 * (pn - 8) + wc;
                    const f32x4 c0 = *(const f32x4*)(cosT + (size_t)row * 32 + 8 * fq), c1 = *(const f32x4*)(cosT + (size_t)row * 32 + 8 * fq + 4);
                    const f32x4 s0 = *(const f32x4*)(sinT + (size_t)row * 32 + 8 * fq), s1 = *(const f32x4*)(sinT + (size_t)row * 32 + 8 * fq + 4);
                    const f32x4 a0 = acc[ai][0][m][0] * rs, a1 = acc[ai][0][m][1] * rs, b0 = acc[ai][1][m][0] * rs, b1 = acc[ai][1][m][1] * rs;
                    const f32x4 x0 = a0 * c0 - b0 * s0, x1 = a1 * c1 - b1 * s1, y0 = a0 * s0 + b0 * c0, y1 = a1 * s1 + b1 * c1;
                    if (f8) { unsigned char* q8 = (unsigned char*)qr + (size_t)row * (NHEAD * DROPE) + head * DROPE + 8 * fq; const f32x4 X0 = x0 * F8_XS, X1 = x1 * F8_XS, Y0 = y0 * F8_XS, Y1 = y1 * F8_XS;
                        const u32x2 ox = {pk4_fp8(X0[0], X0[1], X0[2], X0[3]), pk4_fp8(X1[0], X1[1], X1[2], X1[3])}, oy = {pk4_fp8(Y0[0], Y0[1], Y0[2], Y0[3]), pk4_fp8(Y1[0], Y1[1], Y1[2], Y1[3])};
                        *(u32x2*)q8 = ox; *(u32x2*)(q8 + 32) = oy; }
                    else {
                    *(u32x4*)(qr + (size_t)row * (NHEAD * DROPE) + head * DROPE + 8 * fq) = pack8f(x0, x1);
                    *(u32x4*)(qr + (size_t)row * (NHEAD * DROPE) + head * DROPE + 32 + 8 * fq) = pack8f(y0, y1); }
                } }
    }
};
struct EpiKVup {
    static constexpr bool PERM = true;
    bf16_t *kn, *vv; const float* ss; float sc; static constexpr bool f8 = (QK_F8 != 0), v8 = (QK_F8 != 0) && (PV_F8 != 0);
    __device__ __forceinline__ void operator()(const AccT& acc, const Unit& u, int wr, int wc, int fr, int fq) const {
        bf16_t* dst = u.pn < 8 ? kn : vv; const int c0 = (u.pn & 7) * BM;
#pragma unroll
        for (int ai = 0; ai < 2; ++ai)
#pragma unroll
            for (int m = 0; m < 4; ++m) { const int row = EPI_ROW(u, ai, m); const float rs = row_rs8(ss, row, 1.0f / KVL) * sc;
#pragma unroll
                for (int bj = 0; bj < 2; ++bj) { const f32x4 v0 = acc[ai][bj][m][0] * rs, v1 = acc[ai][bj][m][1] * rs;
                    if (f8 && u.pn < 8) { const f32x4 w0 = v0 * F8_XS, w1 = v1 * F8_XS; const u32x2 o8 = {pk4_fp8(w0[0], w0[1], w0[2], w0[3]), pk4_fp8(w1[0], w1[1], w1[2], w1[3])}; *(u32x2*)((unsigned char*)kn + (size_t)row * DM + c0 + EPI_CB(bj)) = o8; }
                    else if (v8 && u.pn >= 8) { const f32x4 w0 = v0 * F8_XS, w1 = v1 * F8_XS; const unsigned lo = pk4_fp8(w0[0], w0[1], w0[2], w0[3]), hi4 = pk4_fp8(w1[0], w1[1], w1[2], w1[3]);
                        const int jq = fr & 3; const unsigned sel = (unsigned)jq | ((unsigned)(4 + jq) << 8) | 0x0c0c0000u;
                        unsigned T2[2];
#pragma unroll
                        for (int h2 = 0; h2 < 2; ++h2) { const int W = (int)(h2 ? hi4 : lo);
                            const unsigned A0 = (unsigned)__builtin_amdgcn_update_dpp(0, W, 0x00, 0xF, 0xF, false), A1 = (unsigned)__builtin_amdgcn_update_dpp(0, W, 0x55, 0xF, 0xF, false);
                            const unsigned A2 = (unsigned)__builtin_amdgcn_update_dpp(0, W, 0xAA, 0xF, 0xF, false), A3 = (unsigned)__builtin_amdgcn_update_dpp(0, W, 0xFF, 0xF, 0xF, false);
                            const unsigned r01 = __builtin_amdgcn_perm(A1, A0, sel), r23 = __builtin_amdgcn_perm(A3, A2, sel);
                            T2[h2] = __builtin_amdgcn_perm(r23, r01, 0x05040100u); }
                        const int col = c0 + EPI_CB(bj) + jq, k6b = (row - jq) & 63, posb = 32 * ((k6b >> 2) & 1) + 4 * (k6b >> 3);
                        unsigned char* vt = (unsigned char*)vv + ((size_t)((col >> 7) * (SEQ / 64) + (row >> 6)) * 128 + (col & 127)) * 64 + posb;
                        *(unsigned*)vt = T2[0]; *(unsigned*)(vt + 4 * 64) = T2[1]; }
                    else *(u32x4*)(dst + (size_t)row * DM + c0 + EPI_CB(bj)) = pack8f(v0, v1); } }
    }
};
struct EpiPlain {
    static constexpr bool PERM = true;
    bf16_t* O; int ld;
    __device__ __forceinline__ void operator()(const AccT& acc, const Unit& u, int wr, int wc, int fr, int fq) const {
#pragma unroll
        for (int ai = 0; ai < 2; ++ai)
#pragma unroll
            for (int m = 0; m < 4; ++m) { const int row = EPI_ROW(u, ai, m);
#pragma unroll
                for (int bj = 0; bj < 2; ++bj) *(u32x4*)(O + (size_t)row * ld + u.pn * BM + EPI_CB(bj)) = pack8f(acc[ai][bj][m][0], acc[ai][bj][m][1]); }
    }
};
struct EpiGlu {
    static constexpr bool PERM = true;
    const bf16_t* z; const float* bias; bf16_t* ys;
    __device__ __forceinline__ void operator()(const AccT& acc, const Unit& u, int wr, int wc, int fr, int fq) const {
#pragma unroll
        for (int bj = 0; bj < 2; ++bj) { const int col = u.pn * BM + EPI_CB(bj); const f32x4 b0 = *(const f32x4*)(bias + col), b1 = *(const f32x4*)(bias + col + 4);
#pragma unroll
            for (int ai = 0; ai < 2; ++ai)
#pragma unroll
                for (int m = 0; m < 4; ++m) { const size_t off = (size_t)EPI_ROW(u, ai, m) * SSM_W + col; f32x4 z0, z1; unpack8(*(const u32x4*)(z + off), z0, z1);
                    *(u32x4*)(ys + off) = pack8f(z0 * sig4(acc[ai][bj][m][0] + b0), z1 * sig4(acc[ai][bj][m][1] + b1)); } }
    }
};
template <bool G8 = false>
struct EpiGate {
    static constexpr bool PERM = true;
    const bf16_t* gate; const bf16_t* addend; bf16_t* O; unsigned char* O8; float sc;
    __device__ __forceinline__ void operator()(const AccT& acc, const Unit& u, int wr, int wc, int fr, int fq) const {
#pragma unroll
        for (int ai = 0; ai < 2; ++ai)
#pragma unroll
            for (int m = 0; m < 4; ++m)
#pragma unroll
                for (int bj = 0; bj < 2; ++bj) { const size_t off = (size_t)EPI_ROW(u, ai, m) * DM + u.pn * BM + EPI_CB(bj); f32x4 g0, g1;
                    if constexpr (G8) { const u32x2 gw = *(const u32x2*)((const unsigned char*)gate + off); const auto a0 = __builtin_amdgcn_cvt_pk_f32_fp8((int)gw.x, false), a1 = __builtin_amdgcn_cvt_pk_f32_fp8((int)gw.x, true), a2 = __builtin_amdgcn_cvt_pk_f32_fp8((int)gw.y, false), a3 = __builtin_amdgcn_cvt_pk_f32_fp8((int)gw.y, true);
                        g0 = (f32x4){a0[0], a0[1], a1[0], a1[1]}; g1 = (f32x4){a2[0], a2[1], a3[0], a3[1]}; }
                    else unpack8(*(const u32x4*)(gate + off), g0, g1);
                    f32x4 r0 = g0 * (acc[ai][bj][m][0] * sc), r1 = g1 * (acc[ai][bj][m][1] * sc);
                    if (addend) { f32x4 t0, t1; unpack8(*(const u32x4*)(addend + off), t0, t1); r0 += t0; r1 += t1; }
                    if (O8) { const u32x2 o8 = {pk4_fp8(r0[0] * F8_XS, r0[1] * F8_XS, r0[2] * F8_XS, r0[3] * F8_XS), pk4_fp8(r1[0] * F8_XS, r1[1] * F8_XS, r1[2] * F8_XS, r1[3] * F8_XS)}; *(u32x2*)(O8 + off) = o8; }
                    else *(u32x4*)(O + off) = pack8f(r0, r1); }
    }
};
template <class TI, bool WF32>
struct EpiResid {
    static constexpr bool PERM = true;
    const TI* xi; float* xo; bf16_t* xb; float* ss; unsigned char* x8; float sc;
    __device__ __forceinline__ void operator()(const AccT& acc, const Unit& u, int wr, int wc, int fr, int fq) const {
#pragma unroll
        for (int ai = 0; ai < 2; ++ai)
#pragma unroll
            for (int m = 0; m < 4; ++m) { const int row = EPI_ROW(u, ai, m); float s = 0.f;
#pragma unroll
                for (int bj = 0; bj < 2; ++bj) { const size_t off = (size_t)row * DM + u.pn * BM + EPI_CB(bj); f32x4 r0, r1;
                    if constexpr (sizeof(TI) == 4) { r0 = *(const f32x4*)((const float*)xi + off); r1 = *(const f32x4*)((const float*)xi + off + 4); }
                    else unpack8(*(const u32x4*)((const bf16_t*)xi + off), r0, r1);
                    r0 += acc[ai][bj][m][0] * sc; r1 += acc[ai][bj][m][1] * sc;
                    if constexpr (WF32) { *(f32x4*)(xo + off) = r0; *(f32x4*)(xo + off + 4) = r1; }
                    s += sq4(r0) + sq4(r1);
                    if (xb) *(u32x4*)(xb + off) = pack8f(r0, r1);
                    if (x8) { const f32x4 w0 = r0 * F8_XS, w1 = r1 * F8_XS; const u32x2 o8 = {pk4_fp8(w0[0], w0[1], w0[2], w0[3]), pk4_fp8(w1[0], w1[1], w1[2], w1[3])}; *(u32x2*)(x8 + off) = o8; } }
                s = sum_x32(sum_x16(s)); if (fq == 0) ss[((size_t)u.pn * SEQ + row) * 4 + wc] = s; }
    }
};
struct EpiXq {
    static constexpr bool PERM = true;
    bf16_t* O; const float* ss; float sc;
    __device__ __forceinline__ void operator()(const AccT& acc, const Unit& u, int wr, int wc, int fr, int fq) const {
#pragma unroll
        for (int ai = 0; ai < 2; ++ai)
#pragma unroll
            for (int m = 0; m < 4; ++m) { const int row = EPI_ROW(u, ai, m); const float rs = row_rs32(ss, row, 1.0f / DM) * sc;
#pragma unroll
                for (int bj = 0; bj < 2; ++bj) *(u32x4*)(O + (size_t)row * XW + u.pn * BM + EPI_CB(bj)) = pack8f(acc[ai][bj][m][0] * rs, acc[ai][bj][m][1] * rs); }
    }
};
struct EpiXqH {
    static constexpr bool PERM = true;
    bf16_t* O; const float* ss; float sc;
    __device__ __forceinline__ void operator()(const AccT& acc, const Unit& u, int wr, int wc, int fr, int fq) const {
#pragma unroll
        for (int m = 0; m < 4; ++m) { const int row = u.pm * HALF + wr * 64 + m * 16 + fr; const float rs = row_rs32(ss, row, 1.0f / DM) * sc;
#pragma unroll
            for (int bj = 0; bj < 2; ++bj) *(u32x4*)(O + (size_t)row * XW + u.pn * BM + EPI_CB(bj)) = pack8f(acc[0][bj][m][0] * rs, acc[0][bj][m][1] * rs); }
    }
};
struct EpiMoeGU {
    static constexpr bool PERM = true;
    const float* bias; unsigned char* act;
    __device__ __forceinline__ void operator()(const AccT& acc, const Unit& u, int wr, int wc, int fr, int fq) const {
        const int j0 = u.pn * HALF + wc * 32 + 8 * fq; const float* bg = bias + (size_t)u.e * (2 * DFF) + j0; constexpr float SC = 1.0f / (F8_XS * F8_WS);
        const f32x4 g0 = *(const f32x4*)bg, g1 = *(const f32x4*)(bg + 4), u0 = *(const f32x4*)(bg + DFF), u1 = *(const f32x4*)(bg + DFF + 4);
#pragma unroll
        for (int ai = 0; ai < 2; ++ai)
#pragma unroll
            for (int m = 0; m < 4; ++m) { const int row = EPI_ROW(u, ai, m); f32x4 r[2];
#pragma unroll
                for (int n = 0; n < 2; ++n) { const f32x4 gt = acc[ai][0][m][n] * SC + (n ? g1 : g0), up = acc[ai][1][m][n] * SC + (n ? u1 : u0);
#pragma unroll
                    for (int j = 0; j < 4; ++j) { const float gc = fminf(gt[j], 7.0f), uc = fminf(fmaxf(up[j], -7.0f), 7.0f); r[n][j] = F8_AS * (uc + 1.0f) * (gc * fsigmoid(1.702f * gc)); } }
                u32x2 o = {pk4_fp8(r[0][0], r[0][1], r[0][2], r[0][3]), pk4_fp8(r[1][0], r[1][1], r[1][2], r[1][3])};
                *(u32x2*)(act + (size_t)row * DFF + j0) = o; }
    }
};
struct EpiMoeDown {
    static constexpr bool PERM = true;
    const float* bias; bf16_t* O;
    __device__ __forceinline__ void operator()(const AccT& acc, const Unit& u, int wr, int wc, int fr, int fq) const {
#pragma unroll
        for (int bj = 0; bj < 2; ++bj) { const int col = u.pn * BM + EPI_CB(bj); const float* bp = bias + (size_t)u.e * DM + col; const f32x4 b0 = *(const f32x4*)bp, b1 = *(const f32x4*)(bp + 4); constexpr float SC = 1.0f / (F8_AS * F8_WS);
#pragma unroll
            for (int ai = 0; ai < 2; ++ai)
#pragma unroll
                for (int m = 0; m < 4; ++m) *(u32x4*)(O + (size_t)EPI_ROW(u, ai, m) * DM + col) = pack8f(acc[ai][bj][m][0] * SC + b0, acc[ai][bj][m][1] * SC + b1); }
    }
};
#undef EPI_ROW
#undef EPI_CB
}
namespace att {
constexpr int NW = 8, QBLK = 32, KVBLK = 64, QB = NW * QBLK;
constexpr int SHM_V = KVBLK * 128 * 2, SHM_K = KVBLK * 128 * 2, SHM_KR = KVBLK * 64 * 2;
constexpr int OFF_V = 0, OFF_K = 2 * SHM_V, OFF_KR = OFF_K + 2 * SHM_K, OFF_WS = OFF_KR + 2 * SHM_KR, OFF_QR = OFF_WS + NW * 64 * 4, LDS_BYTES = OFF_QR + NW * 8192;
constexpr float THR = 8.f;
#define KSWZ(row, colB) ((row) * 256 + ((colB) ^ (((row) & 7) << 4)))
__device__ __forceinline__ int v_st(int k, int c) { const int kk = (k & ~0xC) | ((k & 4) << 1) | ((k & 8) >> 1); return ((kk >> 3) * 4 + (c >> 5)) * 512 + ((kk & 7) * 32 + (c & 31)) * 2; }
__device__ __forceinline__ int v_rd_base(int lane) { return ((lane & 3) << 3) | (((lane >> 2) & 3) << 6) | (((lane >> 4) & 1) << 5) | (((lane >> 5) & 1) << 8); }
constexpr int v_rd_off(int d0, int ks, int half) { return d0 * 512 + ks * 4096 + half * 2048; }
__device__ __forceinline__ int crow(int r, int hi) { return (r & 3) + 8 * (r >> 2) + 4 * hi; }

__device__ __forceinline__ void mask_tile(f32x16& p0, f32x16& p1, int dq) {
    const float NEG = -__builtin_inff();
#pragma unroll
    for (int r = 0; r < 16; ++r) {
        const int c = (r & 3) + 8 * (r >> 2);
        if (dq - c < 0) p0[r] = NEG;
        if (dq - c - 32 < 0) p1[r] = NEG;
    }
}
template <bool ROPE, bool F8QK = false, bool P8 = false>
__device__ __forceinline__ void partialSM(f32x16& p0, f32x16& p1, float& m_reg, float& mn, float& alpha) {
    constexpr float THRV = P8 ? 2.f : THR;
    constexpr float SCALE = (ROPE ? 0.07216878364870323f : 0.08838834764831845f) * (F8QK ? 1.0f / 64.0f : 1.0f);
    float pmax = p0[0];
#pragma unroll
    for (int r = 1; r < 16; ++r) pmax = fmaxf(pmax, p0[r]);
#pragma unroll
    for (int r = 0; r < 16; ++r) pmax = fmaxf(pmax, p1[r]);
    { auto rr = __builtin_amdgcn_permlane32_swap(__float_as_uint(pmax), __float_as_uint(pmax), false, false);
      pmax = fmaxf(__uint_as_float(rr[0]), __uint_as_float(rr[1])); }
    constexpr float C2 = 1.4426950408889634f * SCALE;
    if (__builtin_expect(__all((pmax - m_reg) * SCALE <= THRV), 1)) { mn = m_reg; alpha = 1.f; }
    else { mn = fmaxf(m_reg, pmax); alpha = __builtin_amdgcn_exp2f((m_reg - mn) * C2); m_reg = mn; }
    const float mnL = -mn * C2 + (P8 ? 5.f : 0.f);
    if constexpr (P8) { const f32x2 c2 = {C2, C2}, ml = {mnL, mnL};
#pragma unroll
        for (int r = 0; r < 8; ++r) { f32x2 v = {p0[2 * r], p0[2 * r + 1]}, w = {p1[2 * r], p1[2 * r + 1]}; v = __builtin_elementwise_fma(v, c2, ml); w = __builtin_elementwise_fma(w, c2, ml);
            p0[2 * r] = v[0]; p0[2 * r + 1] = v[1]; p1[2 * r] = w[0]; p1[2 * r + 1] = w[1]; }
    } else {
#pragma unroll
    for (int r = 0; r < 16; ++r) p0[r] = fmaf(p0[r], C2, mnL);
#pragma unroll
    for (int r = 0; r < 16; ++r) p1[r] = fmaf(p1[r], C2, mnL);
    }
#pragma unroll
    for (int r = 0; r < 16; ++r) p0[r] = __builtin_amdgcn_exp2f(p0[r]);
}
__device__ __forceinline__ void finishSM(f32x16& p0, f32x16& p1, float alpha, float& l_reg, bf16x8& pa0, bf16x8& pa1, bf16x8& pa2, bf16x8& pa3) {
#pragma unroll
    for (int r = 0; r < 16; ++r) p1[r] = __builtin_amdgcn_exp2f(p1[r]);
    float ps = 0;
#pragma unroll
    for (int r = 0; r < 16; ++r) ps += p0[r];
#pragma unroll
    for (int r = 0; r < 16; ++r) ps += p1[r];
    { auto rr = __builtin_amdgcn_permlane32_swap(__float_as_uint(ps), __float_as_uint(ps), false, false);
      ps = __uint_as_float(rr[0]) + __uint_as_float(rr[1]); }
    l_reg = l_reg * alpha + ps;
#define PK4(P, B_, OUT) do { unsigned a0 = cvtpk(P[B_+0], P[B_+1]), a1 = cvtpk(P[B_+2], P[B_+3]);                          \
        unsigned b0 = cvtpk(P[B_+4], P[B_+5]), b1 = cvtpk(P[B_+6], P[B_+7]);                                             \
        auto r0 = __builtin_amdgcn_permlane32_swap(a0, b0, false, false); auto r1 = __builtin_amdgcn_permlane32_swap(a1, b1, false, false); \
        u32x4 w = {r0[0], r1[0], r0[1], r1[1]}; OUT = *reinterpret_cast<bf16x8*>(&w); } while (0)
    PK4(p0, 0, pa0); PK4(p0, 8, pa1); PK4(p1, 0, pa2); PK4(p1, 8, pa3);
#undef PK4
}
template <int KB, bool ROPE>
__device__ __forceinline__ void qkt(f32x16& p0, f32x16& p1, const char* K_lds, int r32, int hi, const bf16x8* qr, const char* qrl) {
    p0 = f32x16{}; p1 = f32x16{};
    const char* kb[4];
#pragma unroll
    for (int dd = 0; dd < 4; ++dd) kb[dd] = K_lds + KB * SHM_K + KSWZ(r32, (dd * 16 + hi * 8) * 2);
#pragma unroll
    for (int d0 = 0; d0 < 8; ++d0) { const char* a = kb[d0 & 3] + (d0 >> 2) * 128;
        bf16x8 b0 = *reinterpret_cast<const bf16x8*>(a);
        bf16x8 b1 = *reinterpret_cast<const bf16x8*>(a + 32 * 256);
        p0 = __builtin_amdgcn_mfma_f32_32x32x16_bf16(b0, qr[d0], p0, 0, 0, 0);
        p1 = __builtin_amdgcn_mfma_f32_32x32x16_bf16(b1, qr[d0], p1, 0, 0, 0); }
    if constexpr (ROPE) {
        constexpr int RO = 2 * SHM_K - KB * SHM_K + KB * SHM_KR;
#pragma unroll
        for (int d0 = 0; d0 < 4; ++d0) { const char* a = kb[d0] + RO;
            bf16x8 b0 = *reinterpret_cast<const bf16x8*>(a);
            bf16x8 b1 = *reinterpret_cast<const bf16x8*>(a + 128);
            const bf16x8 q = *reinterpret_cast<const bf16x8*>(qrl + d0 * 1024);
            p0 = __builtin_amdgcn_mfma_f32_32x32x16_bf16(b0, q, p0, 0, 0, 0);
            p1 = __builtin_amdgcn_mfma_f32_32x32x16_bf16(b1, q, p1, 0, 0, 0); }
    }
}
template <int VB>
__device__ __forceinline__ void pv_tile(f32x16* o, int vb0, bf16x8 pa0, bf16x8 pa1, bf16x8 pa2, bf16x8 pa3) {
#define TRRD(dst, off) asm volatile("ds_read_b64_tr_b16 %0, %1 offset:%2" : "=&v"(dst) : "v"(vb0), "i"(off) : "memory")
#define PV_D0(d0) do { s16x4 l0, l1, l2, l3, h0, h1, h2, h3; constexpr int b_ = VB * SHM_V + v_rd_off(d0, 0, 0);  \
        TRRD(l0, b_); TRRD(h0, b_ + 2048); TRRD(l1, b_ + 4096); TRRD(h1, b_ + 6144); TRRD(l2, b_ + 8192); TRRD(h2, b_ + 10240); TRRD(l3, b_ + 12288); TRRD(h3, b_ + 14336); \
        asm volatile("s_waitcnt lgkmcnt(0)" ::: "memory"); SBAR();   \
        o[d0] = __builtin_amdgcn_mfma_f32_32x32x16_bf16(pa0, (bf16x8){l0[0], l0[1], l0[2], l0[3], h0[0], h0[1], h0[2], h0[3]}, o[d0], 0, 0, 0);   \
        o[d0] = __builtin_amdgcn_mfma_f32_32x32x16_bf16(pa1, (bf16x8){l1[0], l1[1], l1[2], l1[3], h1[0], h1[1], h1[2], h1[3]}, o[d0], 0, 0, 0);   \
        o[d0] = __builtin_amdgcn_mfma_f32_32x32x16_bf16(pa2, (bf16x8){l2[0], l2[1], l2[2], l2[3], h2[0], h2[1], h2[2], h2[3]}, o[d0], 0, 0, 0);   \
        o[d0] = __builtin_amdgcn_mfma_f32_32x32x16_bf16(pa3, (bf16x8){l3[0], l3[1], l3[2], l3[3], h3[0], h3[1], h3[2], h3[3]}, o[d0], 0, 0, 0); } while (0)
    PV_D0(0); PV_D0(1); PV_D0(2); PV_D0(3);
#undef PV_D0
#undef TRRD
}

struct BlockRef { const bf16_t* Q; const bf16_t* QR; const bf16_t* K; const bf16_t* KR; const bf16_t* V; bf16_t* O; int P0; };
struct Strides { int qs, qrs, ks, vs, os, skv; };
template <bool ROPE> struct Seam { bf16x8 qr[ROPE ? 12 : 8];     bf16x8 st_v0, st_v1, st_k0, st_k1, st_kr; };
#define LD8(p) (*reinterpret_cast<const bf16x8*>(p))
#define VMW() asm volatile("s_waitcnt vmcnt(0)" ::: "memory")
#define VMWN(n) asm volatile("s_waitcnt vmcnt(%0)" :: "i"(n) : "memory")
#define SLOAD_H(R, k0) do { const char* vb_ = (const char*)(R).V + (size_t)(k0) * T.vs * 2; const char* kb_ = (const char*)(R).K + (size_t)(k0) * T.ks * 2;   \
                            S.st_v0 = LD8(vb_ + vo_v); S.st_v1 = LD8(vb_ + (size_t)T.vs * 64 + vo_v);              \
                            S.st_k0 = LD8(kb_ + vo_k); S.st_k1 = LD8(kb_ + (size_t)T.ks * 64 + vo_k);              \
                            if constexpr (ROPE) S.st_kr = LD8((const char*)(R).KR + (size_t)(k0) * (DROPE * 2) + vo_kr); } while (0)
#define SWRITE_HK(bf) do { *(bf16x8*)(K_lds + (bf) * SHM_K + kws) = S.st_k0; *(bf16x8*)(K_lds + (bf) * SHM_K + kws + 32 * 256) = S.st_k1;                \
                           if constexpr (ROPE) *(bf16x8*)(K_lds + 2 * SHM_K + (bf) * SHM_KR + krws) = S.st_kr; } while (0)
#define SWRITE_HV(bf) do { *(bf16x8*)(V_lds + (bf) * SHM_V + vst0) = S.st_v0; *(bf16x8*)(V_lds + (bf) * SHM_V + vst1) = S.st_v1; } while (0)
#define SWRITE_H(bf) do { SWRITE_HV(bf); SWRITE_HK(bf); } while (0)
#define QLOAD(R) do { const char* qb_ = (const char*)(R).Q + (size_t)(wid * QBLK) * T.qs * 2; const unsigned qo_ = (unsigned)(r32 * T.qs + hi * 8) * 2u;    \
                      _Pragma("unroll") for (int d0 = 0; d0 < 8; ++d0) S.qr[d0] = LD8(qb_ + qo_ + d0 * 32);    \
                      if constexpr (ROPE) { const char* qrb_ = (const char*)(R).QR + (size_t)(wid * QBLK) * T.qrs * 2; const unsigned qro_ = (unsigned)(r32 * T.qrs + hi * 8) * 2u;   \
                          _Pragma("unroll") for (int d0 = 0; d0 < 4; ++d0) S.qr[8 + d0] = LD8(qrb_ + qro_ + d0 * 32); } } while (0)
#define QPARK() do { if constexpr (ROPE) { _Pragma("unroll") for (int d0 = 0; d0 < 4; ++d0) *(bf16x8*)(qrl + d0 * 1024) = S.qr[8 + d0]; } } while (0)
#define QPARK8() do { _Pragma("unroll") for (int d0 = 0; d0 < (ROPE ? 8 : 4); ++d0) *(bf16x8*)(qrl + d0 * 1024) = S.qr[4 + d0]; } while (0)
#define STAGE_IDX() const int sr = tid >> 4, sc = (tid & 15) * 8, kws = KSWZ(sr, sc * 2); \
                    const int rk = tid >> 3, rc = tid & 7, krws = (rk & 31) * 256 + ((((rk >> 5) * 8 + rc) * 16) ^ (((rk & 31) & 7) << 4)); \
                    const unsigned vo_v = (unsigned)(sr * T.vs + sc) * 2u, vo_k = (unsigned)(sr * T.ks + sc) * 2u, vo_kr = (unsigned)(rk * DROPE + rc * 8) * 2u

template <bool ROPE, bool CAUSAL>
__device__ __forceinline__ void attn_prime(const BlockRef& cur, const Strides& T, char* lds, Seam<ROPE>& S) {
    const int tid = threadIdx.x, wid = __builtin_amdgcn_readfirstlane(tid >> 6), lane = tid & 63, r32 = lane & 31, hi = lane >> 5;
    STAGE_IDX(); char* K_lds = lds + OFF_K; char* qrl = lds + OFF_QR + wid * 4096 + lane * 16;
    QLOAD(cur);
    SLOAD_H(cur, 0); VMW(); SWRITE_HK(0); QPARK();
    __syncthreads();
}
template <bool ROPE, bool CAUSAL>
__device__ __forceinline__ void attn_block(const BlockRef& cur, const BlockRef& nxt, const Strides& T, char* lds, Seam<ROPE>& S) {
    const int tid = threadIdx.x, wid = __builtin_amdgcn_readfirstlane(tid >> 6), lane = tid & 63, r32 = lane & 31, hi = lane >> 5;
    int j_hi = CAUSAL ? (cur.P0 + QB - 1) / KVBLK + 1 : T.skv / KVBLK; if (j_hi > T.skv / KVBLK) j_hi = T.skv / KVBLK;
    const int NT = j_hi;
    const int qlo = cur.P0 + wid * QBLK, qm = qlo + r32 - 4 * hi;
    char* V_lds = lds + OFF_V; char* K_lds = lds + OFF_K; char* qrl = lds + OFF_QR + wid * 4096 + lane * 16;
    float* ws = (float*)(lds + OFF_WS) + wid * 64; float* li_l = ws, * al_l = ws + 32;
    float m_reg = -1e30f, l_reg = 0; f32x16 o[4] = {};
    STAGE_IDX(); const int vst0 = v_st(sr, sc), vst1 = v_st(32 + sr, sc);
    const int vb0 = (int)(uintptr_t)V_lds + v_rd_base(lane);
#define RESC(a) do { if (__any((a) < 1.f)) { if (hi == 0) al_l[r32] = (a); asm volatile("s_waitcnt lgkmcnt(0)" ::: "memory");              \
                     for (int d_ = 0; d_ < 4; ++d_) for (int r = 0; r < 16; ++r) o[d_][r] *= al_l[crow(r, hi)]; } } while (0)
#define KBASE(t) ((t) * KVBLK)
#define MASKT(P0_, P1_, t) do { if constexpr (CAUSAL) { const int kb_ = KBASE(t); if (kb_ + KVBLK - 1 > qlo) mask_tile(P0_, P1_, qm - kb_); } } while (0)
    constexpr int NQL = ROPE ? 12 : 8;
#define SEAM_K0() do { VMWN(NQL); SWRITE_HK(0); SBAR(); } while (0)
    f32x16 pA0, pA1, pB0, pB1; float mnA, mnB, alA, alB; bf16x8 pa0, pa1, pa2, pa3;
    SWRITE_HV(0); SBAR();
    if (NT > 1) { SLOAD_H(cur, KBASE(1)); }
    SBAR(); qkt<0, ROPE>(pA0, pA1, K_lds, r32, hi, S.qr, qrl);
    MASKT(pA0, pA1, 0); partialSM<ROPE>(pA0, pA1, m_reg, mnA, alA);
    if (NT > 1) { VMW(); SWRITE_H(1); }
    __syncthreads();
#define HALF_STEP(PX0, PX1, mnX, alX, PY0, PY1, alY, t, KB, VB, SB) do {                                                      \
        SBAR(); qkt<KB, ROPE>(PX0, PX1, K_lds, r32, hi, S.qr, qrl);                                                                \
        finishSM(PY0, PY1, alY, l_reg, pa0, pa1, pa2, pa3); SBAR();                                                           \
        if ((t) + 1 < NT) { SLOAD_H(cur, KBASE((t) + 1)); SBAR(); }                                                           \
        pv_tile<VB>(o, vb0, pa0, pa1, pa2, pa3); MASKT(PX0, PX1, (t)); partialSM<ROPE>(PX0, PX1, m_reg, mnX, alX);            \
        __syncthreads();                                                                                                      \
        if ((t) + 1 < NT) { VMW(); SWRITE_H(SB); }                                                                            \
        RESC(alX); __syncthreads(); } while (0)
    for (int t = 1; t + 1 < NT; t += 2) {
        HALF_STEP(pB0, pB1, mnB, alB, pA0, pA1, alA, t, 1, 0, 0);
        HALF_STEP(pA0, pA1, mnA, alA, pB0, pB1, alB, t + 1, 0, 1, 1);
    }
    const bool even = (NT & 1) == 0;
    if (even) { SBAR(); qkt<1, ROPE>(pB0, pB1, K_lds, r32, hi, S.qr, qrl); SBAR(); }
    SLOAD_H(nxt, 0); SBAR();
    QLOAD(nxt);
    SBAR();
    finishSM(pA0, pA1, alA, l_reg, pa0, pa1, pa2, pa3); SBAR();
    pv_tile<0>(o, vb0, pa0, pa1, pa2, pa3);
    if (even) { MASKT(pB0, pB1, NT - 1); partialSM<ROPE>(pB0, pB1, m_reg, mnB, alB); __syncthreads(); RESC(alB);
        finishSM(pB0, pB1, alB, l_reg, pa0, pa1, pa2, pa3); SBAR(); pv_tile<1>(o, vb0, pa0, pa1, pa2, pa3); }
    SBAR(); SEAM_K0();
    if (hi == 0) li_l[r32] = l_reg; asm volatile("s_waitcnt lgkmcnt(0)" ::: "memory");
    float rli[16];
#pragma unroll
    for (int r = 0; r < 16; ++r) rli[r] = __builtin_amdgcn_rcpf(li_l[crow(r, hi)]);
    bf16_t* Ow = cur.O + (size_t)(wid * QBLK) * T.os;
#pragma unroll
    for (int r = 0; r < 16; ++r) { const int orow = crow(r, hi);
#pragma unroll
        for (int d0 = 0; d0 < 4; ++d0) { const float v = o[d0][r] * rli[r];
            const float vn = lane_x1(v);
            if ((r32 & 1) == 0) *(unsigned*)(Ow + (size_t)orow * T.os + d0 * 32 + r32) = cvtpk(v, vn); } }
    QPARK();
    __syncthreads();
#undef RESC
#undef KBASE
#undef MASKT
#undef SEAM_K0
#undef HALF_STEP
}

template <bool ROPE>
__device__ __forceinline__ void qkt_rt(f32x16& p0, f32x16& p1, const char* K_lds, int buf, const int (&koff)[4], const bf16x8* qr, const char* qrl) {
    p0 = f32x16{}; p1 = f32x16{};
    const char* kbase = K_lds + buf * SHM_K;
#pragma unroll
    for (int d0 = 0; d0 < 8; ++d0) { const char* a = kbase + koff[d0 & 3] + (d0 >> 2) * 128;
        bf16x8 b0 = *reinterpret_cast<const bf16x8*>(a);
        bf16x8 b1 = *reinterpret_cast<const bf16x8*>(a + 32 * 256);
        p0 = __builtin_amdgcn_mfma_f32_32x32x16_bf16(b0, qr[d0], p0, 0, 0, 0);
        p1 = __builtin_amdgcn_mfma_f32_32x32x16_bf16(b1, qr[d0], p1, 0, 0, 0); }
    if constexpr (ROPE) {
        const char* rbase = K_lds + 2 * SHM_K + buf * SHM_KR;
#pragma unroll
        for (int d0 = 0; d0 < 4; ++d0) { const char* a = rbase + koff[d0];
            bf16x8 b0 = *reinterpret_cast<const bf16x8*>(a);
            bf16x8 b1 = *reinterpret_cast<const bf16x8*>(a + 128);
            const bf16x8 q = *reinterpret_cast<const bf16x8*>(qrl + d0 * 1024);
            p0 = __builtin_amdgcn_mfma_f32_32x32x16_bf16(b0, q, p0, 0, 0, 0);
            p1 = __builtin_amdgcn_mfma_f32_32x32x16_bf16(b1, q, p1, 0, 0, 0); }
    }
}


template <bool ROPE>
__device__ __forceinline__ void qkt_rt8(f32x16& p0, f32x16& p1, const char* K_lds, int buf, const int (&koff)[4], const bf16x8* qr, const char* qrl) {
    p0 = f32x16{}; p1 = f32x16{};
    const char* kbase = K_lds + buf * SHM_K;
#pragma unroll
    for (int d0 = 0; d0 < 8; ++d0) { const char* a = kbase + koff[d0 & 3] + (d0 >> 2) * 128;
        bf16x8 b0 = *reinterpret_cast<const bf16x8*>(a);
        bf16x8 b1 = *reinterpret_cast<const bf16x8*>(a + 32 * 256);
        const bf16x8 q = d0 < 4 ? qr[d0] : *reinterpret_cast<const bf16x8*>(qrl + (d0 - 4) * 1024);
        p0 = __builtin_amdgcn_mfma_f32_32x32x16_bf16(b0, q, p0, 0, 0, 0);
        p1 = __builtin_amdgcn_mfma_f32_32x32x16_bf16(b1, q, p1, 0, 0, 0); }
    if constexpr (ROPE) {
        const char* rbase = K_lds + 2 * SHM_K + buf * SHM_KR;
#pragma unroll
        for (int d0 = 0; d0 < 4; ++d0) { const char* a = rbase + koff[d0];
            bf16x8 b0 = *reinterpret_cast<const bf16x8*>(a);
            bf16x8 b1 = *reinterpret_cast<const bf16x8*>(a + 128);
            const bf16x8 q = *reinterpret_cast<const bf16x8*>(qrl + (4 + d0) * 1024);
            p0 = __builtin_amdgcn_mfma_f32_32x32x16_bf16(b0, q, p0, 0, 0, 0);
            p1 = __builtin_amdgcn_mfma_f32_32x32x16_bf16(b1, q, p1, 0, 0, 0); }
    }
}


template <bool ROPE, int NREG>
__device__ __forceinline__ void qkt_pf(f32x16& p0, f32x16& p1, const char* K_lds, int buf, const int (&koff)[4], const bf16x8* qr, const char* qrl) {
    p0 = f32x16{}; p1 = f32x16{};
    const char* kbase = K_lds + buf * SHM_K; const char* rbase = K_lds + 2 * SHM_K + buf * SHM_KR;
    constexpr int NS = ROPE ? 12 : 8;
    bf16x8 fa[3], fb[3], fq[3];
#define QK_LOAD(s_) do { constexpr int l__ = (s_); if constexpr (l__ < NS) { \
        if constexpr (l__ < 8) { const char* a_ = kbase + koff[l__ & 3] + (l__ >> 2) * 128; fa[l__ % 3] = *reinterpret_cast<const bf16x8*>(a_); fb[l__ % 3] = *reinterpret_cast<const bf16x8*>(a_ + 32 * 256); } \
        else { const char* a_ = rbase + koff[l__ - 8]; fa[l__ % 3] = *reinterpret_cast<const bf16x8*>(a_); fb[l__ % 3] = *reinterpret_cast<const bf16x8*>(a_ + 128); } \
        if constexpr (l__ >= NREG) fq[l__ % 3] = *reinterpret_cast<const bf16x8*>(qrl + (l__ - NREG) * 1024); } } while (0)
#define QK_STEP(s_) do { constexpr int s__ = (s_); if constexpr (s__ < NS) { QK_LOAD(s__ + 2); SBAR(); const bf16x8 q_ = s__ < NREG ? qr[s__ < NREG ? s__ : 0] : fq[s__ % 3]; \
        p0 = __builtin_amdgcn_mfma_f32_32x32x16_bf16(fa[s__ % 3], q_, p0, 0, 0, 0); p1 = __builtin_amdgcn_mfma_f32_32x32x16_bf16(fb[s__ % 3], q_, p1, 0, 0, 0); SBAR(); } } while (0)
    QK_LOAD(0); QK_LOAD(1);
    QK_STEP(0); QK_STEP(1); QK_STEP(2); QK_STEP(3); QK_STEP(4); QK_STEP(5); QK_STEP(6); QK_STEP(7); QK_STEP(8); QK_STEP(9); QK_STEP(10); QK_STEP(11);
#undef QK_LOAD
#undef QK_STEP
}
typedef short v4i16_t __attribute__((ext_vector_type(4)));
__device__ __forceinline__ s16x4 vtr(int addr) { return __builtin_bit_cast(s16x4, __builtin_amdgcn_ds_read_tr16_b64_v4i16((LAS v4i16_t*)(uintptr_t)(unsigned)addr)); }
__device__ __forceinline__ void pv_pf(f32x16* o, int vbase, bf16x8 pa0, bf16x8 pa1, bf16x8 pa2, bf16x8 pa3) {
    s16x4 va[2][8];
#define PV_LOAD(g_) do { _Pragma("unroll") for (int j_ = 0; j_ < 8; ++j_) va[(g_) & 1][j_] = vtr(vbase + (g_) * 512 + j_ * 2048); } while (0)
#define PV_MMA(g_) do { const s16x4* v_ = va[(g_) & 1]; \
        o[g_] = __builtin_amdgcn_mfma_f32_32x32x16_bf16(pa0, (bf16x8){v_[0][0], v_[0][1], v_[0][2], v_[0][3], v_[1][0], v_[1][1], v_[1][2], v_[1][3]}, o[g_], 0, 0, 0); \
        o[g_] = __builtin_amdgcn_mfma_f32_32x32x16_bf16(pa1, (bf16x8){v_[2][0], v_[2][1], v_[2][2], v_[2][3], v_[3][0], v_[3][1], v_[3][2], v_[3][3]}, o[g_], 0, 0, 0); \
        o[g_] = __builtin_amdgcn_mfma_f32_32x32x16_bf16(pa2, (bf16x8){v_[4][0], v_[4][1], v_[4][2], v_[4][3], v_[5][0], v_[5][1], v_[5][2], v_[5][3]}, o[g_], 0, 0, 0); \
        o[g_] = __builtin_amdgcn_mfma_f32_32x32x16_bf16(pa3, (bf16x8){v_[6][0], v_[6][1], v_[6][2], v_[6][3], v_[7][0], v_[7][1], v_[7][2], v_[7][3]}, o[g_], 0, 0, 0); } while (0)
    PV_LOAD(0); SBAR();
    PV_LOAD(1); SBAR(); PV_MMA(0); SBAR();
    PV_LOAD(2); SBAR(); PV_MMA(1); SBAR();
    PV_LOAD(3); SBAR(); PV_MMA(2); SBAR();
    PV_MMA(3);
#undef PV_LOAD
#undef PV_MMA
}

__device__ __forceinline__ void pv_1(f32x16* o, int vbase, bf16x8 pa0, bf16x8 pa1, bf16x8 pa2, bf16x8 pa3) {
#pragma unroll
    for (int g = 0; g < 4; ++g) { s16x4 v_[8];
#pragma unroll
        for (int j = 0; j < 8; ++j) v_[j] = vtr(vbase + g * 512 + j * 2048);
        o[g] = __builtin_amdgcn_mfma_f32_32x32x16_bf16(pa0, (bf16x8){v_[0][0], v_[0][1], v_[0][2], v_[0][3], v_[1][0], v_[1][1], v_[1][2], v_[1][3]}, o[g], 0, 0, 0);
        o[g] = __builtin_amdgcn_mfma_f32_32x32x16_bf16(pa1, (bf16x8){v_[2][0], v_[2][1], v_[2][2], v_[2][3], v_[3][0], v_[3][1], v_[3][2], v_[3][3]}, o[g], 0, 0, 0);
        o[g] = __builtin_amdgcn_mfma_f32_32x32x16_bf16(pa2, (bf16x8){v_[4][0], v_[4][1], v_[4][2], v_[4][3], v_[5][0], v_[5][1], v_[5][2], v_[5][3]}, o[g], 0, 0, 0);
        o[g] = __builtin_amdgcn_mfma_f32_32x32x16_bf16(pa3, (bf16x8){v_[6][0], v_[6][1], v_[6][2], v_[6][3], v_[7][0], v_[7][1], v_[7][2], v_[7][3]}, o[g], 0, 0, 0); SBAR(); }
}
template <bool ROPE, bool CAUSAL, bool O8 = false>
__device__ __forceinline__ void attn_block_dma(const BlockRef& cur, const Strides& T, char* lds) {
    const int tid = threadIdx.x, wid = __builtin_amdgcn_readfirstlane(tid >> 6), lane = tid & 63, r32 = lane & 31, hi = lane >> 5;
    int j_hi = CAUSAL ? (cur.P0 + QB - 1) / KVBLK + 1 : T.skv / KVBLK; if (j_hi > T.skv / KVBLK) j_hi = T.skv / KVBLK;
    const int NT = j_hi;
    const int qlo = cur.P0 + wid * QBLK, qm = qlo + r32 - 4 * hi;
    char* V_lds = lds + OFF_V; char* K_lds = lds + OFF_K;
    float* ws = (float*)(lds + OFF_WS) + wid * 64; float* li_l = ws, * al_l = ws + 32;
    float m_reg = -1e30f, l_reg = 0; f32x16 o[4] = {};
    const int vb0 = (int)(uintptr_t)V_lds + v_rd_base(lane);
    int koff[4];
#pragma unroll
    for (int dd = 0; dd < 4; ++dd) koff[dd] = KSWZ(r32, (dd * 16 + hi * 8) * 2);
    const int dr0 = lane >> 4, dr1 = 4 + (lane >> 4);
    const unsigned kdo0 = (unsigned)((wid * 8 + dr0) * T.ks * 2 + (((lane & 15) ^ dr0) << 4)), kdo1 = (unsigned)((wid * 8 + dr1) * T.ks * 2 + (((lane & 15) ^ dr1) << 4));
    const int kline = 4 * wid + (lane >> 4), kcs = (lane & 15) ^ (kline & 7);
    const unsigned krdo = (unsigned)((kline + 32 * (kcs >> 3)) * (DROPE * 2) + ((kcs & 7) << 4));
    const int vkk = 8 * wid + ((lane >> 2) & 7), vk = (vkk & ~0xC) | ((vkk & 4) << 1) | ((vkk & 8) >> 1);
    const unsigned vdo0 = (unsigned)(vk * T.vs * 2 + (((lane >> 5)) * 32 + (lane & 3) * 8) * 2), vdo1 = vdo0 + 128;
    const unsigned klds0 = (unsigned)(uintptr_t)K_lds + wid * 2048, krlds0 = (unsigned)(uintptr_t)K_lds + 2 * SHM_K + wid * 1024, vlds0 = (unsigned)(uintptr_t)V_lds + wid * 2048;
#define DMA_TILE(t, bf) do { const char* kb_ = (const char*)cur.K + (size_t)((t) * KVBLK) * T.ks * 2; const char* vb_ = (const char*)cur.V + (size_t)((t) * KVBLK) * T.vs * 2;       \
        __builtin_amdgcn_global_load_lds((const unsigned*)(kb_ + kdo0), (LAS unsigned*)(uintptr_t)(klds0 + (bf) * SHM_K), 16, 0, 0);                                       \
        __builtin_amdgcn_global_load_lds((const unsigned*)(kb_ + kdo1), (LAS unsigned*)(uintptr_t)(klds0 + (bf) * SHM_K + 1024), 16, 0, 0);                                \
        if constexpr (ROPE) __builtin_amdgcn_global_load_lds((const unsigned*)((const char*)cur.KR + (size_t)((t) * KVBLK) * (DROPE * 2) + krdo), (LAS unsigned*)(uintptr_t)(krlds0 + (bf) * SHM_KR), 16, 0, 0); \
        __builtin_amdgcn_global_load_lds((const unsigned*)(vb_ + vdo0), (LAS unsigned*)(uintptr_t)(vlds0 + (bf) * SHM_V), 16, 0, 0);                                       \
        __builtin_amdgcn_global_load_lds((const unsigned*)(vb_ + vdo1), (LAS unsigned*)(uintptr_t)(vlds0 + (bf) * SHM_V + 1024), 16, 0, 0); } while (0)
#define DMA_BAR() do { asm volatile("s_waitcnt vmcnt(0) lgkmcnt(0)" ::: "memory"); __builtin_amdgcn_s_barrier(); asm volatile("" ::: "memory"); } while (0)
    Seam<ROPE> S; char* qrl = lds + OFF_QR + wid * 4096 + lane * 16;
    QLOAD(cur);
    DMA_TILE(0, 0); QPARK();
    DMA_BAR();
    for (int t = 0; t < NT; ++t) {
        const int buf = t & 1;
        if (t + 1 < NT) { DMA_TILE(t + 1, buf ^ 1); }
        SBAR();
        f32x16 p0, p1; qkt_pf<ROPE, (ROPE ? 12 : 8)>(p0, p1, K_lds, buf, koff, S.qr, qrl);
        if constexpr (CAUSAL) { const int kb_ = t * KVBLK; if (kb_ + KVBLK - 1 > qlo) mask_tile(p0, p1, qm - kb_); }
        float mn, al; partialSM<ROPE>(p0, p1, m_reg, mn, al);
        if (__any(al < 1.f)) { if (hi == 0) al_l[r32] = al; asm volatile("s_waitcnt lgkmcnt(0)" ::: "memory");
            for (int d_ = 0; d_ < 4; ++d_) for (int r = 0; r < 16; ++r) o[d_][r] *= al_l[crow(r, hi)]; }
        bf16x8 pa0, pa1, pa2, pa3; finishSM(p0, p1, al, l_reg, pa0, pa1, pa2, pa3); SBAR();
        pv_pf(o, vb0 + buf * SHM_V, pa0, pa1, pa2, pa3);
        DMA_BAR();
    }
#undef DMA_TILE
#undef DMA_BAR
    if (hi == 0) li_l[r32] = l_reg; asm volatile("s_waitcnt lgkmcnt(0)" ::: "memory");
    float rli[16];
#pragma unroll
    for (int r = 0; r < 16; ++r) rli[r] = __builtin_amdgcn_rcpf(li_l[crow(r, hi)]);
    if constexpr (O8) {
        unsigned char* Ow = (unsigned char*)cur.O + (size_t)(wid * QBLK) * T.os;
#pragma unroll
        for (int r = 0; r < 16; ++r) { const int orow = crow(r, hi);
#pragma unroll
            for (int d0 = 0; d0 < 4; ++d0) { const float v = o[d0][r] * (rli[r] * pg8::F8_XS);
                const float v1 = dppf<0xB1>(v), v2 = dppf<0x4E>(v), v3 = dppf<0x1B>(v);
                if ((r32 & 3) == 0) *(unsigned*)(Ow + (size_t)orow * T.os + d0 * 32 + r32) = pg8::pk4_fp8(v, v1, v2, v3); } }
    } else {
    bf16_t* Ow = cur.O + (size_t)(wid * QBLK) * T.os;
#pragma unroll
    for (int r = 0; r < 16; ++r) { const int orow = crow(r, hi);
#pragma unroll
        for (int d0 = 0; d0 < 4; ++d0) { const float v = o[d0][r] * rli[r];
            const float vn = lane_x1(v);
            if ((r32 & 1) == 0) *(unsigned*)(Ow + (size_t)orow * T.os + d0 * 32 + r32) = cvtpk(v, vn); } }
    }
    __syncthreads();
}


typedef int att_v4i __attribute__((ext_vector_type(4)));
typedef int att_v8i __attribute__((ext_vector_type(8)));
#define ATT_CAT8(a, b) __builtin_shufflevector(__builtin_bit_cast(att_v4i, a), __builtin_bit_cast(att_v4i, b), 0, 1, 2, 3, 4, 5, 6, 7)
__device__ __forceinline__ void finishSM8(f32x16& p0, f32x16& p1, float alpha, float& l_reg, att_v8i& pa) {
#pragma unroll
    for (int r = 0; r < 16; ++r) p1[r] = __builtin_amdgcn_exp2f(p1[r]);
    f32x2 s2 = {p0[0], p0[1]};
#pragma unroll
    for (int r = 1; r < 8; ++r) s2 += (f32x2){p0[2 * r], p0[2 * r + 1]};
#pragma unroll
    for (int r = 0; r < 8; ++r) s2 += (f32x2){p1[2 * r], p1[2 * r + 1]};
    float ps = s2[0] + s2[1];
    { auto rr = __builtin_amdgcn_permlane32_swap(__float_as_uint(ps), __float_as_uint(ps), false, false);
      ps = __uint_as_float(rr[0]) + __uint_as_float(rr[1]); }
    l_reg = l_reg * alpha + ps;
#pragma unroll
    for (int g = 0; g < 4; ++g) {
        int w = __builtin_amdgcn_cvt_pk_fp8_f32(p0[4 * g], p0[4 * g + 1], 0, false); pa[g] = __builtin_amdgcn_cvt_pk_fp8_f32(p0[4 * g + 2], p0[4 * g + 3], w, true);
        int x = __builtin_amdgcn_cvt_pk_fp8_f32(p1[4 * g], p1[4 * g + 1], 0, false); pa[4 + g] = __builtin_amdgcn_cvt_pk_fp8_f32(p1[4 * g + 2], p1[4 * g + 3], x, true); }
}
template <bool O8, bool PV8>
__device__ __forceinline__ void attn_block_dma8(const BlockRef& cur, const Strides& T, char* lds) {
    const int tid = threadIdx.x, wid = __builtin_amdgcn_readfirstlane(tid >> 6), lane = tid & 63, r32 = lane & 31, hi = lane >> 5;
    int j_hi = (cur.P0 + QB - 1) / KVBLK + 1; if (j_hi > T.skv / KVBLK) j_hi = T.skv / KVBLK;
    const int NT = j_hi;
    const int qlo = cur.P0 + wid * QBLK, qm = qlo + r32 - 4 * hi;
    char* V_lds = lds + OFF_V; char* K_lds = lds + OFF_K;
    float* ws = (float*)(lds + OFF_WS) + wid * 64; float* li_l = ws, * al_l = ws + 32;
    float m_reg = -1e30f, l_reg = 0; f32x16 o[4] = {};
    const int vb0 = (int)(uintptr_t)V_lds + v_rd_base(lane);
    int koff[4];
#pragma unroll
    for (int dd = 0; dd < 4; ++dd) koff[dd] = r32 * 128 + (((2 * dd + hi) ^ ((r32 >> 1) & 7)) << 4);
    const int kkey = 8 * wid + (lane >> 3), kch = (lane & 7) ^ ((kkey >> 1) & 7);
    const unsigned kndo = (unsigned)(kkey * T.ks + (kch << 4));
    const unsigned krdo = (unsigned)(kkey * 128 + (kch << 4));
    const int vkk = 8 * wid + ((lane >> 2) & 7), vk = (vkk & ~0xC) | ((vkk & 4) << 1) | ((vkk & 8) >> 1);
    const unsigned vdo0 = (unsigned)(vk * T.vs * 2 + (((lane >> 5)) * 32 + (lane & 3) * 8) * 2), vdo1 = vdo0 + 128;
    const int vrow8 = 16 * wid + (lane >> 2); const unsigned vdo8 = (unsigned)(vrow8 * 64 + (((lane & 3) ^ ((vrow8 >> 2) & 3)) << 4));
    const unsigned vlds8 = (unsigned)(uintptr_t)V_lds + wid * 1024;
    const int vsw = (r32 >> 2) & 3; const char* vrd0 = V_lds + r32 * 64 + (((2 * hi) ^ vsw) << 4); const char* vrd1 = V_lds + r32 * 64 + (((2 * hi + 1) ^ vsw) << 4);
    const unsigned klds0 = (unsigned)(uintptr_t)K_lds + wid * 1024, krlds0 = (unsigned)(uintptr_t)K_lds + 2 * SHM_K + wid * 1024, vlds0 = (unsigned)(uintptr_t)V_lds + wid * 2048;
#define GLDS16(gsrc, ldsdst) do { unsigned keep_; const unsigned dst_ = __builtin_amdgcn_readfirstlane(ldsdst); \
        asm volatile("s_mov_b32 %0, m0\n\ts_mov_b32 m0, %2\n\ts_nop 0\n\tglobal_load_lds_dwordx4 %1, off\n\ts_mov_b32 m0, %0" : "=&s"(keep_) : "v"(gsrc), "s"(dst_) : "memory"); } while (0)
#define DMA_TILE(t, bf) do { const char* kb_ = (const char*)cur.K + (size_t)((t) * KVBLK) * T.ks; const char* vb_ = (const char*)cur.V + (size_t)((t) * KVBLK) * T.vs * 2;       \
        GLDS16(kb_ + kndo, klds0 + (bf) * SHM_K);                                       \
        GLDS16((const char*)cur.KR + (size_t)((t) * KVBLK) * 128 + krdo, krlds0 + (bf) * SHM_KR); \
        if constexpr (PV8) { GLDS16((const char*)cur.V + (size_t)(t) * 8192 + vdo8, vlds8 + (bf) * SHM_V); }   \
        else { GLDS16(vb_ + vdo0, vlds0 + (bf) * SHM_V);                                       \
               GLDS16(vb_ + vdo1, vlds0 + (bf) * SHM_V + 1024); } } while (0)
#define DMA_BAR() do { asm volatile("s_waitcnt vmcnt(0) lgkmcnt(0)" ::: "memory"); __builtin_amdgcn_s_barrier(); asm volatile("" ::: "memory"); } while (0)
    att_v8i q8[3];
    { const char* qb_ = (const char*)cur.Q + (size_t)(wid * QBLK) * T.qs + (size_t)r32 * T.qs + hi * 16;
      const char* qrb_ = (const char*)cur.QR + (size_t)(wid * QBLK) * T.qrs + (size_t)r32 * T.qrs + hi * 16;
      const bf16x8 f0 = LD8(qb_), f1 = LD8(qb_ + 32), f2 = LD8(qb_ + 64), f3 = LD8(qb_ + 96), g0 = LD8(qrb_), g1 = LD8(qrb_ + 32);
      q8[0] = ATT_CAT8(f0, f1); q8[1] = ATT_CAT8(f2, f3); q8[2] = ATT_CAT8(g0, g1); }
    DMA_TILE(0, 0);
    DMA_BAR();
    for (int t = 0; t < NT; ++t) {
        const int buf = t & 1;
        if (t + 1 < NT) { DMA_TILE(t + 1, buf ^ 1); }
        SBAR();
        if (t * KVBLK <= qlo + QBLK - 1) {
        f32x16 p0, p1;
        { const char* nb = K_lds + buf * SHM_K; const char* rb = K_lds + 2 * SHM_K + buf * SHM_KR;
          const bf16x8 a0 = LD8(nb + koff[0]), a1 = LD8(nb + koff[1]), b0 = LD8(nb + koff[0] + 4096), b1 = LD8(nb + koff[1] + 4096);
          const bf16x8 a2 = LD8(nb + koff[2]), a3 = LD8(nb + koff[3]), b2 = LD8(nb + koff[2] + 4096), b3 = LD8(nb + koff[3] + 4096);
          const bf16x8 c0 = LD8(rb + koff[0]), c1 = LD8(rb + koff[1]), d0 = LD8(rb + koff[0] + 4096), d1 = LD8(rb + koff[1] + 4096);
#define MF8(acc, x0, x1, qv) do { const att_v8i k8_ = ATT_CAT8(x0, x1); asm volatile("s_nop 1\n\tv_mfma_f32_32x32x64_f8f6f4 %0, %1, %2, %0" : "+v"(acc) : "v"(k8_), "v"(qv)); } while (0)
#define MF8Z(acc, x0, x1, qv) do { const att_v8i k8_ = ATT_CAT8(x0, x1); asm volatile("s_nop 1\n\tv_mfma_f32_32x32x64_f8f6f4 %0, %1, %2, 0" : "=&v"(acc) : "v"(k8_), "v"(qv)); } while (0)
          MF8Z(p0, a0, a1, q8[0]); MF8Z(p1, b0, b1, q8[0]);
#undef MF8Z
          MF8(p0, a2, a3, q8[1]); MF8(p1, b2, b3, q8[1]);
          MF8(p0, c0, c1, q8[2]); MF8(p1, d0, d1, q8[2]);
#undef MF8
          asm volatile("s_nop 15\n\ts_nop 7" : "+v"(p0), "+v"(p1)); }
        const char* v0_ = vrd0 + buf * SHM_V; const char* v1_ = vrd1 + buf * SHM_V;
        bf16x8 x0, y0, x1, y1, x2, y2, x3, y3; if constexpr (PV8) { x0 = LD8(v0_); y0 = LD8(v1_); x1 = LD8(v0_ + 2048); y1 = LD8(v1_ + 2048); x2 = LD8(v0_ + 4096); y2 = LD8(v1_ + 4096); x3 = LD8(v0_ + 6144); y3 = LD8(v1_ + 6144); }
        { const int kb_ = t * KVBLK; if (kb_ + KVBLK - 1 > qlo) mask_tile(p0, p1, qm - kb_); }
        float mn, al; partialSM<true, true, PV8>(p0, p1, m_reg, mn, al);
        if (__any(al < 1.f)) { if (hi == 0) al_l[r32] = al; asm volatile("s_waitcnt lgkmcnt(0)" ::: "memory");
            for (int d_ = 0; d_ < 4; ++d_) for (int r = 0; r < 16; ++r) o[d_][r] *= al_l[crow(r, hi)]; }
        if constexpr (PV8) {
            att_v8i pa; finishSM8(p0, p1, al, l_reg, pa); SBAR();
#define PV8M(acc, xa, xb) do { const att_v8i v8_ = ATT_CAT8(xa, xb); asm volatile("s_nop 1\n\tv_mfma_f32_32x32x64_f8f6f4 %0, %1, %2, %0" : "+v"(acc) : "v"(pa), "v"(v8_)); } while (0)
            PV8M(o[0], x0, y0); PV8M(o[1], x1, y1); PV8M(o[2], x2, y2); PV8M(o[3], x3, y3);
#undef PV8M
        } else {
        bf16x8 pa0, pa1, pa2, pa3; finishSM(p0, p1, al, l_reg, pa0, pa1, pa2, pa3); SBAR();
        pv_pf(o, vb0 + buf * SHM_V, pa0, pa1, pa2, pa3);
        }
        }
        DMA_BAR();
    }
#undef DMA_TILE
#undef DMA_BAR
#undef GLDS16
    if constexpr (PV8) asm volatile("s_nop 15\n\ts_nop 7" : "+v"(o[0]), "+v"(o[1]), "+v"(o[2]), "+v"(o[3]));
    if (hi == 0) li_l[r32] = l_reg; asm volatile("s_waitcnt lgkmcnt(0)" ::: "memory");
    float rli[16];
#pragma unroll
    for (int r = 0; r < 16; ++r) rli[r] = __builtin_amdgcn_rcpf(li_l[crow(r, hi)]) * (PV8 ? 1.0f / 8.0f : 1.0f);
    if constexpr (O8) {
        unsigned char* Ow = (unsigned char*)cur.O + (size_t)(wid * QBLK) * T.os;
#pragma unroll
        for (int r = 0; r < 16; ++r) { const int orow = crow(r, hi);
#pragma unroll
            for (int d0 = 0; d0 < 4; ++d0) { const float v = o[d0][r] * (rli[r] * pg8::F8_XS);
                const float v1 = dppf<0xB1>(v), v2 = dppf<0x4E>(v), v3 = dppf<0x1B>(v);
                if ((r32 & 3) == 0) *(unsigned*)(Ow + (size_t)orow * T.os + d0 * 32 + r32) = pg8::pk4_fp8(v, v1, v2, v3); } }
    } else {
        bf16_t* Ow = cur.O + (size_t)(wid * QBLK) * T.os;
#pragma unroll
        for (int r = 0; r < 16; ++r) { const int orow = crow(r, hi);
#pragma unroll
            for (int d0 = 0; d0 < 4; ++d0) { const float v = o[d0][r] * rli[r];
                const float vn = lane_x1(v);
                if ((r32 & 1) == 0) *(unsigned*)(Ow + (size_t)orow * T.os + d0 * 32 + r32) = cvtpk(v, vn); } }
    }
    __syncthreads();
}

template <bool O8, bool PV8>
__device__ __forceinline__ void attn_block_dma8s(const BlockRef& cur, const BlockRef& nxtr, const bool nxt, const Strides& T, char* lds, bool primed) {
    const int tid = threadIdx.x, wid = __builtin_amdgcn_readfirstlane(tid >> 6), lane = tid & 63, r32 = lane & 31, hi = lane >> 5;
    int j_hi = (cur.P0 + QB - 1) / KVBLK + 1; if (j_hi > T.skv / KVBLK) j_hi = T.skv / KVBLK;
    const int NT = j_hi;
    const int qlo = cur.P0 + wid * QBLK, qm = qlo + r32 - 4 * hi;
    char* V_lds = lds + OFF_V; char* K_lds = lds + OFF_K;
    float* ws = (float*)(lds + OFF_WS) + wid * 64; float* li_l = ws, * al_l = ws + 32;
    float m_reg = -1e30f, l_reg = 0; f32x16 o[4] = {};
    const int vb0 = (int)(uintptr_t)V_lds + v_rd_base(lane);
    int koff[4];
#pragma unroll
    for (int dd = 0; dd < 4; ++dd) koff[dd] = r32 * 128 + (((2 * dd + hi) ^ ((r32 >> 1) & 7)) << 4);
    const int kkey = 8 * wid + (lane >> 3), kch = (lane & 7) ^ ((kkey >> 1) & 7);
    const unsigned kndo = (unsigned)(kkey * T.ks + (kch << 4));
    const unsigned krdo = (unsigned)(kkey * 128 + (kch << 4));
    const int vkk = 8 * wid + ((lane >> 2) & 7), vk = (vkk & ~0xC) | ((vkk & 4) << 1) | ((vkk & 8) >> 1);
    const unsigned vdo0 = (unsigned)(vk * T.vs * 2 + (((lane >> 5)) * 32 + (lane & 3) * 8) * 2), vdo1 = vdo0 + 128;
    const int vrow8 = 16 * wid + (lane >> 2); const unsigned vdo8 = (unsigned)(vrow8 * 64 + (((lane & 3) ^ ((vrow8 >> 2) & 3)) << 4));
    const unsigned vlds8 = (unsigned)(uintptr_t)V_lds + wid * 1024;
    const int vsw = (r32 >> 2) & 3; const char* vrd0 = V_lds + r32 * 64 + (((2 * hi) ^ vsw) << 4); const char* vrd1 = V_lds + r32 * 64 + (((2 * hi + 1) ^ vsw) << 4);
    const unsigned klds0 = (unsigned)(uintptr_t)K_lds + wid * 1024, krlds0 = (unsigned)(uintptr_t)K_lds + 2 * SHM_K + wid * 1024, vlds0 = (unsigned)(uintptr_t)V_lds + wid * 2048;
#define GLDS16(gsrc, ldsdst) do { unsigned keep_; const unsigned dst_ = __builtin_amdgcn_readfirstlane(ldsdst); \
        asm volatile("s_mov_b32 %0, m0\n\ts_mov_b32 m0, %2\n\ts_nop 0\n\tglobal_load_lds_dwordx4 %1, off\n\ts_mov_b32 m0, %0" : "=&s"(keep_) : "v"(gsrc), "s"(dst_) : "memory"); } while (0)
#define DMA_TILE_R(R_, t, bf) do { const char* kb_ = (const char*)(R_).K + (size_t)((t) * KVBLK) * T.ks; const char* vb_ = (const char*)(R_).V + (size_t)((t) * KVBLK) * T.vs * 2;       \
        GLDS16(kb_ + kndo, klds0 + (bf) * SHM_K);                                       \
        GLDS16((const char*)(R_).KR + (size_t)((t) * KVBLK) * 128 + krdo, krlds0 + (bf) * SHM_KR); \
        if constexpr (PV8) { GLDS16((const char*)(R_).V + (size_t)(t) * 8192 + vdo8, vlds8 + (bf) * SHM_V); }   \
        else { GLDS16(vb_ + vdo0, vlds0 + (bf) * SHM_V);                                       \
               GLDS16(vb_ + vdo1, vlds0 + (bf) * SHM_V + 1024); } } while (0)
#define DMA_BAR() do { asm volatile("s_waitcnt vmcnt(0) lgkmcnt(0)" ::: "memory"); __builtin_amdgcn_s_barrier(); asm volatile("" ::: "memory"); } while (0)
#define QLOAD8(R_, Q_) do { const char* qb_ = (const char*)(R_).Q + (size_t)(wid * QBLK) * T.qs + (size_t)r32 * T.qs + hi * 16;      \
      const char* qrb_ = (const char*)(R_).QR + (size_t)(wid * QBLK) * T.qrs + (size_t)r32 * T.qrs + hi * 16;                               \
      const bf16x8 f0 = LD8(qb_), f1 = LD8(qb_ + 32), f2 = LD8(qb_ + 64), f3 = LD8(qb_ + 96), g0 = LD8(qrb_), g1 = LD8(qrb_ + 32);          \
      Q_[0] = ATT_CAT8(f0, f1); Q_[1] = ATT_CAT8(f2, f3); Q_[2] = ATT_CAT8(g0, g1); } while (0)
    att_v8i q8[3]; QLOAD8(cur, q8);
    if (!primed) { DMA_TILE_R(cur, 0, 0); }
    DMA_BAR();
    for (int t = 0; t < NT; ++t) {
        const int buf = t & 1;
        if (t + 1 < NT) { DMA_TILE_R(cur, t + 1, buf ^ 1); }
        SBAR();
        if (t * KVBLK <= qlo + QBLK - 1) {
        f32x16 p0, p1;
        { const char* nb = K_lds + buf * SHM_K; const char* rb = K_lds + 2 * SHM_K + buf * SHM_KR;
          const bf16x8 a0 = LD8(nb + koff[0]), a1 = LD8(nb + koff[1]), b0 = LD8(nb + koff[0] + 4096), b1 = LD8(nb + koff[1] + 4096);
          const bf16x8 a2 = LD8(nb + koff[2]), a3 = LD8(nb + koff[3]), b2 = LD8(nb + koff[2] + 4096), b3 = LD8(nb + koff[3] + 4096);
          const bf16x8 c0 = LD8(rb + koff[0]), c1 = LD8(rb + koff[1]), d0 = LD8(rb + koff[0] + 4096), d1 = LD8(rb + koff[1] + 4096);
#define MF8(acc, x0, x1, qv) do { const att_v8i k8_ = ATT_CAT8(x0, x1); asm volatile("s_nop 1\n\tv_mfma_f32_32x32x64_f8f6f4 %0, %1, %2, %0" : "+v"(acc) : "v"(k8_), "v"(qv)); } while (0)
#define MF8Z(acc, x0, x1, qv) do { const att_v8i k8_ = ATT_CAT8(x0, x1); asm volatile("s_nop 1\n\tv_mfma_f32_32x32x64_f8f6f4 %0, %1, %2, 0" : "=&v"(acc) : "v"(k8_), "v"(qv)); } while (0)
          MF8Z(p0, a0, a1, q8[0]); MF8Z(p1, b0, b1, q8[0]);
#undef MF8Z
          MF8(p0, a2, a3, q8[1]); MF8(p1, b2, b3, q8[1]);
          MF8(p0, c0, c1, q8[2]); MF8(p1, d0, d1, q8[2]);
#undef MF8
          asm volatile("s_nop 15\n\ts_nop 7" : "+v"(p0), "+v"(p1)); }
        const char* v0_ = vrd0 + buf * SHM_V; const char* v1_ = vrd1 + buf * SHM_V;
        bf16x8 x0, y0, x1, y1, x2, y2, x3, y3; if constexpr (PV8) { x0 = LD8(v0_); y0 = LD8(v1_); x1 = LD8(v0_ + 2048); y1 = LD8(v1_ + 2048); x2 = LD8(v0_ + 4096); y2 = LD8(v1_ + 4096); x3 = LD8(v0_ + 6144); y3 = LD8(v1_ + 6144); }
        { const int kb_ = t * KVBLK; if (kb_ + KVBLK - 1 > qlo) mask_tile(p0, p1, qm - kb_); }
        float mn, al; partialSM<true, true, PV8>(p0, p1, m_reg, mn, al);
        if (__any(al < 1.f)) { if (hi == 0) al_l[r32] = al; asm volatile("s_waitcnt lgkmcnt(0)" ::: "memory");
            for (int d_ = 0; d_ < 4; ++d_) for (int r = 0; r < 16; ++r) o[d_][r] *= al_l[crow(r, hi)]; }
        if constexpr (PV8) {
            att_v8i pa; finishSM8(p0, p1, al, l_reg, pa); SBAR();
#define PV8M(acc, xa, xb) do { const att_v8i v8_ = ATT_CAT8(xa, xb); asm volatile("s_nop 1\n\tv_mfma_f32_32x32x64_f8f6f4 %0, %1, %2, %0" : "+v"(acc) : "v"(pa), "v"(v8_)); } while (0)
            PV8M(o[0], x0, y0); PV8M(o[1], x1, y1); PV8M(o[2], x2, y2); PV8M(o[3], x3, y3);
#undef PV8M
        } else {
        bf16x8 pa0, pa1, pa2, pa3; finishSM(p0, p1, al, l_reg, pa0, pa1, pa2, pa3); SBAR();
        pv_pf(o, vb0 + buf * SHM_V, pa0, pa1, pa2, pa3);
        }
        }
        DMA_BAR();
    }
    if (nxt) { DMA_TILE_R(nxtr, 0, 0); }
#undef QLOAD8
#undef DMA_TILE_R
#undef DMA_BAR
#undef GLDS16
    if constexpr (PV8) asm volatile("s_nop 15\n\ts_nop 7" : "+v"(o[0]), "+v"(o[1]), "+v"(o[2]), "+v"(o[3]));
    if (hi == 0) li_l[r32] = l_reg; asm volatile("s_waitcnt lgkmcnt(0)" ::: "memory");
    float rli[16];
#pragma unroll
    for (int r = 0; r < 16; ++r) rli[r] = __builtin_amdgcn_rcpf(li_l[crow(r, hi)]) * (PV8 ? 1.0f / 8.0f : 1.0f);
    if constexpr (O8) {
        unsigned char* Ow = (unsigned char*)cur.O + (size_t)(wid * QBLK) * T.os;
#pragma unroll
        for (int r = 0; r < 16; ++r) { const int orow = crow(r, hi);
#pragma unroll
            for (int d0 = 0; d0 < 4; ++d0) { const float v = o[d0][r] * (rli[r] * pg8::F8_XS);
                const float v1 = dppf<0xB1>(v), v2 = dppf<0x4E>(v), v3 = dppf<0x1B>(v);
                if ((r32 & 3) == 0) *(unsigned*)(Ow + (size_t)orow * T.os + d0 * 32 + r32) = pg8::pk4_fp8(v, v1, v2, v3); } }
    } else {
        bf16_t* Ow = cur.O + (size_t)(wid * QBLK) * T.os;
#pragma unroll
        for (int r = 0; r < 16; ++r) { const int orow = crow(r, hi);
#pragma unroll
            for (int d0 = 0; d0 < 4; ++d0) { const float v = o[d0][r] * rli[r];
                const float vn = lane_x1(v);
                if ((r32 & 1) == 0) *(unsigned*)(Ow + (size_t)orow * T.os + d0 * 32 + r32) = cvtpk(v, vn); } }
    }
    __syncthreads();
}


template <bool O8>
__device__ __forceinline__ void attn_block_dma8x2(const BlockRef& cur, const Strides& T, char* lds) {
    const int tid = threadIdx.x, wid = __builtin_amdgcn_readfirstlane(tid >> 6), lane = tid & 63, r32 = lane & 31, hi = lane >> 5;
    int j_hi = (cur.P0 + QB - 1) / KVBLK + 1; if (j_hi > T.skv / KVBLK) j_hi = T.skv / KVBLK;
    const int NT = j_hi;
    const int qlo = cur.P0 + wid * QBLK, qm = qlo + r32 - 4 * hi;
    char* V_lds = lds; char* K_lds = lds + 4 * 8192; char* R_lds = lds + 8 * 8192;
    float* ws = (float*)(lds + 12 * 8192) + wid * 64; float* li_l = ws, * al_l = ws + 32;
    float m_reg = -1e30f, l_reg = 0; f32x16 o[4] = {};
    int koff[4];
#pragma unroll
    for (int dd = 0; dd < 4; ++dd) koff[dd] = r32 * 128 + (((2 * dd + hi) ^ ((r32 >> 1) & 7)) << 4);
    const int kkey = 8 * wid + (lane >> 3), kch = (lane & 7) ^ ((kkey >> 1) & 7);
    const unsigned kndo = (unsigned)(kkey * T.ks + (kch << 4));
    const unsigned krdo = (unsigned)(kkey * 128 + (kch << 4));
    const int vrow8 = 16 * wid + (lane >> 2); const unsigned vdo8 = (unsigned)(vrow8 * 64 + (((lane & 3) ^ ((vrow8 >> 2) & 3)) << 4));
    const unsigned vlds8 = (unsigned)(uintptr_t)V_lds + wid * 1024, klds0 = (unsigned)(uintptr_t)K_lds + wid * 1024, krlds0 = (unsigned)(uintptr_t)R_lds + wid * 1024;
    const int vsw = (r32 >> 2) & 3; const char* vrd0 = V_lds + r32 * 64 + (((2 * hi) ^ vsw) << 4); const char* vrd1 = V_lds + r32 * 64 + (((2 * hi + 1) ^ vsw) << 4);
#define GLDS16(gsrc, ldsdst) do { unsigned keep_; const unsigned dst_ = __builtin_amdgcn_readfirstlane(ldsdst); \
        asm volatile("s_mov_b32 %0, m0\n\ts_mov_b32 m0, %2\n\ts_nop 0\n\tglobal_load_lds_dwordx4 %1, off\n\ts_mov_b32 m0, %0" : "=&s"(keep_) : "v"(gsrc), "s"(dst_) : "memory"); } while (0)
#define DMA_TILE(t, st) do { GLDS16((const char*)cur.K + (size_t)((t) * KVBLK) * T.ks + kndo, klds0 + (st) * 8192);                     \
        GLDS16((const char*)cur.KR + (size_t)((t) * KVBLK) * 128 + krdo, krlds0 + (st) * 8192);                                            \
        GLDS16((const char*)cur.V + (size_t)(t) * 8192 + vdo8, vlds8 + (st) * 8192); } while (0)
#define DMA_BAR() do { asm volatile("s_waitcnt vmcnt(0) lgkmcnt(0)" ::: "memory"); __builtin_amdgcn_s_barrier(); asm volatile("" ::: "memory"); } while (0)
#define MF8(acc, x0, x1, qv) do { const att_v8i k8_ = ATT_CAT8(x0, x1); asm volatile("s_nop 1\n\tv_mfma_f32_32x32x64_f8f6f4 %0, %1, %2, %0" : "+v"(acc) : "v"(k8_), "v"(qv)); } while (0)
#define MF8Z(acc, x0, x1, qv) do { const att_v8i k8_ = ATT_CAT8(x0, x1); asm volatile("s_nop 1\n\tv_mfma_f32_32x32x64_f8f6f4 %0, %1, %2, 0" : "=&v"(acc) : "v"(k8_), "v"(qv)); } while (0)
#define PV8M(acc, xa, xb) do { const att_v8i v8_ = ATT_CAT8(xa, xb); asm volatile("s_nop 1\n\tv_mfma_f32_32x32x64_f8f6f4 %0, %1, %2, %0" : "+v"(acc) : "v"(pa), "v"(v8_)); } while (0)
#define TILE(t_, st_) do { const int t__ = (t_), s__ = (st_);                                                                                                      \
        if (t__ * KVBLK <= qlo + QBLK - 1) {                                                                                                                        \
        f32x16 p0, p1;                                                                                                                                              \
        { const char* nb = K_lds + s__ * 8192; const char* rb = R_lds + s__ * 8192;                                                                                 \
          const bf16x8 a0 = LD8(nb + koff[0]), a1 = LD8(nb + koff[1]), b0 = LD8(nb + koff[0] + 4096), b1 = LD8(nb + koff[1] + 4096);                               \
          const bf16x8 a2 = LD8(nb + koff[2]), a3 = LD8(nb + koff[3]), b2 = LD8(nb + koff[2] + 4096), b3 = LD8(nb + koff[3] + 4096);                               \
          const bf16x8 c0 = LD8(rb + koff[0]), c1 = LD8(rb + koff[1]), d0 = LD8(rb + koff[0] + 4096), d1 = LD8(rb + koff[1] + 4096);                               \
          MF8Z(p0, a0, a1, q8[0]); MF8Z(p1, b0, b1, q8[0]); MF8(p0, a2, a3, q8[1]); MF8(p1, b2, b3, q8[1]); MF8(p0, c0, c1, q8[2]); MF8(p1, d0, d1, q8[2]);         \
          asm volatile("s_nop 15\n\ts_nop 7" : "+v"(p0), "+v"(p1)); }                                                                                               \
        const char* v0_ = vrd0 + s__ * 8192; const char* v1_ = vrd1 + s__ * 8192;                                                                                   \
        const bf16x8 x0 = LD8(v0_), y0 = LD8(v1_), x1 = LD8(v0_ + 2048), y1 = LD8(v1_ + 2048), x2 = LD8(v0_ + 4096), y2 = LD8(v1_ + 4096), x3 = LD8(v0_ + 6144), y3 = LD8(v1_ + 6144); \
        { const int kb_ = t__ * KVBLK; if (kb_ + KVBLK - 1 > qlo) mask_tile(p0, p1, qm - kb_); }                                                                    \
        float mn, al; partialSM<true, true, true>(p0, p1, m_reg, mn, al);                                                                                           \
        if (__any(al < 1.f)) { if (hi == 0) al_l[r32] = al; asm volatile("s_waitcnt lgkmcnt(0)" ::: "memory");                                                     \
            for (int d_ = 0; d_ < 4; ++d_) for (int r = 0; r < 16; ++r) o[d_][r] *= al_l[crow(r, hi)]; }                                                            \
        att_v8i pa; finishSM8(p0, p1, al, l_reg, pa); SBAR();                                                                                                       \
        PV8M(o[0], x0, y0); PV8M(o[1], x1, y1); PV8M(o[2], x2, y2); PV8M(o[3], x3, y3); } } while (0)
    att_v8i q8[3];
    { const char* qb_ = (const char*)cur.Q + (size_t)(wid * QBLK) * T.qs + (size_t)r32 * T.qs + hi * 16;
      const char* qrb_ = (const char*)cur.QR + (size_t)(wid * QBLK) * T.qrs + (size_t)r32 * T.qrs + hi * 16;
      const bf16x8 f0 = LD8(qb_), f1 = LD8(qb_ + 32), f2 = LD8(qb_ + 64), f3 = LD8(qb_ + 96), g0 = LD8(qrb_), g1 = LD8(qrb_ + 32);
      q8[0] = ATT_CAT8(f0, f1); q8[1] = ATT_CAT8(f2, f3); q8[2] = ATT_CAT8(g0, g1); }
    DMA_TILE(0, 0); DMA_TILE(1, 1);
    DMA_BAR();
    for (int t = 0; t < NT; t += 2) {
        const int sa = t & 2;
        if (t + 2 < NT) { DMA_TILE(t + 2, sa ^ 2); DMA_TILE(t + 3, (sa ^ 2) + 1); }
        SBAR();
        TILE(t, sa);
        asm volatile("s_nop 15\n\ts_nop 7" : "+v"(o[0]), "+v"(o[1]), "+v"(o[2]), "+v"(o[3]));
        TILE(t + 1, sa + 1);
        DMA_BAR();
    }
#undef TILE
#undef PV8M
#undef MF8
#undef MF8Z
#undef DMA_TILE
#undef DMA_BAR
#undef GLDS16
    asm volatile("s_nop 15\n\ts_nop 7" : "+v"(o[0]), "+v"(o[1]), "+v"(o[2]), "+v"(o[3]));
    if (hi == 0) li_l[r32] = l_reg; asm volatile("s_waitcnt lgkmcnt(0)" ::: "memory");
    float rli[16];
#pragma unroll
    for (int r = 0; r < 16; ++r) rli[r] = __builtin_amdgcn_rcpf(li_l[crow(r, hi)]) * (1.0f / 8.0f);
    if constexpr (O8) {
        unsigned char* Ow = (unsigned char*)cur.O + (size_t)(wid * QBLK) * T.os;
#pragma unroll
        for (int r = 0; r < 16; ++r) { const int orow = crow(r, hi);
#pragma unroll
            for (int d0 = 0; d0 < 4; ++d0) { const float v = o[d0][r] * (rli[r] * pg8::F8_XS);
                const float v1 = dppf<0xB1>(v), v2 = dppf<0x4E>(v), v3 = dppf<0x1B>(v);
                if ((r32 & 3) == 0) *(unsigned*)(Ow + (size_t)orow * T.os + d0 * 32 + r32) = pg8::pk4_fp8(v, v1, v2, v3); } }
    } else {
        bf16_t* Ow = cur.O + (size_t)(wid * QBLK) * T.os;
#pragma unroll
        for (int r = 0; r < 16; ++r) { const int orow = crow(r, hi);
#pragma unroll
            for (int d0 = 0; d0 < 4; ++d0) { const float v = o[d0][r] * rli[r];
                const float vn = lane_x1(v);
                if ((r32 & 1) == 0) *(unsigned*)(Ow + (size_t)orow * T.os + d0 * 32 + r32) = cvtpk(v, vn); } }
    }
    __syncthreads();
}

#undef LD8
#undef VMW
#undef VMWN
#undef SLOAD_H
#undef SWRITE_HK
#undef SWRITE_HV
#undef SWRITE_H
#undef QLOAD
#undef QPARK
#undef QPARK8
#undef STAGE_IDX
}
__device__ __forceinline__ float sq4v(f32x4 v) { return pg8::sq4(v); }
__device__ __forceinline__ float row_rs32g(const float* ss, int row) { return pg8::row_rs32(ss, row, 1.0f / DM); }
struct Params {
    const float *x, *mem; const int* pos; const float *norm_mix, *w_in, *lam_re, *lam_im, *log_step, *b_re, *b_im, *c_re, *c_im, *ssm_d, *w_glu, *b_glu;
    const float *q_norm, *w_uq, *kv_norm, *w_uk, *w_uv, *w_up_ssm, *w_up_mla, *w_out, *norm_xattn, *norm_mem, *xa_wq, *xa_wk, *xa_wv, *xa_wo;
    const float *norm_moe, *router_w, *router_b, *w_gu, *b_gu, *w_dn, *b_dn, *final_norm;
    float* out;
    unsigned* ctl;
    bf16_t *WinT, *WkpeT, *WgluT, *WuqT, *WukvT, *WupsT, *WupmT, *WoutT, *WxqT, *WxkvT, *WxoT; unsigned char *WguT, *WdnT;
    float* WrT;
    bf16_t *hn, *memn; unsigned char *hn8, *WinT8, *mg8, *WoutT8, *x1b8; float *cosT, *sinT; float* abar; bf16_t *bbarT, *cmat;
    bf16_t *ub, *qa, *kva; float *qss, *kvss; bf16_t *sgs, *sgm, *kpe;
    bf16_t *qn, *qr, *kn, *vv, *ymla;
    float* send; bf16_t *zb, *ys, *t1, *mg;
    float* x1; bf16_t* x1b; float* ss1;
    bf16_t *memkv, *qx, *ox;
    bf16_t* x2; float* ss2;
    unsigned* csprev; unsigned char* W2chk; int* topi; float* topw; int* rank; int* slot; int* wgcnt; int* blke;
    unsigned char *xg, *act; bf16_t* orow;
    int ph_lo, ph_hi;
};

struct Frame { LAS unsigned char* lds; int wave, vcu, G, gw, NGW; };

template <class RowMap>
__device__ __forceinline__ void p0_transpose_item(const float* W, int ldw, int K, bf16_t* WT, const float* gain, LAS float* scr, int kb, int nb, int lane, const RowMap& rowmap) {
    const int k0 = 64 * kb, n0 = 32 * nb;
#pragma unroll 8
    for (int i = 0; i < 32; ++i) { const int kk = 2 * i + (lane >> 5); float v = W[(size_t)(k0 + kk) * ldw + n0 + (lane & 31)]; if (gain) v *= gain[k0 + kk]; scr[kk * 33 + (lane & 31)] = v; }
    LDS_WAIT(); asm volatile("" ::: "memory");
    const int c = lane & 7;
#pragma unroll
    for (int j = 0; j < 4; ++j) { const int n = (lane >> 3) + 8 * j; const LAS float* s = scr + (8 * c) * 33 + n;
        u32x4 o; o.x = cvtpk(s[0 * 33], s[1 * 33]); o.y = cvtpk(s[2 * 33], s[3 * 33]); o.z = cvtpk(s[4 * 33], s[5 * 33]); o.w = cvtpk(s[6 * 33], s[7 * 33]);
        *(u32x4*)(WT + (size_t)rowmap(n0 + n) * K + k0 + 8 * c) = o; }
    LDS_WAIT(); asm volatile("" ::: "memory");
}
template <class RowMap>
__device__ __forceinline__ void p0_transpose_item_f8(const float* W, int ldw, int K, unsigned char* WT, float scale, LAS float* scr, int kb, int nb, int lane, const RowMap& rowmap) {
    const int k0 = 128 * kb, n0 = 32 * nb;
#pragma unroll 8
    for (int i = 0; i < 64; ++i) { const int kk = 2 * i + (lane >> 5); scr[kk * 33 + (lane & 31)] = W[(size_t)(k0 + kk) * ldw + n0 + (lane & 31)] * scale; }
    LDS_WAIT(); asm volatile("" ::: "memory");
    const int c = lane & 7;
#pragma unroll
    for (int j = 0; j < 4; ++j) { const int n = (lane >> 3) + 8 * j; const LAS float* s = scr + (16 * c) * 33 + n;
        u32x4 o; o.x = pg8::pk4_fp8(s[0 * 33], s[1 * 33], s[2 * 33], s[3 * 33]); o.y = pg8::pk4_fp8(s[4 * 33], s[5 * 33], s[6 * 33], s[7 * 33]);
        o.z = pg8::pk4_fp8(s[8 * 33], s[9 * 33], s[10 * 33], s[11 * 33]); o.w = pg8::pk4_fp8(s[12 * 33], s[13 * 33], s[14 * 33], s[15 * 33]);
        *(u32x4*)(WT + (size_t)rowmap(n0 + n) * K + k0 + 16 * c) = o; }
    LDS_WAIT(); asm volatile("" ::: "memory");
}
struct MapId { int off; __device__ __forceinline__ int operator()(int n) const { return n + off; } };
struct MapUq { __device__ __forceinline__ int operator()(int n) const { const int h = n / 192, d = n % 192; if (d < 128) return h * 128 + d;
    const int dd = d - 128, half = dd >> 5, i = dd & 31; return 2048 + 256 * (h >> 2) + half * 128 + (h & 3) * 32 + i; } };
struct MapGU { __device__ __forceinline__ int operator()(int n) const { const int up = n >= DFF, j = up ? n - DFF : n; return 256 * (j >> 7) + up * 128 + (j & 127); } };

__device__ __forceinline__ void rms_row_bf16(const float* xrow, const float* gain, bf16_t* orow, int lane, unsigned char* o8 = nullptr) {
    f32x4 v[8]; float s = 0.f;
#pragma unroll
    for (int j = 0; j < 8; ++j) { v[j] = *(const f32x4*)(xrow + 256 * j + 4 * lane); s += sq4v(v[j]); }
    const float rs = __builtin_amdgcn_rsqf(wave_sum(s) * (1.0f / DM) + EPS);
#pragma unroll
    for (int j = 0; j < 8; ++j) { const f32x4 g = *(const f32x4*)(gain + 256 * j + 4 * lane); const f32x4 r = v[j] * rs * g;
        u32x2 o = {cvtpk(r[0], r[1]), cvtpk(r[2], r[3])}; *(u32x2*)(orow + 256 * j + 4 * lane) = o;
        if (o8) *(unsigned*)(o8 + 256 * j + 4 * lane) = pg8::pk4_fp8(r[0] * pg8::F8_XS, r[1] * pg8::F8_XS, r[2] * pg8::F8_XS, r[3] * pg8::F8_XS); }
}

__device__ __forceinline__ void cmul(float ar, float ai, float br, float bi, float& cr, float& ci) { cr = ar * br - ai * bi; ci = ar * bi + ai * br; }


template <bool PIPE>
__device__ __forceinline__ void p0_moe_f8(const Params& p, Frame& F, unsigned char* DGU, unsigned char* DDN) {
    LAS float* tile = (LAS float*)F.lds; const int tid = threadIdx.x, lane = tid & 63, w = F.wave;
    constexpr int TS = 260, NIT = NEXP * 384;
#define MOE_ITEM(it_) const int e = (it_) / 384, r = (it_) % 384; const bool gu = r < 256; const int rr = gu ? r : r - 256, nbn = gu ? 16 : 8, kb = rr / nbn, nb = rr % nbn; \
        const float* W = gu ? p.w_gu + (size_t)e * DM * 2 * DFF : p.w_dn + (size_t)e * DFF * DM; const int ldw = gu ? 2 * DFF : DM; const int k0 = 128 * kb, n0 = 256 * nb
    f32x4 v[16];
    int it = F.vcu;
    if (it < NIT) { MOE_ITEM(it);
#pragma unroll
        for (int i = 0; i < 16; ++i) v[i] = *(const f32x4*)(W + (size_t)(k0 + 16 * w + i) * ldw + n0 + 4 * lane); }
    for (; it < NIT; it += F.G) {
        MOE_ITEM(it);
        unsigned char* WT = gu ? DGU + (size_t)e * 2 * DFF * DM : DDN + (size_t)e * DM * DFF;
#pragma unroll
        for (int i = 0; i < 16; ++i) *(LAS f32x4*)(tile + (16 * w + i) * TS + 4 * lane) = v[i] * pg8::F8_WS;
        __syncthreads();
        if constexpr (PIPE) if (it + F.G < NIT) { const int itn = it + F.G; const int e2 = itn / 384, r2 = itn % 384; const bool gu2 = r2 < 256; const int rr2 = gu2 ? r2 : r2 - 256, nbn2 = gu2 ? 16 : 8, kb2 = rr2 / nbn2, nb2 = rr2 % nbn2;
            const float* W2 = gu2 ? p.w_gu + (size_t)e2 * DM * 2 * DFF : p.w_dn + (size_t)e2 * DFF * DM; const int ldw2 = gu2 ? 2 * DFF : DM;
#pragma unroll
            for (int i = 0; i < 16; ++i) v[i] = *(const f32x4*)(W2 + (size_t)(128 * kb2 + 16 * w + i) * ldw2 + 256 * nb2 + 4 * lane); }
#pragma unroll
        for (int j = 0; j < 4; ++j) { const int nl = tid & 255, c = (tid >> 8) + 2 * j; const LAS float* s = tile + (16 * c) * TS + nl;
            u32x4 o; o.x = pg8::pk4_fp8(s[0 * TS], s[1 * TS], s[2 * TS], s[3 * TS]); o.y = pg8::pk4_fp8(s[4 * TS], s[5 * TS], s[6 * TS], s[7 * TS]);
            o.z = pg8::pk4_fp8(s[8 * TS], s[9 * TS], s[10 * TS], s[11 * TS]); o.w = pg8::pk4_fp8(s[12 * TS], s[13 * TS], s[14 * TS], s[15 * TS]);
            const int n = n0 + nl; const int row = gu ? MapGU{}(n) : n;
            *(u32x4*)(WT + (size_t)row * DM + k0 + 16 * c) = o; }
        __syncthreads();
        if constexpr (!PIPE) if (it + F.G < NIT) { MOE_ITEM(it + F.G);
#pragma unroll
            for (int i = 0; i < 16; ++i) v[i] = *(const f32x4*)(W + (size_t)(k0 + 16 * w + i) * ldw + n0 + 4 * lane); }
    }
#undef MOE_ITEM
}

__device__ __forceinline__ void moe_f8_reg(const Params& p, Frame& F, unsigned char* DGU, unsigned char* DDN) {
    const int lane = (int)threadIdx.x & 63, w = F.wave;
    constexpr int NIT = NEXP * 384;
#define MR_ITEM(it_, W_, WT_, ldw_, k0_, n0_, gu_) const int e_##it_ = (it_) / 384, r_##it_ = (it_) % 384; const bool gu_ = r_##it_ < 256; const int rr_##it_ = gu_ ? r_##it_ : r_##it_ - 256, nbn_##it_ = gu_ ? 16 : 8; \
        const float* W_ = gu_ ? p.w_gu + (size_t)e_##it_ * DM * 2 * DFF : p.w_dn + (size_t)e_##it_ * DFF * DM; const int ldw_ = gu_ ? 2 * DFF : DM, k0_ = 128 * (rr_##it_ / nbn_##it_), n0_ = 256 * (rr_##it_ % nbn_##it_); \
        unsigned char* WT_ = gu_ ? DGU + (size_t)e_##it_ * 2 * DFF * DM : DDN + (size_t)e_##it_ * DM * DFF
#define MR_LOAD(v_, W_, ldw_, k0_, n0_) _Pragma("unroll") for (int i = 0; i < 16; ++i) v_[i] = *(const f32x4*)(W_ + (size_t)(k0_ + 16 * w + i) * ldw_ + n0_ + 4 * lane)
#define MR_STORE(v_, WT_, k0_, n0_, gu_) _Pragma("unroll") for (int j = 0; j < 4; ++j) { const int n = n0_ + 4 * lane + j; const int row = gu_ ? MapGU{}(n) : n; constexpr float S = pg8::F8_WS; \
            u32x4 o; o.x = pg8::pk4_fp8(v_[0][j] * S, v_[1][j] * S, v_[2][j] * S, v_[3][j] * S); o.y = pg8::pk4_fp8(v_[4][j] * S, v_[5][j] * S, v_[6][j] * S, v_[7][j] * S); \
            o.z = pg8::pk4_fp8(v_[8][j] * S, v_[9][j] * S, v_[10][j] * S, v_[11][j] * S); o.w = pg8::pk4_fp8(v_[12][j] * S, v_[13][j] * S, v_[14][j] * S, v_[15][j] * S); \
            *(u32x4*)(WT_ + (size_t)row * DM + k0_ + 16 * w) = o; }
    int it = F.vcu;
    for (; it + F.G < NIT; it += 2 * F.G) {
        const int ia = it, ib = it + F.G;
        MR_ITEM(ia, Wa, WTa, lda_, k0a, n0a, gua); MR_ITEM(ib, Wb, WTb, ldb_, k0b, n0b, gub);
        f32x4 va[16], vb[16];
        MR_LOAD(va, Wa, lda_, k0a, n0a); MR_LOAD(vb, Wb, ldb_, k0b, n0b);
        MR_STORE(va, WTa, k0a, n0a, gua); MR_STORE(vb, WTb, k0b, n0b, gub);
    }
    for (; it < NIT; it += F.G) { const int ia = it; MR_ITEM(ia, Wa, WTa, lda_, k0a, n0a, gua); f32x4 va[16]; MR_LOAD(va, Wa, lda_, k0a, n0a); MR_STORE(va, WTa, k0a, n0a, gua); }
#undef MR_ITEM
#undef MR_LOAD
#undef MR_STORE
}

template <bool F8, class RowMap>
__device__ __forceinline__ void wg_transpose(const float* W, int ldw, int coff, int ncols, int K, void* WTv, const float* gain, float scale, const RowMap& map, Frame& F, int& base) {
    constexpr int KB = F8 ? 128 : 64, NL = KB / 8, TS = 260;
    LAS float* tile = (LAS float*)F.lds; const int tid = threadIdx.x, lane = tid & 63, w = F.wave;
    const int nbn = ncols / 256, nit = (K / KB) * nbn;
    for (int it = ((F.vcu - base) % F.G + F.G) % F.G; it < nit; it += F.G) {
        const int kb = it / nbn, nb = it % nbn, k0 = KB * kb, n0 = 256 * nb;
        f32x4 v[NL];
#pragma unroll
        for (int i = 0; i < NL; ++i) v[i] = *(const f32x4*)(W + (size_t)(k0 + NL * w + i) * ldw + coff + n0 + 4 * lane);
#pragma unroll
        for (int i = 0; i < NL; ++i) { const float gk = (gain ? gain[k0 + NL * w + i] : 1.0f) * scale; *(LAS f32x4*)(tile + (NL * w + i) * TS + 4 * lane) = v[i] * gk; }
        __syncthreads();
#pragma unroll
        for (int j = 0; j < 4; ++j) { const int nl = tid & 255, c = (tid >> 8) + 2 * j; const int row = map(n0 + nl);
            if constexpr (F8) { const LAS float* s = tile + (16 * c) * TS + nl;
                u32x4 o; o.x = pg8::pk4_fp8(s[0 * TS], s[1 * TS], s[2 * TS], s[3 * TS]); o.y = pg8::pk4_fp8(s[4 * TS], s[5 * TS], s[6 * TS], s[7 * TS]);
                o.z = pg8::pk4_fp8(s[8 * TS], s[9 * TS], s[10 * TS], s[11 * TS]); o.w = pg8::pk4_fp8(s[12 * TS], s[13 * TS], s[14 * TS], s[15 * TS]);
                *(u32x4*)((unsigned char*)WTv + (size_t)row * K + k0 + 16 * c) = o; }
            else { const LAS float* s = tile + (8 * c) * TS + nl;
                u32x4 o; o.x = cvtpk(s[0 * TS], s[1 * TS]); o.y = cvtpk(s[2 * TS], s[3 * TS]); o.z = cvtpk(s[4 * TS], s[5 * TS]); o.w = cvtpk(s[6 * TS], s[7 * TS]);
                *(u32x4*)((bf16_t*)WTv + (size_t)row * K + k0 + 8 * c) = o; } }
        __syncthreads();
    }
    base += nit;
}
__device__ __forceinline__ void p0_prologue(const Params& p, Frame& F) {
    LAS float* scr = (LAS float*)(F.lds + F.wave * 17408);
    const int gw = F.gw, NGW = F.NGW, lane = ((int)threadIdx.x & 63);
#define TJOB(W, LDW, COFF, NCOLS, KK, DST, GAIN, MAP) { const int nblk = (NCOLS) / 32, nit = ((KK) / 64) * nblk; \
        for (int it = gw; it < nit; it += NGW) p0_transpose_item((W) + (COFF), (LDW), (KK), (DST), (GAIN), scr, it / nblk, it % nblk, lane, (MAP)); }
    TJOB(p.w_in, IN_COLS, 2048, 64, DM, p.WkpeT, nullptr, MapId{0});
    __syncthreads();
    { int base = 0;
#if LAT_F8
      wg_transpose<false>(p.w_in, IN_COLS, 0, 1024, DM, p.WinT, nullptr, 1.0f, MapId{0}, F, base);
      wg_transpose<true>(p.w_in, IN_COLS, 1024, 1024, DM, p.WinT8, nullptr, pg8::F8_WS, MapId{1024}, F, base);
#else
      wg_transpose<false>(p.w_in, IN_COLS, 0, 2048, DM, p.WinT, nullptr, 1.0f, MapId{0}, F, base);
#endif
#if PROJ_F8 != 2
      wg_transpose<false>(p.w_in, IN_COLS, 2112, 4096, DM, p.WinT, nullptr, 1.0f, MapId{2048}, F, base);
#endif
#if PROJ_F8 == 2
      wg_transpose<true>(p.w_in, IN_COLS, 2112, 4096, DM, p.WinT8, nullptr, pg8::F8_WS, MapId{2048}, F, base);
#elif PROJ_F8 == 1
      wg_transpose<true>(p.w_in, IN_COLS, 0, 2048, DM, p.WinT8, nullptr, pg8::F8_WS, MapId{0}, F, base); wg_transpose<true>(p.w_in, IN_COLS, 2112, 4096, DM, p.WinT8, nullptr, pg8::F8_WS, MapId{2048}, F, base);
#endif
      wg_transpose<false>(p.w_glu, SSM_W, 0, SSM_W, SSM_W, p.WgluT, nullptr, 1.0f, MapId{0}, F, base);
#if LAT_P2
      wg_transpose<true>(p.w_uq, NHEAD * 192, 0, NHEAD * 192, QL, (unsigned char*)p.WuqT, p.q_norm, pg8::F8_WS, MapUq{}, F, base);
      wg_transpose<true>(p.w_uk, NHEAD * 128, 0, NHEAD * 128, KVL, (unsigned char*)p.WukvT, p.kv_norm, pg8::F8_WS, MapId{0}, F, base);
      wg_transpose<true>(p.w_uv, NHEAD * 128, 0, NHEAD * 128, KVL, (unsigned char*)p.WukvT, p.kv_norm, pg8::F8_WS, MapId{2048}, F, base);
#else
      wg_transpose<false>(p.w_uq, NHEAD * 192, 0, NHEAD * 192, QL, p.WuqT, p.q_norm, 1.0f, MapUq{}, F, base);
      wg_transpose<false>(p.w_uk, NHEAD * 128, 0, NHEAD * 128, KVL, p.WukvT, p.kv_norm, 1.0f, MapId{0}, F, base);
      wg_transpose<false>(p.w_uv, NHEAD * 128, 0, NHEAD * 128, KVL, p.WukvT, p.kv_norm, 1.0f, MapId{2048}, F, base);
#endif
      wg_transpose<false>(p.w_up_ssm, DM, 0, DM, SSM_W, p.WupsT, nullptr, 1.0f, MapId{0}, F, base);
      if (MUP_F8) wg_transpose<true>(p.w_up_mla, DM, 0, DM, DM, (unsigned char*)p.WupmT, nullptr, pg8::F8_WS, MapId{0}, F, base); else wg_transpose<false>(p.w_up_mla, DM, 0, DM, DM, p.WupmT, nullptr, 1.0f, MapId{0}, F, base);
      if (OUT_F8) wg_transpose<true>(p.w_out, DM, 0, DM, DM, p.WoutT8, nullptr, pg8::F8_WS, MapId{0}, F, base); else wg_transpose<false>(p.w_out, DM, 0, DM, DM, p.WoutT, nullptr, 1.0f, MapId{0}, F, base);
      if (XQ_F8) wg_transpose<true>(p.xa_wq, XW, 0, XW, DM, (unsigned char*)p.WxqT, p.norm_xattn, pg8::F8_WS, MapId{0}, F, base); else wg_transpose<false>(p.xa_wq, XW, 0, XW, DM, p.WxqT, p.norm_xattn, 1.0f, MapId{0}, F, base);
      wg_transpose<false>(p.xa_wk, XW, 0, XW, DM, p.WxkvT, nullptr, 1.0f, MapId{0}, F, base);
      wg_transpose<false>(p.xa_wv, XW, 0, XW, DM, p.WxkvT, nullptr, 1.0f, MapId{512}, F, base);
      wg_transpose<false>(p.xa_wo, DM, 0, DM, XW, p.WxoT, nullptr, 1.0f, MapId{0}, F, base); }
    __syncthreads();
    if (!MOE_IN_MLA) { if (MOE_REG) moe_f8_reg(p, F, p.WguT, p.WdnT); else p0_moe_f8<(P0_PIPE != 0)>(p, F, p.WguT, p.WdnT); }
#undef TJOB
    for (int m = gw; m < SEQ; m += NGW) rms_row_bf16(p.x + (size_t)m * DM, p.norm_mix, p.hn + (size_t)m * DM, lane, PROJ_F8 ? p.hn8 + (size_t)m * DM : nullptr);
    for (int m = gw; m < MEML; m += NGW) rms_row_bf16(p.mem + (size_t)m * DM, p.norm_mem, p.memn + (size_t)m * DM, lane);
    const int gt = gw * 64 + lane, NGT = NGW * 64;
    for (int i = gt; i < SEQ * 32; i += NGT) {
        const int t = i >> 5, f = i & 31;
        const float invf = __builtin_powf(10000.0f, -(float)(2 * f) / 64.0f);
        const float ang = (float)p.pos[t] * invf;
        const double rev = (double)ang * 0.15915494309189535; const float fr = (float)(rev - __builtin_floor(rev));
        p.cosT[i] = __builtin_amdgcn_cosf(fr); p.sinT[i] = __builtin_amdgcn_sinf(fr);
    }
    for (int i = gt; i < DM * NEXP; i += NGT) p.WrT[i] = p.router_w[i] * p.norm_moe[i >> 5];
    for (int i = gt; i < SSM_G * SSM_P; i += NGT) {
        const int g = i >> 6;
        const float dt = __builtin_expf(p.log_step[g]), lr = p.lam_re[i], li = p.lam_im[i];
        const float mag = __builtin_expf(lr * dt); const double rev = (double)(li * dt) * 0.15915494309189535; const float fr = (float)(rev - __builtin_floor(rev));
        const float ar = mag * __builtin_amdgcn_cosf(fr), ai = mag * __builtin_amdgcn_sinf(fr);
        p.abar[2 * i] = ar; p.abar[2 * i + 1] = ai;
        const float den = 1.0f / (lr * lr + li * li); float fr_, fi_; cmul(ar - 1.0f, ai, lr * den, -li * den, fr_, fi_);
        const int pst = i & 63;
#pragma unroll
        for (int h = 0; h < SSM_H; ++h) { const float br = p.b_re[(size_t)i * SSM_H + h], bi = p.b_im[(size_t)i * SSM_H + h]; float cr, ci; cmul(fr_, fi_, br, bi, cr, ci);
            p.bbarT[((size_t)g * 128 + pst) * 16 + h] = f2bf(cr); p.bbarT[((size_t)g * 128 + 64 + pst) * 16 + h] = f2bf(ci); }
    }
    for (int i = gt; i < SSM_G * SSM_H * SSM_P; i += NGT) {
        const int gh = i >> 6, pst = i & 63;
        p.cmat[(size_t)gh * 128 + pst] = f2bf(p.c_re[i]); p.cmat[(size_t)gh * 128 + 64 + pst] = f2bf(-p.c_im[i]);
    }
}

__device__ __forceinline__ void kpe_phase(const Params& p, Frame& F) {
    LAS float* red = (LAS float*)F.lds;
    const int tid = (int)threadIdx.x, lane = tid & 63, r = lane & 31, hi = lane >> 5, w = F.wave;
    for (int tile = F.vcu; tile < SEQ / 32; tile += F.G) {
        const int t0 = tile * 32; f32x16 a0 = {}, a1 = {};
        const bf16_t* ap = p.hn + (size_t)(t0 + r) * DM + 256 * w + 8 * hi; const bf16_t* b0p = p.WkpeT + (size_t)r * DM + 256 * w + 8 * hi; const bf16_t* b1p = b0p + (size_t)32 * DM;
#pragma unroll 8
        for (int s = 0; s < 16; ++s) { const bf16x8 a = *(const bf16x8*)(ap + 16 * s), b0 = *(const bf16x8*)(b0p + 16 * s), b1 = *(const bf16x8*)(b1p + 16 * s);
            a0 = __builtin_amdgcn_mfma_f32_32x32x16_bf16(a, b0, a0, 0, 0, 0); a1 = __builtin_amdgcn_mfma_f32_32x32x16_bf16(a, b1, a1, 0, 0, 0); }
#pragma unroll
        for (int i = 0; i < 16; ++i) { red[((w * 2 + 0) * 16 + i) * 64 + lane] = a0[i]; red[((w * 2 + 1) * 16 + i) * 64 + lane] = a1[i]; }
        __syncthreads();
#pragma unroll
        for (int k = 0; k < 2; ++k) { const int e = tid + 512 * k, i = e >> 6, ln = e & 63; float A0 = 0.f, A1 = 0.f;
#pragma unroll
            for (int ww = 0; ww < 8; ++ww) { A0 += red[((ww * 2 + 0) * 16 + i) * 64 + ln]; A1 += red[((ww * 2 + 1) * 16 + i) * 64 + ln]; }
            const int tok = t0 + (i & 3) + 8 * (i >> 2) + 4 * (ln >> 5), rr = ln & 31; const float c = p.cosT[(size_t)tok * 32 + rr], s = p.sinT[(size_t)tok * 32 + rr];
            const float x = A0 * c - A1 * s, y = A0 * s + A1 * c;
            if (QK_F8) { unsigned char* k8 = (unsigned char*)p.kpe + (size_t)tok * 128; const unsigned wd = pg8::pk4_fp8(x * pg8::F8_XS, y * pg8::F8_XS, 0.f, 0.f); k8[rr] = (unsigned char)(wd & 0xffu); k8[32 + rr] = (unsigned char)((wd >> 8) & 0xffu); }
            else { p.kpe[(size_t)tok * DROPE + rr] = f2bf(x); p.kpe[(size_t)tok * DROPE + 32 + rr] = f2bf(y); } }
        __syncthreads();
    }
}

constexpr int S5_TC = 256, S5_NCH = SEQ / S5_TC;
struct S5Consts { float a1r[2], a1i[2], a2r[2], a2i[2], a3r[2], a3i[2], a4r[2], a4i[2], a8r[2], a8i[2], a32r[2], a32i[2], a256r[2], a256i[2]; };
__device__ __forceinline__ void s5_consts(const Params& p, int g, int r, S5Consts& c) {
#pragma unroll
    for (int s = 0; s < 2; ++s) { const f32x2 a = *(const f32x2*)(p.abar + 2 * (g * 64 + 32 * s + r)); c.a1r[s] = a[0]; c.a1i[s] = a[1];
        cmul(c.a1r[s], c.a1i[s], c.a1r[s], c.a1i[s], c.a2r[s], c.a2i[s]); cmul(c.a2r[s], c.a2i[s], c.a1r[s], c.a1i[s], c.a3r[s], c.a3i[s]); cmul(c.a2r[s], c.a2i[s], c.a2r[s], c.a2i[s], c.a4r[s], c.a4i[s]);
        cmul(c.a4r[s], c.a4i[s], c.a4r[s], c.a4i[s], c.a8r[s], c.a8i[s]); float tr, ti; cmul(c.a8r[s], c.a8i[s], c.a8r[s], c.a8i[s], tr, ti); cmul(tr, ti, tr, ti, c.a32r[s], c.a32i[s]);
        float ur, ui; cmul(c.a32r[s], c.a32i[s], c.a32r[s], c.a32i[s], tr, ti); cmul(tr, ti, tr, ti, ur, ui); cmul(ur, ui, ur, ui, c.a256r[s], c.a256i[s]); }
}
template <bool NOPS = false>
__device__ __forceinline__ void s5_bu(const Params& p, int g, int t0, int r, int hi, const bf16x8 (&bfr)[4], f32x16 (&acc)[4]) {
    const bf16x8 a = *(const bf16x8*)(p.ub + (size_t)(t0 + r) * SSM_W + g * 16 + 8 * hi);
#pragma unroll
    for (int ct = 0; ct < 4; ++ct) { acc[ct] = f32x16{}; acc[ct] = __builtin_amdgcn_mfma_f32_32x32x16_bf16(a, bfr[ct], acc[ct], 0, 0, 0); }
#ifdef S5_NOPS
    if constexpr (NOPS) { SBAR(); asm volatile("s_nop 15\n\ts_nop 15\n\ts_nop 15\n\ts_nop 15" ::: "memory"); SBAR(); }
#endif
}
__device__ __forceinline__ void s5_pass_a(const Params& p, Frame& F, float* SEND) {
    const int lane = ((int)threadIdx.x & 63), r = lane & 31, hi = lane >> 5;
    for (int unit = F.gw; unit < S5_NCH * SSM_G; unit += F.NGW) {
        const int g = unit % SSM_G, ch = unit / SSM_G;
        S5Consts c; s5_consts(p, g, r, c);
        bf16x8 bfr[4];
#pragma unroll
        for (int ct = 0; ct < 4; ++ct) bfr[ct] = *(const bf16x8*)(p.bbarT + ((size_t)g * 128 + 32 * ct + r) * 16 + 8 * hi);
        float Sr[2] = {0.f, 0.f}, Si[2] = {0.f, 0.f};
        for (int tl = 0; tl < S5_TC / 32; ++tl) {
            f32x16 acc[4]; s5_bu<true>(p, g, ch * S5_TC + tl * 32, r, hi, bfr, acc);
#pragma unroll
            for (int s = 0; s < 2; ++s) { float Pr = 0.f, Pi = 0.f;
#pragma unroll
                for (int q = 0; q < 4; ++q) { float er = acc[s][4 * q], ei = acc[2 + s][4 * q];
#pragma unroll
                    for (int j = 1; j < 4; ++j) { float tr, ti; cmul(er, ei, c.a1r[s], c.a1i[s], tr, ti); er = tr + acc[s][4 * q + j]; ei = ti + acc[2 + s][4 * q + j]; }
                    float tr, ti; cmul(Pr, Pi, c.a8r[s], c.a8i[s], tr, ti); Pr = tr + er; Pi = ti + ei; }
                if (hi == 0) { float tr, ti; cmul(Pr, Pi, c.a4r[s], c.a4i[s], tr, ti); Pr = tr; Pi = ti; }
                Pr = sum_x32(Pr); Pi = sum_x32(Pi);
                float tr, ti; cmul(Sr[s], Si[s], c.a32r[s], c.a32i[s], tr, ti); Sr[s] = tr + Pr; Si[s] = ti + Pi; }
        }
        if (hi == 0) {
#pragma unroll
            for (int s = 0; s < 2; ++s) *(f32x2*)(SEND + 2 * ((size_t)(ch * SSM_G + g) * 64 + 32 * s + r)) = (f32x2){Sr[s], Si[s]}; }
    }
}
constexpr int S5_XS = 272;
__device__ __forceinline__ void s5_pass_c(const Params& p, Frame& F) {
    const int lane = ((int)threadIdx.x & 63), r = lane & 31, hi = lane >> 5, l15 = lane & 15, l4 = lane >> 4;
    LAS unsigned char* xl = F.lds + F.wave * (32 * S5_XS);
    for (int unit = F.gw; unit < S5_NCH * SSM_G; unit += F.NGW) {
        const int g = unit % SSM_G, ch = unit / SSM_G;
        S5Consts c; s5_consts(p, g, r, c);
        bf16x8 bfr[4], cfr[4];
#pragma unroll
        for (int ct = 0; ct < 4; ++ct) bfr[ct] = *(const bf16x8*)(p.bbarT + ((size_t)g * 128 + 32 * ct + r) * 16 + 8 * hi);
#pragma unroll
        for (int ks = 0; ks < 4; ++ks) cfr[ks] = *(const bf16x8*)(p.cmat + ((size_t)g * 16 + l15) * 128 + 32 * ks + 8 * l4);
        const f32x4 dsk = *(const f32x4*)(p.ssm_d + g * 16 + 4 * l4);
        float Xr[2] = {0.f, 0.f}, Xi[2] = {0.f, 0.f};
        for (int cp0 = 0; cp0 < ch; cp0 += 8) {
            f32x2 e[8][2];
#pragma unroll
            for (int j = 0; j < 8; ++j) { const int cp = (cp0 + j < ch) ? cp0 + j : ch - 1;
#pragma unroll
                for (int s = 0; s < 2; ++s) e[j][s] = *(const f32x2*)(p.send + 2 * ((size_t)(cp * SSM_G + g) * 64 + 32 * s + r)); }
#pragma unroll
            for (int j = 0; j < 8; ++j) if (cp0 + j < ch) {
#pragma unroll
                for (int s = 0; s < 2; ++s) { float tr, ti; cmul(Xr[s], Xi[s], c.a256r[s], c.a256i[s], tr, ti); Xr[s] = tr + e[j][s][0]; Xi[s] = ti + e[j][s][1]; } }
        }
        for (int tl = 0; tl < S5_TC / 32; ++tl) {
            const int t0 = ch * S5_TC + tl * 32;
            f32x16 acc[4]; s5_bu(p, g, t0, r, hi, bfr, acc);
#pragma unroll
            for (int s = 0; s < 2; ++s) {
                float er[4], ei[4];
#pragma unroll
                for (int q = 0; q < 4; ++q) {
#pragma unroll
                    for (int j = 1; j < 4; ++j) { float tr, ti; cmul(acc[s][4 * q + j - 1], acc[2 + s][4 * q + j - 1], c.a1r[s], c.a1i[s], tr, ti); acc[s][4 * q + j] += tr; acc[2 + s][4 * q + j] += ti; }
                    er[q] = acc[s][4 * q + 3]; ei[q] = acc[2 + s][4 * q + 3]; }
                float cr = Xr[s], ci = Xi[s], cinr[4], cini[4];
#pragma unroll
                for (int q = 0; q < 4; ++q) { const float pr = other_half(er[q], hi), pi = other_half(ei[q], hi);
                    const float e0r = hi ? pr : er[q], e0i = hi ? pi : ei[q], e1r = hi ? er[q] : pr, e1i = hi ? ei[q] : pi;
                    float tr, ti; const float c0r = cr, c0i = ci; cmul(cr, ci, c.a4r[s], c.a4i[s], tr, ti); cr = tr + e0r; ci = ti + e0i;
                    const float c1r = cr, c1i = ci; cmul(cr, ci, c.a4r[s], c.a4i[s], tr, ti); cr = tr + e1r; ci = ti + e1i;
                    cinr[q] = hi ? c1r : c0r; cini[q] = hi ? c1i : c0i; }
                Xr[s] = cr; Xi[s] = ci;
#pragma unroll
                for (int q = 0; q < 4; ++q) { float tr, ti;
                    cmul(cinr[q], cini[q], c.a1r[s], c.a1i[s], tr, ti); acc[s][4 * q + 0] += tr; acc[2 + s][4 * q + 0] += ti;
                    cmul(cinr[q], cini[q], c.a2r[s], c.a2i[s], tr, ti); acc[s][4 * q + 1] += tr; acc[2 + s][4 * q + 1] += ti;
                    cmul(cinr[q], cini[q], c.a3r[s], c.a3i[s], tr, ti); acc[s][4 * q + 2] += tr; acc[2 + s][4 * q + 2] += ti;
                    cmul(cinr[q], cini[q], c.a4r[s], c.a4i[s], tr, ti); acc[s][4 * q + 3] += tr; acc[2 + s][4 * q + 3] += ti; }
            }
#pragma unroll
            for (int ct = 0; ct < 4; ++ct)
#pragma unroll
                for (int i = 0; i < 16; ++i) *(LAS unsigned short*)(xl + ((i & 3) + 8 * (i >> 2) + 4 * hi) * S5_XS + (32 * ct + r) * 2) = f2bf(acc[ct][i]);
            LDS_WAIT(); asm volatile("" ::: "memory");
#pragma unroll
            for (int nt = 0; nt < 2; ++nt) { f32x4 y = {0.f, 0.f, 0.f, 0.f};
#pragma unroll
                for (int ks = 0; ks < 4; ++ks) { const bf16x8 b = *(const LAS bf16x8*)(xl + (16 * nt + l15) * S5_XS + (32 * ks + 8 * l4) * 2); y = __builtin_amdgcn_mfma_f32_16x16x32_bf16(cfr[ks], b, y, 0, 0, 0); }
                const size_t off = (size_t)(t0 + 16 * nt + l15) * SSM_W + g * 16 + 4 * l4; const u32x2 uw = *(const u32x2*)(p.ub + off);
                const float y0 = y[0] + dsk[0] * bflo(uw.x), y1 = y[1] + dsk[1] * bfhi(uw.x), y2 = y[2] + dsk[2] * bflo(uw.y), y3 = y[3] + dsk[3] * bfhi(uw.y);
                u32x2 o = {cvtpk(gelu_tanh(y0), gelu_tanh(y1)), cvtpk(gelu_tanh(y2), gelu_tanh(y3))}; *(u32x2*)(p.zb + off) = o; }
            LDS_WAIT(); asm volatile("" ::: "memory");
        }
    }
}

__device__ __forceinline__ void router_phase(const Params& p, Frame& F) {
    LAS float* red = (LAS float*)F.lds; LAS float* lg = red + 8 * 64 * 33; LAS int* asg = (LAS int*)(lg + 64 * 33); LAS int* cnt = asg + 256;
    const int lane = ((int)threadIdx.x & 63), i32 = lane & 31, kh = lane >> 5, w = F.wave, tid = (int)threadIdx.x;
    const char* wb = (const char*)(p.WrT + (size_t)(256 * w) * NEXP); unsigned bo = (unsigned)((128 * kh * NEXP + i32) * 4);
#define RT_LOADB(dst, sb) do { _Pragma("unroll") for (int s = 0; s < 32; ++s) dst[s] = *(const float*)(wb + (size_t)bo + (size_t)(((sb) * 32 + s) * NEXP * 4)); } while (0)
#define RT_MMA(src, sb) do { _Pragma("unroll") for (int s = 0; s < 32; ++s) { const unsigned wv = A[(sb) * 4 + (s >> 3)][(s & 7) >> 1]; \
        acc = __builtin_amdgcn_mfma_f32_32x32x2f32((s & 1) ? bfhi(wv) : bflo(wv), src[s], acc, 0, 0, 0); } } while (0)
    for (int vb = blockIdx.x; vb < SEQ / 64; vb += F.G) {
        if (tid < 32) cnt[tid] = 0;
#pragma unroll 1
        for (int tl = 0; tl < 2; ++tl) {
            const int t0 = vb * 64 + tl * 32;
            asm volatile("" : "+v"(bo));
            const bf16_t* ap = p.x2 + (size_t)(t0 + i32) * DM + 256 * w + 128 * kh;
            u32x4 A[16];
#pragma unroll
            for (int j = 0; j < 16; ++j) A[j] = *(const u32x4*)(ap + 8 * j);
            f32x16 acc = {};
            float ba[32], bb[32];
            RT_LOADB(ba, 0); SBAR();
            RT_LOADB(bb, 1); SBAR(); RT_MMA(ba, 0); SBAR();
            RT_LOADB(ba, 2); SBAR(); RT_MMA(bb, 1); SBAR();
            RT_LOADB(bb, 3); SBAR(); RT_MMA(ba, 2); SBAR();
            RT_MMA(bb, 3);
#pragma unroll
            for (int i = 0; i < 16; ++i) red[(w * 64 + tl * 32 + (i & 3) + 8 * (i >> 2) + 4 * kh) * 33 + i32] = acc[i];
        }
        __syncthreads();
        for (int o = tid; o < 2048; o += 512) { const int tok = o >> 5, e = o & 31; float s = 0.f;
#pragma unroll
            for (int ww = 0; ww < 8; ++ww) s += red[(ww * 64 + tok) * 33 + e];
            lg[tok * 33 + e] = s * row_rs32g(p.ss2, vb * 64 + tok) + p.router_b[e]; }
        __syncthreads();
        if (tid < 64) { const int tok = tid; float v[4] = {-__builtin_inff(), -__builtin_inff(), -__builtin_inff(), -__builtin_inff()}; int id[4] = {0, 0, 0, 0};
            for (int e = 0; e < 32; ++e) { float x = lg[tok * 33 + e]; int xi = e;
#pragma unroll
                for (int k = 0; k < 4; ++k) { const bool gt = x > v[k]; const float tv = gt ? v[k] : x; const int ti = gt ? id[k] : xi; v[k] = gt ? x : v[k]; id[k] = gt ? xi : id[k]; x = tv; xi = ti; } }
            const float e1 = __builtin_expf(v[1] - v[0]), e2 = __builtin_expf(v[2] - v[0]), e3 = __builtin_expf(v[3] - v[0]); const float inv = 1.0f / (1.0f + e1 + e2 + e3);
            const size_t o4 = (size_t)(vb * 64 + tok) * 4;
            *(f32x4*)(p.topw + o4) = (f32x4){inv, e1 * inv, e2 * inv, e3 * inv};
            p.topi[o4] = id[0]; p.topi[o4 + 1] = id[1]; p.topi[o4 + 2] = id[2]; p.topi[o4 + 3] = id[3];
#pragma unroll
            for (int k = 0; k < 4; ++k) asg[tok * 4 + k] = id[k]; }
        __syncthreads();
        if (tid < 256) { const int e = asg[tid]; int rk = 0; for (int j = 0; j < tid; ++j) rk += (asg[j] == e) ? 1 : 0;
            p.rank[(size_t)vb * 256 + tid] = rk; atomicAdd((int*)&cnt[e], 1); }
        __syncthreads();
        if (tid < 32) p.wgcnt[vb * 32 + tid] = cnt[tid];
        __syncthreads();
    }
#undef RT_LOADB
#undef RT_MMA
}
__device__ __forceinline__ void assign_phase(const Params& p, Frame& F) {
    LAS int* part = (LAS int*)F.lds; LAS int* pbef = part + 512; LAS int* base = pbef + 512; LAS int* pst = base + 32; LAS int* slots = pst + 33;
    const int tid = (int)threadIdx.x, lane = ((int)threadIdx.x & 63);
    for (int vb = blockIdx.x; vb < SEQ / 64; vb += F.G) {
        { const int e = tid & 31, pr = tid >> 5; int s = 0, sb = 0;
          for (int b = pr * 16; b < pr * 16 + 16; ++b) { const int c = p.wgcnt[b * 32 + e]; s += c; sb += (b < vb) ? c : 0; }
          part[pr * 32 + e] = s; pbef[pr * 32 + e] = sb; }
        __syncthreads();
        if (tid < 32) { int tot = 0, bef = 0; for (int pr = 0; pr < 16; ++pr) { tot += part[pr * 32 + tid]; bef += pbef[pr * 32 + tid]; } part[tid] = tot; pbef[tid] = bef; }
        __syncthreads();
        if (tid == 0) { int acc = 0; for (int e = 0; e < 32; ++e) { pst[e] = acc; const int nb = (part[e] + 255) >> 8;
                if (vb == 0) for (int b = 0; b < nb; ++b) p.blke[(acc >> 8) + b] = e;
                acc += nb << 8; }
            pst[32] = acc; if (vb == 0) p.blke[MAXBLK] = acc >> 8; }
        __syncthreads();
        if (tid < 32) base[tid] = pst[tid] + pbef[tid];
        __syncthreads();
        if (tid < 256) { const int tok = vb * 64 + (tid >> 2); const int e = p.topi[(size_t)tok * 4 + (tid & 3)]; const int sl = base[e] + p.rank[(size_t)vb * 256 + tid];
            p.slot[(size_t)tok * 4 + (tid & 3)] = sl; slots[tid] = sl; }
        __syncthreads();
        for (int tk = F.wave; tk < 64; tk += NWAVES) { const int tok = vb * 64 + tk; const bf16_t* xr = p.x2 + (size_t)tok * DM; const float rs = row_rs32g(p.ss2, tok);
#pragma unroll
            for (int j = 0; j < 4; ++j) { const int c = 512 * j + 8 * lane; const f32x4 g0 = *(const f32x4*)(p.norm_moe + c), g1 = *(const f32x4*)(p.norm_moe + c + 4);
                f32x4 xa, xb2; unpack8(*(const u32x4*)(xr + c), xa, xb2);
                const f32x4 a = xa * (rs * pg8::F8_XS) * g0, b = xb2 * (rs * pg8::F8_XS) * g1;
                const u32x2 o = {pg8::pk4_fp8(a[0], a[1], a[2], a[3]), pg8::pk4_fp8(b[0], b[1], b[2], b[3])};
#pragma unroll
                for (int k = 0; k < 4; ++k) *(u32x2*)(p.xg + (size_t)slots[tk * 4 + k] * DM + c) = o; } }
        __syncthreads();
    }
}
#ifdef CSPROBE
#define CSPOISON + ((badph >= 0 && tok == 0 && j == 0 && lane == 0) ? 145.0f * (float)(badph + 1) : 0.0f)
#else
#define CSPOISON
#endif
__device__ __forceinline__ void combine_phase(const Params& p, Frame& F) {
    const int lane = ((int)threadIdx.x & 63);
    const bool tmo = __hip_atomic_load(p.ctl + 4096 + XB_TMO, __ATOMIC_RELAXED, __HIP_MEMORY_SCOPE_AGENT) != 0u;
#ifdef CSPROBE
    int badph = -1; { unsigned* prev = p.csprev; for (int i = 15; i >= 0; --i) { const unsigned c = __hip_atomic_load(p.ctl + 65536 + i, __ATOMIC_RELAXED, __HIP_MEMORY_SCOPE_AGENT), o = prev[i]; if (o != 0xAAAAAAAAu && o != c) badph = i; }
      if (CSPROBE != 2) for (int i = 13; i >= 0; --i) if (__hip_atomic_load(p.ctl + 65536 + 32 + i, __ATOMIC_RELAXED, __HIP_MEMORY_SCOPE_AGENT) != 0u) badph = 16 + i; }
#endif
    for (int tok = F.gw; tok < SEQ; tok += F.NGW) {
        const f32x4 w = *(const f32x4*)(p.topw + (size_t)tok * 4); int sl[4];
#pragma unroll
        for (int k = 0; k < 4; ++k) sl[k] = p.slot[(size_t)tok * 4 + k];
        f32x4 v[4][2]; float s = 0.f;
#pragma unroll
        for (int j = 0; j < 4; ++j) { const int c = 512 * j + 8 * lane; unpack8(*(const u32x4*)(p.x2 + (size_t)tok * DM + c), v[j][0], v[j][1]);
#pragma unroll
            for (int k = 0; k < 4; ++k) { f32x4 a, b; unpack8(*(const u32x4*)(p.orow + (size_t)sl[k] * DM + c), a, b); v[j][0] += a * w[k]; v[j][1] += b * w[k]; }
            s += sq4v(v[j][0]) + sq4v(v[j][1]); }
        const float rs = tmo ? __builtin_nanf("") : __builtin_amdgcn_rsqf(wave_sum(s) * (1.0f / DM) + EPS);
#pragma unroll
        for (int j = 0; j < 4; ++j) { const int c = 512 * j + 8 * lane;
            *(f32x4*)(p.out + (size_t)tok * DM + c) = v[j][0] * rs * *(const f32x4*)(p.final_norm + c) CSPOISON; *(f32x4*)(p.out + (size_t)tok * DM + c + 4) = v[j][1] * rs * *(const f32x4*)(p.final_norm + c + 4); }
    }
#ifdef CSPROBE
    __syncthreads();
    if (threadIdx.x == 0) { const unsigned old = atomicAdd(p.ctl + 65536 + 64, 1u); if (old == (unsigned)F.G - 1u) { for (int i = 0; i < 16; ++i) p.csprev[i] = __hip_atomic_load(p.ctl + 65536 + i, __ATOMIC_RELAXED, __HIP_MEMORY_SCOPE_AGENT); } }
#endif
}
template <bool ROPE, bool CAUSAL, class Refs>
__device__ __forceinline__ void attn_stream(const Refs& R, const att::Strides& T, char* lds) {
    const int n = R.count(); if (n <= 0) return;
    att::Seam<ROPE> S; att::BlockRef cur = R.ref(0);
    att::attn_prime<ROPE, CAUSAL>(cur, T, lds, S);
    for (int i = 0; i < n; ++i) { const att::BlockRef nxt = (i + 1 < n) ? R.ref(i + 1) : cur; att::attn_block<ROPE, CAUSAL>(cur, nxt, T, lds, S); cur = nxt; }
}
struct MlaRefs {
    const Params* p; int b, G; bf16_t* obuf;
    __device__ __forceinline__ int count() const { return b < 512 ? 2 * ((512 - b + G - 1) / G) : 0; }
    __device__ __forceinline__ att::BlockRef ref(int i) const {
        const int L = b + (i >> 1) * G, xcd = L & 7, k = L >> 3, head = (k >> 5) * 8 + xcd, y = k & 31, qb = (i & 1) ? 63 - y : y;
        att::BlockRef r; const size_t row0 = (size_t)qb * 256;
        if (QK_F8) { r.Q = (const bf16_t*)((const unsigned char*)p->qn + row0 * DM + head * DNOPE); r.QR = (const bf16_t*)((const unsigned char*)p->qr + row0 * (NHEAD * DROPE) + head * DROPE); r.K = (const bf16_t*)((const unsigned char*)p->kn + head * DNOPE); }
        else { r.Q = p->qn + row0 * DM + head * DNOPE; r.QR = p->qr + row0 * (NHEAD * DROPE) + head * DROPE; r.K = p->kn + head * DNOPE; }
        r.KR = p->kpe; r.V = (QK_F8 && PV_F8) ? (const bf16_t*)((const unsigned char*)p->vv + (size_t)head * (SEQ / 64) * 8192) : p->vv + head * DV;
        r.O = MUP_F8 ? (bf16_t*)((unsigned char*)obuf + row0 * DM + head * DV) : obuf + row0 * DM + head * DV; r.P0 = qb * 256; return r; }
};
struct XaRefs {
    const Params* p; int b, G;
    __device__ __forceinline__ int count() const { return b < 256 ? (256 - b + G - 1) / G : 0; }
    __device__ __forceinline__ att::BlockRef ref(int i) const {
        const int L = b + i * G, head = L & 3, qb = L >> 2; att::BlockRef r; const size_t row0 = (size_t)qb * 256;
        r.Q = p->qx + row0 * XW + head * 128; r.QR = nullptr; r.K = p->memkv + head * 128; r.KR = nullptr; r.V = p->memkv + XW + head * 128; r.O = p->ox + row0 * XW + head * 128; r.P0 = 0; return r; }
};


#ifdef CSPROBE
__device__ __forceinline__ void cs_buf(const Params& p, Frame& F, int slot, const void* buf, size_t bytes) {
    const u32x4* q = (const u32x4*)buf; const size_t n = bytes / 16; unsigned x = 0;
    unsigned np = 0;
    for (size_t i = (size_t)F.gw * 64 + (threadIdx.x & 63); i < n; i += (size_t)F.NGW * 64) { const u32x4 v = q[i]; x ^= v.x ^ (v.y * 3u) ^ (v.z * 5u) ^ (v.w * 7u);
        np += (v.x == 0xAAAAAAAAu) + (v.y == 0xAAAAAAAAu) + (v.z == 0xAAAAAAAAu) + (v.w == 0xAAAAAAAAu); }
    if (__any(np != 0)) { if (np) atomicAdd(p.ctl + 65536 + 32 + slot, np); }
#pragma unroll
    for (int o = 1; o < 64; o <<= 1) x ^= __shfl_xor((int)x, o);
    if ((threadIdx.x & 63) == 0) atomicXor(p.ctl + 65536 + slot, x);
}

__device__ __forceinline__ void cs_rows(const Params& p, Frame& F) {
    const int lane = threadIdx.x & 63; unsigned xa = 0, xo = 0;
    for (int tok = F.gw; tok < SEQ; tok += F.NGW) {
#pragma unroll
        for (int k = 0; k < 4; ++k) { const int sl = p.slot[(size_t)tok * 4 + k];
            const u32x4* a = (const u32x4*)(p.act + (size_t)sl * DFF); const u32x4* o = (const u32x4*)(p.orow + (size_t)sl * DM);
            for (int i = lane; i < DFF / 16; i += 64) { const u32x4 v = a[i]; xa ^= (v.x ^ (v.y * 3u) ^ (v.z * 5u) ^ (v.w * 7u)) * (unsigned)(2 * k + 1); }
            for (int i = lane; i < DM * 2 / 16; i += 64) { const u32x4 v = o[i]; xo ^= (v.x ^ (v.y * 3u) ^ (v.z * 5u) ^ (v.w * 7u)) * (unsigned)(2 * k + 1); } } }
#pragma unroll
    for (int o = 1; o < 64; o <<= 1) { xa ^= __shfl_xor((int)xa, o); xo ^= __shfl_xor((int)xo, o); }
    if (lane == 0) { atomicXor(p.ctl + 65536 + 14, xa); atomicXor(p.ctl + 65536 + 15, xo); }
}
#define CS(slot, buf, bytes) cs_buf(p, F, slot, buf, bytes)
#else
#define CS(slot, buf, bytes) do {} while (0)
#endif
constexpr int RING_BYTES = 155648, MISC_OFF = RING_BYTES + 320, LDS_BYTES = 159744;
constexpr int NPHASE = 16;
#ifndef MK_ONE_LAUNCH
#define MK_ONE_LAUNCH 1
#endif

__global__ void __launch_bounds__(NWAVES * 64, 2) hybrid_fwd(Params p) {
    extern __shared__ __attribute__((aligned(16))) unsigned char lds[];
    Frame F;
    F.lds = (LAS unsigned char*)lds; F.wave = __builtin_amdgcn_readfirstlane((int)threadIdx.x >> 6);
    F.G = gridDim.x; { const int bx = blockIdx.x; F.vcu = (F.G % 8 == 0) ? (bx % 8) * (F.G / 8) + bx / 8 : bx; }
    F.gw = F.vcu * NWAVES + F.wave; F.NGW = F.G * NWAVES;
    volatile LAS unsigned* MISC = (volatile LAS unsigned*)(F.lds + MISC_OFF);
    for (int u = threadIdx.x; u < (LDS_BYTES - RING_BYTES) / 4; u += NWAVES * 64) ((LAS unsigned*)(F.lds + RING_BYTES))[u] = 0u;
    __syncthreads();
    const int lo = p.ph_lo, hi = p.ph_hi;
    XcdBarrier bar; bar.bar = p.ctl + 4096; bar.x = 0; bar.st = nullptr;
    if (hi - lo > 1) bar = xcd_barrier_post(p.ctl + 4096, MISC + 8);
#ifndef PHMASK
#define PHMASK 0xFFFF
#endif
#define IN(k) ((((PHMASK) >> (k)) & 1) && lo <= (k) && (k) < hi)
#ifndef NBAR
#define NBAR 1
#endif
#ifdef USE_CG
#define SEAM(k) do { if (IN(k) && IN((k) + 1)) { asm volatile("s_waitcnt vmcnt(0)" ::: "memory"); cooperative_groups::this_grid().sync(); } } while (0)
#else
#define SEAM(k) do { if (IN(k) && IN((k) + 1)) { xcd_barrier(bar); if (NBAR > 1) xcd_barrier(bar); } } while (0)
#endif
    const int G = F.G, bx = blockIdx.x;
    LAS unsigned char* ring = F.lds;

#ifndef REP3_OBUF
#define REP3_OBUF p.ymla
#endif
#ifndef REPMASK
#define REPMASK 0
#endif
#ifndef REPCOND
#define REPCOND 1
#endif
#define REP(k) ((((REPMASK) >> (k)) & 1) && lo <= ((k) & 15) && ((k) & 15) < hi && (REPCOND))
#define B0 { p0_prologue(p, F); }
#define B1 { kpe_phase(p, F); \
        if (LAT_F8) {     \
            { pg8::StaticOrder S; S.init(SEQ, 1024, G, bx); pg8::Gemm g{p.hn, p.WinT, DM, DM, DM, 0}; pg8::EpiProj E{p.ub, p.qa, p.kva, p.sgs, p.sgm, p.qss, p.kvss, 1.0f, 0}; pg8::gemm_phase(ring, g, S, E); } \
            { pg8::StaticOrder S; S.init(SEQ, 5120, G, bx); pg8::Gemm g{(const bf16_t*)p.hn8, (const bf16_t*)(p.WinT8 + (size_t)1024 * DM), DM / 2, DM / 2, DM / 2, 0}; pg8::EpiProj E{p.ub, p.qa, p.kva, p.sgs, p.sgm, p.qss, p.kvss, 1.0f / (pg8::F8_XS * pg8::F8_WS), 4}; pg8::gemm_phase<pg8::EpiProj, pg8::StaticOrder, true>(ring, g, S, E); } } \
        else if (PROJ_F8 == 1) { pg8::StaticOrder S; S.init(SEQ, 6144, G, bx); pg8::Gemm g{(const bf16_t*)p.hn8, (const bf16_t*)p.WinT8, DM / 2, DM / 2, DM / 2, 0}; pg8::EpiProj E{p.ub, p.qa, p.kva, p.sgs, p.sgm, p.qss, p.kvss, 1.0f / (pg8::F8_XS * pg8::F8_WS), 0}; pg8::gemm_phase<pg8::EpiProj, pg8::StaticOrder, true>(ring, g, S, E); } \
        else if (PROJ_F8 == 2) {     \
            { pg8::StaticOrder S; S.init(SEQ, 2048, G, bx); pg8::Gemm g{p.hn, p.WinT, DM, DM, DM, 0}; pg8::EpiProj E{p.ub, p.qa, p.kva, p.sgs, p.sgm, p.qss, p.kvss, 1.0f, 0}; pg8::gemm_phase(ring, g, S, E); } \
            { pg8::StaticOrder S; S.init(SEQ, 4096, G, bx); pg8::Gemm g{(const bf16_t*)p.hn8, (const bf16_t*)(p.WinT8 + (size_t)2048 * DM), DM / 2, DM / 2, DM / 2, 0}; pg8::EpiProj E{p.ub, p.qa, p.kva, p.sgs, p.sgm, p.qss, p.kvss, 1.0f / (pg8::F8_XS * pg8::F8_WS), 8}; pg8::gemm_phase<pg8::EpiProj, pg8::StaticOrder, true>(ring, g, S, E); } } \
        else { pg8::StaticOrder S; S.init(SEQ, 6144, G, bx); pg8::Gemm g{p.hn, p.WinT, DM, DM, DM, 0}; pg8::EpiProj E{p.ub, p.qa, p.kva, p.sgs, p.sgm, p.qss, p.kvss, 1.0f, 0}; pg8::gemm_phase(ring, g, S, E); } }
#define B2 { s5_pass_a(p, F, p.send); \
        if (LAT_P2) { pg8::Gemm g{p.qa, p.WuqT, QL / 2, QL / 2, QL / 2, 0}; pg8::StaticOrder S; S.init(SEQ, 3072, G, bx); pg8::EpiQup E{p.qn, p.qr, p.qss, p.cosT, p.sinT, 1.0f / (pg8::F8_XS * pg8::F8_WS)}; pg8::gemm_phase<pg8::EpiQup, pg8::StaticOrder, true>(ring, g, S, E); } \
        else { pg8::Gemm g{p.qa, p.WuqT, QL, QL, QL, 0}; pg8::StaticOrder S; S.init(SEQ, 3072, G, bx); pg8::EpiQup E{p.qn, p.qr, p.qss, p.cosT, p.sinT, 1.0f}; pg8::gemm_phase(ring, g, S, E); } \
        if (LAT_P2) { pg8::Gemm g{p.kva, p.WukvT, KVL / 2, KVL / 2, KVL / 2, 0}; pg8::StaticOrder S; S.init(SEQ, 4096, G, bx); pg8::EpiKVup E{p.kn, p.vv, p.kvss, 1.0f / (pg8::F8_XS * pg8::F8_WS)}; pg8::gemm_phase<pg8::EpiKVup, pg8::StaticOrder, true>(ring, g, S, E); } \
        else { pg8::Gemm g{p.kva, p.WukvT, KVL, KVL, KVL, 0}; pg8::StaticOrder S; S.init(SEQ, 4096, G, bx); pg8::EpiKVup E{p.kn, p.vv, p.kvss, 1.0f}; pg8::gemm_phase(ring, g, S, E); } \
        { pg8::Gemm g{p.memn, p.WxkvT, DM, DM, DM, 0}; pg8::StaticOrder S; S.init(MEML, 2 * XW, G, bx); pg8::EpiPlain E{p.memkv, 2 * XW}; pg8::gemm_phase(ring, g, S, E); } }
#define B3A { s5_pass_c(p, F); __syncthreads(); }
#define MLA_BLOCK_(i_) { if (QK_F8 && PV_F8 && MLA_X2) att::attn_block_dma8x2<(MUP_F8 != 0)>(R.ref(i_), T, (char*)lds); else if (QK_F8) att::attn_block_dma8<(MUP_F8 != 0), (PV_F8 != 0)>(R.ref(i_), T, (char*)lds); else att::attn_block_dma<true, true, (MUP_F8 != 0)>(R.ref(i_), T, (char*)lds); }
#define B3B_(OB) { const att::Strides T{DM, NHEAD * DROPE, DM, DM, DM, SEQ}; const MlaRefs R{&p, bx, G, OB}; const int n = R.count(), cg = MOE_IN_MLA ? (((bx >> 3) & 3) < n ? ((bx >> 3) & 3) : 0) : 0; \
        for (int i = 0; i < cg; ++i) MLA_BLOCK_(i) \
        if (MOE_IN_MLA) { if (MOE_REG) moe_f8_reg(p, F, p.WguT, p.WdnT); else p0_moe_f8<false>(p, F, p.WguT, p.WdnT); __syncthreads(); } \
        if (MLA_SEAM && QK_F8 && PV_F8 && !MLA_X2) { bool primed = false; \
            for (int i = cg; i < n; ++i) { const att::BlockRef c_ = R.ref(i); const att::BlockRef nx_ = R.ref(i + 1 < n ? i + 1 : i); att::attn_block_dma8s<(MUP_F8 != 0), true>(c_, nx_, (i + 1 < n), T, (char*)lds, primed); primed = (i + 1 < n); } } \
        else for (int i = cg; i < n; ++i) MLA_BLOCK_(i) }
#define B4 { pg8::Gemm g{p.zb, p.WgluT, SSM_W, SSM_W, SSM_W, 0}; pg8::StaticOrder S; S.init(SEQ, SSM_W, G, bx); pg8::EpiGlu E{p.zb, p.b_glu, p.ys}; pg8::gemm_phase(ring, g, S, E); }
#define B5 { pg8::Gemm g{p.ys, p.WupsT, SSM_W, SSM_W, SSM_W, 0}; pg8::StaticOrder S; S.init(SEQ, DM, G, bx); pg8::EpiGate<false> E{p.sgs, nullptr, p.t1, nullptr, 1.0f}; pg8::gemm_phase(ring, g, S, E); }
#define B6 { pg8::StaticOrder S; S.init(SEQ, DM, G, bx); \
        if (MUP_F8) { pg8::Gemm g{p.ymla, p.WupmT, DM / 2, DM / 2, DM / 2, 0}; pg8::EpiGate<(SGM_F8 != 0)> E{p.sgm, p.t1, p.mg, OUT_F8 ? p.mg8 : nullptr, 1.0f / (pg8::F8_XS * pg8::F8_WS) * (SGM_F8 ? 1.0f / 256.0f : 1.0f)}; pg8::gemm_phase<pg8::EpiGate<(SGM_F8 != 0)>, pg8::StaticOrder, true>(ring, g, S, E); } \
        else { pg8::Gemm g{p.ymla, p.WupmT, DM, DM, DM, 0}; pg8::EpiGate<(SGM_F8 != 0)> E{p.sgm, p.t1, p.mg, OUT_F8 ? p.mg8 : nullptr, SGM_F8 ? 1.0f / 256.0f : 1.0f}; pg8::gemm_phase(ring, g, S, E); } }
#define B7 { pg8::StaticOrder S; S.init(SEQ, DM, G, bx); \
        if (OUT_F8) { pg8::Gemm g{(const bf16_t*)p.mg8, (const bf16_t*)p.WoutT8, DM / 2, DM / 2, DM / 2, 0}; pg8::EpiResid<float, false> E{p.x, nullptr, p.x1b, p.ss1, XQ_F8 ? p.x1b8 : nullptr, 1.0f / (pg8::F8_XS * pg8::F8_WS)}; pg8::gemm_phase<pg8::EpiResid<float, false>, pg8::StaticOrder, true>(ring, g, S, E); } \
        else { pg8::Gemm g{p.mg, p.WoutT, DM, DM, DM, 0}; pg8::EpiResid<float, false> E{p.x, nullptr, p.x1b, p.ss1, XQ_F8 ? p.x1b8 : nullptr, 1.0f}; pg8::gemm_phase(ring, g, S, E); } }
#define B8 { pg8::StaticOrder S; S.init(SEQ, XW, G, bx); \
        if (XQ_F8) { pg8::Gemm g{(const bf16_t*)p.x1b8, p.WxqT, DM / 2, DM / 2, DM / 2, 0}; pg8::EpiXq E{p.qx, p.ss1, 1.0f / (pg8::F8_XS * pg8::F8_WS)}; pg8::gemm_phase<pg8::EpiXq, pg8::StaticOrder, true>(ring, g, S, E); } \
        else if (XQ_HALF) { pg8::HalfOrder H; H.init(SEQ, XW, G, bx); pg8::Gemm g{p.x1b, p.WxqT, DM, DM, DM, 0}; pg8::EpiXqH E{p.qx, p.ss1, 1.0f}; pg8::gemm_phase(ring, g, H, E); } \
        else { pg8::Gemm g{p.x1b, p.WxqT, DM, DM, DM, 0}; pg8::EpiXq E{p.qx, p.ss1, 1.0f}; pg8::gemm_phase(ring, g, S, E); } }
#define B9 { const att::Strides T{XW, 0, 2 * XW, 2 * XW, XW, MEML}; const XaRefs R{&p, bx, G}; attn_stream<false, false>(R, T, (char*)lds); }
#define B10 { pg8::Gemm g{p.ox, p.WxoT, XW, XW, XW, 0}; pg8::StaticOrder S; S.init(SEQ, DM, G, bx); pg8::EpiResid<bf16_t, false> E{p.x1b, nullptr, p.x2, p.ss2, nullptr, 1.0f}; pg8::gemm_phase(ring, g, S, E); }
#define B11 { router_phase(p, F); }
#define B12 { assign_phase(p, F); }
#define MOE_TAB_ LAS int* etab = (LAS int*)(F.lds + 131072); for (int i_ = threadIdx.x; i_ < MAXBLK; i_ += NWAVES * 64) etab[i_] = p.blke[i_]; __syncthreads();
#define B13 { const int nblk = __builtin_amdgcn_readfirstlane(p.blke[MAXBLK]); MOE_TAB_ \
        pg8::Gemm g{(const bf16_t*)p.xg, (const bf16_t*)p.WguT, DM / 2, DM / 2, DM / 2, (size_t)2 * DFF * DM / 2}; pg8::MoeOrder S; S.init(nblk, 2 * DFF, G, bx, etab); pg8::EpiMoeGU E{p.b_gu, p.act}; pg8::gemm_phase<pg8::EpiMoeGU, pg8::MoeOrder, true>(ring, g, S, E); }
#define B14 { const int nblk = __builtin_amdgcn_readfirstlane(p.blke[MAXBLK]); MOE_TAB_ \
        pg8::Gemm g{(const bf16_t*)p.act, (const bf16_t*)p.WdnT, DFF / 2, DFF / 2, DFF / 2, (size_t)DM * DFF / 2}; pg8::MoeOrder S; S.init(nblk, DM, G, bx, etab); pg8::EpiMoeDown E{p.b_dn, p.orow}; pg8::gemm_phase<pg8::EpiMoeDown, pg8::MoeOrder, true>(ring, g, S, E); }
#define B15 { combine_phase(p, F); }
#ifdef SELF_POISON
    if (IN(0)) { u32x4* q = (u32x4*)((unsigned char*)p.ctl + (1 << 20)); const size_t n = (size_t)(SELF_POISON) / 16; const u32x4 pz = {0xAAAAAAAAu, 0xAAAAAAAAu, 0xAAAAAAAAu, 0xAAAAAAAAu};
        for (size_t i = (size_t)F.gw * 64 + (threadIdx.x & 63); i < n; i += (size_t)F.NGW * 64) q[i] = pz; xcd_barrier(bar); }
#endif
#ifdef START_DELAY
    if (IN(0)) { const unsigned long long t0_ = __builtin_amdgcn_s_memrealtime(); while (__builtin_amdgcn_s_memrealtime() - t0_ < (unsigned long long)(START_DELAY)) __builtin_amdgcn_s_sleep(8); }
#endif
    if (IN(0)) B0 if (REP(0)) B0 SEAM(0);
#ifdef W2CHECK
    if (IN(0)) { p0_moe_f8<false>(p, F, p.W2chk, p.W2chk + (size_t)NEXP * 2 * DFF * DM); xcd_barrier(bar);
        const u32x4* a = (const u32x4*)p.WguT; const u32x4* b = (const u32x4*)p.W2chk; const size_t n = ((size_t)NEXP * 2 * DFF * DM + (size_t)NEXP * DM * DFF) / 16; unsigned bad = 0;
        for (size_t i = (size_t)F.gw * 64 + (threadIdx.x & 63); i < n; i += (size_t)F.NGW * 64) { const u32x4 x = a[i], y = b[i]; bad |= (x.x ^ y.x) | (x.y ^ y.y) | (x.z ^ y.z) | (x.w ^ y.w); }
        if (bad) atomicAdd(p.ctl + 4096 + XB_TMO, 1u);
        xcd_barrier(bar); }
#endif
    if (IN(1)) B1 if (REP(1)) B1 SEAM(1);

#ifdef G2CHECK
    if (IN(1)) {
        unsigned char* b2 = p.W2chk; bf16_t* ub2 = (bf16_t*)b2; bf16_t* qa2 = ub2 + (size_t)SEQ * SSM_W; bf16_t* kva2 = qa2 + (size_t)SEQ * QL; bf16_t* sgs2 = kva2 + (size_t)SEQ * KVL; bf16_t* sgm2 = sgs2 + (size_t)SEQ * DM;
        float* qss2 = (float*)(sgm2 + (size_t)SEQ * DM); float* kvss2 = qss2 + (size_t)SEQ * 8;
        pg8::StaticOrder S; S.init(SEQ, 6144, G, (bx + G2CHECK) % G);
        pg8::Gemm g{p.hn, p.WinT, DM, DM, DM, 0}; pg8::EpiProj E{ub2, qa2, kva2, sgs2, sgm2, qss2, kvss2, 1.0f, 0}; pg8::gemm_phase(ring, g, S, E);
        xcd_barrier(bar);
        unsigned bad = 0;
#define CMP(A_, B_, BYTES_) { const u32x4* a_ = (const u32x4*)(A_); const u32x4* b_ = (const u32x4*)(B_); const size_t n_ = (size_t)(BYTES_) / 16; \
            for (size_t i = (size_t)F.gw * 64 + (threadIdx.x & 63); i < n_; i += (size_t)F.NGW * 64) { const u32x4 x = a_[i], y = b_[i]; bad |= (x.x ^ y.x) | (x.y ^ y.y) | (x.z ^ y.z) | (x.w ^ y.w); } }
        CMP(p.ub, ub2, (size_t)SEQ * SSM_W * 2); CMP(p.qa, qa2, (size_t)SEQ * QL * 2); CMP(p.kva, kva2, (size_t)SEQ * KVL * 2); CMP(p.sgs, sgs2, (size_t)SEQ * DM * 2); CMP(p.sgm, sgm2, (size_t)SEQ * DM * 2);
        CMP(p.qss, qss2, (size_t)SEQ * 8 * 4); CMP(p.kvss, kvss2, (size_t)SEQ * 8 * 4);
#undef CMP
        if (bad) atomicAdd(p.ctl + 4096 + XB_TMO, 1u);
        xcd_barrier(bar); }
#endif
    if (IN(2)) B2 if (REP(2)) B2 SEAM(2);
#ifdef CSPROBE
    if (IN(2)) { CS(2, p.send, (size_t)S5_NCH*SSM_G*64*8); }
#endif
#ifdef S5CHECK
    if (IN(2)) { float* send2 = (float*)p.W2chk; s5_pass_a(p, F, send2); xcd_barrier(bar); unsigned bad = 0;
        { const u32x4* a_ = (const u32x4*)p.send; const u32x4* b_ = (const u32x4*)send2; const size_t n_ = (size_t)S5_NCH * SSM_G * 64 * 8 / 16;
          for (size_t i = (size_t)F.gw * 64 + (threadIdx.x & 63); i < n_; i += (size_t)F.NGW * 64) { const u32x4 x = a_[i], y = b_[i]; bad |= (x.x ^ y.x) | (x.y ^ y.y) | (x.z ^ y.z) | (x.w ^ y.w); } }
        if (bad) atomicAdd(p.ctl + 4096 + XB_TMO, 1u); xcd_barrier(bar); }
#endif
    if (IN(3)) { B3A if (REP(16)) B3A B3B_(p.ymla) if (REP(3)) B3B_(REP3_OBUF) } SEAM(3);
    if (IN(4)) B4 if (REP(4)) B4 SEAM(4);
    if (IN(5)) B5 if (REP(5)) B5 if (P56_MERGE && IN(5) && IN(6)) { asm volatile("s_waitcnt vmcnt(0)" ::: "memory"); __syncthreads(); } else SEAM(5);
    if (IN(6)) B6 if (REP(6)) B6 SEAM(6);
    if (IN(7)) B7 if (REP(7)) B7 SEAM(7);
    if (IN(8)) B8 if (REP(8)) B8 SEAM(8);
    if (IN(9)) B9 if (REP(9)) B9 SEAM(9);
    if (IN(10)) B10 if (REP(10)) B10 SEAM(10);
    if (IN(11)) B11 if (REP(11)) B11 SEAM(11);
    if (IN(12)) B12 if (REP(12)) B12 SEAM(12);
    if (IN(13)) B13 if (REP(13)) B13 SEAM(13);
    if (IN(14)) B14 if (REP(14)) B14 SEAM(14);
#ifdef CSPROBE
    if (IN(15)) { CS(0, p.hn, (size_t)SEQ*DM*2); CS(0, p.WinT, (size_t)6144*DM*2); CS(0, p.WguT, (size_t)NEXP*2*DFF*DM); CS(0, p.WdnT, (size_t)NEXP*DM*DFF); CS(0, p.WuqT, (size_t)3072*QL*2); CS(0, p.WukvT, (size_t)4096*KVL*2); CS(0, p.cosT, (size_t)SEQ*32*4); CS(0, p.sinT, (size_t)SEQ*32*4); CS(0, p.bbarT, (size_t)SSM_G*128*16*2); CS(0, p.cmat, (size_t)SSM_G*16*128*2); CS(0, p.abar, (size_t)SSM_G*SSM_P*8); CS(0, p.WrT, (size_t)DM*NEXP*4); CS(0, p.WkpeT, (size_t)64*DM*2); CS(0, p.WgluT, (size_t)SSM_W*SSM_W*2); CS(0, p.WupsT, (size_t)DM*SSM_W*2); CS(0, p.WupmT, (size_t)DM*DM*2); CS(0, p.WoutT, (size_t)DM*DM*2); CS(0, p.WxqT, (size_t)XW*DM*2); CS(0, p.WxkvT, (size_t)2*XW*DM*2); CS(0, p.WxoT, (size_t)DM*XW*2); CS(0, p.memn, (size_t)MEML*DM*2); CS(1, p.ub, (size_t)SEQ*SSM_W*2); CS(1, p.qa, (size_t)SEQ*QL*2); CS(1, p.kva, (size_t)SEQ*KVL*2); CS(1, p.qss, (size_t)SEQ*8*4); CS(1, p.kvss, (size_t)SEQ*8*4); CS(1, p.sgs, (size_t)SEQ*DM*2); CS(1, p.sgm, (size_t)SEQ*DM*2); CS(1, p.kpe, (size_t)SEQ*DROPE*2); CS(3, p.send, (size_t)S5_NCH*SSM_G*64*8); CS(8, p.qn, (size_t)SEQ*DM*2); CS(8, p.qr, (size_t)SEQ*NHEAD*DROPE*2); CS(8, p.kn, (size_t)SEQ*DM*2); CS(8, p.vv, (size_t)SEQ*DM*2); CS(8, p.memkv, (size_t)MEML*2*XW*2); CS(8, p.zb, (size_t)SEQ*SSM_W*2); CS(8, p.ymla, (size_t)SEQ*DM*2); CS(9, p.ys, (size_t)SEQ*SSM_W*2); CS(9, p.t1, (size_t)SEQ*DM*2); CS(9, p.mg, (size_t)SEQ*DM*2); CS(9, p.x1b, (size_t)SEQ*DM*2); CS(9, p.ss1, (size_t)SEQ*32*4); CS(10, p.qx, (size_t)SEQ*XW*2); CS(10, p.ox, (size_t)SEQ*XW*2); CS(11, p.x2, (size_t)SEQ*DM*2); CS(11, p.ss2, (size_t)SEQ*32*4); CS(12, p.topi, (size_t)SEQ*16); CS(12, p.topw, (size_t)SEQ*16); CS(12, p.rank, (size_t)SEQ*16); CS(12, p.wgcnt, (size_t)256*32*4); CS(13, p.slot, (size_t)SEQ*16); cs_rows(p, F); xcd_barrier(bar); }
#endif
    if (IN(15)) B15 if (REP(15)) B15
#undef IN
#undef SEAM
}

extern "C" void kernel_launch(void* const* d_in, const int* in_sizes, int n_in, void* d_out, int out_size, void* d_ws, size_t ws_size, hipStream_t stream) {
    static int grid = 0;
    if (grid == 0) {
        if (n_in != 37 || in_sizes[0] != SEQ * DM || out_size != SEQ * DM) { fprintf(stderr, "kernel_launch: unexpected shapes (n_in %d)\n", n_in); grid = -1; return; }
        int dev = 0, cus = 0;
        if (hipGetDevice(&dev) != hipSuccess || hipDeviceGetAttribute(&cus, hipDeviceAttributeMultiprocessorCount, dev) != hipSuccess) { grid = -1; return; }
        if (hipFuncSetAttribute((const void*)hybrid_fwd, hipFuncAttributeMaxDynamicSharedMemorySize, LDS_BYTES) != hipSuccess) { fprintf(stderr, "kernel_launch: hipFuncSetAttribute failed\n"); grid = -1; return; }
        int per_cu = 0;
        if (hipOccupancyMaxActiveBlocksPerMultiprocessor(&per_cu, (const void*)hybrid_fwd, NWAVES * 64, LDS_BYTES) != hipSuccess || per_cu < 1) { fprintf(stderr, "kernel_launch: occupancy query says %d\n", per_cu); }
        (void)hipGetLastError();
        grid = cus > 0 ? cus : 256;
    }
    if (grid < 0) return;
    Params p; memset(&p, 0, sizeof(p));
    const float* const* in = (const float* const*)d_in;
    p.x = in[0]; p.mem = in[1]; p.pos = (const int*)d_in[2]; p.norm_mix = in[3]; p.w_in = in[4]; p.lam_re = in[5]; p.lam_im = in[6]; p.log_step = in[7]; p.b_re = in[8]; p.b_im = in[9];
    p.c_re = in[10]; p.c_im = in[11]; p.ssm_d = in[12]; p.w_glu = in[13]; p.b_glu = in[14]; p.q_norm = in[15]; p.w_uq = in[16]; p.kv_norm = in[17]; p.w_uk = in[18]; p.w_uv = in[19];
    p.w_up_ssm = in[20]; p.w_up_mla = in[21]; p.w_out = in[22]; p.norm_xattn = in[23]; p.norm_mem = in[24]; p.xa_wq = in[25]; p.xa_wk = in[26]; p.xa_wv = in[27]; p.xa_wo = in[28];
    p.norm_moe = in[29]; p.router_w = in[30]; p.router_b = in[31]; p.w_gu = in[32]; p.b_gu = in[33]; p.w_dn = in[34]; p.b_dn = in[35]; p.final_norm = in[36];
    p.out = (float*)d_out;
    size_t off = 0; unsigned char* ws = (unsigned char*)d_ws;
    auto take = [&](size_t bytes) { unsigned char* r = ws + off; off += (bytes + 4095) & ~(size_t)4095; return r; };
    p.ctl = (unsigned*)take(1 << 20);
    p.WinT = (bf16_t*)take((size_t)6144 * DM * 2); p.WkpeT = (bf16_t*)take((size_t)64 * DM * 2); p.WgluT = (bf16_t*)take((size_t)SSM_W * SSM_W * 2); p.WuqT = (bf16_t*)take((size_t)3072 * QL * 2);
    p.WukvT = (bf16_t*)take((size_t)4096 * KVL * 2); p.WupsT = (bf16_t*)take((size_t)DM * SSM_W * 2); p.WupmT = (bf16_t*)take((size_t)DM * DM * 2); p.WoutT = (bf16_t*)take((size_t)DM * DM * 2);
    p.WxqT = (bf16_t*)take((size_t)XW * DM * 2); p.WxkvT = (bf16_t*)take((size_t)2 * XW * DM * 2); p.WxoT = (bf16_t*)take((size_t)DM * XW * 2);
    p.WguT = (unsigned char*)take((size_t)NEXP * 2 * DFF * DM); p.WdnT = (unsigned char*)take((size_t)NEXP * DM * DFF); p.WrT = (float*)take((size_t)DM * NEXP * 4);
    p.hn = (bf16_t*)take((size_t)SEQ * DM * 2); p.hn8 = (unsigned char*)take((size_t)SEQ * DM); p.WinT8 = (unsigned char*)take((size_t)6144 * DM); p.memn = (bf16_t*)take((size_t)MEML * DM * 2); p.cosT = (float*)take((size_t)SEQ * 32 * 4); p.sinT = (float*)take((size_t)SEQ * 32 * 4);
    p.abar = (float*)take((size_t)SSM_G * SSM_P * 8); p.bbarT = (bf16_t*)take((size_t)SSM_G * 128 * 16 * 2); p.cmat = (bf16_t*)take((size_t)SSM_G * 16 * 128 * 2);
    p.ub = (bf16_t*)take((size_t)SEQ * SSM_W * 2); p.qa = (bf16_t*)take((size_t)SEQ * QL * 2); p.kva = (bf16_t*)take((size_t)SEQ * KVL * 2); p.qss = (float*)take((size_t)SEQ * 8 * 4); p.kvss = (float*)take((size_t)SEQ * 8 * 4);
    p.sgs = (bf16_t*)take((size_t)SEQ * DM * 2); p.sgm = (bf16_t*)take((size_t)SEQ * DM * 2); p.kpe = (bf16_t*)take((size_t)SEQ * DROPE * 2);
    p.qn = (bf16_t*)take((size_t)SEQ * DM * 2); p.qr = (bf16_t*)take((size_t)SEQ * NHEAD * DROPE * 2); p.kn = (bf16_t*)take((size_t)SEQ * DM * 2); p.vv = (bf16_t*)take((size_t)SEQ * DM * 2); p.ymla = (bf16_t*)take((size_t)SEQ * DM * 2);
    p.send = (float*)take((size_t)S5_NCH * SSM_G * 64 * 8); p.mg8 = (unsigned char*)take((size_t)SEQ * DM); p.WoutT8 = (unsigned char*)take((size_t)DM * DM); p.zb = (bf16_t*)take((size_t)SEQ * SSM_W * 2); p.ys = (bf16_t*)take((size_t)SEQ * SSM_W * 2); p.t1 = (bf16_t*)take((size_t)SEQ * DM * 2); p.mg = (bf16_t*)take((size_t)SEQ * DM * 2);
    p.x1 = nullptr; p.x1b8 = (unsigned char*)take((size_t)SEQ * DM); p.x1b = (bf16_t*)take((size_t)SEQ * DM * 2); p.ss1 = (float*)take((size_t)SEQ * 32 * 4);
    p.memkv = (bf16_t*)take((size_t)MEML * 2 * XW * 2); p.qx = (bf16_t*)take((size_t)SEQ * XW * 2); p.ox = (bf16_t*)take((size_t)SEQ * XW * 2);
    p.x2 = (bf16_t*)take((size_t)SEQ * DM * 2); p.ss2 = (float*)take((size_t)SEQ * 32 * 4);
    p.csprev = (unsigned*)take(4096); p.W2chk = (unsigned char*)take((size_t)NEXP * 2 * DFF * DM + (size_t)NEXP * DM * DFF + 4096); p.topi = (int*)take((size_t)SEQ * 4 * 4); p.topw = (float*)take((size_t)SEQ * 4 * 4); p.rank = (int*)take((size_t)SEQ * 4 * 4); p.slot = (int*)take((size_t)SEQ * 4 * 4); p.wgcnt = (int*)take((size_t)256 * 32 * 4); p.blke = (int*)take((size_t)(MAXBLK + 8) * 4);
    p.xg = (unsigned char*)take((size_t)NSLOT * DM); p.act = (unsigned char*)take((size_t)NSLOT * DFF); p.orow = (bf16_t*)take((size_t)NSLOT * DM * 2);
    if (off > ws_size) { fprintf(stderr, "kernel_launch: workspace too small: need %zu have %zu\n", off, ws_size); return; }
    (void)hipMemsetAsync(p.ctl, 0, 1 << 20, stream);
#if MK_ONE_LAUNCH
    p.ph_lo = 0; p.ph_hi = NPHASE;
#ifdef USE_CG
    { void* args[] = {&p}; hipError_t e_ = hipLaunchCooperativeKernel((const void*)hybrid_fwd, dim3(grid), dim3(NWAVES * 64), args, LDS_BYTES, stream); if (e_ != hipSuccess) fprintf(stderr, "coop launch failed: %s\n", hipGetErrorName(e_)); }
#else
    hipLaunchKernelGGL(hybrid_fwd, dim3(grid), dim3(NWAVES * 64), LDS_BYTES, stream, p);
#endif
#else
    for (int k = 0; k < NPHASE; ++k) { p.ph_lo = k; p.ph_hi = k + 1; hipLaunchKernelGGL(hybrid_fwd, dim3(grid), dim3(NWAVES * 64), LDS_BYTES, stream, p); }
#endif
}
```

```cpp
#include <hip/hip_runtime.h>
#ifdef USE_CG
#include <hip/hip_cooperative_groups.h>
#endif
#include <cstdio>
#include <cstdint>
#include <cstring>

#ifndef PROJ_F8
#define PROJ_F8 2
#endif
#ifndef OUT_F8
#define OUT_F8 1
#endif
#ifndef MUP_F8
#define MUP_F8 1
#endif
#ifndef QK_F8
#define QK_F8 1
#endif
#ifndef PV_F8
#define PV_F8 1
#endif
#ifndef LAT_F8
#define LAT_F8 1
#endif
#ifndef LAT_P2
#define LAT_P2 1
#endif
#ifndef MLA_X2
#define MLA_X2 0
#endif
#ifndef MOE_IN_MLA
#define MOE_IN_MLA 0
#endif
#ifndef MOE_REG
#define MOE_REG 0
#endif
#ifndef SGM_F8
#define SGM_F8 1
#endif
#ifndef MLA_SEAM
#define MLA_SEAM 0
#endif
#ifndef P56_MERGE
#define P56_MERGE 0
#endif
#ifndef XQ_HALF
#define XQ_HALF 1
#endif
#ifndef XQ_F8
#define XQ_F8 0
#endif
#ifndef P0_PIPE
#define P0_PIPE 0
#endif

#define LAS __attribute__((address_space(3)))
#define GAS __attribute__((address_space(1)))
typedef unsigned short bf16_t;
typedef short bf16x8 __attribute__((ext_vector_type(8)));
typedef short s16x4 __attribute__((ext_vector_type(4)));
typedef float f32x4 __attribute__((ext_vector_type(4)));
typedef float f32x2 __attribute__((ext_vector_type(2)));
typedef float f32x16 __attribute__((ext_vector_type(16)));
typedef unsigned u32x4 __attribute__((ext_vector_type(4)));
typedef unsigned u32x2 __attribute__((ext_vector_type(2)));
typedef GAS unsigned gu32;

constexpr int SEQ = 16384, DM = 2048;
constexpr int SSM_W = 1024, SSM_G = 64, SSM_P = 64, SSM_H = 16;
constexpr int QL = 512, KVL = 512, NHEAD = 16, DNOPE = 128, DROPE = 64, DV = 128;
constexpr int IN_COLS = 6208;
constexpr int MEML = 256, XH = 4, XW = 512;
constexpr int NEXP = 32, TOPK = 4, DFF = 2048;
constexpr int NSLOT = SEQ * TOPK + NEXP * 256;
constexpr int MAXBLK = NSLOT / 256;
constexpr float EPS = 1e-6f;
constexpr int NWAVES = 8;

#define LDS_WAIT() asm volatile("s_waitcnt lgkmcnt(0)" ::: "memory")
#define VM_WAIT() asm volatile("s_waitcnt vmcnt(0)" ::: "memory")
#define SBAR() __builtin_amdgcn_sched_barrier(0)
__device__ __forceinline__ unsigned cvtpk(float lo, float hi) { unsigned r; asm volatile("v_cvt_pk_bf16_f32 %0, %1, %2" : "=v"(r) : "v"(lo), "v"(hi)); return r; }
__device__ __forceinline__ float bf2f(unsigned short b) { return __uint_as_float(((unsigned)b) << 16); }
__device__ __forceinline__ float bflo(unsigned w) { return __uint_as_float(w << 16); }
__device__ __forceinline__ float bfhi(unsigned w) { return __uint_as_float(w & 0xffff0000u); }
__device__ __forceinline__ unsigned short f2bf(float f) { return (unsigned short)(cvtpk(f, f) & 0xffffu); }
__device__ __forceinline__ u32x4 pack8f(f32x4 a, f32x4 b) { u32x4 w = {cvtpk(a[0], a[1]), cvtpk(a[2], a[3]), cvtpk(b[0], b[1]), cvtpk(b[2], b[3])}; return w; }
__device__ __forceinline__ void unpack8(u32x4 w, f32x4& a, f32x4& b) { a = (f32x4){bflo(w.x), bfhi(w.x), bflo(w.y), bfhi(w.y)}; b = (f32x4){bflo(w.z), bfhi(w.z), bflo(w.w), bfhi(w.w)}; }
__device__ __forceinline__ float fsigmoid(float x) { return __builtin_amdgcn_rcpf(1.0f + __builtin_amdgcn_exp2f(-1.4426950408889634f * x)); }
__device__ __forceinline__ float gelu_tanh(float x) {
    const float u = 0.7978845608028654f * (x + 0.044715f * x * x * x);
    return x * fsigmoid(2.0f * u);
}
template <int CTRL> __device__ __forceinline__ float dppf(float v) { return __uint_as_float((unsigned)__builtin_amdgcn_update_dpp(0, (int)__float_as_uint(v), CTRL, 0xF, 0xF, false)); }
__device__ __forceinline__ float sum_x32(float v) { auto r = __builtin_amdgcn_permlane32_swap(__float_as_uint(v), __float_as_uint(v), false, false); return __uint_as_float(r[0]) + __uint_as_float(r[1]); }
__device__ __forceinline__ float sum_x16(float v) { auto r = __builtin_amdgcn_permlane16_swap(__float_as_uint(v), __float_as_uint(v), false, false); return __uint_as_float(r[0]) + __uint_as_float(r[1]); }
__device__ __forceinline__ float other_half(float v, int hi) { auto r = __builtin_amdgcn_permlane32_swap(__float_as_uint(v), __float_as_uint(v), false, false); return __uint_as_float(hi ? r[0] : r[1]); }
__device__ __forceinline__ float lane_x1(float v) { return dppf<0xB1>(v); }
__device__ __forceinline__ float wave_sum(float v) {
    v += dppf<0x128>(v); v += dppf<0x124>(v); v += dppf<0x122>(v); v += dppf<0x121>(v);
    return sum_x32(sum_x16(v));
}

#define XB_TMO      128
#define XB_XCNT(j)  (256  + 64 * (j))
#define XB_XSUB(j)  (1280 + 64 * (j))
#define XB_XGEN(j)  (2304 + 64 * (j))
#define XB_TOP      3328
#define XB_TOPGEN   3392
#define XCD_BAR_WORDS 3456
#define XB_SPIN_CAP (1u << 18)
__device__ __forceinline__ unsigned xb_ld(unsigned* p)              { return __hip_atomic_load(p, __ATOMIC_RELAXED, __HIP_MEMORY_SCOPE_AGENT); }
__device__ __forceinline__ unsigned xb_add(unsigned* p, unsigned v) { return __hip_atomic_fetch_add(p, v, __ATOMIC_RELAXED, __HIP_MEMORY_SCOPE_AGENT); }
__device__ __forceinline__ unsigned xb_xcc_id() { return (unsigned)__builtin_amdgcn_s_getreg((3 << 11) | 20) & 0xFu; }
#define XB_SPIN(cond, bar) do { unsigned _sp = 0; while (cond) { __builtin_amdgcn_s_sleep(1); \
    if ((++_sp & 255u) == 0u) { if (xb_ld(&(bar)[XB_TMO])) break; if (_sp > XB_SPIN_CAP) { atomicAdd(&(bar)[XB_TMO], 1u); break; } } } } while (0)
#ifndef XB_ACQ_SYS
#define XB_ACQ_SYS 0
#endif
#define XB_ACQUIRE() do { if (XB_ACQ_SYS) __builtin_amdgcn_fence(__ATOMIC_ACQUIRE, ""); else __builtin_amdgcn_fence(__ATOMIC_ACQUIRE, "agent"); } while (0)
struct XcdBarrier { unsigned* bar; unsigned x; volatile LAS unsigned* st; };
__device__ __forceinline__ XcdBarrier xcd_barrier_post(unsigned* bar, volatile LAS unsigned* st) {
    XcdBarrier b; b.bar = bar; b.x = xb_xcc_id(); b.st = st;
    if (threadIdx.x == 0) (void)xb_add(&bar[XB_XCNT(b.x)], 1u);
    return b;
}
__device__ __forceinline__ void xcd_barrier_complete(unsigned* bar, unsigned x, unsigned& nloc, unsigned& nx) {
    const unsigned G = gridDim.x * gridDim.y * gridDim.z;
    unsigned sum, cnt, mine, sp = 0u;
    for (;;) {
        sum = 0u; cnt = 0u; mine = 0u;
#pragma unroll
        for (unsigned j = 0; j < 16; ++j) { const unsigned c = xb_ld(&bar[XB_XCNT(j)]); sum += c; cnt += (c > 0u) ? 1u : 0u; mine = (j == x) ? c : mine; }
        if (sum == G) break;
        __builtin_amdgcn_s_sleep(1);
        if ((++sp & 255u) == 0u) { if (xb_ld(&bar[XB_TMO])) break; if (sp > XB_SPIN_CAP) { atomicAdd(&bar[XB_TMO], 1u); break; } }
    }
    nloc = mine > 0u ? mine : 1u; nx = cnt > 0u ? cnt : 1u;
}
__device__ __forceinline__ void xcd_barrier(const XcdBarrier& b) {
    asm volatile("s_waitcnt vmcnt(0)" ::: "memory");
    __syncthreads();
    if (threadIdx.x == 0) {
        unsigned* bar = b.bar;
        __builtin_amdgcn_s_waitcnt(0);
        unsigned nloc = b.st[0], nx = b.st[1];
        if (nloc == 0u) { xcd_barrier_complete(bar, b.x, nloc, nx); b.st[0] = nloc; b.st[1] = nx; }
        const unsigned old = xb_add(&bar[XB_XSUB(b.x)], 1u);
        const unsigned gen = old / nloc;
        if (old + 1u == (gen + 1u) * nloc) {
            __builtin_amdgcn_fence(__ATOMIC_RELEASE, "agent");
            asm volatile("s_waitcnt vmcnt(0)" ::: "memory");
            const unsigned og = xb_add(&bar[XB_TOP], 1u);
            const unsigned tg = og / nx;
            if (og + 1u == (tg + 1u) * nx) xb_add(&bar[XB_TOPGEN], 1u);
            else XB_SPIN(xb_ld(&bar[XB_TOPGEN]) == tg, bar);
            XB_ACQUIRE();
            xb_add(&bar[XB_XGEN(b.x)], 1u);
            asm volatile("s_waitcnt vmcnt(0)" ::: "memory");
        } else {
            XB_SPIN(xb_ld(&bar[XB_XGEN(b.x)]) == gen, bar);
            XB_ACQUIRE();
            asm volatile("s_waitcnt vmcnt(0)" ::: "memory");
        }
    }
    __syncthreads();
}
namespace pg8 {
constexpr int BM = 256, BK = 64, HALF = 128, HTB = HALF * BK * 2, NXCD = 8, WGM = 4;
__host__ __device__ __forceinline__ int lds_byte(int r, int c) { const int st = (r >> 4) * 2 + (c >> 5), rr = r & 15, cc = c & 31, ob = rr * 64 + cc * 2; return st * 1024 + (ob ^ (((ob >> 9) & 1) << 5)); }
__host__ __device__ __forceinline__ void stage_rc(int b, int& R, int& C) { const int st = b / 1024, sb = b % 1024, swz = sb ^ (((sb >> 9) & 1) << 5); R = (st >> 1) * 16 + swz / 64; C = (st & 1) * 32 + (swz % 64) / 2; }
__host__ __device__ __forceinline__ int perm32(int rho) { const int n = rho >> 4, i = rho & 15; return 8 * (i >> 2) + 4 * n + (i & 3); }

struct Unit { int pm, pn, e; };
struct Gemm { const bf16_t* A; const bf16_t* Bt; int lda, ldb, K; size_t bstride; };

struct StaticOrder {
    static constexpr int RB = BM; static constexpr bool HM = false;
    int nM, nN, nwg, G, c;
    __device__ void init(int M, int N, int G_, int c_) { nM = M / BM; nN = N / BM; nwg = nM * nN; G = G_; c = c_; }
    __device__ bool next(int i, Unit& u) const {
        const long L = (long)i * G + c; if (L >= nwg) return false;
        int wgid = (int)L; { const int q = nwg / NXCD, r = nwg % NXCD, xcd = wgid % NXCD, off = wgid / NXCD; wgid = (xcd < r ? xcd * (q + 1) : r * (q + 1) + (xcd - r) * q) + off; }
        const int nig = WGM * nN, gid = wgid / nig, fm = gid * WGM, gsz = (nM - fm) < WGM ? (nM - fm) : WGM;
        u.pm = fm + ((wgid % nig) % gsz); u.pn = (wgid % nig) / gsz; u.e = 0; return true;
    }
};
struct HalfOrder {
    static constexpr int RB = HALF; static constexpr bool HM = true;
    StaticOrder so;
    __device__ void init(int M, int N, int G_, int c_) { so.nM = M / HALF; so.nN = N / BM; so.nwg = so.nM * so.nN; so.G = G_; so.c = c_; }
    __device__ bool next(int i, Unit& u) const { return so.next(i, u); }
};
struct MoeOrder {
    static constexpr int RB = BM; static constexpr bool HM = false;
    StaticOrder so; const LAS int* blk_e;
    __device__ void init(int nblk, int N, int G_, int c_, const LAS int* be) { so.nM = nblk; so.nN = N / BM; so.nwg = so.nM * so.nN; so.G = G_; so.c = c_; blk_e = be; }
    __device__ bool next(int i, Unit& u) const { if (!so.next(i, u)) return false; u.e = __builtin_amdgcn_readfirstlane(blk_e[u.pm]); return true; }
};

typedef int v4i_t __attribute__((ext_vector_type(4)));
typedef int v8i_t __attribute__((ext_vector_type(8)));
#define PG8_CAT8(a, b) __builtin_shufflevector(__builtin_bit_cast(v4i_t, a), __builtin_bit_cast(v4i_t, b), 0, 1, 2, 3, 4, 5, 6, 7)
template <class Epi, class Sched, bool F8 = false>
__device__ __forceinline__ void gemm_phase(LAS unsigned char* lds, const Gemm g, const Sched& S, const Epi& E) {
    constexpr bool ALIGN_EPI = true;
    int tid = threadIdx.x; asm volatile("" : "+v"(tid));
    const int wid = __builtin_amdgcn_readfirstlane(tid >> 6), lane = tid & 63, wr = wid >> 2, wc = wid & 3, fr = lane & 15, fq = lane >> 4;
    const int K = g.K, nt = K / BK;
    unsigned voffA[2], voffB[2];
#pragma unroll
    for (int i = 0; i < 2; ++i) { int R, C; stage_rc(tid * 16 + i * 8192, R, C); const int Rb = Epi::PERM ? ((R & ~31) + perm32(R & 31)) : R;
        voffA[i] = (unsigned)(R * g.lda + C) * 2u; voffB[i] = (unsigned)(Rb * g.ldb + C) * 2u; }
    const size_t kstep = (size_t)(BK * 2);
    const size_t hstepA = (size_t)HALF * g.lda * 2, hstepB = (size_t)HALF * g.ldb * 2;
    const unsigned ldsw = (unsigned)wid * 1024u;
    const int aoff = lds_byte(wr * 64 + fr, fq * 8), boff = lds_byte(wc * 32 + fr, fq * 8);
#define PG8_SA(b, h) (((b) * 2 + (h)) * HTB)
#define PG8_SB(b, h) ((4 + (b) * 2 + (h)) * HTB)
#define PG8_STAGE(bufoff, gbase, voff) do { _Pragma("unroll") for (int _i = 0; _i < 2; ++_i) \
        __builtin_amdgcn_global_load_lds((const unsigned*)((const char*)(gbase) + (voff)[_i]), (LAS unsigned*)(lds + (bufoff) + ldsw + _i * 8192), 16, 0, 0); } while (0)
#define PG8_LDA(dst, b, h) do { _Pragma("unroll") for (int m = 0; m < 4; ++m) _Pragma("unroll") for (int k = 0; k < 2; ++k) dst[m][k] = *(const LAS bf16x8*)(lds + PG8_SA(b, h) + aoff + m * 2048 + k * 1024); } while (0)
#define PG8_LDB(dst, b, h) do { _Pragma("unroll") for (int n = 0; n < 2; ++n) _Pragma("unroll") for (int k = 0; k < 2; ++k) dst[n][k] = *(const LAS bf16x8*)(lds + PG8_SB(b, h) + boff + n * 2048 + k * 1024); } while (0)
#define PG8_MMA(ai, bj, At, Bt) do { __builtin_amdgcn_s_setprio(1); _Pragma("unroll") for (int m = 0; m < 4; ++m) _Pragma("unroll") for (int n = 0; n < 2; ++n) { \
        if constexpr (F8) { const v8i_t b8_ = PG8_CAT8(Bt[n][0], Bt[n][1]), a8_ = PG8_CAT8(At[m][0], At[m][1]); asm volatile("v_mfma_f32_16x16x128_f8f6f4 %0, %1, %2, %0" : "+v"(acc[ai][bj][m][n]) : "v"(b8_), "v"(a8_)); }   \
        else { _Pragma("unroll") for (int k = 0; k < 2; ++k) acc[ai][bj][m][n] = __builtin_amdgcn_mfma_f32_16x16x32_bf16(Bt[n][k], At[m][k], acc[ai][bj][m][n], 0, 0, 0); } } __builtin_amdgcn_s_setprio(0); } while (0)
#define PG8_WAIT_V(n) asm volatile("s_waitcnt vmcnt(" #n ")" ::: "memory")
#define PG8_WAIT_L(n) asm volatile("s_waitcnt lgkmcnt(" #n ")" ::: "memory")
#define PG8_BAR __builtin_amdgcn_s_barrier()
#define PG8_SCHED __builtin_amdgcn_sched_barrier(0)
#define PG8_ABASE(u) ((const char*)g.A + (size_t)(u).pm * Sched::RB * g.lda * 2)
#define PG8_BBASE(u) ((const char*)g.Bt + ((size_t)(u).e * g.bstride + (size_t)(u).pn * BM * g.ldb) * 2)
    Unit cur, nxt; int ui = 0;
    if (!S.next(0, cur)) return;
    f32x4 acc[2][2][4][2];
#pragma unroll
    for (int a = 0; a < 2; ++a)
#pragma unroll
        for (int b = 0; b < 2; ++b)
#pragma unroll
            for (int m = 0; m < 4; ++m)
#pragma unroll
                for (int n = 0; n < 2; ++n) acc[a][b][m][n] = (f32x4){0.f, 0.f, 0.f, 0.f};
    if constexpr (F8) {
#pragma unroll
        for (int a = 0; a < 2; ++a)
#pragma unroll
            for (int b = 0; b < 2; ++b)
#pragma unroll
                for (int m = 0; m < 4; ++m)
#pragma unroll
                    for (int n = 0; n < 2; ++n) asm volatile("" : "+v"(acc[a][b][m][n])); }
    bf16x8 At[4][2], B0[2][2], B1[2][2];
    const char* cA = PG8_ABASE(cur); const char* cB = PG8_BBASE(cur);
    PG8_STAGE(PG8_SB(0, 0), cB, voffB); PG8_STAGE(PG8_SB(0, 1), cB + hstepB, voffB); PG8_STAGE(PG8_SA(0, 0), cA, voffA); PG8_STAGE(PG8_SA(0, 1), cA + hstepA, voffA);
    if (wr == 1) PG8_BAR;
    PG8_WAIT_V(2); PG8_BAR;
    PG8_STAGE(PG8_SB(1, 0), cB + kstep, voffB); PG8_STAGE(PG8_SA(1, 0), cA + kstep, voffA); PG8_STAGE(PG8_SB(1, 1), cB + hstepB + kstep, voffB);
    PG8_WAIT_V(6); PG8_BAR;
    for (;;) {
        const bool has_next = S.next(ui + 1, nxt);
        const char* nA = has_next ? PG8_ABASE(nxt) : cA; const char* nB = has_next ? PG8_BBASE(nxt) : cB;
        for (int t = 0; t < nt; t += 2) {
            const bool last = (t == nt - 2);
            const char* a1 = cA + (size_t)(t + 1) * kstep;
            const char* a2 = last ? nA : cA + (size_t)(t + 2) * kstep; const char* b2 = last ? nB : cB + (size_t)(t + 2) * kstep;
            const char* a3 = a2 + kstep; const char* b3 = b2 + kstep;
            PG8_LDB(B0, 0, 0); PG8_LDB(B1, 0, 1); PG8_SCHED; PG8_LDA(At, 0, 0); PG8_STAGE(PG8_SA(1, 1), a1 + hstepA, voffA);
            PG8_WAIT_V(8); PG8_WAIT_L(0); PG8_BAR; PG8_MMA(0, 0, At, B0); PG8_MMA(0, 1, At, B1); PG8_BAR; PG8_SCHED;
            if constexpr (!Sched::HM) { PG8_LDA(At, 0, 1); } PG8_STAGE(PG8_SB(0, 0), b2, voffB); PG8_STAGE(PG8_SB(0, 1), b2 + hstepB, voffB); PG8_STAGE(PG8_SA(0, 0), a2, voffA);
            PG8_WAIT_V(8); PG8_WAIT_L(0); PG8_BAR; if constexpr (!Sched::HM) { PG8_MMA(1, 0, At, B0); PG8_MMA(1, 1, At, B1); } PG8_BAR; PG8_SCHED;
            PG8_LDB(B0, 1, 0); PG8_LDB(B1, 1, 1); PG8_SCHED; PG8_LDA(At, 1, 0); PG8_STAGE(PG8_SA(0, 1), a2 + hstepA, voffA);
            PG8_WAIT_V(8); PG8_WAIT_L(0); PG8_BAR; PG8_MMA(0, 0, At, B0); PG8_MMA(0, 1, At, B1); PG8_BAR; PG8_SCHED;
            if constexpr (!Sched::HM) { PG8_LDA(At, 1, 1); } PG8_STAGE(PG8_SB(1, 0), b3, voffB); PG8_STAGE(PG8_SB(1, 1), b3 + hstepB, voffB); PG8_STAGE(PG8_SA(1, 0), a3, voffA);
            PG8_WAIT_V(8); PG8_WAIT_L(0); PG8_BAR; if constexpr (!Sched::HM) { PG8_MMA(1, 0, At, B0); PG8_MMA(1, 1, At, B1); } PG8_BAR; PG8_SCHED;
        }
        if constexpr (ALIGN_EPI) { if (wr == 0) PG8_BAR; }
        if constexpr (F8) asm volatile("s_nop 15\n\ts_nop 15\n\ts_nop 15" ::: "memory");
        E(acc, cur, wr, wc, fr, fq);
        if (!has_next) break;
#pragma unroll
        for (int a = 0; a < 2; ++a)
#pragma unroll
            for (int b = 0; b < 2; ++b)
#pragma unroll
                for (int m = 0; m < 4; ++m)
#pragma unroll
                    for (int n = 0; n < 2; ++n) acc[a][b][m][n] = (f32x4){0.f, 0.f, 0.f, 0.f};
    if constexpr (F8) {
#pragma unroll
        for (int a = 0; a < 2; ++a)
#pragma unroll
            for (int b = 0; b < 2; ++b)
#pragma unroll
                for (int m = 0; m < 4; ++m)
#pragma unroll
                    for (int n = 0; n < 2; ++n) asm volatile("" : "+v"(acc[a][b][m][n])); }
        cur = nxt; cA = nA; cB = nB; ++ui;
        if constexpr (ALIGN_EPI) { if (wr == 1) PG8_BAR; }
    }
    PG8_WAIT_V(0);
    if constexpr (!ALIGN_EPI) { if (wr == 0) PG8_BAR; }
    PG8_BAR;
#undef PG8_SA
#undef PG8_SB
#undef PG8_STAGE
#undef PG8_LDA
#undef PG8_LDB
#undef PG8_MMA
#undef PG8_WAIT_V
#undef PG8_WAIT_L
#undef PG8_BAR
#undef PG8_SCHED
#undef PG8_ABASE
#undef PG8_BBASE
}

#define EPI_ROW(u, ai, m) ((u).pm * BM + (ai) * HALF + wr * 64 + (m) * 16 + fr)
#define EPI_CB(bj) ((bj) * HALF + wc * 32 + 8 * fq)
typedef f32x4 AccT[2][2][4][2];

__device__ __forceinline__ f32x4 sig4(f32x4 v) { return (f32x4){fsigmoid(v[0]), fsigmoid(v[1]), fsigmoid(v[2]), fsigmoid(v[3])}; }
__device__ __forceinline__ float sq4(f32x4 v) { return (v[0] * v[0] + v[1] * v[1]) + (v[2] * v[2] + v[3] * v[3]); }

constexpr float F8_XS = 8.0f, F8_WS = 512.0f, F8_AS = 4.0f;
__device__ __forceinline__ unsigned pk4_fp8(float a, float b, float c, float d) {
    a = fminf(fmaxf(a, -448.f), 448.f); b = fminf(fmaxf(b, -448.f), 448.f); c = fminf(fmaxf(c, -448.f), 448.f); d = fminf(fmaxf(d, -448.f), 448.f);
    int w = __builtin_amdgcn_cvt_pk_fp8_f32(a, b, 0, false); w = __builtin_amdgcn_cvt_pk_fp8_f32(c, d, w, true); return (unsigned)w; }
struct EpiProj {
    static constexpr bool PERM = true;
    bf16_t *ub, *qa, *kva, *sgs, *sgm; float *qss, *kvss; float sc; int pn_off; static constexpr bool l8 = (LAT_P2 != 0);
    __device__ __forceinline__ void operator()(const AccT& acc, const Unit& u, int wr, int wc, int fr, int fq) const {
        const int pn = u.pn + pn_off; bf16_t* dst; int ld, c0; float* ss = nullptr; int ssl = 0; bool sg = false;
        if (pn < 4) { dst = ub; ld = SSM_W; c0 = pn * BM; }
        else if (pn < 6) { dst = qa; ld = QL; c0 = (pn - 4) * BM; ss = qss; ssl = (pn - 4) * 4 + wc; }
        else if (pn < 8) { dst = kva; ld = KVL; c0 = (pn - 6) * BM; ss = kvss; ssl = (pn - 6) * 4 + wc; }
        else if (pn < 16) { dst = sgs; ld = DM; c0 = (pn - 8) * BM; sg = true; }
        else { dst = sgm; ld = DM; c0 = (pn - 16) * BM; sg = true; }
#pragma unroll
        for (int ai = 0; ai < 2; ++ai)
#pragma unroll
            for (int m = 0; m < 4; ++m) { const int row = EPI_ROW(u, ai, m); float s = 0.f;
#pragma unroll
                for (int bj = 0; bj < 2; ++bj) { f32x4 v0 = acc[ai][bj][m][0] * sc, v1 = acc[ai][bj][m][1] * sc;
                    if (sg) { v0 = sig4(v0); v1 = sig4(v1); }
                    s += sq4(v0) + sq4(v1);
                    if (SGM_F8 && pn >= 16) { const f32x4 w0 = v0 * 256.0f, w1 = v1 * 256.0f; const u32x2 o8 = {pk4_fp8(w0[0], w0[1], w0[2], w0[3]), pk4_fp8(w1[0], w1[1], w1[2], w1[3])}; *(u32x2*)((unsigned char*)dst + (size_t)row * ld + c0 + EPI_CB(bj)) = o8; }
                    else if (l8 && ss) { const f32x4 w0 = v0 * F8_XS, w1 = v1 * F8_XS; const u32x2 o8 = {pk4_fp8(w0[0], w0[1], w0[2], w0[3]), pk4_fp8(w1[0], w1[1], w1[2], w1[3])}; *(u32x2*)((unsigned char*)dst + (size_t)row * ld + c0 + EPI_CB(bj)) = o8; }
                    else *(u32x4*)(dst + (size_t)row * ld + c0 + EPI_CB(bj)) = pack8f(v0, v1); }
                if (ss) { s = sum_x32(sum_x16(s)); if (fq == 0) ss[((size_t)(ssl >> 2) * SEQ + row) * 4 + (ssl & 3)] = s; } }
    }
};
__device__ __forceinline__ float row_rs8(const float* ss, int row, float invn) { const f32x4 a = *(const f32x4*)(ss + (size_t)row * 4), b = *(const f32x4*)(ss + ((size_t)SEQ + row) * 4);
    return __builtin_amdgcn_rsqf(((a[0] + a[1]) + (a[2] + a[3]) + (b[0] + b[1]) + (b[2] + b[3])) * invn + EPS); }
__device__ __forceinline__ float row_rs32(const float* ss, int row, float invn) { float s = 0.f;
#pragma unroll
    for (int i = 0; i < 8; ++i) { const f32x4 a = *(const f32x4*)(ss + ((size_t)i * SEQ + row) * 4); s += (a[0] + a[1]) + (a[2] + a[3]); }
    return __builtin_amdgcn_rsqf(s * invn + EPS); }

struct EpiQup {
    static constexpr bool PERM = true;
    bf16_t *qn, *qr; const float *ss, *cosT, *sinT; float sc; static constexpr bool f8 = (QK_F8 != 0);
    __device__ __forceinline__ void operator()(const AccT& acc, const Unit& u, int wr, int wc, int fr, int fq) const {
        const int pn = u.pn;
#pragma unroll
        for (int ai = 0; ai < 2; ++ai)
#pragma unroll
            for (int m = 0; m < 4; ++m) { const int row = EPI_ROW(u, ai, m); const float rs = row_rs8(ss, row, 1.0f / QL) * sc;
                if (pn < 8) {
#pragma unroll
                    for (int bj = 0; bj < 2; ++bj) { const f32x4 v0 = acc[ai][bj][m][0] * rs, v1 = acc[ai][bj][m][1] * rs;
                        if (f8) { const f32x4 w0 = v0 * F8_XS, w1 = v1 * F8_XS; const u32x2 o8 = {pk4_fp8(w0[0], w0[1], w0[2], w0[3]), pk4_fp8(w1[0], w1[1], w1[2], w1[3])}; *(u32x2*)((unsigned char*)qn + (size_t)row * DM + pn * BM + EPI_CB(bj)) = o8; }
                        else *(u32x4*)(qn + (size_t)row * DM + pn * BM + EPI_CB(bj)) = pack8f(v0, v1); }
                } else {
                    const int head = 4 * (pn - 8) + wc;
                    const f32x4 c0 = *(const f32x4*)(cosT + (size_t)row * 32 + 8 * fq), c1 = *(const f32x4*)(cosT + (size_t)row * 32 + 8 * fq + 4);
                    const f32x4 s0 = *(const f32x4*)(sinT + (size_t)row * 32 + 8 * fq), s1 = *(const f32x4*)(sinT + (size_t)row * 32 + 8 * fq + 4);
                    const f32x4 a0 = acc[ai][0][m][0] * rs, a1 = acc[ai][0][m][1] * rs, b0 = acc[ai][1][m][0] * rs, b1 = acc[ai][1][m][1] * rs;
                    const f32x4 x0 = a0 * c0 - b0 * s0, x1 = a1 * c1 - b1 * s1, y0 = a0 * s0 + b0 * c0, y1 = a1 * s1 + b1 * c1;
                    if (f8) { unsigned char* q8 = (unsigned char*)qr + (size_t)row * (NHEAD * DROPE) + head * DROPE + 8 * fq; const f32x4 X0 = x0 * F8_XS, X1 = x1 * F8_XS, Y0 = y0 * F8_XS, Y1 = y1 * F8_XS;
                        const u32x2 ox = {pk4_fp8(X0[0], X0[1], X0[2], X0[3]), pk4_fp8(X1[0], X1[1], X1[2], X1[3])}, oy = {pk4_fp8(Y0[0], Y0[1], Y0[2], Y0[3]), pk4_fp8(Y1[0], Y1[1], Y1[2], Y1[3])};
                        *(u32x2*)q8 = ox; *(u32x2*)(q8 + 32) = oy; }
                    else {
                    *(u32x4*)(qr + (size_t)row * (NHEAD * DROPE) + head * DROPE + 8 * fq) = pack8f(x0, x1);
                    *(u32x4*)(qr + (size_t)row * (NHEAD * DROPE) + head * DROPE + 32 + 8 * fq) = pack8f(y0, y1); }
                } }
    }
};
struct EpiKVup {
    static constexpr bool PERM = true;
    bf16_t *kn, *vv; const float* ss; float sc; static constexpr bool f8 = (QK_F8 != 0), v8 = (QK_F8 != 0) && (PV_F8 != 0);
    __device__ __forceinline__ void operator()(const AccT& acc, const Unit& u, int wr, int wc, int fr, int fq) const {
        bf16_t* dst = u.pn < 8 ? kn : vv; const int c0 = (u.pn & 7) * BM;
#pragma unroll
        for (int ai = 0; ai < 2; ++ai)
#pragma unroll
            for (int m = 0; m < 4; ++m) { const int row = EPI_ROW(u, ai, m); const float rs = row_rs8(ss, row, 1.0f / KVL) * sc;
#pragma unroll
                for (int bj = 0; bj < 2; ++bj) { const f32x4 v0 = acc[ai][bj][m][0] * rs, v1 = acc[ai][bj][m][1] * rs;
                    if (f8 && u.pn < 8) { const f32x4 w0 = v0 * F8_XS, w1 = v1 * F8_XS; const u32x2 o8 = {pk4_fp8(w0[0], w0[1], w0[2], w0[3]), pk4_fp8(w1[0], w1[1], w1[2], w1[3])}; *(u32x2*)((unsigned char*)kn + (size_t)row * DM + c0 + EPI_CB(bj)) = o8; }
                    else if (v8 && u.pn >= 8) { const f32x4 w0 = v0 * F8_XS, w1 = v1 * F8_XS; const unsigned lo = pk4_fp8(w0[0], w0[1], w0[2], w0[3]), hi4 = pk4_fp8(w1[0], w1[1], w1[2], w1[3]);
                        const int jq = fr & 3; const unsigned sel = (unsigned)jq | ((unsigned)(4 + jq) << 8) | 0x0c0c0000u;
                        unsigned T2[2];
#pragma unroll
                        for (int h2 = 0; h2 < 2; ++h2) { const int W = (int)(h2 ? hi4 : lo);
                            const unsigned A0 = (unsigned)__builtin_amdgcn_update_dpp(0, W, 0x00, 0xF, 0xF, false), A1 = (unsigned)__builtin_amdgcn_update_dpp(0, W, 0x55, 0xF, 0xF, false);
                            const unsigned A2 = (unsigned)__builtin_amdgcn_update_dpp(0, W, 0xAA, 0xF, 0xF, false), A3 = (unsigned)__builtin_amdgcn_update_dpp(0, W, 0xFF, 0xF, 0xF, false);
                            const unsigned r01 = __builtin_amdgcn_perm(A1, A0, sel), r23 = __builtin_amdgcn_perm(A3, A2, sel);
                            T2[h2] = __builtin_amdgcn_perm(r23, r01, 0x05040100u); }
                        const int col = c0 + EPI_CB(bj) + jq, k6b = (row - jq) & 63, posb = 32 * ((k6b >> 2) & 1) + 4 * (k6b >> 3);
                        unsigned char* vt = (unsigned char*)vv + ((size_t)((col >> 7) * (SEQ / 64) + (row >> 6)) * 128 + (col & 127)) * 64 + posb;
                        *(unsigned*)vt = T2[0]; *(unsigned*)(vt + 4 * 64) = T2[1]; }
                    else *(u32x4*)(dst + (size_t)row * DM + c0 + EPI_CB(bj)) = pack8f(v0, v1); } }
    }
};
struct EpiPlain {
    static constexpr bool PERM = true;
    bf16_t* O; int ld;
    __device__ __forceinline__ void operator()(const AccT& acc, const Unit& u, int wr, int wc, int fr, int fq) const {
#pragma unroll
        for (int ai = 0; ai < 2; ++ai)
#pragma unroll
            for (int m = 0; m < 4; ++m) { const int row = EPI_ROW(u, ai, m);
#pragma unroll
                for (int bj = 0; bj < 2; ++bj) *(u32x4*)(O + (size_t)row * ld + u.pn * BM + EPI_CB(bj)) = pack8f(acc[ai][bj][m][0], acc[ai][bj][m][1]); }
    }
};
struct EpiGlu {
    static constexpr bool PERM = true;
    const bf16_t* z; const float* bias; bf16_t* ys;
    __device__ __forceinline__ void operator()(const AccT& acc, const Unit& u, int wr, int wc, int fr, int fq) const {
#pragma unroll
        for (int bj = 0; bj < 2; ++bj) { const int col = u.pn * BM + EPI_CB(bj); const f32x4 b0 = *(const f32x4*)(bias + col), b1 = *(const f32x4*)(bias + col + 4);
#pragma unroll
            for (int ai = 0; ai < 2; ++ai)
#pragma unroll
                for (int m = 0; m < 4; ++m) { const size_t off = (size_t)EPI_ROW(u, ai, m) * SSM_W + col; f32x4 z0, z1; unpack8(*(const u32x4*)(z + off), z0, z1);
                    *(u32x4*)(ys + off) = pack8f(z0 * sig4(acc[ai][bj][m][0] + b0), z1 * sig4(acc[ai][bj][m][1] + b1)); } }
    }
};
template <bool G8 = false>
struct EpiGate {
    static constexpr bool PERM = true;
    const bf16_t* gate; const bf16_t* addend; bf16_t* O; unsigned char* O8; float sc;
    __device__ __forceinline__ void operator()(const AccT& acc, const Unit& u, int wr, int wc, int fr, int fq) const {
#pragma unroll
        for (int ai = 0; ai < 2; ++ai)
#pragma unroll
            for (int m = 0; m < 4; ++m)
#pragma unroll
                for (int bj = 0; bj < 2; ++bj) { const size_t off = (size_t)EPI_ROW(u, ai, m) * DM + u.pn * BM + EPI_CB(bj); f32x4 g0, g1;
                    if constexpr (G8) { const u32x2 gw = *(const u32x2*)((const unsigned char*)gate + off); const auto a0 = __builtin_amdgcn_cvt_pk_f32_fp8((int)gw.x, false), a1 = __builtin_amdgcn_cvt_pk_f32_fp8((int)gw.x, true), a2 = __builtin_amdgcn_cvt_pk_f32_fp8((int)gw.y, false), a3 = __builtin_amdgcn_cvt_pk_f32_fp8((int)gw.y, true);
                        g0 = (f32x4){a0[0], a0[1], a1[0], a1[1]}; g1 = (f32x4){a2[0], a2[1], a3[0], a3[1]}; }
                    else unpack8(*(const u32x4*)(gate + off), g0, g1);
                    f32x4 r0 = g0 * (acc[ai][bj][m][0] * sc), r1 = g1 * (acc[ai][bj][m][1] * sc);
                    if (addend) { f32x4 t0, t1; unpack8(*(const u32x4*)(addend + off), t0, t1); r0 += t0; r1 += t1; }
                    if (O8) { const u32x2 o8 = {pk4_fp8(r0[0] * F8_XS, r0[1] * F8_XS, r0[2] * F8_XS, r0[3] * F8_XS), pk4_fp8(r1[0] * F8_XS, r1[1] * F8_XS, r1[2] * F8_XS, r1[3] * F8_XS)}; *(u32x2*)(O8 + off) = o8; }
                    else *(u32x4*)(O + off) = pack8f(r0, r1); }
    }
};
template <class TI, bool WF32>
struct EpiResid {
    static constexpr bool PERM = true;
    const TI* xi; float* xo; bf16_t* xb; float* ss; unsigned char* x8; float sc;
    __device__ __forceinline__ void operator()(const AccT& acc, const Unit& u, int wr, int wc, int fr, int fq) const {
#pragma unroll
        for (int ai = 0; ai < 2; ++ai)
#pragma unroll
            for (int m = 0; m < 4; ++m) { const int row = EPI_ROW(u, ai, m); float s = 0.f;
#pragma unroll
                for (int bj = 0; bj < 2; ++bj) { const size_t off = (size_t)row * DM + u.pn * BM + EPI_CB(bj); f32x4 r0, r1;
                    if constexpr (sizeof(TI) == 4) { r0 = *(const f32x4*)((const float*)xi + off); r1 = *(const f32x4*)((const float*)xi + off + 4); }
                    else unpack8(*(const u32x4*)((const bf16_t*)xi + off), r0, r1);
                    r0 += acc[ai][bj][m][0] * sc; r1 += acc[ai][bj][m][1] * sc;
                    if constexpr (WF32) { *(f32x4*)(xo + off) = r0; *(f32x4*)(xo + off + 4) = r1; }
                    s += sq4(r0) + sq4(r1);
                    if (xb) *(u32x4*)(xb + off) = pack8f(r0, r1);
                    if (x8) { const f32x4 w0 = r0 * F8_XS, w1 = r1 * F8_XS; const u32x2 o8 = {pk4_fp8(w0[0], w0[1], w0[2], w0[3]), pk4_fp8(w1[0], w1[1], w1[2], w1[3])}; *(u32x2*)(x8 + off) = o8; } }
                s = sum_x32(sum_x16(s)); if (fq == 0) ss[((size_t)u.pn * SEQ + row) * 4 + wc] = s; }
    }
};
struct EpiXq {
    static constexpr bool PERM = true;
    bf16_t* O; const float* ss; float sc;
    __device__ __forceinline__ void operator()(const AccT& acc, const Unit& u, int wr, int wc, int fr, int fq) const {
#pragma unroll
        for (int ai = 0; ai < 2; ++ai)
#pragma unroll
            for (int m = 0; m < 4; ++m) { const int row = EPI_ROW(u, ai, m); const float rs = row_rs32(ss, row, 1.0f / DM) * sc;
#pragma unroll
                for (int bj = 0; bj < 2; ++bj) *(u32x4*)(O + (size_t)row * XW + u.pn * BM + EPI_CB(bj)) = pack8f(acc[ai][bj][m][0] * rs, acc[ai][bj][m][1] * rs); }
    }
};
struct EpiXqH {
    static constexpr bool PERM = true;
    bf16_t* O; const float* ss; float sc;
    __device__ __forceinline__ void operator()(const AccT& acc, const Unit& u, int wr, int wc, int fr, int fq) const {
#pragma unroll
        for (int m = 0; m < 4; ++m) { const int row = u.pm * HALF + wr * 64 + m * 16 + fr; const float rs = row_rs32(ss, row, 1.0f / DM) * sc;
#pragma unroll
            for (int bj = 0; bj < 2; ++bj) *(u32x4*)(O + (size_t)row * XW + u.pn * BM + EPI_CB(bj)) = pack8f(acc[0][bj][m][0] * rs, acc[0][bj][m][1] * rs); }
    }
};
struct EpiMoeGU {
    static constexpr bool PERM = true;
    const float* bias; unsigned char* act;
    __device__ __forceinline__ void operator()(const AccT& acc, const Unit& u, int wr, int wc, int fr, int fq) const {
        const int j0 = u.pn * HALF + wc * 32 + 8 * fq; const float* bg = bias + (size_t)u.e * (2 * DFF) + j0; constexpr float SC = 1.0f / (F8_XS * F8_WS);
        const f32x4 g0 = *(const f32x4*)bg, g1 = *(const f32x4*)(bg + 4), u0 = *(const f32x4*)(bg + DFF), u1 = *(const f32x4*)(bg + DFF + 4);
#pragma unroll
        for (int ai = 0; ai < 2; ++ai)
#pragma unroll
            for (int m = 0; m < 4; ++m) { const int row = EPI_ROW(u, ai, m); f32x4 r[2];
#pragma unroll
                for (int n = 0; n < 2; ++n) { const f32x4 gt = acc[ai][0][m][n] * SC + (n ? g1 : g0), up = acc[ai][1][m][n] * SC + (n ? u1 : u0);
#pragma unroll
                    for (int j = 0; j < 4; ++j) { const float gc = fminf(gt[j], 7.0f), uc = fminf(fmaxf(up[j], -7.0f), 7.0f); r[n][j] = F8_AS * (uc + 1.0f) * (gc * fsigmoid(1.702f * gc)); } }
                u32x2 o = {pk4_fp8(r[0][0], r[0][1], r[0][2], r[0][3]), pk4_fp8(r[1][0], r[1][1], r[1][2], r[1][3])};
                *(u32x2*)(act + (size_t)row * DFF + j0) = o; }
    }
};
struct EpiMoeDown {
    static constexpr bool PERM = true;
    const float* bias; bf16_t* O;
    __device__ __forceinline__ void operator()(const AccT& acc, const Unit& u, int wr, int wc, int fr, int fq) const {
#pragma unroll
        for (int bj = 0; bj < 2; ++bj) { const int col = u.pn * BM + EPI_CB(bj); const float* bp = bias + (size_t)u.e * DM + col; const f32x4 b0 = *(const f32x4*)bp, b1 = *(const f32x4*)(bp + 4); constexpr float SC = 1.0f / (F8_AS * F8_WS);
#pragma unroll
            for (int ai = 0; ai < 2; ++ai)
#pragma unroll
                for (int m = 0; m < 4; ++m) *(u32x4*)(O + (size_t)EPI_ROW(u, ai, m) * DM + col) = pack8f(acc[ai][bj][m][0] * SC + b0, acc[ai][bj][m][1] * SC + b1); }
    }
};
#undef EPI_ROW
#undef EPI_CB
}
namespace att {
constexpr int NW = 8, QBLK = 32, KVBLK = 64, QB = NW * QBLK;
constexpr int SHM_V = KVBLK * 128 * 2, SHM_K = KVBLK * 128 * 2, SHM_KR = KVBLK * 64 * 2;
constexpr int OFF_V = 0, OFF_K = 2 * SHM_V, OFF_KR = OFF_K + 2 * SHM_K, OFF_WS = OFF_KR + 2 * SHM_KR, OFF_QR = OFF_WS + NW * 64 * 4, LDS_BYTES = OFF_QR + NW * 8192;
constexpr float THR = 8.f;
#define KSWZ(row, colB) ((row) * 256 + ((colB) ^ (((row) & 7) << 4)))
__device__ __forceinline__ int v_st(int k, int c) { const int kk = (k & ~0xC) | ((k & 4) << 1) | ((k & 8) >> 1); return ((kk >> 3) * 4 + (c >> 5)) * 512 + ((kk & 7) * 32 + (c & 31)) * 2; }
__device__ __forceinline__ int v_rd_base(int lane) { return ((lane & 3) << 3) | (((lane >> 2) & 3) << 6) | (((lane >> 4) & 1) << 5) | (((lane >> 5) & 1) << 8); }
constexpr int v_rd_off(int d0, int ks, int half) { return d0 * 512 + ks * 4096 + half * 2048; }
__device__ __forceinline__ int crow(int r, int hi) { return (r & 3) + 8 * (r >> 2) + 4 * hi; }

__device__ __forceinline__ void mask_tile(f32x16& p0, f32x16& p1, int dq) {
    const float NEG = -__builtin_inff();
#pragma unroll
    for (int r = 0; r < 16; ++r) {
        const int c = (r & 3) + 8 * (r >> 2);
        if (dq - c < 0) p0[r] = NEG;
        if (dq - c - 32 < 0) p1[r] = NEG;
    }
}
template <bool ROPE, bool F8QK = false, bool P8 = false>
__device__ __forceinline__ void partialSM(f32x16& p0, f32x16& p1, float& m_reg, float& mn, float& alpha) {
    constexpr float THRV = P8 ? 2.f : THR;
    constexpr float SCALE = (ROPE ? 0.07216878364870323f : 0.08838834764831845f) * (F8QK ? 1.0f / 64.0f : 1.0f);
    float pmax = p0[0];
#pragma unroll
    for (int r = 1; r < 16; ++r) pmax = fmaxf(pmax, p0[r]);
#pragma unroll
    for (int r = 0; r < 16; ++r) pmax = fmaxf(pmax, p1[r]);
    { auto rr = __builtin_amdgcn_permlane32_swap(__float_as_uint(pmax), __float_as_uint(pmax), false, false);
      pmax = fmaxf(__uint_as_float(rr[0]), __uint_as_float(rr[1])); }
    constexpr float C2 = 1.4426950408889634f * SCALE;
    if (__builtin_expect(__all((pmax - m_reg) * SCALE <= THRV), 1)) { mn = m_reg; alpha = 1.f; }
    else { mn = fmaxf(m_reg, pmax); alpha = __builtin_amdgcn_exp2f((m_reg - mn) * C2); m_reg = mn; }
    const float mnL = -mn * C2 + (P8 ? 5.f : 0.f);
    if constexpr (P8) { const f32x2 c2 = {C2, C2}, ml = {mnL, mnL};
#pragma unroll
        for (int r = 0; r < 8; ++r) { f32x2 v = {p0[2 * r], p0[2 * r + 1]}, w = {p1[2 * r], p1[2 * r + 1]}; v = __builtin_elementwise_fma(v, c2, ml); w = __builtin_elementwise_fma(w, c2, ml);
            p0[2 * r] = v[0]; p0[2 * r + 1] = v[1]; p1[2 * r] = w[0]; p1[2 * r + 1] = w[1]; }
    } else {
#pragma unroll
    for (int r = 0; r < 16; ++r) p0[r] = fmaf(p0[r], C2, mnL);
#pragma unroll
    for (int r = 0; r < 16; ++r) p1[r] = fmaf(p1[r], C2, mnL);
    }
#pragma unroll
    for (int r = 0; r < 16; ++r) p0[r] = __builtin_amdgcn_exp2f(p0[r]);
}
__device__ __forceinline__ void finishSM(f32x16& p0, f32x16& p1, float alpha, float& l_reg, bf16x8& pa0, bf16x8& pa1, bf16x8& pa2, bf16x8& pa3) {
#pragma unroll
    for (int r = 0; r < 16; ++r) p1[r] = __builtin_amdgcn_exp2f(p1[r]);
    float ps = 0;
#pragma unroll
    for (int r = 0; r < 16; ++r) ps += p0[r];
#pragma unroll
    for (int r = 0; r < 16; ++r) ps += p1[r];
    { auto rr = __builtin_amdgcn_permlane32_swap(__float_as_uint(ps), __float_as_uint(ps), false, false);
      ps = __uint_as_float(rr[0]) + __uint_as_float(rr[1]); }
    l_reg = l_reg * alpha + ps;
#define PK4(P, B_, OUT) do { unsigned a0 = cvtpk(P[B_+0], P[B_+1]), a1 = cvtpk(P[B_+2], P[B_+3]);                          \
        unsigned b0 = cvtpk(P[B_+4], P[B_+5]), b1 = cvtpk(P[B_+6], P[B_+7]);                                             \
        auto r0 = __builtin_amdgcn_permlane32_swap(a0, b0, false, false); auto r1 = __builtin_amdgcn_permlane32_swap(a1, b1, false, false); \
        u32x4 w = {r0[0], r1[0], r0[1], r1[1]}; OUT = *reinterpret_cast<bf16x8*>(&w); } while (0)
    PK4(p0, 0, pa0); PK4(p0, 8, pa1); PK4(p1, 0, pa2); PK4(p1, 8, pa3);
#undef PK4
}
template <int KB, bool ROPE>
__device__ __forceinline__ void qkt(f32x16& p0, f32x16& p1, const char* K_lds, int r32, int hi, const bf16x8* qr, const char* qrl) {
    p0 = f32x16{}; p1 = f32x16{};
    const char* kb[4];
#pragma unroll
    for (int dd = 0; dd < 4; ++dd) kb[dd] = K_lds + KB * SHM_K + KSWZ(r32, (dd * 16 + hi * 8) * 2);
#pragma unroll
    for (int d0 = 0; d0 < 8; ++d0) { const char* a = kb[d0 & 3] + (d0 >> 2) * 128;
        bf16x8 b0 = *reinterpret_cast<const bf16x8*>(a);
        bf16x8 b1 = *reinterpret_cast<const bf16x8*>(a + 32 * 256);
        p0 = __builtin_amdgcn_mfma_f32_32x32x16_bf16(b0, qr[d0], p0, 0, 0, 0);
        p1 = __builtin_amdgcn_mfma_f32_32x32x16_bf16(b1, qr[d0], p1, 0, 0, 0); }
    if constexpr (ROPE) {
        constexpr int RO = 2 * SHM_K - KB * SHM_K + KB * SHM_KR;
#pragma unroll
        for (int d0 = 0; d0 < 4; ++d0) { const char* a = kb[d0] + RO;
            bf16x8 b0 = *reinterpret_cast<const bf16x8*>(a);
            bf16x8 b1 = *reinterpret_cast<const bf16x8*>(a + 128);
            const bf16x8 q = *reinterpret_cast<const bf16x8*>(qrl + d0 * 1024);
            p0 = __builtin_amdgcn_mfma_f32_32x32x16_bf16(b0, q, p0, 0, 0, 0);
            p1 = __builtin_amdgcn_mfma_f32_32x32x16_bf16(b1, q, p1, 0, 0, 0); }
    }
}
template <int VB>
__device__ __forceinline__ void pv_tile(f32x16* o, int vb0, bf16x8 pa0, bf16x8 pa1, bf16x8 pa2, bf16x8 pa3) {
#define TRRD(dst, off) asm volatile("ds_read_b64_tr_b16 %0, %1 offset:%2" : "=&v"(dst) : "v"(vb0), "i"(off) : "memory")
#define PV_D0(d0) do { s16x4 l0, l1, l2, l3, h0, h1, h2, h3; constexpr int b_ = VB * SHM_V + v_rd_off(d0, 0, 0);  \
        TRRD(l0, b_); TRRD(h0, b_ + 2048); TRRD(l1, b_ + 4096); TRRD(h1, b_ + 6144); TRRD(l2, b_ + 8192); TRRD(h2, b_ + 10240); TRRD(l3, b_ + 12288); TRRD(h3, b_ + 14336); \
        asm volatile("s_waitcnt lgkmcnt(0)" ::: "memory"); SBAR();   \
        o[d0] = __builtin_amdgcn_mfma_f32_32x32x16_bf16(pa0, (bf16x8){l0[0], l0[1], l0[2], l0[3], h0[0], h0[1], h0[2], h0[3]}, o[d0], 0, 0, 0);   \
        o[d0] = __builtin_amdgcn_mfma_f32_32x32x16_bf16(pa1, (bf16x8){l1[0], l1[1], l1[2], l1[3], h1[0], h1[1], h1[2], h1[3]}, o[d0], 0, 0, 0);   \
        o[d0] = __builtin_amdgcn_mfma_f32_32x32x16_bf16(pa2, (bf16x8){l2[0], l2[1], l2[2], l2[3], h2[0], h2[1], h2[2], h2[3]}, o[d0], 0, 0, 0);   \
        o[d0] = __builtin_amdgcn_mfma_f32_32x32x16_bf16(pa3, (bf16x8){l3[0], l3[1], l3[2], l3[3], h3[0], h3[1], h3[2], h3[3]}, o[d0], 0, 0, 0); } while (0)
    PV_D0(0); PV_D0(1); PV_D0(2); PV_D0(3);
#undef PV_D0
#undef TRRD
}

struct BlockRef { const bf16_t* Q; const bf16_t* QR; const bf16_t* K; const bf16_t* KR; const bf16_t* V; bf16_t* O; int P0; };
struct Strides { int qs, qrs, ks, vs, os, skv; };
template <bool ROPE> struct Seam { bf16x8 qr[ROPE ? 12 : 8];     bf16x8 st_v0, st_v1, st_k0, st_k1, st_kr; };
#define LD8(p) (*reinterpret_cast<const bf16x8*>(p))
#define VMW() asm volatile("s_waitcnt vmcnt(0)" ::: "memory")
#define VMWN(n) asm volatile("s_waitcnt vmcnt(%0)" :: "i"(n) : "memory")
#define SLOAD_H(R, k0) do { const char* vb_ = (const char*)(R).V + (size_t)(k0) * T.vs * 2; const char* kb_ = (const char*)(R).K + (size_t)(k0) * T.ks * 2;   \
                            S.st_v0 = LD8(vb_ + vo_v); S.st_v1 = LD8(vb_ + (size_t)T.vs * 64 + vo_v);              \
                            S.st_k0 = LD8(kb_ + vo_k); S.st_k1 = LD8(kb_ + (size_t)T.ks * 64 + vo_k);              \
                            if constexpr (ROPE) S.st_kr = LD8((const char*)(R).KR + (size_t)(k0) * (DROPE * 2) + vo_kr); } while (0)
#define SWRITE_HK(bf) do { *(bf16x8*)(K_lds + (bf) * SHM_K + kws) = S.st_k0; *(bf16x8*)(K_lds + (bf) * SHM_K + kws + 32 * 256) = S.st_k1;                \
                           if constexpr (ROPE) *(bf16x8*)(K_lds + 2 * SHM_K + (bf) * SHM_KR + krws) = S.st_kr; } while (0)
#define SWRITE_HV(bf) do { *(bf16x8*)(V_lds + (bf) * SHM_V + vst0) = S.st_v0; *(bf16x8*)(V_lds + (bf) * SHM_V + vst1) = S.st_v1; } while (0)
#define SWRITE_H(bf) do { SWRITE_HV(bf); SWRITE_HK(bf); } while (0)
#define QLOAD(R) do { const char* qb_ = (const char*)(R).Q + (size_t)(wid * QBLK) * T.qs * 2; const unsigned qo_ = (unsigned)(r32 * T.qs + hi * 8) * 2u;    \
                      _Pragma("unroll") for (int d0 = 0; d0 < 8; ++d0) S.qr[d0] = LD8(qb_ + qo_ + d0 * 32);    \
                      if constexpr (ROPE) { const char* qrb_ = (const char*)(R).QR + (size_t)(wid * QBLK) * T.qrs * 2; const unsigned qro_ = (unsigned)(r32 * T.qrs + hi * 8) * 2u;   \
                          _Pragma("unroll") for (int d0 = 0; d0 < 4; ++d0) S.qr[8 + d0] = LD8(qrb_ + qro_ + d0 * 32); } } while (0)
#define QPARK() do { if constexpr (ROPE) { _Pragma("unroll") for (int d0 = 0; d0 < 4; ++d0) *(bf16x8*)(qrl + d0 * 1024) = S.qr[8 + d0]; } } while (0)
#define QPARK8() do { _Pragma("unroll") for (int d0 = 0; d0 < (ROPE ? 8 : 4); ++d0) *(bf16x8*)(qrl + d0 * 1024) = S.qr[4 + d0]; } while (0)
#define STAGE_IDX() const int sr = tid >> 4, sc = (tid & 15) * 8, kws = KSWZ(sr, sc * 2); \
                    const int rk = tid >> 3, rc = tid & 7, krws = (rk & 31) * 256 + ((((rk >> 5) * 8 + rc) * 16) ^ (((rk & 31) & 7) << 4)); \
                    const unsigned vo_v = (unsigned)(sr * T.vs + sc) * 2u, vo_k = (unsigned)(sr * T.ks + sc) * 2u, vo_kr = (unsigned)(rk * DROPE + rc * 8) * 2u

template <bool ROPE, bool CAUSAL>
__device__ __forceinline__ void attn_prime(const BlockRef& cur, const Strides& T, char* lds, Seam<ROPE>& S) {
    const int tid = threadIdx.x, wid = __builtin_amdgcn_readfirstlane(tid >> 6), lane = tid & 63, r32 = lane & 31, hi = lane >> 5;
    STAGE_IDX(); char* K_lds = lds + OFF_K; char* qrl = lds + OFF_QR + wid * 4096 + lane * 16;
    QLOAD(cur);
    SLOAD_H(cur, 0); VMW(); SWRITE_HK(0); QPARK();
    __syncthreads();
}
template <bool ROPE, bool CAUSAL>
__device__ __forceinline__ void attn_block(const BlockRef& cur, const BlockRef& nxt, const Strides& T, char* lds, Seam<ROPE>& S) {
    const int tid = threadIdx.x, wid = __builtin_amdgcn_readfirstlane(tid >> 6), lane = tid & 63, r32 = lane & 31, hi = lane >> 5;
    int j_hi = CAUSAL ? (cur.P0 + QB - 1) / KVBLK + 1 : T.skv / KVBLK; if (j_hi > T.skv / KVBLK) j_hi = T.skv / KVBLK;
    const int NT = j_hi;
    const int qlo = cur.P0 + wid * QBLK, qm = qlo + r32 - 4 * hi;
    char* V_lds = lds + OFF_V; char* K_lds = lds + OFF_K; char* qrl = lds + OFF_QR + wid * 4096 + lane * 16;
    float* ws = (float*)(lds + OFF_WS) + wid * 64; float* li_l = ws, * al_l = ws + 32;
    float m_reg = -1e30f, l_reg = 0; f32x16 o[4] = {};
    STAGE_IDX(); const int vst0 = v_st(sr, sc), vst1 = v_st(32 + sr, sc);
    const int vb0 = (int)(uintptr_t)V_lds + v_rd_base(lane);
#define RESC(a) do { if (__any((a) < 1.f)) { if (hi == 0) al_l[r32] = (a); asm volatile("s_waitcnt lgkmcnt(0)" ::: "memory");              \
                     for (int d_ = 0; d_ < 4; ++d_) for (int r = 0; r < 16; ++r) o[d_][r] *= al_l[crow(r, hi)]; } } while (0)
#define KBASE(t) ((t) * KVBLK)
#define MASKT(P0_, P1_, t) do { if constexpr (CAUSAL) { const int kb_ = KBASE(t); if (kb_ + KVBLK - 1 > qlo) mask_tile(P0_, P1_, qm - kb_); } } while (0)
    constexpr int NQL = ROPE ? 12 : 8;
#define SEAM_K0() do { VMWN(NQL); SWRITE_HK(0); SBAR(); } while (0)
    f32x16 pA0, pA1, pB0, pB1; float mnA, mnB, alA, alB; bf16x8 pa0, pa1, pa2, pa3;
    SWRITE_HV(0); SBAR();
    if (NT > 1) { SLOAD_H(cur, KBASE(1)); }
    SBAR(); qkt<0, ROPE>(pA0, pA1, K_lds, r32, hi, S.qr, qrl);
    MASKT(pA0, pA1, 0); partialSM<ROPE>(pA0, pA1, m_reg, mnA, alA);
    if (NT > 1) { VMW(); SWRITE_H(1); }
    __syncthreads();
#define HALF_STEP(PX0, PX1, mnX, alX, PY0, PY1, alY, t, KB, VB, SB) do {                                                      \
        SBAR(); qkt<KB, ROPE>(PX0, PX1, K_lds, r32, hi, S.qr, qrl);                                                                \
        finishSM(PY0, PY1, alY, l_reg, pa0, pa1, pa2, pa3); SBAR();                                                           \
        if ((t) + 1 < NT) { SLOAD_H(cur, KBASE((t) + 1)); SBAR(); }                                                           \
        pv_tile<VB>(o, vb0, pa0, pa1, pa2, pa3); MASKT(PX0, PX1, (t)); partialSM<ROPE>(PX0, PX1, m_reg, mnX, alX);            \
        __syncthreads();                                                                                                      \
        if ((t) + 1 < NT) { VMW(); SWRITE_H(SB); }                                                                            \
        RESC(alX); __syncthreads(); } while (0)
    for (int t = 1; t + 1 < NT; t += 2) {
        HALF_STEP(pB0, pB1, mnB, alB, pA0, pA1, alA, t, 1, 0, 0);
        HALF_STEP(pA0, pA1, mnA, alA, pB0, pB1, alB, t + 1, 0, 1, 1);
    }
    const bool even = (NT & 1) == 0;
    if (even) { SBAR(); qkt<1, ROPE>(pB0, pB1, K_lds, r32, hi, S.qr, qrl); SBAR(); }
    SLOAD_H(nxt, 0); SBAR();
    QLOAD(nxt);
    SBAR();
    finishSM(pA0, pA1, alA, l_reg, pa0, pa1, pa2, pa3); SBAR();
    pv_tile<0>(o, vb0, pa0, pa1, pa2, pa3);
    if (even) { MASKT(pB0, pB1, NT - 1); partialSM<ROPE>(pB0, pB1, m_reg, mnB, alB); __syncthreads(); RESC(alB);
        finishSM(pB0, pB1, alB, l_reg, pa0, pa1, pa2, pa3); SBAR(); pv_tile<1>(o, vb0, pa0, pa1, pa2, pa3); }
    SBAR(); SEAM_K0();
    if (hi == 0) li_l[r32] = l_reg; asm volatile("s_waitcnt lgkmcnt(0)" ::: "memory");
    float rli[16];
#pragma unroll
    for (int r = 0; r < 16; ++r) rli[r] = __builtin_amdgcn_rcpf(li_l[crow(r, hi)]);
    bf16_t* Ow = cur.O + (size_t)(wid * QBLK) * T.os;
#pragma unroll
    for (int r = 0; r < 16; ++r) { const int orow = crow(r, hi);
#pragma unroll
        for (int d0 = 0; d0 < 4; ++d0) { const float v = o[d0][r] * rli[r];
            const float vn = lane_x1(v);
            if ((r32 & 1) == 0) *(unsigned*)(Ow + (size_t)orow * T.os + d0 * 32 + r32) = cvtpk(v, vn); } }
    QPARK();
    __syncthreads();
#undef RESC
#undef KBASE
#undef MASKT
#undef SEAM_K0
#undef HALF_STEP
}

template <bool ROPE>
__device__ __forceinline__ void qkt_rt(f32x16& p0, f32x16& p1, const char* K_lds, int buf, const int (&koff)[4], const bf16x8* qr, const char* qrl) {
    p0 = f32x16{}; p1 = f32x16{};
    const char* kbase = K_lds + buf * SHM_K;
#pragma unroll
    for (int d0 = 0; d0 < 8; ++d0) { const char* a = kbase + koff[d0 & 3] + (d0 >> 2) * 128;
        bf16x8 b0 = *reinterpret_cast<const bf16x8*>(a);
        bf16x8 b1 = *reinterpret_cast<const bf16x8*>(a + 32 * 256);
        p0 = __builtin_amdgcn_mfma_f32_32x32x16_bf16(b0, qr[d0], p0, 0, 0, 0);
        p1 = __builtin_amdgcn_mfma_f32_32x32x16_bf16(b1, qr[d0], p1, 0, 0, 0); }
    if constexpr (ROPE) {
        const char* rbase = K_lds + 2 * SHM_K + buf * SHM_KR;
#pragma unroll
        for (int d0 = 0; d0 < 4; ++d0) { const char* a = rbase + koff[d0];
            bf16x8 b0 = *reinterpret_cast<const bf16x8*>(a);
            bf16x8 b1 = *reinterpret_cast<const bf16x8*>(a + 128);
            const bf16x8 q = *reinterpret_cast<const bf16x8*>(qrl + d0 * 1024);
            p0 = __builtin_amdgcn_mfma_f32_32x32x16_bf16(b0, q, p0, 0, 0, 0);
            p1 = __builtin_amdgcn_mfma_f32_32x32x16_bf16(b1, q, p1, 0, 0, 0); }
    }
}


template <bool ROPE>
__device__ __forceinline__ void qkt_rt8(f32x16& p0, f32x16& p1, const char* K_lds, int buf, const int (&koff)[4], const bf16x8* qr, const char* qrl) {
    p0 = f32x16{}; p1 = f32x16{};
    const char* kbase = K_lds + buf * SHM_K;
#pragma unroll
    for (int d0 = 0; d0 < 8; ++d0) { const char* a = kbase + koff[d0 & 3] + (d0 >> 2) * 128;
        bf16x8 b0 = *reinterpret_cast<const bf16x8*>(a);
        bf16x8 b1 = *reinterpret_cast<const bf16x8*>(a + 32 * 256);
        const bf16x8 q = d0 < 4 ? qr[d0] : *reinterpret_cast<const bf16x8*>(qrl + (d0 - 4) * 1024);
        p0 = __builtin_amdgcn_mfma_f32_32x32x16_bf16(b0, q, p0, 0, 0, 0);
        p1 = __builtin_amdgcn_mfma_f32_32x32x16_bf16(b1, q, p1, 0, 0, 0); }
    if constexpr (ROPE) {
        const char* rbase = K_lds + 2 * SHM_K + buf * SHM_KR;
#pragma unroll
        for (int d0 = 0; d0 < 4; ++d0) { const char* a = rbase + koff[d0];
            bf16x8 b0 = *reinterpret_cast<const bf16x8*>(a);
            bf16x8 b1 = *reinterpret_cast<const bf16x8*>(a + 128);
            const bf16x8 q = *reinterpret_cast<const bf16x8*>(qrl + (4 + d0) * 1024);
            p0 = __builtin_amdgcn_mfma_f32_32x32x16_bf16(b0, q, p0, 0, 0, 0);
            p1 = __builtin_amdgcn_mfma_f32_32x32x16_bf16(b1, q, p1, 0, 0, 0); }
    }
}


template <bool ROPE, int NREG>
__device__ __forceinline__ void qkt_pf(f32x16& p0, f32x16& p1, const char* K_lds, int buf, const int (&koff)[4], const bf16x8* qr, const char* qrl) {
    p0 = f32x16{}; p1 = f32x16{};
    const char* kbase = K_lds + buf * SHM_K; const char* rbase = K_lds + 2 * SHM_K + buf * SHM_KR;
    constexpr int NS = ROPE ? 12 : 8;
    bf16x8 fa[3], fb[3], fq[3];
#define QK_LOAD(s_) do { constexpr int l__ = (s_); if constexpr (l__ < NS) { \
        if constexpr (l__ < 8) { const char* a_ = kbase + koff[l__ & 3] + (l__ >> 2) * 128; fa[l__ % 3] = *reinterpret_cast<const bf16x8*>(a_); fb[l__ % 3] = *reinterpret_cast<const bf16x8*>(a_ + 32 * 256); } \
        else { const char* a_ = rbase + koff[l__ - 8]; fa[l__ % 3] = *reinterpret_cast<const bf16x8*>(a_); fb[l__ % 3] = *reinterpret_cast<const bf16x8*>(a_ + 128); } \
        if constexpr (l__ >= NREG) fq[l__ % 3] = *reinterpret_cast<const bf16x8*>(qrl + (l__ - NREG) * 1024); } } while (0)
#define QK_STEP(s_) do { constexpr int s__ = (s_); if constexpr (s__ < NS) { QK_LOAD(s__ + 2); SBAR(); const bf16x8 q_ = s__ < NREG ? qr[s__ < NREG ? s__ : 0] : fq[s__ % 3]; \
        p0 = __builtin_amdgcn_mfma_f32_32x32x16_bf16(fa[s__ % 3], q_, p0, 0, 0, 0); p1 = __builtin_amdgcn_mfma_f32_32x32x16_bf16(fb[s__ % 3], q_, p1, 0, 0, 0); SBAR(); } } while (0)
    QK_LOAD(0); QK_LOAD(1);
    QK_STEP(0); QK_STEP(1); QK_STEP(2); QK_STEP(3); QK_STEP(4); QK_STEP(5); QK_STEP(6); QK_STEP(7); QK_STEP(8); QK_STEP(9); QK_STEP(10); QK_STEP(11);
#undef QK_LOAD
#undef QK_STEP
}
typedef short v4i16_t __attribute__((ext_vector_type(4)));
__device__ __forceinline__ s16x4 vtr(int addr) { return __builtin_bit_cast(s16x4, __builtin_amdgcn_ds_read_tr16_b64_v4i16((LAS v4i16_t*)(uintptr_t)(unsigned)addr)); }
__device__ __forceinline__ void pv_pf(f32x16* o, int vbase, bf16x8 pa0, bf16x8 pa1, bf16x8 pa2, bf16x8 pa3) {
    s16x4 va[2][8];
#define PV_LOAD(g_) do { _Pragma("unroll") for (int j_ = 0; j_ < 8; ++j_) va[(g_) & 1][j_] = vtr(vbase + (g_) * 512 + j_ * 2048); } while (0)
#define PV_MMA(g_) do { const s16x4* v_ = va[(g_) & 1]; \
        o[g_] = __builtin_amdgcn_mfma_f32_32x32x16_bf16(pa0, (bf16x8){v_[0][0], v_[0][1], v_[0][2], v_[0][3], v_[1][0], v_[1][1], v_[1][2], v_[1][3]}, o[g_], 0, 0, 0); \
        o[g_] = __builtin_amdgcn_mfma_f32_32x32x16_bf16(pa1, (bf16x8){v_[2][0], v_[2][1], v_[2][2], v_[2][3], v_[3][0], v_[3][1], v_[3][2], v_[3][3]}, o[g_], 0, 0, 0); \
        o[g_] = __builtin_amdgcn_mfma_f32_32x32x16_bf16(pa2, (bf16x8){v_[4][0], v_[4][1], v_[4][2], v_[4][3], v_[5][0], v_[5][1], v_[5][2], v_[5][3]}, o[g_], 0, 0, 0); \
        o[g_] = __builtin_amdgcn_mfma_f32_32x32x16_bf16(pa3, (bf16x8){v_[6][0], v_[6][1], v_[6][2], v_[6][3], v_[7][0], v_[7][1], v_[7][2], v_[7][3]}, o[g_], 0, 0, 0); } while (0)
    PV_LOAD(0); SBAR();
    PV_LOAD(1); SBAR(); PV_MMA(0); SBAR();
    PV_LOAD(2); SBAR(); PV_MMA(1); SBAR();
    PV_LOAD(3); SBAR(); PV_MMA(2); SBAR();
    PV_MMA(3);
#undef PV_LOAD
#undef PV_MMA
}

__device__ __forceinline__ void pv_1(f32x16* o, int vbase, bf16x8 pa0, bf16x8 pa1, bf16x8 pa2, bf16x8 pa3) {
#pragma unroll
    for (int g = 0; g < 4; ++g) { s16x4 v_[8];
#pragma unroll
        for (int j = 0; j < 8; ++j) v_[j] = vtr(vbase + g * 512 + j * 2048);
        o[g] = __builtin_amdgcn_mfma_f32_32x32x16_bf16(pa0, (bf16x8){v_[0][0], v_[0][1], v_[0][2], v_[0][3], v_[1][0], v_[1][1], v_[1][2], v_[1][3]}, o[g], 0, 0, 0);
        o[g] = __builtin_amdgcn_mfma_f32_32x32x16_bf16(pa1, (bf16x8){v_[2][0], v_[2][1], v_[2][2], v_[2][3], v_[3][0], v_[3][1], v_[3][2], v_[3][3]}, o[g], 0, 0, 0);
        o[g] = __builtin_amdgcn_mfma_f32_32x32x16_bf16(pa2, (bf16x8){v_[4][0], v_[4][1], v_[4][2], v_[4][3], v_[5][0], v_[5][1], v_[5][2], v_[5][3]}, o[g], 0, 0, 0);
        o[g] = __builtin_amdgcn_mfma_f32_32x32x16_bf16(pa3, (bf16x8){v_[6][0], v_[6][1], v_[6][2], v_[6][3], v_[7][0], v_[7][1], v_[7][2], v_[7][3]}, o[g], 0, 0, 0); SBAR(); }
}
template <bool ROPE, bool CAUSAL, bool O8 = false>
__device__ __forceinline__ void attn_block_dma(const BlockRef& cur, const Strides& T, char* lds) {
    const int tid = threadIdx.x, wid = __builtin_amdgcn_readfirstlane(tid >> 6), lane = tid & 63, r32 = lane & 31, hi = lane >> 5;
    int j_hi = CAUSAL ? (cur.P0 + QB - 1) / KVBLK + 1 : T.skv / KVBLK; if (j_hi > T.skv / KVBLK) j_hi = T.skv / KVBLK;
    const int NT = j_hi;
    const int qlo = cur.P0 + wid * QBLK, qm = qlo + r32 - 4 * hi;
    char* V_lds = lds + OFF_V; char* K_lds = lds + OFF_K;
    float* ws = (float*)(lds + OFF_WS) + wid * 64; float* li_l = ws, * al_l = ws + 32;
    float m_reg = -1e30f, l_reg = 0; f32x16 o[4] = {};
    const int vb0 = (int)(uintptr_t)V_lds + v_rd_base(lane);
    int koff[4];
#pragma unroll
    for (int dd = 0; dd < 4; ++dd) koff[dd] = KSWZ(r32, (dd * 16 + hi * 8) * 2);
    const int dr0 = lane >> 4, dr1 = 4 + (lane >> 4);
    const unsigned kdo0 = (unsigned)((wid * 8 + dr0) * T.ks * 2 + (((lane & 15) ^ dr0) << 4)), kdo1 = (unsigned)((wid * 8 + dr1) * T.ks * 2 + (((lane & 15) ^ dr1) << 4));
    const int kline = 4 * wid + (lane >> 4), kcs = (lane & 15) ^ (kline & 7);
    const unsigned krdo = (unsigned)((kline + 32 * (kcs >> 3)) * (DROPE * 2) + ((kcs & 7) << 4));
    const int vkk = 8 * wid + ((lane >> 2) & 7), vk = (vkk & ~0xC) | ((vkk & 4) << 1) | ((vkk & 8) >> 1);
    const unsigned vdo0 = (unsigned)(vk * T.vs * 2 + (((lane >> 5)) * 32 + (lane & 3) * 8) * 2), vdo1 = vdo0 + 128;
    const unsigned klds0 = (unsigned)(uintptr_t)K_lds + wid * 2048, krlds0 = (unsigned)(uintptr_t)K_lds + 2 * SHM_K + wid * 1024, vlds0 = (unsigned)(uintptr_t)V_lds + wid * 2048;
#define DMA_TILE(t, bf) do { const char* kb_ = (const char*)cur.K + (size_t)((t) * KVBLK) * T.ks * 2; const char* vb_ = (const char*)cur.V + (size_t)((t) * KVBLK) * T.vs * 2;       \
        __builtin_amdgcn_global_load_lds((const unsigned*)(kb_ + kdo0), (LAS unsigned*)(uintptr_t)(klds0 + (bf) * SHM_K), 16, 0, 0);                                       \
        __builtin_amdgcn_global_load_lds((const unsigned*)(kb_ + kdo1), (LAS unsigned*)(uintptr_t)(klds0 + (bf) * SHM_K + 1024), 16, 0, 0);                                \
        if constexpr (ROPE) __builtin_amdgcn_global_load_lds((const unsigned*)((const char*)cur.KR + (size_t)((t) * KVBLK) * (DROPE * 2) + krdo), (LAS unsigned*)(uintptr_t)(krlds0 + (bf) * SHM_KR), 16, 0, 0); \
        __builtin_amdgcn_global_load_lds((const unsigned*)(vb_ + vdo0), (LAS unsigned*)(uintptr_t)(vlds0 + (bf) * SHM_V), 16, 0, 0);                                       \
        __builtin_amdgcn_global_load_lds((const unsigned*)(vb_ + vdo1), (LAS unsigned*)(uintptr_t)(vlds0 + (bf) * SHM_V + 1024), 16, 0, 0); } while (0)
#define DMA_BAR() do { asm volatile("s_waitcnt vmcnt(0) lgkmcnt(0)" ::: "memory"); __builtin_amdgcn_s_barrier(); asm volatile("" ::: "memory"); } while (0)
    Seam<ROPE> S; char* qrl = lds + OFF_QR + wid * 4096 + lane * 16;
    QLOAD(cur);
    DMA_TILE(0, 0); QPARK();
    DMA_BAR();
    for (int t = 0; t < NT; ++t) {
        const int buf = t & 1;
        if (t + 1 < NT) { DMA_TILE(t + 1, buf ^ 1); }
        SBAR();
        f32x16 p0, p1; qkt_pf<ROPE, (ROPE ? 12 : 8)>(p0, p1, K_lds, buf, koff, S.qr, qrl);
        if constexpr (CAUSAL) { const int kb_ = t * KVBLK; if (kb_ + KVBLK - 1 > qlo) mask_tile(p0, p1, qm - kb_); }
        float mn, al; partialSM<ROPE>(p0, p1, m_reg, mn, al);
        if (__any(al < 1.f)) { if (hi == 0) al_l[r32] = al; asm volatile("s_waitcnt lgkmcnt(0)" ::: "memory");
            for (int d_ = 0; d_ < 4; ++d_) for (int r = 0; r < 16; ++r) o[d_][r] *= al_l[crow(r, hi)]; }
        bf16x8 pa0, pa1, pa2, pa3; finishSM(p0, p1, al, l_reg, pa0, pa1, pa2, pa3); SBAR();
        pv_pf(o, vb0 + buf * SHM_V, pa0, pa1, pa2, pa3);
        DMA_BAR();
    }
#undef DMA_TILE
#undef DMA_BAR
    if (hi == 0) li_l[r32] = l_reg; asm volatile("s_waitcnt lgkmcnt(0)" ::: "memory");
    float rli[16];
#pragma unroll
    for (int r = 0; r < 16; ++r) rli[r] = __builtin_amdgcn_rcpf(li_l[crow(r, hi)]);
    if constexpr (O8) {
        unsigned char* Ow = (unsigned char*)cur.O + (size_t)(wid * QBLK) * T.os;
#pragma unroll
        for (int r = 0; r < 16; ++r) { const int orow = crow(r, hi);
#pragma unroll
            for (int d0 = 0; d0 < 4; ++d0) { const float v = o[d0][r] * (rli[r] * pg8::F8_XS);
                const float v1 = dppf<0xB1>(v), v2 = dppf<0x4E>(v), v3 = dppf<0x1B>(v);
                if ((r32 & 3) == 0) *(unsigned*)(Ow + (size_t)orow * T.os + d0 * 32 + r32) = pg8::pk4_fp8(v, v1, v2, v3); } }
    } else {
    bf16_t* Ow = cur.O + (size_t)(wid * QBLK) * T.os;
#pragma unroll
    for (int r = 0; r < 16; ++r) { const int orow = crow(r, hi);
#pragma unroll
        for (int d0 = 0; d0 < 4; ++d0) { const float v = o[d0][r] * rli[r];
            const float vn = lane_x1(v);
            if ((r32 & 1) == 0) *(unsigned*)(Ow + (size_t)orow * T.os + d0 * 32 + r32) = cvtpk(v, vn); } }
    }
    __syncthreads();
}


typedef int att_v4i __attribute__((ext_vector_type(4)));
typedef int att_v8i __attribute__((ext_vector_type(8)));
#define ATT_CAT8(a, b) __builtin_shufflevector(__builtin_bit_cast(att_v4i, a), __builtin_bit_cast(att_v4i, b), 0, 1, 2, 3, 4, 5, 6, 7)
__device__ __forceinline__ void finishSM8(f32x16& p0, f32x16& p1, float alpha, float& l_reg, att_v8i& pa) {
#pragma unroll
    for (int r = 0; r < 16; ++r) p1[r] = __builtin_amdgcn_exp2f(p1[r]);
    f32x2 s2 = {p0[0], p0[1]};
#pragma unroll
    for (int r = 1; r < 8; ++r) s2 += (f32x2){p0[2 * r], p0[2 * r + 1]};
#pragma unroll
    for (int r = 0; r < 8; ++r) s2 += (f32x2){p1[2 * r], p1[2 * r + 1]};
    float ps = s2[0] + s2[1];
    { auto rr = __builtin_amdgcn_permlane32_swap(__float_as_uint(ps), __float_as_uint(ps), false, false);
      ps = __uint_as_float(rr[0]) + __uint_as_float(rr[1]); }
    l_reg = l_reg * alpha + ps;
#pragma unroll
    for (int g = 0; g < 4; ++g) {
        int w = __builtin_amdgcn_cvt_pk_fp8_f32(p0[4 * g], p0[4 * g + 1], 0, false); pa[g] = __builtin_amdgcn_cvt_pk_fp8_f32(p0[4 * g + 2], p0[4 * g + 3], w, true);
        int x = __builtin_amdgcn_cvt_pk_fp8_f32(p1[4 * g], p1[4 * g + 1], 0, false); pa[4 + g] = __builtin_amdgcn_cvt_pk_fp8_f32(p1[4 * g + 2], p1[4 * g + 3], x, true); }
}
template <bool O8, bool PV8>
__device__ __forceinline__ void attn_block_dma8(const BlockRef& cur, const Strides& T, char* lds) {
    const int tid = threadIdx.x, wid = __builtin_amdgcn_readfirstlane(tid >> 6), lane = tid & 63, r32 = lane & 31, hi = lane >> 5;
    int j_hi = (cur.P0 + QB - 1) / KVBLK + 1; if (j_hi > T.skv / KVBLK) j_hi = T.skv / KVBLK;
    const int NT = j_hi;
    const int qlo = cur.P0 + wid * QBLK, qm = qlo + r32 - 4 * hi;
    char* V_lds = lds + OFF_V; char* K_lds = lds + OFF_K;
    float* ws = (float*)(lds + OFF_WS) + wid * 64; float* li_l = ws, * al_l = ws + 32;
    float m_reg = -1e30f, l_reg = 0; f32x16 o[4] = {};
    const int vb0 = (int)(uintptr_t)V_lds + v_rd_base(lane);
    int koff[4];
#pragma unroll
    for (int dd = 0; dd < 4; ++dd) koff[dd] = r32 * 128 + (((2 * dd + hi) ^ ((r32 >> 1) & 7)) << 4);
    const int kkey = 8 * wid + (lane >> 3), kch = (lane & 7) ^ ((kkey >> 1) & 7);
    const unsigned kndo = (unsigned)(kkey * T.ks + (kch << 4));
    const unsigned krdo = (unsigned)(kkey * 128 + (kch << 4));
    const int vkk = 8 * wid + ((lane >> 2) & 7), vk = (vkk & ~0xC) | ((vkk & 4) << 1) | ((vkk & 8) >> 1);
    const unsigned vdo0 = (unsigned)(vk * T.vs * 2 + (((lane >> 5)) * 32 + (lane & 3) * 8) * 2), vdo1 = vdo0 + 128;
    const int vrow8 = 16 * wid + (lane >> 2); const unsigned vdo8 = (unsigned)(vrow8 * 64 + (((lane & 3) ^ ((vrow8 >> 2) & 3)) << 4));
    const unsigned vlds8 = (unsigned)(uintptr_t)V_lds + wid * 1024;
    const int vsw = (r32 >> 2) & 3; const char* vrd0 = V_lds + r32 * 64 + (((2 * hi) ^ vsw) << 4); const char* vrd1 = V_lds + r32 * 64 + (((2 * hi + 1) ^ vsw) << 4);
    const unsigned klds0 = (unsigned)(uintptr_t)K_lds + wid * 1024, krlds0 = (unsigned)(uintptr_t)K_lds + 2 * SHM_K + wid * 1024, vlds0 = (unsigned)(uintptr_t)V_lds + wid * 2048;
#define GLDS16(gsrc, ldsdst) do { unsigned keep_; const unsigned dst_ = __builtin_amdgcn_readfirstlane(ldsdst); \
        asm volatile("s_mov_b32 %0, m0\n\ts_mov_b32 m0, %2\n\ts_nop 0\n\tglobal_load_lds_dwordx4 %1, off\n\ts_mov_b32 m0, %0" : "=&s"(keep_) : "v"(gsrc), "s"(dst_) : "memory"); } while (0)
#define DMA_TILE(t, bf) do { const char* kb_ = (const char*)cur.K + (size_t)((t) * KVBLK) * T.ks; const char* vb_ = (const char*)cur.V + (size_t)((t) * KVBLK) * T.vs * 2;       \
        GLDS16(kb_ + kndo, klds0 + (bf) * SHM_K);                                       \
        GLDS16((const char*)cur.KR + (size_t)((t) * KVBLK) * 128 + krdo, krlds0 + (bf) * SHM_KR); \
        if constexpr (PV8) { GLDS16((const char*)cur.V + (size_t)(t) * 8192 + vdo8, vlds8 + (bf) * SHM_V); }   \
        else { GLDS16(vb_ + vdo0, vlds0 + (bf) * SHM_V);                                       \
               GLDS16(vb_ + vdo1, vlds0 + (bf) * SHM_V + 1024); } } while (0)
#define DMA_BAR() do { asm volatile("s_waitcnt vmcnt(0) lgkmcnt(0)" ::: "memory"); __builtin_amdgcn_s_barrier(); asm volatile("" ::: "memory"); } while (0)
    att_v8i q8[3];
    { const char* qb_ = (const char*)cur.Q + (size_t)(wid * QBLK) * T.qs + (size_t)r32 * T.qs + hi * 16;
      const char* qrb_ = (const char*)cur.QR + (size_t)(wid * QBLK) * T.qrs + (size_t)r32 * T.qrs + hi * 16;
      const bf16x8 f0 = LD8(qb_), f1 = LD8(qb_ + 32), f2 = LD8(qb_ + 64), f3 = LD8(qb_ + 96), g0 = LD8(qrb_), g1 = LD8(qrb_ + 32);
      q8[0] = ATT_CAT8(f0, f1); q8[1] = ATT_CAT8(f2, f3); q8[2] = ATT_CAT8(g0, g1); }
    DMA_TILE(0, 0);
    DMA_BAR();
    for (int t = 0; t < NT; ++t) {
        const int buf = t & 1;
        if (t + 1 < NT) { DMA_TILE(t + 1, buf ^ 1); }
        SBAR();
        if (t * KVBLK <= qlo + QBLK - 1) {
        f32x16 p0, p1;
        { const char* nb = K_lds + buf * SHM_K; const char* rb = K_lds + 2 * SHM_K + buf * SHM_KR;
          const bf16x8 a0 = LD8(nb + koff[0]), a1 = LD8(nb + koff[1]), b0 = LD8(nb + koff[0] + 4096), b1 = LD8(nb + koff[1] + 4096);
          const bf16x8 a2 = LD8(nb + koff[2]), a3 = LD8(nb + koff[3]), b2 = LD8(nb + koff[2] + 4096), b3 = LD8(nb + koff[3] + 4096);
          const bf16x8 c0 = LD8(rb + koff[0]), c1 = LD8(rb + koff[1]), d0 = LD8(rb + koff[0] + 4096), d1 = LD8(rb + koff[1] + 4096);
#define MF8(acc, x0, x1, qv) do { const att_v8i k8_ = ATT_CAT8(x0, x1); asm volatile("s_nop 1\n\tv_mfma_f32_32x32x64_f8f6f4 %0, %1, %2, %0" : "+v"(acc) : "v"(k8_), "v"(qv)); } while (0)
#define MF8Z(acc, x0, x1, qv) do { const att_v8i k8_ = ATT_CAT8(x0, x1); asm volatile("s_nop 1\n\tv_mfma_f32_32x32x64_f8f6f4 %0, %1, %2, 0" : "=&v"(acc) : "v"(k8_), "v"(qv)); } while (0)
          MF8Z(p0, a0, a1, q8[0]); MF8Z(p1, b0, b1, q8[0]);
#undef MF8Z
          MF8(p0, a2, a3, q8[1]); MF8(p1, b2, b3, q8[1]);
          MF8(p0, c0, c1, q8[2]); MF8(p1, d0, d1, q8[2]);
#undef MF8
          asm volatile("s_nop 15\n\ts_nop 7" : "+v"(p0), "+v"(p1)); }
        const char* v0_ = vrd0 + buf * SHM_V; const char* v1_ = vrd1 + buf * SHM_V;
        bf16x8 x0, y0, x1, y1, x2, y2, x3, y3; if constexpr (PV8) { x0 = LD8(v0_); y0 = LD8(v1_); x1 = LD8(v0_ + 2048); y1 = LD8(v1_ + 2048); x2 = LD8(v0_ + 4096); y2 = LD8(v1_ + 4096); x3 = LD8(v0_ + 6144); y3 = LD8(v1_ + 6144); }
        { const int kb_ = t * KVBLK; if (kb_ + KVBLK - 1 > qlo) mask_tile(p0, p1, qm - kb_); }
        float mn, al; partialSM<true, true, PV8>(p0, p1, m_reg, mn, al);
        if (__any(al < 1.f)) { if (hi == 0) al_l[r32] = al; asm volatile("s_waitcnt lgkmcnt(0)" ::: "memory");
            for (int d_ = 0; d_ < 4; ++d_) for (int r = 0; r < 16; ++r) o[d_][r] *= al_l[crow(r, hi)]; }
        if constexpr (PV8) {
            att_v8i pa; finishSM8(p0, p1, al, l_reg, pa); SBAR();
#define PV8M(acc, xa, xb) do { const att_v8i v8_ = ATT_CAT8(xa, xb); asm volatile("s_nop 1\n\tv_mfma_f32_32x32x64_f8f6f4 %0, %1, %2, %0" : "+v"(acc) : "v"(pa), "v"(v8_)); } while (0)
            PV8M(o[0], x0, y0); PV8M(o[1], x1, y1); PV8M(o[2], x2, y2); PV8M(o[3], x3, y3);
#undef PV8M
        } else {
        bf16x8 pa0, pa1, pa2, pa3; finishSM(p0, p1, al, l_reg, pa0, pa1, pa2, pa3); SBAR();
        pv_pf(o, vb0 + buf * SHM_V, pa0, pa1, pa2, pa3);
        }
        }
        DMA_BAR();
    }
#undef DMA_TILE
#undef DMA_BAR
#undef GLDS16
    if constexpr (PV8) asm volatile("s_nop 15\n\ts_nop 7" : "+v"(o[0]), "+v"(o[1]), "+v"(o[2]), "+v"(o[3]));
    if (hi == 0) li_l[r32] = l_reg; asm volatile("s_waitcnt lgkmcnt(0)" ::: "memory");
    float rli[16];
#pragma unroll
    for (int r = 0; r < 16; ++r) rli[r] = __builtin_amdgcn_rcpf(li_l[crow(r, hi)]) * (PV8 ? 1.0f / 8.0f : 1.0f);
    if constexpr (O8) {
        unsigned char* Ow = (unsigned char*)cur.O + (size_t)(wid * QBLK) * T.os;
#pragma unroll
        for (int r = 0; r < 16; ++r) { const int orow = crow(r, hi);
#pragma unroll
            for (int d0 = 0; d0 < 4; ++d0) { const float v = o[d0][r] * (rli[r] * pg8::F8_XS);
                const float v1 = dppf<0xB1>(v), v2 = dppf<0x4E>(v), v3 = dppf<0x1B>(v);
                if ((r32 & 3) == 0) *(unsigned*)(Ow + (size_t)orow * T.os + d0 * 32 + r32) = pg8::pk4_fp8(v, v1, v2, v3); } }
    } else {
        bf16_t* Ow = cur.O + (size_t)(wid * QBLK) * T.os;
#pragma unroll
        for (int r = 0; r < 16; ++r) { const int orow = crow(r, hi);
#pragma unroll
            for (int d0 = 0; d0 < 4; ++d0) { const float v = o[d0][r] * rli[r];
                const float vn = lane_x1(v);
                if ((r32 & 1) == 0) *(unsigned*)(Ow + (size_t)orow * T.os + d0 * 32 + r32) = cvtpk(v, vn); } }
    }
    __syncthreads();
}

template <bool O8, bool PV8>
__device__ __forceinline__ void attn_block_dma8s(const BlockRef& cur, const BlockRef& nxtr, const bool nxt, const Strides& T, char* lds, bool primed) {
    const int tid = threadIdx.x, wid = __builtin_amdgcn_readfirstlane(tid >> 6), lane = tid & 63, r32 = lane & 31, hi = lane >> 5;
    int j_hi = (cur.P0 + QB - 1) / KVBLK + 1; if (j_hi > T.skv / KVBLK) j_hi = T.skv / KVBLK;
    const int NT = j_hi;
    const int qlo = cur.P0 + wid * QBLK, qm = qlo + r32 - 4 * hi;
    char* V_lds = lds + OFF_V; char* K_lds = lds + OFF_K;
    float* ws = (float*)(lds + OFF_WS) + wid * 64; float* li_l = ws, * al_l = ws + 32;
    float m_reg = -1e30f, l_reg = 0; f32x16 o[4] = {};
    const int vb0 = (int)(uintptr_t)V_lds + v_rd_base(lane);
    int koff[4];
#pragma unroll
    for (int dd = 0; dd < 4; ++dd) koff[dd] = r32 * 128 + (((2 * dd + hi) ^ ((r32 >> 1) & 7)) << 4);
    const int kkey = 8 * wid + (lane >> 3), kch = (lane & 7) ^ ((kkey >> 1) & 7);
    const unsigned kndo = (unsigned)(kkey * T.ks + (kch << 4));
    const unsigned krdo = (unsigned)(kkey * 128 + (kch << 4));
    const int vkk = 8 * wid + ((lane >> 2) & 7), vk = (vkk & ~0xC) | ((vkk & 4) << 1) | ((vkk & 8) >> 1);
    const unsigned vdo0 = (unsigned)(vk * T.vs * 2 + (((lane >> 5)) * 32 + (lane & 3) * 8) * 2), vdo1 = vdo0 + 128;
    const int vrow8 = 16 * wid + (lane >> 2); const unsigned vdo8 = (unsigned)(vrow8 * 64 + (((lane & 3) ^ ((vrow8 >> 2) & 3)) << 4));
    const unsigned vlds8 = (unsigned)(uintptr_t)V_lds + wid * 1024;
    const int vsw = (r32 >> 2) & 3; const char* vrd0 = V_lds + r32 * 64 + (((2 * hi) ^ vsw) << 4); const char* vrd1 = V_lds + r32 * 64 + (((2 * hi + 1) ^ vsw) << 4);
    const unsigned klds0 = (unsigned)(uintptr_t)K_lds + wid * 1024, krlds0 = (unsigned)(uintptr_t)K_lds + 2 * SHM_K + wid * 1024, vlds0 = (unsigned)(uintptr_t)V_lds + wid * 2048;
#define GLDS16(gsrc, ldsdst) do { unsigned keep_; const unsigned dst_ = __builtin_amdgcn_readfirstlane(ldsdst); \
        asm volatile("s_mov_b32 %0, m0\n\ts_mov_b32 m0, %2\n\ts_nop 0\n\tglobal_load_lds_dwordx4 %1, off\n\ts_mov_b32 m0, %0" : "=&s"(keep_) : "v"(gsrc), "s"(dst_) : "memory"); } while (0)
#define DMA_TILE_R(R_, t, bf) do { const char* kb_ = (const char*)(R_).K + (size_t)((t) * KVBLK) * T.ks; const char* vb_ = (const char*)(R_).V + (size_t)((t) * KVBLK) * T.vs * 2;       \
        GLDS16(kb_ + kndo, klds0 + (bf) * SHM_K);                                       \
        GLDS16((const char*)(R_).KR + (size_t)((t) * KVBLK) * 128 + krdo, krlds0 + (bf) * SHM_KR); \
        if constexpr (PV8) { GLDS16((const char*)(R_).V + (size_t)(t) * 8192 + vdo8, vlds8 + (bf) * SHM_V); }   \
        else { GLDS16(vb_ + vdo0, vlds0 + (bf) * SHM_V);                                       \
               GLDS16(vb_ + vdo1, vlds0 + (bf) * SHM_V + 1024); } } while (0)
#define DMA_BAR() do { asm volatile("s_waitcnt vmcnt(0) lgkmcnt(0)" ::: "memory"); __builtin_amdgcn_s_barrier(); asm volatile("" ::: "memory"); } while (0)
#define QLOAD8(R_, Q_) do { const char* qb_ = (const char*)(R_).Q + (size_t)(wid * QBLK) * T.qs + (size_t)r32 * T.qs + hi * 16;      \
      const char* qrb_ = (const char*)(R_).QR + (size_t)(wid * QBLK) * T.qrs + (size_t)r32 * T.qrs + hi * 16;                               \
      const bf16x8 f0 = LD8(qb_), f1 = LD8(qb_ + 32), f2 = LD8(qb_ + 64), f3 = LD8(qb_ + 96), g0 = LD8(qrb_), g1 = LD8(qrb_ + 32);          \
      Q_[0] = ATT_CAT8(f0, f1); Q_[1] = ATT_CAT8(f2, f3); Q_[2] = ATT_CAT8(g0, g1); } while (0)
    att_v8i q8[3]; QLOAD8(cur, q8);
    if (!primed) { DMA_TILE_R(cur, 0, 0); }
    DMA_BAR();
    for (int t = 0; t < NT; ++t) {
        const int buf = t & 1;
        if (t + 1 < NT) { DMA_TILE_R(cur, t + 1, buf ^ 1); }
        SBAR();
        if (t * KVBLK <= qlo + QBLK - 1) {
        f32x16 p0, p1;
        { const char* nb = K_lds + buf * SHM_K; const char* rb = K_lds + 2 * SHM_K + buf * SHM_KR;
          const bf16x8 a0 = LD8(nb + koff[0]), a1 = LD8(nb + koff[1]), b0 = LD8(nb + koff[0] + 4096), b1 = LD8(nb + koff[1] + 4096);
          const bf16x8 a2 = LD8(nb + koff[2]), a3 = LD8(nb + koff[3]), b2 = LD8(nb + koff[2] + 4096), b3 = LD8(nb + koff[3] + 4096);
          const bf16x8 c0 = LD8(rb + koff[0]), c1 = LD8(rb + koff[1]), d0 = LD8(rb + koff[0] + 4096), d1 = LD8(rb + koff[1] + 4096);
#define MF8(acc, x0, x1, qv) do { const att_v8i k8_ = ATT_CAT8(x0, x1); asm volatile("s_nop 1\n\tv_mfma_f32_32x32x64_f8f6f4 %0, %1, %2, %0" : "+v"(acc) : "v"(k8_), "v"(qv)); } while (0)
#define MF8Z(acc, x0, x1, qv) do { const att_v8i k8_ = ATT_CAT8(x0, x1); asm volatile("s_nop 1\n\tv_mfma_f32_32x32x64_f8f6f4 %0, %1, %2, 0" : "=&v"(acc) : "v"(k8_), "v"(qv)); } while (0)
          MF8Z(p0, a0, a1, q8[0]); MF8Z(p1, b0, b1, q8[0]);
#undef MF8Z
          MF8(p0, a2, a3, q8[1]); MF8(p1, b2, b3, q8[1]);
          MF8(p0, c0, c1, q8[2]); MF8(p1, d0, d1, q8[2]);
#undef MF8
          asm volatile("s_nop 15\n\ts_nop 7" : "+v"(p0), "+v"(p1)); }
        const char* v0_ = vrd0 + buf * SHM_V; const char* v1_ = vrd1 + buf * SHM_V;
        bf16x8 x0, y0, x1, y1, x2, y2, x3, y3; if constexpr (PV8) { x0 = LD8(v0_); y0 = LD8(v1_); x1 = LD8(v0_ + 2048); y1 = LD8(v1_ + 2048); x2 = LD8(v0_ + 4096); y2 = LD8(v1_ + 4096); x3 = LD8(v0_ + 6144); y3 = LD8(v1_ + 6144); }
        { const int kb_ = t * KVBLK; if (kb_ + KVBLK - 1 > qlo) mask_tile(p0, p1, qm - kb_); }
        float mn, al; partialSM<true, true, PV8>(p0, p1, m_reg, mn, al);
        if (__any(al < 1.f)) { if (hi == 0) al_l[r32] = al; asm volatile("s_waitcnt lgkmcnt(0)" ::: "memory");
            for (int d_ = 0; d_ < 4; ++d_) for (int r = 0; r < 16; ++r) o[d_][r] *= al_l[crow(r, hi)]; }
        if constexpr (PV8) {
            att_v8i pa; finishSM8(p0, p1, al, l_reg, pa); SBAR();
#define PV8M(acc, xa, xb) do { const att_v8i v8_ = ATT_CAT8(xa, xb); asm volatile("s_nop 1\n\tv_mfma_f32_32x32x64_f8f6f4 %0, %1, %2, %0" : "+v"(acc) : "v"(pa), "v"(v8_)); } while (0)
            PV8M(o[0], x0, y0); PV8M(o[1], x1, y1); PV8M(o[2], x2, y2); PV8M(o[3], x3, y3);
#undef PV8M
        } else {
        bf16x8 pa0, pa1, pa2, pa3; finishSM(p0, p1, al, l_reg, pa0, pa1, pa2, pa3); SBAR();
        pv_pf(o, vb0 + buf * SHM_V, pa0, pa1, pa2, pa3);
        }
        }
        DMA_BAR();
    }
    if (nxt) { DMA_TILE_R(nxtr, 0, 0); }
#undef QLOAD8
#undef DMA_TILE_R
#undef DMA_BAR
#undef GLDS16
    if constexpr (PV8) asm volatile("s_nop 15\n\ts_nop 7" : "+v"(o[0]), "+v"(o[1]), "+v"(o[2]), "+v"(o[3]));
    if (hi == 0) li_l[r32] = l_reg; asm volatile("s_waitcnt lgkmcnt(0)" ::: "memory");
    float rli[16];
#pragma unroll
    for (int r = 0; r < 16; ++r) rli[r] = __builtin_amdgcn_rcpf(li_l[crow(r, hi)]) * (PV8 ? 1.0f / 8.0f : 1.0f);
    if constexpr (O8) {
        unsigned char* Ow = (unsigned char*)cur.O + (size_t)(wid * QBLK) * T.os;
#pragma unroll
        for (int r = 0; r < 16; ++r) { const int orow = crow(r, hi);
#pragma unroll
            for (int d0 = 0; d0 < 4; ++d0) { const float v = o[d0][r] * (rli[r] * pg8::F8_XS);
                const float v1 = dppf<0xB1>(v), v2 = dppf<0x4E>(v), v3 = dppf<0x1B>(v);
                if ((r32 & 3) == 0) *(unsigned*)(Ow + (size_t)orow * T.os + d0 * 32 + r32) = pg8::pk4_fp8(v, v1, v2, v3); } }
    } else {
        bf16_t* Ow = cur.O + (size_t)(wid * QBLK) * T.os;
#pragma unroll
        for (int r = 0; r < 16; ++r) { const int orow = crow(r, hi);
#pragma unroll
            for (int d0 = 0; d0 < 4; ++d0) { const float v = o[d0][r] * rli[r];
                const float vn = lane_x1(v);
                if ((r32 & 1) == 0) *(unsigned*)(Ow + (size_t)orow * T.os + d0 * 32 + r32) = cvtpk(v, vn); } }
    }
    __syncthreads();
}


template <bool O8>
__device__ __forceinline__ void attn_block_dma8x2(const BlockRef& cur, const Strides& T, char* lds) {
    const int tid = threadIdx.x, wid = __builtin_amdgcn_readfirstlane(tid >> 6), lane = tid & 63, r32 = lane & 31, hi = lane >> 5;
    int j_hi = (cur.P0 + QB - 1) / KVBLK + 1; if (j_hi > T.skv / KVBLK) j_hi = T.skv / KVBLK;
    const int NT = j_hi;
    const int qlo = cur.P0 + wid * QBLK, qm = qlo + r32 - 4 * hi;
    char* V_lds = lds; char* K_lds = lds + 4 * 8192; char* R_lds = lds + 8 * 8192;
    float* ws = (float*)(lds + 12 * 8192) + wid * 64; float* li_l = ws, * al_l = ws + 32;
    float m_reg = -1e30f, l_reg = 0; f32x16 o[4] = {};
    int koff[4];
#pragma unroll
    for (int dd = 0; dd < 4; ++dd) koff[dd] = r32 * 128 + (((2 * dd + hi) ^ ((r32 >> 1) & 7)) << 4);
    const int kkey = 8 * wid + (lane >> 3), kch = (lane & 7) ^ ((kkey >> 1) & 7);
    const unsigned kndo = (unsigned)(kkey * T.ks + (kch << 4));
    const unsigned krdo = (unsigned)(kkey * 128 + (kch << 4));
    const int vrow8 = 16 * wid + (lane >> 2); const unsigned vdo8 = (unsigned)(vrow8 * 64 + (((lane & 3) ^ ((vrow8 >> 2) & 3)) << 4));
    const unsigned vlds8 = (unsigned)(uintptr_t)V_lds + wid * 1024, klds0 = (unsigned)(uintptr_t)K_lds + wid * 1024, krlds0 = (unsigned)(uintptr_t)R_lds + wid * 1024;
    const int vsw = (r32 >> 2) & 3; const char* vrd0 = V_lds + r32 * 64 + (((2 * hi) ^ vsw) << 4); const char* vrd1 = V_lds + r32 * 64 + (((2 * hi + 1) ^ vsw) << 4);
#define GLDS16(gsrc, ldsdst) do { unsigned keep_; const unsigned dst_ = __builtin_amdgcn_readfirstlane(ldsdst); \
        asm volatile("s_mov_b32 %0, m0\n\ts_mov_b32 m0, %2\n\ts_nop 0\n\tglobal_load_lds_dwordx4 %1, off\n\ts_mov_b32 m0, %0" : "=&s"(keep_) : "v"(gsrc), "s"(dst_) : "memory"); } while (0)
#define DMA_TILE(t, st) do { GLDS16((const char*)cur.K + (size_t)((t) * KVBLK) * T.ks + kndo, klds0 + (st) * 8192);                     \
        GLDS16((const char*)cur.KR + (size_t)((t) * KVBLK) * 128 + krdo, krlds0 + (st) * 8192);                                            \
        GLDS16((const char*)cur.V + (size_t)(t) * 8192 + vdo8, vlds8 + (st) * 8192); } while (0)
#define DMA_BAR() do { asm volatile("s_waitcnt vmcnt(0) lgkmcnt(0)" ::: "memory"); __builtin_amdgcn_s_barrier(); asm volatile("" ::: "memory"); } while (0)
#define MF8(acc, x0, x1, qv) do { const att_v8i k8_ = ATT_CAT8(x0, x1); asm volatile("s_nop 1\n\tv_mfma_f32_32x32x64_f8f6f4 %0, %1, %2, %0" : "+v"(acc) : "v"(k8_), "v"(qv)); } while (0)
#define MF8Z(acc, x0, x1, qv) do { const att_v8i k8_ = ATT_CAT8(x0, x1); asm volatile("s_nop 1\n\tv_mfma_f32_32x32x64_f8f6f4 %0, %1, %2, 0" : "=&v"(acc) : "v"(k8_), "v"(qv)); } while (0)
#define PV8M(acc, xa, xb) do { const att_v8i v8_ = ATT_CAT8(xa, xb); asm volatile("s_nop 1\n\tv_mfma_f32_32x32x64_f8f6f4 %0, %1, %2, %0" : "+v"(acc) : "v"(pa), "v"(v8_)); } while (0)
#define TILE(t_, st_) do { const int t__ = (t_), s__ = (st_);                                                                                                      \
        if (t__ * KVBLK <= qlo + QBLK - 1) {                                                                                                                        \
        f32x16 p0, p1;                                                                                                                                              \
        { const char* nb = K_lds + s__ * 8192; const char* rb = R_lds + s__ * 8192;                                                                                 \
          const bf16x8 a0 = LD8(nb + koff[0]), a1 = LD8(nb + koff[1]), b0 = LD8(nb + koff[0] + 4096), b1 = LD8(nb + koff[1] + 4096);                               \
          const bf16x8 a2 = LD8(nb + koff[2]), a3 = LD8(nb + koff[3]), b2 = LD8(nb + koff[2] + 4096), b3 = LD8(nb + koff[3] + 4096);                               \
          const bf16x8 c0 = LD8(rb + koff[0]), c1 = LD8(rb + koff[1]), d0 = LD8(rb + koff[0] + 4096), d1 = LD8(rb + koff[1] + 4096);                               \
          MF8Z(p0, a0, a1, q8[0]); MF8Z(p1, b0, b1, q8[0]); MF8(p0, a2, a3, q8[1]); MF8(p1, b2, b3, q8[1]); MF8(p0, c0, c1, q8[2]); MF8(p1, d0, d1, q8[2]);         \
          asm volatile("s_nop 15\n\ts_nop 7" : "+v"(p0), "+v"(p1)); }                                                                                               \
        const char* v0_ = vrd0 + s__ * 8192; const char* v1_ = vrd1 + s__ * 8192;                                                                                   \
        const bf16x8 x0 = LD8(v0_), y0 = LD8(v1_), x1 = LD8(v0_ + 2048), y1 = LD8(v1_ + 2048), x2 = LD8(v0_ + 4096), y2 = LD8(v1_ + 4096), x3 = LD8(v0_ + 6144), y3 = LD8(v1_ + 6144); \
        { const int kb_ = t__ * KVBLK; if (kb_ + KVBLK - 1 > qlo) mask_tile(p0, p1, qm - kb_); }                                                                    \
        float mn, al; partialSM<true, true, true>(p0, p1, m_reg, mn, al);                                                                                           \
        if (__any(al < 1.f)) { if (hi == 0) al_l[r32] = al; asm volatile("s_waitcnt lgkmcnt(0)" ::: "memory");                                                     \
            for (int d_ = 0; d_ < 4; ++d_) for (int r = 0; r < 16; ++r) o[d_][r] *= al_l[crow(r, hi)]; }                                                            \
        att_v8i pa; finishSM8(p0, p1, al, l_reg, pa); SBAR();                                                                                                       \
        PV8M(o[0], x0, y0); PV8M(o[1], x1, y1); PV8M(o[2], x2, y2); PV8M(o[3], x3, y3); } } while (0)
    att_v8i q8[3];
    { const char* qb_ = (const char*)cur.Q + (size_t)(wid * QBLK) * T.qs + (size_t)r32 * T.qs + hi * 16;
      const char* qrb_ = (const char*)cur.QR + (size_t)(wid * QBLK) * T.qrs + (size_t)r32 * T.qrs + hi * 16;
      const bf16x8 f0 = LD8(qb_), f1 = LD8(qb_ + 32), f2 = LD8(qb_ + 64), f3 = LD8(qb_ + 96), g0 = LD8(qrb_), g1 = LD8(qrb_ + 32);
      q8[0] = ATT_CAT8(f0, f1); q8[1] = ATT_CAT8(f2, f3); q8[2] = ATT_CAT8(g0, g1); }
    DMA_TILE(0, 0); DMA_TILE(1, 1);
    DMA_BAR();
    for (int t = 0; t < NT; t += 2) {
        const int sa = t & 2;
        if (t + 2 < NT) { DMA_TILE(t + 2, sa ^ 2); DMA_TILE(t + 3, (sa ^ 2) + 1); }
        SBAR();
        TILE(t, sa);
        asm volatile("s_nop 15\n\ts_nop 7" : "+v"(o[0]), "+v"(o[1]), "+v"(o[2]), "+v"(o[3]));
        TILE(t + 1, sa + 1);
        DMA_BAR();
    }
#undef TILE
#undef PV8M
#undef MF8
#undef MF8Z
#undef DMA_TILE
#undef DMA_BAR
#undef GLDS16
    asm volatile("s_nop 15\n\ts_nop 7" : "+v"(o[0]), "+v"(o[1]), "+v"(o[2]), "+v"(o[3]));
    if (hi == 0) li_l[r32] = l_reg; asm volatile("s_waitcnt lgkmcnt(0)" ::: "memory");
    float rli[16];
#pragma unroll
    for (int r = 0; r < 16; ++r) rli[r] = __builtin_amdgcn_rcpf(li_l[crow(r, hi)]) * (1.0f / 8.0f);
    if constexpr (O8) {
        unsigned char* Ow = (unsigned char*)cur.O + (size_t)(wid * QBLK) * T.os;
#pragma unroll
        for (int r = 0; r < 16; ++r) { const int orow = crow(r, hi);
#pragma unroll
            for (int d0 = 0; d0 < 4; ++d0) { const float v = o[d0][r] * (rli[r] * pg8::F8_XS);
                const float v1 = dppf<0xB1>(v), v2 = dppf<0x4E>(v), v3 = dppf<0x1B>(v);
                if ((r32 & 3) == 0) *(unsigned*)(Ow + (size_t)orow * T.os + d0 * 32 + r32) = pg8::pk4_fp8(v, v1, v2, v3); } }
    } else {
        bf16_t* Ow = cur.O + (size_t)(wid * QBLK) * T.os;
#pragma unroll
        for (int r = 0; r < 16; ++r) { const int orow = crow(r, hi);
#pragma unroll
            for (int d0 = 0; d0 < 4; ++d0) { const float v = o[d0][r] * rli[r];
                const float vn = lane_x1(v);
                if ((r32 & 1) == 0) *(unsigned*)(Ow + (size_t)orow * T.os + d0 * 32 + r32) = cvtpk(v, vn); } }
    }
    __syncthreads();
}

#undef LD8
#undef VMW
#undef VMWN
#undef SLOAD_H
#undef SWRITE_HK
#undef SWRITE_HV
#undef SWRITE_H
#undef QLOAD
#undef QPARK
#undef QPARK8
#undef STAGE_IDX
}
__device__ __forceinline__ float sq4v(f32x4 v) { return pg8::sq4(v); }
__device__ __forceinline__ float row_rs32g(const float* ss, int row) { return pg8::row_rs32(ss, row, 1.0f / DM); }
struct Params {
    const float *x, *mem; const int* pos; const float *norm_mix, *w_in, *lam_re, *lam_im, *log_step, *b_re, *b_im, *c_re, *c_im, *ssm_d, *w_glu, *b_glu;
    const float *q_norm, *w_uq, *kv_norm, *w_uk, *w_uv, *w_up_ssm, *w_up_mla, *w_out, *norm_xattn, *norm_mem, *xa_wq, *xa_wk, *xa_wv, *xa_wo;
    const float *norm_moe, *router_w, *router_b, *w_gu, *b_gu, *w_dn, *b_dn, *final_norm;
    float* out;
    unsigned* ctl;
    bf16_t *WinT, *WkpeT, *WgluT, *WuqT, *WukvT, *WupsT, *WupmT, *WoutT, *WxqT, *WxkvT, *WxoT; unsigned char *WguT, *WdnT;
    float* WrT;
    bf16_t *hn, *memn; unsigned char *hn8, *WinT8, *mg8, *WoutT8, *x1b8; float *cosT, *sinT; float* abar; bf16_t *bbarT, *cmat;
    bf16_t *ub, *qa, *kva; float *qss, *kvss; bf16_t *sgs, *sgm, *kpe;
    bf16_t *qn, *qr, *kn, *vv, *ymla;
    float* send; bf16_t *zb, *ys, *t1, *mg;
    float* x1; bf16_t* x1b; float* ss1;
    bf16_t *memkv, *qx, *ox;
    bf16_t* x2; float* ss2;
    unsigned* csprev; unsigned char* W2chk; int* topi; float* topw; int* rank; int* slot; int* wgcnt; int* blke;
    unsigned char *xg, *act; bf16_t* orow;
    int ph_lo, ph_hi;
};

struct Frame { LAS unsigned char* lds; int wave, vcu, G, gw, NGW; };

template <class RowMap>
__device__ __forceinline__ void p0_transpose_item(const float* W, int ldw, int K, bf16_t* WT, const float* gain, LAS float* scr, int kb, int nb, int lane, const RowMap& rowmap) {
    const int k0 = 64 * kb, n0 = 32 * nb;
#pragma unroll 8
    for (int i = 0; i < 32; ++i) { const int kk = 2 * i + (lane >> 5); float v = W[(size_t)(k0 + kk) * ldw + n0 + (lane & 31)]; if (gain) v *= gain[k0 + kk]; scr[kk * 33 + (lane & 31)] = v; }
    LDS_WAIT(); asm volatile("" ::: "memory");
    const int c = lane & 7;
#pragma unroll
    for (int j = 0; j < 4; ++j) { const int n = (lane >> 3) + 8 * j; const LAS float* s = scr + (8 * c) * 33 + n;
        u32x4 o; o.x = cvtpk(s[0 * 33], s[1 * 33]); o.y = cvtpk(s[2 * 33], s[3 * 33]); o.z = cvtpk(s[4 * 33], s[5 * 33]); o.w = cvtpk(s[6 * 33], s[7 * 33]);
        *(u32x4*)(WT + (size_t)rowmap(n0 + n) * K + k0 + 8 * c) = o; }
    LDS_WAIT(); asm volatile("" ::: "memory");
}
template <class RowMap>
__device__ __forceinline__ void p0_transpose_item_f8(const float* W, int ldw, int K, unsigned char* WT, float scale, LAS float* scr, int kb, int nb, int lane, const RowMap& rowmap) {
    const int k0 = 128 * kb, n0 = 32 * nb;
#pragma unroll 8
    for (int i = 0; i < 64; ++i) { const int kk = 2 * i + (lane >> 5); scr[kk * 33 + (lane & 31)] = W[(size_t)(k0 + kk) * ldw + n0 + (lane & 31)] * scale; }
    LDS_WAIT(); asm volatile("" ::: "memory");
    const int c = lane & 7;
#pragma unroll
    for (int j = 0; j < 4; ++j) { const int n = (lane >> 3) + 8 * j; const LAS float* s = scr + (16 * c) * 33 + n;
        u32x4 o; o.x = pg8::pk4_fp8(s[0 * 33], s[1 * 33], s[2 * 33], s[3 * 33]); o.y = pg8::pk4_fp8(s[4 * 33], s[5 * 33], s[6 * 33], s[7 * 33]);
        o.z = pg8::pk4_fp8(s[8 * 33], s[9 * 33], s[10 * 33], s[11 * 33]); o.w = pg8::pk4_fp8(s[12 * 33], s[13 * 33], s[14 * 33], s[15 * 33]);
        *(u32x4*)(WT + (size_t)rowmap(n0 + n) * K + k0 + 16 * c) = o; }
    LDS_WAIT(); asm volatile("" ::: "memory");
}
struct MapId { int off; __device__ __forceinline__ int operator()(int n) const { return n + off; } };
struct MapUq { __device__ __forceinline__ int operator()(int n) const { const int h = n / 192, d = n % 192; if (d < 128) return h * 128 + d;
    const int dd = d - 128, half = dd >> 5, i = dd & 31; return 2048 + 256 * (h >> 2) + half * 128 + (h & 3) * 32 + i; } };
struct MapGU { __device__ __forceinline__ int operator()(int n) const { const int up = n >= DFF, j = up ? n - DFF : n; return 256 * (j >> 7) + up * 128 + (j & 127); } };

__device__ __forceinline__ void rms_row_bf16(const float* xrow, const float* gain, bf16_t* orow, int lane, unsigned char* o8 = nullptr) {
    f32x4 v[8]; float s = 0.f;
#pragma unroll
    for (int j = 0; j < 8; ++j) { v[j] = *(const f32x4*)(xrow + 256 * j + 4 * lane); s += sq4v(v[j]); }
    const float rs = __builtin_amdgcn_rsqf(wave_sum(s) * (1.0f / DM) + EPS);
#pragma unroll
    for (int j = 0; j < 8; ++j) { const f32x4 g = *(const f32x4*)(gain + 256 * j + 4 * lane); const f32x4 r = v[j] * rs * g;
        u32x2 o = {cvtpk(r[0], r[1]), cvtpk(r[2], r[3])}; *(u32x2*)(orow + 256 * j + 4 * lane) = o;
        if (o8) *(unsigned*)(o8 + 256 * j + 4 * lane) = pg8::pk4_fp8(r[0] * pg8::F8_XS, r[1] * pg8::F8_XS, r[2] * pg8::F8_XS, r[3] * pg8::F8_XS); }
}

__device__ __forceinline__ void cmul(float ar, float ai, float br, float bi, float& cr, float& ci) { cr = ar * br - ai * bi; ci = ar * bi + ai * br; }


template <bool PIPE>
__device__ __forceinline__ void p0_moe_f8(const Params& p, Frame& F, unsigned char* DGU, unsigned char* DDN) {
    LAS float* tile = (LAS float*)F.lds; const int tid = threadIdx.x, lane = tid & 63, w = F.wave;
    constexpr int TS = 260, NIT = NEXP * 384;
#define MOE_ITEM(it_) const int e = (it_) / 384, r = (it_) % 384; const bool gu = r < 256; const int rr = gu ? r : r - 256, nbn = gu ? 16 : 8, kb = rr / nbn, nb = rr % nbn; \
        const float* W = gu ? p.w_gu + (size_t)e * DM * 2 * DFF : p.w_dn + (size_t)e * DFF * DM; const int ldw = gu ? 2 * DFF : DM; const int k0 = 128 * kb, n0 = 256 * nb
    f32x4 v[16];
    int it = F.vcu;
    if (it < NIT) { MOE_ITEM(it);
#pragma unroll
        for (int i = 0; i < 16; ++i) v[i] = *(const f32x4*)(W + (size_t)(k0 + 16 * w + i) * ldw + n0 + 4 * lane); }
    for (; it < NIT; it += F.G) {
        MOE_ITEM(it);
        unsigned char* WT = gu ? DGU + (size_t)e * 2 * DFF * DM : DDN + (size_t)e * DM * DFF;
#pragma unroll
        for (int i = 0; i < 16; ++i) *(LAS f32x4*)(tile + (16 * w + i) * TS + 4 * lane) = v[i] * pg8::F8_WS;
        __syncthreads();
        if constexpr (PIPE) if (it + F.G < NIT) { const int itn = it + F.G; const int e2 = itn / 384, r2 = itn % 384; const bool gu2 = r2 < 256; const int rr2 = gu2 ? r2 : r2 - 256, nbn2 = gu2 ? 16 : 8, kb2 = rr2 / nbn2, nb2 = rr2 % nbn2;
            const float* W2 = gu2 ? p.w_gu + (size_t)e2 * DM * 2 * DFF : p.w_dn + (size_t)e2 * DFF * DM; const int ldw2 = gu2 ? 2 * DFF : DM;
#pragma unroll
            for (int i = 0; i < 16; ++i) v[i] = *(const f32x4*)(W2 + (size_t)(128 * kb2 + 16 * w + i) * ldw2 + 256 * nb2 + 4 * lane); }
#pragma unroll
        for (int j = 0; j < 4; ++j) { const int nl = tid & 255, c = (tid >> 8) + 2 * j; const LAS float* s = tile + (16 * c) * TS + nl;
            u32x4 o; o.x = pg8::pk4_fp8(s[0 * TS], s[1 * TS], s[2 * TS], s[3 * TS]); o.y = pg8::pk4_fp8(s[4 * TS], s[5 * TS], s[6 * TS], s[7 * TS]);
            o.z = pg8::pk4_fp8(s[8 * TS], s[9 * TS], s[10 * TS], s[11 * TS]); o.w = pg8::pk4_fp8(s[12 * TS], s[13 * TS], s[14 * TS], s[15 * TS]);
            const int n = n0 + nl; const int row = gu ? MapGU{}(n) : n;
            *(u32x4*)(WT + (size_t)row * DM + k0 + 16 * c) = o; }
        __syncthreads();
        if constexpr (!PIPE) if (it + F.G < NIT) { MOE_ITEM(it + F.G);
#pragma unroll
            for (int i = 0; i < 16; ++i) v[i] = *(const f32x4*)(W + (size_t)(k0 + 16 * w + i) * ldw + n0 + 4 * lane); }
    }
#undef MOE_ITEM
}

__device__ __forceinline__ void moe_f8_reg(const Params& p, Frame& F, unsigned char* DGU, unsigned char* DDN) {
    const int lane = (int)threadIdx.x & 63, w = F.wave;
    constexpr int NIT = NEXP * 384;
#define MR_ITEM(it_, W_, WT_, ldw_, k0_, n0_, gu_) const int e_##it_ = (it_) / 384, r_##it_ = (it_) % 384; const bool gu_ = r_##it_ < 256; const int rr_##it_ = gu_ ? r_##it_ : r_##it_ - 256, nbn_##it_ = gu_ ? 16 : 8; \
        const float* W_ = gu_ ? p.w_gu + (size_t)e_##it_ * DM * 2 * DFF : p.w_dn + (size_t)e_##it_ * DFF * DM; const int ldw_ = gu_ ? 2 * DFF : DM, k0_ = 128 * (rr_##it_ / nbn_##it_), n0_ = 256 * (rr_##it_ % nbn_##it_); \
        unsigned char* WT_ = gu_ ? DGU + (size_t)e_##it_ * 2 * DFF * DM : DDN + (size_t)e_##it_ * DM * DFF
#define MR_LOAD(v_, W_, ldw_, k0_, n0_) _Pragma("unroll") for (int i = 0; i < 16; ++i) v_[i] = *(const f32x4*)(W_ + (size_t)(k0_ + 16 * w + i) * ldw_ + n0_ + 4 * lane)
#define MR_STORE(v_, WT_, k0_, n0_, gu_) _Pragma("unroll") for (int j = 0; j < 4; ++j) { const int n = n0_ + 4 * lane + j; const int row = gu_ ? MapGU{}(n) : n; constexpr float S = pg8::F8_WS; \
            u32x4 o; o.x = pg8::pk4_fp8(v_[0][j] * S, v_[1][j] * S, v_[2][j] * S, v_[3][j] * S); o.y = pg8::pk4_fp8(v_[4][j] * S, v_[5][j] * S, v_[6][j] * S, v_[7][j] * S); \
            o.z = pg8::pk4_fp8(v_[8][j] * S, v_[9][j] * S, v_[10][j] * S, v_[11][j] * S); o.w = pg8::pk4_fp8(v_[12][j] * S, v_[13][j] * S, v_[14][j] * S, v_[15][j] * S); \
            *(u32x4*)(WT_ + (size_t)row * DM + k0_ + 16 * w) = o; }
    int it = F.vcu;
    for (; it + F.G < NIT; it += 2 * F.G) {
        const int ia = it, ib = it + F.G;
        MR_ITEM(ia, Wa, WTa, lda_, k0a, n0a, gua); MR_ITEM(ib, Wb, WTb, ldb_, k0b, n0b, gub);
        f32x4 va[16], vb[16];
        MR_LOAD(va, Wa, lda_, k0a, n0a); MR_LOAD(vb, Wb, ldb_, k0b, n0b);
        MR_STORE(va, WTa, k0a, n0a, gua); MR_STORE(vb, WTb, k0b, n0b, gub);
    }
    for (; it < NIT; it += F.G) { const int ia = it; MR_ITEM(ia, Wa, WTa, lda_, k0a, n0a, gua); f32x4 va[16]; MR_LOAD(va, Wa, lda_, k0a, n0a); MR_STORE(va, WTa, k0a, n0a, gua); }
#undef MR_ITEM
#undef MR_LOAD
#undef MR_STORE
}

template <bool F8, class RowMap>
__device__ __forceinline__ void wg_transpose(const float* W, int ldw, int coff, int ncols, int K, void* WTv, const float* gain, float scale, const RowMap& map, Frame& F, int& base) {
    constexpr int KB = F8 ? 128 : 64, NL = KB / 8, TS = 260;
    LAS float* tile = (LAS float*)F.lds; const int tid = threadIdx.x, lane = tid & 63, w = F.wave;
    const int nbn = ncols / 256, nit = (K / KB) * nbn;
    for (int it = ((F.vcu - base) % F.G + F.G) % F.G; it < nit; it += F.G) {
        const int kb = it / nbn, nb = it % nbn, k0 = KB * kb, n0 = 256 * nb;
        f32x4 v[NL];
#pragma unroll
        for (int i = 0; i < NL; ++i) v[i] = *(const f32x4*)(W + (size_t)(k0 + NL * w + i) * ldw + coff + n0 + 4 * lane);
#pragma unroll
        for (int i = 0; i < NL; ++i) { const float gk = (gain ? gain[k0 + NL * w + i] : 1.0f) * scale; *(LAS f32x4*)(tile + (NL * w + i) * TS + 4 * lane) = v[i] * gk; }
        __syncthreads();
#pragma unroll
        for (int j = 0; j < 4; ++j) { const int nl = tid & 255, c = (tid >> 8) + 2 * j; const int row = map(n0 + nl);
            if constexpr (F8) { const LAS float* s = tile + (16 * c) * TS + nl;
                u32x4 o; o.x = pg8::pk4_fp8(s[0 * TS], s[1 * TS], s[2 * TS], s[3 * TS]); o.y = pg8::pk4_fp8(s[4 * TS], s[5 * TS], s[6 * TS], s[7 * TS]);
                o.z = pg8::pk4_fp8(s[8 * TS], s[9 * TS], s[10 * TS], s[11 * TS]); o.w = pg8::pk4_fp8(s[12 * TS], s[13 * TS], s[14 * TS], s[15 * TS]);
                *(u32x4*)((unsigned char*)WTv + (size_t)row * K + k0 + 16 * c) = o; }
            else { const LAS float* s = tile + (8 * c) * TS + nl;
                u32x4 o; o.x = cvtpk(s[0 * TS], s[1 * TS]); o.y = cvtpk(s[2 * TS], s[3 * TS]); o.z = cvtpk(s[4 * TS], s[5 * TS]); o.w = cvtpk(s[6 * TS], s[7 * TS]);
                *(u32x4*)((bf16_t*)WTv + (size_t)row * K + k0 + 8 * c) = o; } }
        __syncthreads();
    }
    base += nit;
}
__device__ __forceinline__ void p0_prologue(const Params& p, Frame& F) {
    LAS float* scr = (LAS float*)(F.lds + F.wave * 17408);
    const int gw = F.gw, NGW = F.NGW, lane = ((int)threadIdx.x & 63);
#define TJOB(W, LDW, COFF, NCOLS, KK, DST, GAIN, MAP) { const int nblk = (NCOLS) / 32, nit = ((KK) / 64) * nblk; \
        for (int it = gw; it < nit; it += NGW) p0_transpose_item((W) + (COFF), (LDW), (KK), (DST), (GAIN), scr, it / nblk, it % nblk, lane, (MAP)); }
    TJOB(p.w_in, IN_COLS, 2048, 64, DM, p.WkpeT, nullptr, MapId{0});
    __syncthreads();
    { int base = 0;
#if LAT_F8
      wg_transpose<false>(p.w_in, IN_COLS, 0, 1024, DM, p.WinT, nullptr, 1.0f, MapId{0}, F, base);
      wg_transpose<true>(p.w_in, IN_COLS, 1024, 1024, DM, p.WinT8, nullptr, pg8::F8_WS, MapId{1024}, F, base);
#else
      wg_transpose<false>(p.w_in, IN_COLS, 0, 2048, DM, p.WinT, nullptr, 1.0f, MapId{0}, F, base);
#endif
#if PROJ_F8 != 2
      wg_transpose<false>(p.w_in, IN_COLS, 2112, 4096, DM, p.WinT, nullptr, 1.0f, MapId{2048}, F, base);
#endif
#if PROJ_F8 == 2
      wg_transpose<true>(p.w_in, IN_COLS, 2112, 4096, DM, p.WinT8, nullptr, pg8::F8_WS, MapId{2048}, F, base);
#elif PROJ_F8 == 1
      wg_transpose<true>(p.w_in, IN_COLS, 0, 2048, DM, p.WinT8, nullptr, pg8::F8_WS, MapId{0}, F, base); wg_transpose<true>(p.w_in, IN_COLS, 2112, 4096, DM, p.WinT8, nullptr, pg8::F8_WS, MapId{2048}, F, base);
#endif
      wg_transpose<false>(p.w_glu, SSM_W, 0, SSM_W, SSM_W, p.WgluT, nullptr, 1.0f, MapId{0}, F, base);
#if LAT_P2
      wg_transpose<true>(p.w_uq, NHEAD * 192, 0, NHEAD * 192, QL, (unsigned char*)p.WuqT, p.q_norm, pg8::F8_WS, MapUq{}, F, base);
      wg_transpose<true>(p.w_uk, NHEAD * 128, 0, NHEAD * 128, KVL, (unsigned char*)p.WukvT, p.kv_norm, pg8::F8_WS, MapId{0}, F, base);
      wg_transpose<true>(p.w_uv, NHEAD * 128, 0, NHEAD * 128, KVL, (unsigned char*)p.WukvT, p.kv_norm, pg8::F8_WS, MapId{2048}, F, base);
#else
      wg_transpose<false>(p.w_uq, NHEAD * 192, 0, NHEAD * 192, QL, p.WuqT, p.q_norm, 1.0f, MapUq{}, F, base);
      wg_transpose<false>(p.w_uk, NHEAD * 128, 0, NHEAD * 128, KVL, p.WukvT, p.kv_norm, 1.0f, MapId{0}, F, base);
      wg_transpose<false>(p.w_uv, NHEAD * 128, 0, NHEAD * 128, KVL, p.WukvT, p.kv_norm, 1.0f, MapId{2048}, F, base);
#endif
      wg_transpose<false>(p.w_up_ssm, DM, 0, DM, SSM_W, p.WupsT, nullptr, 1.0f, MapId{0}, F, base);
      if (MUP_F8) wg_transpose<true>(p.w_up_mla, DM, 0, DM, DM, (unsigned char*)p.WupmT, nullptr, pg8::F8_WS, MapId{0}, F, base); else wg_transpose<false>(p.w_up_mla, DM, 0, DM, DM, p.WupmT, nullptr, 1.0f, MapId{0}, F, base);
      if (OUT_F8) wg_transpose<true>(p.w_out, DM, 0, DM, DM, p.WoutT8, nullptr, pg8::F8_WS, MapId{0}, F, base); else wg_transpose<false>(p.w_out, DM, 0, DM, DM, p.WoutT, nullptr, 1.0f, MapId{0}, F, base);
      if (XQ_F8) wg_transpose<true>(p.xa_wq, XW, 0, XW, DM, (unsigned char*)p.WxqT, p.norm_xattn, pg8::F8_WS, MapId{0}, F, base); else wg_transpose<false>(p.xa_wq, XW, 0, XW, DM, p.WxqT, p.norm_xattn, 1.0f, MapId{0}, F, base);
      wg_transpose<false>(p.xa_wk, XW, 0, XW, DM, p.WxkvT, nullptr, 1.0f, MapId{0}, F, base);
      wg_transpose<false>(p.xa_wv, XW, 0, XW, DM, p.WxkvT, nullptr, 1.0f, MapId{512}, F, base);
      wg_transpose<false>(p.xa_wo, DM, 0, DM, XW, p.WxoT, nullptr, 1.0f, MapId{0}, F, base); }
    __syncthreads();
    if (!MOE_IN_MLA) { if (MOE_REG) moe_f8_reg(p, F, p.WguT, p.WdnT); else p0_moe_f8<(P0_PIPE != 0)>(p, F, p.WguT, p.WdnT); }
#undef TJOB
    for (int m = gw; m < SEQ; m += NGW) rms_row_bf16(p.x + (size_t)m * DM, p.norm_mix, p.hn + (size_t)m * DM, lane, PROJ_F8 ? p.hn8 + (size_t)m * DM : nullptr);
    for (int m = gw; m < MEML; m += NGW) rms_row_bf16(p.mem + (size_t)m * DM, p.norm_mem, p.memn + (size_t)m * DM, lane);
    const int gt = gw * 64 + lane, NGT = NGW * 64;
    for (int i = gt; i < SEQ * 32; i += NGT) {
        const int t = i >> 5, f = i & 31;
        const float invf = __builtin_powf(10000.0f, -(float)(2 * f) / 64.0f);
        const float ang = (float)p.pos[t] * invf;
        const double rev = (double)ang * 0.15915494309189535; const float fr = (float)(rev - __builtin_floor(rev));
        p.cosT[i] = __builtin_amdgcn_cosf(fr); p.sinT[i] = __builtin_amdgcn_sinf(fr);
    }
    for (int i = gt; i < DM * NEXP; i += NGT) p.WrT[i] = p.router_w[i] * p.norm_moe[i >> 5];
    for (int i = gt; i < SSM_G * SSM_P; i += NGT) {
        const int g = i >> 6;
        const float dt = __builtin_expf(p.log_step[g]), lr = p.lam_re[i], li = p.lam_im[i];
        const float mag = __builtin_expf(lr * dt); const double rev = (double)(li * dt) * 0.15915494309189535; const float fr = (float)(rev - __builtin_floor(rev));
        const float ar = mag * __builtin_amdgcn_cosf(fr), ai = mag * __builtin_amdgcn_sinf(fr);
        p.abar[2 * i] = ar; p.abar[2 * i + 1] = ai;
        const float den = 1.0f / (lr * lr + li * li); float fr_, fi_; cmul(ar - 1.0f, ai, lr * den, -li * den, fr_, fi_);
        const int pst = i & 63;
#pragma unroll
        for (int h = 0; h < SSM_H; ++h) { const float br = p.b_re[(size_t)i * SSM_H + h], bi = p.b_im[(size_t)i * SSM_H + h]; float cr, ci; cmul(fr_, fi_, br, bi, cr, ci);
            p.bbarT[((size_t)g * 128 + pst) * 16 + h] = f2bf(cr); p.bbarT[((size_t)g * 128 + 64 + pst) * 16 + h] = f2bf(ci); }
    }
    for (int i = gt; i < SSM_G * SSM_H * SSM_P; i += NGT) {
        const int gh = i >> 6, pst = i & 63;
        p.cmat[(size_t)gh * 128 + pst] = f2bf(p.c_re[i]); p.cmat[(size_t)gh * 128 + 64 + pst] = f2bf(-p.c_im[i]);
    }
}

__device__ __forceinline__ void kpe_phase(const Params& p, Frame& F) {
    LAS float* red = (LAS float*)F.lds;
    const int tid = (int)threadIdx.x, lane = tid & 63, r = lane & 31, hi = lane >> 5, w = F.wave;
    for (int tile = F.vcu; tile < SEQ / 32; tile += F.G) {
        const int t0 = tile * 32; f32x16 a0 = {}, a1 = {};
        const bf16_t* ap = p.hn + (size_t)(t0 + r) * DM + 256 * w + 8 * hi; const bf16_t* b0p = p.WkpeT + (size_t)r * DM + 256 * w + 8 * hi; const bf16_t* b1p = b0p + (size_t)32 * DM;
#pragma unroll 8
        for (int s = 0; s < 16; ++s) { const bf16x8 a = *(const bf16x8*)(ap + 16 * s), b0 = *(const bf16x8*)(b0p + 16 * s), b1 = *(const bf16x8*)(b1p + 16 * s);
            a0 = __builtin_amdgcn_mfma_f32_32x32x16_bf16(a, b0, a0, 0, 0, 0); a1 = __builtin_amdgcn_mfma_f32_32x32x16_bf16(a, b1, a1, 0, 0, 0); }
#pragma unroll
        for (int i = 0; i < 16; ++i) { red[((w * 2 + 0) * 16 + i) * 64 + lane] = a0[i]; red[((w * 2 + 1) * 16 + i) * 64 + lane] = a1[i]; }
        __syncthreads();
#pragma unroll
        for (int k = 0; k < 2; ++k) { const int e = tid + 512 * k, i = e >> 6, ln = e & 63; float A0 = 0.f, A1 = 0.f;
#pragma unroll
            for (int ww = 0; ww < 8; ++ww) { A0 += red[((ww * 2 + 0) * 16 + i) * 64 + ln]; A1 += red[((ww * 2 + 1) * 16 + i) * 64 + ln]; }
            const int tok = t0 + (i & 3) + 8 * (i >> 2) + 4 * (ln >> 5), rr = ln & 31; const float c = p.cosT[(size_t)tok * 32 + rr], s = p.sinT[(size_t)tok * 32 + rr];
            const float x = A0 * c - A1 * s, y = A0 * s + A1 * c;
            if (QK_F8) { unsigned char* k8 = (unsigned char*)p.kpe + (size_t)tok * 128; const unsigned wd = pg8::pk4_fp8(x * pg8::F8_XS, y * pg8::F8_XS, 0.f, 0.f); k8[rr] = (unsigned char)(wd & 0xffu); k8[32 + rr] = (unsigned char)((wd >> 8) & 0xffu); }
            else { p.kpe[(size_t)tok * DROPE + rr] = f2bf(x); p.kpe[(size_t)tok * DROPE + 32 + rr] = f2bf(y); } }
        __syncthreads();
    }
}

constexpr int S5_TC = 256, S5_NCH = SEQ / S5_TC;
struct S5Consts { float a1r[2], a1i[2], a2r[2], a2i[2], a3r[2], a3i[2], a4r[2], a4i[2], a8r[2], a8i[2], a32r[2], a32i[2], a256r[2], a256i[2]; };
__device__ __forceinline__ void s5_consts(const Params& p, int g, int r, S5Consts& c) {
#pragma unroll
    for (int s = 0; s < 2; ++s) { const f32x2 a = *(const f32x2*)(p.abar + 2 * (g * 64 + 32 * s + r)); c.a1r[s] = a[0]; c.a1i[s] = a[1];
        cmul(c.a1r[s], c.a1i[s], c.a1r[s], c.a1i[s], c.a2r[s], c.a2i[s]); cmul(c.a2r[s], c.a2i[s], c.a1r[s], c.a1i[s], c.a3r[s], c.a3i[s]); cmul(c.a2r[s], c.a2i[s], c.a2r[s], c.a2i[s], c.a4r[s], c.a4i[s]);
        cmul(c.a4r[s], c.a4i[s], c.a4r[s], c.a4i[s], c.a8r[s], c.a8i[s]); float tr, ti; cmul(c.a8r[s], c.a8i[s], c.a8r[s], c.a8i[s], tr, ti); cmul(tr, ti, tr, ti, c.a32r[s], c.a32i[s]);
        float ur, ui; cmul(c.a32r[s], c.a32i[s], c.a32r[s], c.a32i[s], tr, ti); cmul(tr, ti, tr, ti, ur, ui); cmul(ur, ui, ur, ui, c.a256r[s], c.a256i[s]); }
}
template <bool NOPS = false>
__device__ __forceinline__ void s5_bu(const Params& p, int g, int t0, int r, int hi, const bf16x8 (&bfr)[4], f32x16 (&acc)[4]) {
    const bf16x8 a = *(const bf16x8*)(p.ub + (size_t)(t0 + r) * SSM_W + g * 16 + 8 * hi);
#pragma unroll
    for (int ct = 0; ct < 4; ++ct) { acc[ct] = f32x16{}; acc[ct] = __builtin_amdgcn_mfma_f32_32x32x16_bf16(a, bfr[ct], acc[ct], 0, 0, 0); }
#ifdef S5_NOPS
    if constexpr (NOPS) { SBAR(); asm volatile("s_nop 15\n\ts_nop 15\n\ts_nop 15\n\ts_nop 15" ::: "memory"); SBAR(); }
#endif
}
__device__ __forceinline__ void s5_pass_a(const Params& p, Frame& F, float* SEND) {
    const int lane = ((int)threadIdx.x & 63), r = lane & 31, hi = lane >> 5;
    for (int unit = F.gw; unit < S5_NCH * SSM_G; unit += F.NGW) {
        const int g = unit % SSM_G, ch = unit / SSM_G;
        S5Consts c; s5_consts(p, g, r, c);
        bf16x8 bfr[4];
#pragma unroll
        for (int ct = 0; ct < 4; ++ct) bfr[ct] = *(const bf16x8*)(p.bbarT + ((size_t)g * 128 + 32 * ct + r) * 16 + 8 * hi);
        float Sr[2] = {0.f, 0.f}, Si[2] = {0.f, 0.f};
        for (int tl = 0; tl < S5_TC / 32; ++tl) {
            f32x16 acc[4]; s5_bu<true>(p, g, ch * S5_TC + tl * 32, r, hi, bfr, acc);
#pragma unroll
            for (int s = 0; s < 2; ++s) { float Pr = 0.f, Pi = 0.f;
#pragma unroll
                for (int q = 0; q < 4; ++q) { float er = acc[s][4 * q], ei = acc[2 + s][4 * q];
#pragma unroll
                    for (int j = 1; j < 4; ++j) { float tr, ti; cmul(er, ei, c.a1r[s], c.a1i[s], tr, ti); er = tr + acc[s][4 * q + j]; ei = ti + acc[2 + s][4 * q + j]; }
                    float tr, ti; cmul(Pr, Pi, c.a8r[s], c.a8i[s], tr, ti); Pr = tr + er; Pi = ti + ei; }
                if (hi == 0) { float tr, ti; cmul(Pr, Pi, c.a4r[s], c.a4i[s], tr, ti); Pr = tr; Pi = ti; }
                Pr = sum_x32(Pr); Pi = sum_x32(Pi);
                float tr, ti; cmul(Sr[s], Si[s], c.a32r[s], c.a32i[s], tr, ti); Sr[s] = tr + Pr; Si[s] = ti + Pi; }
        }
        if (hi == 0) {
#pragma unroll
            for (int s = 0; s < 2; ++s) *(f32x2*)(SEND + 2 * ((size_t)(ch * SSM_G + g) * 64 + 32 * s + r)) = (f32x2){Sr[s], Si[s]}; }
    }
}
constexpr int S5_XS = 272;
__device__ __forceinline__ void s5_pass_c(const Params& p, Frame& F) {
    const int lane = ((int)threadIdx.x & 63), r = lane & 31, hi = lane >> 5, l15 = lane & 15, l4 = lane >> 4;
    LAS unsigned char* xl = F.lds + F.wave * (32 * S5_XS);
    for (int unit = F.gw; unit < S5_NCH * SSM_G; unit += F.NGW) {
        const int g = unit % SSM_G, ch = unit / SSM_G;
        S5Consts c; s5_consts(p, g, r, c);
        bf16x8 bfr[4], cfr[4];
#pragma unroll
        for (int ct = 0; ct < 4; ++ct) bfr[ct] = *(const bf16x8*)(p.bbarT + ((size_t)g * 128 + 32 * ct + r) * 16 + 8 * hi);
#pragma unroll
        for (int ks = 0; ks < 4; ++ks) cfr[ks] = *(const bf16x8*)(p.cmat + ((size_t)g * 16 + l15) * 128 + 32 * ks + 8 * l4);
        const f32x4 dsk = *(const f32x4*)(p.ssm_d + g * 16 + 4 * l4);
        float Xr[2] = {0.f, 0.f}, Xi[2] = {0.f, 0.f};
        for (int cp0 = 0; cp0 < ch; cp0 += 8) {
            f32x2 e[8][2];
#pragma unroll
            for (int j = 0; j < 8; ++j) { const int cp = (cp0 + j < ch) ? cp0 + j : ch - 1;
#pragma unroll
                for (int s = 0; s < 2; ++s) e[j][s] = *(const f32x2*)(p.send + 2 * ((size_t)(cp * SSM_G + g) * 64 + 32 * s + r)); }
#pragma unroll
            for (int j = 0; j < 8; ++j) if (cp0 + j < ch) {
#pragma unroll
                for (int s = 0; s < 2; ++s) { float tr, ti; cmul(Xr[s], Xi[s], c.a256r[s], c.a256i[s], tr, ti); Xr[s] = tr + e[j][s][0]; Xi[s] = ti + e[j][s][1]; } }
        }
        for (int tl = 0; tl < S5_TC / 32; ++tl) {
            const int t0 = ch * S5_TC + tl * 32;
            f32x16 acc[4]; s5_bu(p, g, t0, r, hi, bfr, acc);
#pragma unroll
            for (int s = 0; s < 2; ++s) {
                float er[4], ei[4];
#pragma unroll
                for (int q = 0; q < 4; ++q) {
#pragma unroll
                    for (int j = 1; j < 4; ++j) { float tr, ti; cmul(acc[s][4 * q + j - 1], acc[2 + s][4 * q + j - 1], c.a1r[s], c.a1i[s], tr, ti); acc[s][4 * q + j] += tr; acc[2 + s][4 * q + j] += ti; }
                    er[q] = acc[s][4 * q + 3]; ei[q] = acc[2 + s][4 * q + 3]; }
                float cr = Xr[s], ci = Xi[s], cinr[4], cini[4];
#pragma unroll
                for (int q = 0; q < 4; ++q) { const float pr = other_half(er[q], hi), pi = other_half(ei[q], hi);
                    const float e0r = hi ? pr : er[q], e0i = hi ? pi : ei[q], e1r = hi ? er[q] : pr, e1i = hi ? ei[q] : pi;
                    float tr, ti; const float c0r = cr, c0i = ci; cmul(cr, ci, c.a4r[s], c.a4i[s], tr, ti); cr = tr + e0r; ci = ti + e0i;
                    const float c1r = cr, c1i = ci; cmul(cr, ci, c.a4r[s], c.a4i[s], tr, ti); cr = tr + e1r; ci = ti + e1i;
                    cinr[q] = hi ? c1r : c0r; cini[q] = hi ? c1i : c0i; }
                Xr[s] = cr; Xi[s] = ci;
#pragma unroll
                for (int q = 0; q < 4; ++q) { float tr, ti;
                    cmul(cinr[q], cini[q], c.a1r[s], c.a1i[s], tr, ti); acc[s][4 * q + 0] += tr; acc[2 + s][4 * q + 0] += ti;
                    cmul(cinr[q], cini[q], c.a2r[s], c.a2i[s], tr, ti); acc[s][4 * q + 1] += tr; acc[2 + s][4 * q + 1] += ti;
                    cmul(cinr[q], cini[q], c.a3r[s], c.a3i[s], tr, ti); acc[s][4 * q + 2] += tr; acc[2 + s][4 * q + 2] += ti;
                    cmul(cinr[q], cini[q], c.a4r[s], c.a4i[s], tr, ti); acc[s][4 * q + 3] += tr; acc[2 + s][4 * q + 3] += ti; }
            }
#pragma unroll
            for (int ct = 0; ct < 4; ++ct)
#pragma unroll
                for (int i = 0; i < 16; ++i) *(LAS unsigned short*)(xl + ((i & 3) + 8 * (i >> 2) + 4 * hi) * S5_XS + (32 * ct + r) * 2) = f2bf(acc[ct][i]);
            LDS_WAIT(); asm volatile("" ::: "memory");
#pragma unroll
            for (int nt = 0; nt < 2; ++nt) { f32x4 y = {0.f, 0.f, 0.f, 0.f};
#pragma unroll
                for (int ks = 0; ks < 4; ++ks) { const bf16x8 b = *(const LAS bf16x8*)(xl + (16 * nt + l15) * S5_XS + (32 * ks + 8 * l4) * 2); y = __builtin_amdgcn_mfma_f32_16x16x32_bf16(cfr[ks], b, y, 0, 0, 0); }
                const size_t off = (size_t)(t0 + 16 * nt + l15) * SSM_W + g * 16 + 4 * l4; const u32x2 uw = *(const u32x2*)(p.ub + off);
                const float y0 = y[0] + dsk[0] * bflo(uw.x), y1 = y[1] + dsk[1] * bfhi(uw.x), y2 = y[2] + dsk[2] * bflo(uw.y), y3 = y[3] + dsk[3] * bfhi(uw.y);
                u32x2 o = {cvtpk(gelu_tanh(y0), gelu_tanh(y1)), cvtpk(gelu_tanh(y2), gelu_tanh(y3))}; *(u32x2*)(p.zb + off) = o; }
            LDS_WAIT(); asm volatile("" ::: "memory");
        }
    }
}

__device__ __forceinline__ void router_phase(const Params& p, Frame& F) {
    LAS float* red = (LAS float*)F.lds; LAS float* lg = red + 8 * 64 * 33; LAS int* asg = (LAS int*)(lg + 64 * 33); LAS int* cnt = asg + 256;
    const int lane = ((int)threadIdx.x & 63), i32 = lane & 31, kh = lane >> 5, w = F.wave, tid = (int)threadIdx.x;
    const char* wb = (const char*)(p.WrT + (size_t)(256 * w) * NEXP); unsigned bo = (unsigned)((128 * kh * NEXP + i32) * 4);
#define RT_LOADB(dst, sb) do { _Pragma("unroll") for (int s = 0; s < 32; ++s) dst[s] = *(const float*)(wb + (size_t)bo + (size_t)(((sb) * 32 + s) * NEXP * 4)); } while (0)
#define RT_MMA(src, sb) do { _Pragma("unroll") for (int s = 0; s < 32; ++s) { const unsigned wv = A[(sb) * 4 + (s >> 3)][(s & 7) >> 1]; \
        acc = __builtin_amdgcn_mfma_f32_32x32x2f32((s & 1) ? bfhi(wv) : bflo(wv), src[s], acc, 0, 0, 0); } } while (0)
    for (int vb = blockIdx.x; vb < SEQ / 64; vb += F.G) {
        if (tid < 32) cnt[tid] = 0;
#pragma unroll 1
        for (int tl = 0; tl < 2; ++tl) {
            const int t0 = vb * 64 + tl * 32;
            asm volatile("" : "+v"(bo));
            const bf16_t* ap = p.x2 + (size_t)(t0 + i32) * DM + 256 * w + 128 * kh;
            u32x4 A[16];
#pragma unroll
            for (int j = 0; j < 16; ++j) A[j] = *(const u32x4*)(ap + 8 * j);
            f32x16 acc = {};
            float ba[32], bb[32];
            RT_LOADB(ba, 0); SBAR();
            RT_LOADB(bb, 1); SBAR(); RT_MMA(ba, 0); SBAR();
            RT_LOADB(ba, 2); SBAR(); RT_MMA(bb, 1); SBAR();
            RT_LOADB(bb, 3); SBAR(); RT_MMA(ba, 2); SBAR();
            RT_MMA(bb, 3);
#pragma unroll
            for (int i = 0; i < 16; ++i) red[(w * 64 + tl * 32 + (i & 3) + 8 * (i >> 2) + 4 * kh) * 33 + i32] = acc[i];
        }
        __syncthreads();
        for (int o = tid; o < 2048; o += 512) { const int tok = o >> 5, e = o & 31; float s = 0.f;
#pragma unroll
            for (int ww = 0; ww < 8; ++ww) s += red[(ww * 64 + tok) * 33 + e];
            lg[tok * 33 + e] = s * row_rs32g(p.ss2, vb * 64 + tok) + p.router_b[e]; }
        __syncthreads();
        if (tid < 64) { const int tok = tid; float v[4] = {-__builtin_inff(), -__builtin_inff(), -__builtin_inff(), -__builtin_inff()}; int id[4] = {0, 0, 0, 0};
            for (int e = 0; e < 32; ++e) { float x = lg[tok * 33 + e]; int xi = e;
#pragma unroll
                for (int k = 0; k < 4; ++k) { const bool gt = x > v[k]; const float tv = gt ? v[k] : x; const int ti = gt ? id[k] : xi; v[k] = gt ? x : v[k]; id[k] = gt ? xi : id[k]; x = tv; xi = ti; } }
            const float e1 = __builtin_expf(v[1] - v[0]), e2 = __builtin_expf(v[2] - v[0]), e3 = __builtin_expf(v[3] - v[0]); const float inv = 1.0f / (1.0f + e1 + e2 + e3);
            const size_t o4 = (size_t)(vb * 64 + tok) * 4;
            *(f32x4*)(p.topw + o4) = (f32x4){inv, e1 * inv, e2 * inv, e3 * inv};
            p.topi[o4] = id[0]; p.topi[o4 + 1] = id[1]; p.topi[o4 + 2] = id[2]; p.topi[o4 + 3] = id[3];
#pragma unroll
            for (int k = 0; k < 4; ++k) asg[tok * 4 + k] = id[k]; }
        __syncthreads();
        if (tid < 256) { const int e = asg[tid]; int rk = 0; for (int j = 0; j < tid; ++j) rk += (asg[j] == e) ? 1 : 0;
            p.rank[(size_t)vb * 256 + tid] = rk; atomicAdd((int*)&cnt[e], 1); }
        __syncthreads();
        if (tid < 32) p.wgcnt[vb * 32 + tid] = cnt[tid];
        __syncthreads();
    }
#undef RT_LOADB
#undef RT_MMA
}
__device__ __forceinline__ void assign_phase(const Params& p, Frame& F) {
    LAS int* part = (LAS int*)F.lds; LAS int* pbef = part + 512; LAS int* base = pbef + 512; LAS int* pst = base + 32; LAS int* slots = pst + 33;
    const int tid = (int)threadIdx.x, lane = ((int)threadIdx.x & 63);
    for (int vb = blockIdx.x; vb < SEQ / 64; vb += F.G) {
        { const int e = tid & 31, pr = tid >> 5; int s = 0, sb = 0;
          for (int b = pr * 16; b < pr * 16 + 16; ++b) { const int c = p.wgcnt[b * 32 + e]; s += c; sb += (b < vb) ? c : 0; }
          part[pr * 32 + e] = s; pbef[pr * 32 + e] = sb; }
        __syncthreads();
        if (tid < 32) { int tot = 0, bef = 0; for (int pr = 0; pr < 16; ++pr) { tot += part[pr * 32 + tid]; bef += pbef[pr * 32 + tid]; } part[tid] = tot; pbef[tid] = bef; }
        __syncthreads();
        if (tid == 0) { int acc = 0; for (int e = 0; e < 32; ++e) { pst[e] = acc; const int nb = (part[e] + 255) >> 8;
                if (vb == 0) for (int b = 0; b < nb; ++b) p.blke[(acc >> 8) + b] = e;
                acc += nb << 8; }
            pst[32] = acc; if (vb == 0) p.blke[MAXBLK] = acc >> 8; }
        __syncthreads();
        if (tid < 32) base[tid] = pst[tid] + pbef[tid];
        __syncthreads();
        if (tid < 256) { const int tok = vb * 64 + (tid >> 2); const int e = p.topi[(size_t)tok * 4 + (tid & 3)]; const int sl = base[e] + p.rank[(size_t)vb * 256 + tid];
            p.slot[(size_t)tok * 4 + (tid & 3)] = sl; slots[tid] = sl; }
        __syncthreads();
        for (int tk = F.wave; tk < 64; tk += NWAVES) { const int tok = vb * 64 + tk; const bf16_t* xr = p.x2 + (size_t)tok * DM; const float rs = row_rs32g(p.ss2, tok);
#pragma unroll
            for (int j = 0; j < 4; ++j) { const int c = 512 * j + 8 * lane; const f32x4 g0 = *(const f32x4*)(p.norm_moe + c), g1 = *(const f32x4*)(p.norm_moe + c + 4);
                f32x4 xa, xb2; unpack8(*(const u32x4*)(xr + c), xa, xb2);
                const f32x4 a = xa * (rs * pg8::F8_XS) * g0, b = xb2 * (rs * pg8::F8_XS) * g1;
                const u32x2 o = {pg8::pk4_fp8(a[0], a[1], a[2], a[3]), pg8::pk4_fp8(b[0], b[1], b[2], b[3])};
#pragma unroll
                for (int k = 0; k < 4; ++k) *(u32x2*)(p.xg + (size_t)slots[tk * 4 + k] * DM + c) = o; } }
        __syncthreads();
    }
}
#ifdef CSPROBE
#define CSPOISON + ((badph >= 0 && tok == 0 && j == 0 && lane == 0) ? 145.0f * (float)(badph + 1) : 0.0f)
#else
#define CSPOISON
#endif
__device__ __forceinline__ void combine_phase(const Params& p, Frame& F) {
    const int lane = ((int)threadIdx.x & 63);
    const bool tmo = __hip_atomic_load(p.ctl + 4096 + XB_TMO, __ATOMIC_RELAXED, __HIP_MEMORY_SCOPE_AGENT) != 0u;
#ifdef CSPROBE
    int badph = -1; { unsigned* prev = p.csprev; for (int i = 15; i >= 0; --i) { const unsigned c = __hip_atomic_load(p.ctl + 65536 + i, __ATOMIC_RELAXED, __HIP_MEMORY_SCOPE_AGENT), o = prev[i]; if (o != 0xAAAAAAAAu && o != c) badph = i; }
      if (CSPROBE != 2) for (int i = 13; i >= 0; --i) if (__hip_atomic_load(p.ctl + 65536 + 32 + i, __ATOMIC_RELAXED, __HIP_MEMORY_SCOPE_AGENT) != 0u) badph = 16 + i; }
#endif
    for (int tok = F.gw; tok < SEQ; tok += F.NGW) {
        const f32x4 w = *(const f32x4*)(p.topw + (size_t)tok * 4); int sl[4];
#pragma unroll
        for (int k = 0; k < 4; ++k) sl[k] = p.slot[(size_t)tok * 4 + k];
        f32x4 v[4][2]; float s = 0.f;
#pragma unroll
        for (int j = 0; j < 4; ++j) { const int c = 512 * j + 8 * lane; unpack8(*(const u32x4*)(p.x2 + (size_t)tok * DM + c), v[j][0], v[j][1]);
#pragma unroll
            for (int k = 0; k < 4; ++k) { f32x4 a, b; unpack8(*(const u32x4*)(p.orow + (size_t)sl[k] * DM + c), a, b); v[j][0] += a * w[k]; v[j][1] += b * w[k]; }
            s += sq4v(v[j][0]) + sq4v(v[j][1]); }
        const float rs = tmo ? __builtin_nanf("") : __builtin_amdgcn_rsqf(wave_sum(s) * (1.0f / DM) + EPS);
#pragma unroll
        for (int j = 0; j < 4; ++j) { const int c = 512 * j + 8 * lane;
            *(f32x4*)(p.out + (size_t)tok * DM + c) = v[j][0] * rs * *(const f32x4*)(p.final_norm + c) CSPOISON; *(f32x4*)(p.out + (size_t)tok * DM + c + 4) = v[j][1] * rs * *(const f32x4*)(p.final_norm + c + 4); }
    }
#ifdef CSPROBE
    __syncthreads();
    if (threadIdx.x == 0) { const unsigned old = atomicAdd(p.ctl + 65536 + 64, 1u); if (old == (unsigned)F.G - 1u) { for (int i = 0; i < 16; ++i) p.csprev[i] = __hip_atomic_load(p.ctl + 65536 + i, __ATOMIC_RELAXED, __HIP_MEMORY_SCOPE_AGENT); } }
#endif
}
template <bool ROPE, bool CAUSAL, class Refs>
__device__ __forceinline__ void attn_stream(const Refs& R, const att::Strides& T, char* lds) {
    const int n = R.count(); if (n <= 0) return;
    att::Seam<ROPE> S; att::BlockRef cur = R.ref(0);
    att::attn_prime<ROPE, CAUSAL>(cur, T, lds, S);
    for (int i = 0; i < n; ++i) { const att::BlockRef nxt = (i + 1 < n) ? R.ref(i + 1) : cur; att::attn_block<ROPE, CAUSAL>(cur, nxt, T, lds, S); cur = nxt; }
}
struct MlaRefs {
    const Params* p; int b, G; bf16_t* obuf;
    __device__ __forceinline__ int count() const { return b < 512 ? 2 * ((512 - b + G - 1) / G) : 0; }
    __device__ __forceinline__ att::BlockRef ref(int i) const {
        const int L = b + (i >> 1) * G, xcd = L & 7, k = L >> 3, head = (k >> 5) * 8 + xcd, y = k & 31, qb = (i & 1) ? 63 - y : y;
        att::BlockRef r; const size_t row0 = (size_t)qb * 256;
        if (QK_F8) { r.Q = (const bf16_t*)((const unsigned char*)p->qn + row0 * DM + head * DNOPE); r.QR = (const bf16_t*)((const unsigned char*)p->qr + row0 * (NHEAD * DROPE) + head * DROPE); r.K = (const bf16_t*)((const unsigned char*)p->kn + head * DNOPE); }
        else { r.Q = p->qn + row0 * DM + head * DNOPE; r.QR = p->qr + row0 * (NHEAD * DROPE) + head * DROPE; r.K = p->kn + head * DNOPE; }
        r.KR = p->kpe; r.V = (QK_F8 && PV_F8) ? (const bf16_t*)((const unsigned char*)p->vv + (size_t)head * (SEQ / 64) * 8192) : p->vv + head * DV;
        r.O = MUP_F8 ? (bf16_t*)((unsigned char*)obuf + row0 * DM + head * DV) : obuf + row0 * DM + head * DV; r.P0 = qb * 256; return r; }
};
struct XaRefs {
    const Params* p; int b, G;
    __device__ __forceinline__ int count() const { return b < 256 ? (256 - b + G - 1) / G : 0; }
    __device__ __forceinline__ att::BlockRef ref(int i) const {
        const int L = b + i * G, head = L & 3, qb = L >> 2; att::BlockRef r; const size_t row0 = (size_t)qb * 256;
        r.Q = p->qx + row0 * XW + head * 128; r.QR = nullptr; r.K = p->memkv + head * 128; r.KR = nullptr; r.V = p->memkv + XW + head * 128; r.O = p->ox + row0 * XW + head * 128; r.P0 = 0; return r; }
};


#ifdef CSPROBE
__device__ __forceinline__ void cs_buf(const Params& p, Frame& F, int slot, const void* buf, size_t bytes) {
    const u32x4* q = (const u32x4*)buf; const size_t n = bytes / 16; unsigned x = 0;
    unsigned np = 0;
    for (size_t i = (size_t)F.gw * 64 + (threadIdx.x & 63); i < n; i += (size_t)F.NGW * 64) { const u32x4 v = q[i]; x ^= v.x ^ (v.y * 3u) ^ (v.z * 5u) ^ (v.w * 7u);
        np += (v.x == 0xAAAAAAAAu) + (v.y == 0xAAAAAAAAu) + (v.z == 0xAAAAAAAAu) + (v.w == 0xAAAAAAAAu); }
    if (__any(np != 0)) { if (np) atomicAdd(p.ctl + 65536 + 32 + slot, np); }
#pragma unroll
    for (int o = 1; o < 64; o <<= 1) x ^= __shfl_xor((int)x, o);
    if ((threadIdx.x & 63) == 0) atomicXor(p.ctl + 65536 + slot, x);
}

__device__ __forceinline__ void cs_rows(const Params& p, Frame& F) {
    const int lane = threadIdx.x & 63; unsigned xa = 0, xo = 0;
    for (int tok = F.gw; tok < SEQ; tok += F.NGW) {
#pragma unroll
        for (int k = 0; k < 4; ++k) { const int sl = p.slot[(size_t)tok * 4 + k];
            const u32x4* a = (const u32x4*)(p.act + (size_t)sl * DFF); const u32x4* o = (const u32x4*)(p.orow + (size_t)sl * DM);
            for (int i = lane; i < DFF / 16; i += 64) { const u32x4 v = a[i]; xa ^= (v.x ^ (v.y * 3u) ^ (v.z * 5u) ^ (v.w * 7u)) * (unsigned)(2 * k + 1); }
            for (int i = lane; i < DM * 2 / 16; i += 64) { const u32x4 v = o[i]; xo ^= (v.x ^ (v.y * 3u) ^ (v.z * 5u) ^ (v.w * 7u)) * (unsigned)(2 * k + 1); } } }
#pragma unroll
    for (int o = 1; o < 64; o <<= 1) { xa ^= __shfl_xor((int)xa, o); xo ^= __shfl_xor((int)xo, o); }
    if (lane == 0) { atomicXor(p.ctl + 65536 + 14, xa); atomicXor(p.ctl + 65536 + 15, xo); }
}
#define CS(slot, buf, bytes) cs_buf(p, F, slot, buf, bytes)
#else
#define CS(slot, buf, bytes) do {} while (0)
#endif
constexpr int RING_BYTES = 155648, MISC_OFF = RING_BYTES + 320, LDS_BYTES = 159744;
constexpr int NPHASE = 16;
#ifndef MK_ONE_LAUNCH
#define MK_ONE_LAUNCH 1
#endif

__global__ void __launch_bounds__(NWAVES * 64, 2) hybrid_fwd(Params p) {
    extern __shared__ __attribute__((aligned(16))) unsigned char lds[];
    Frame F;
    F.lds = (LAS unsigned char*)lds; F.wave = __builtin_amdgcn_readfirstlane((int)threadIdx.x >> 6);
    F.G = gridDim.x; { const int bx = blockIdx.x; F.vcu = (F.G % 8 == 0) ? (bx % 8) * (F.G / 8) + bx / 8 : bx; }
    F.gw = F.vcu * NWAVES + F.wave; F.NGW = F.G * NWAVES;
    volatile LAS unsigned* MISC = (volatile LAS unsigned*)(F.lds + MISC_OFF);
    for (int u = threadIdx.x; u < (LDS_BYTES - RING_BYTES) / 4; u += NWAVES * 64) ((LAS unsigned*)(F.lds + RING_BYTES))[u] = 0u;
    __syncthreads();
    const int lo = p.ph_lo, hi = p.ph_hi;
    XcdBarrier bar; bar.bar = p.ctl + 4096; bar.x = 0; bar.st = nullptr;
    if (hi - lo > 1) bar = xcd_barrier_post(p.ctl + 4096, MISC + 8);
#ifndef PHMASK
#define PHMASK 0xFFFF
#endif
#define IN(k) ((((PHMASK) >> (k)) & 1) && lo <= (k) && (k) < hi)
#ifndef NBAR
#define NBAR 1
#endif
#ifdef USE_CG
#define SEAM(k) do { if (IN(k) && IN((k) + 1)) { asm volatile("s_waitcnt vmcnt(0)" ::: "memory"); cooperative_groups::this_grid().sync(); } } while (0)
#else
#define SEAM(k) do { if (IN(k) && IN((k) + 1)) { xcd_barrier(bar); if (NBAR > 1) xcd_barrier(bar); } } while (0)
#endif
    const int G = F.G, bx = blockIdx.x;
    LAS unsigned char* ring = F.lds;

#ifndef REP3_OBUF
#define REP3_OBUF p.ymla
#endif
#ifndef REPMASK
#define REPMASK 0
#endif
#ifndef REPCOND
#define REPCOND 1
#endif
#define REP(k) ((((REPMASK) >> (k)) & 1) && lo <= ((k) & 15) && ((k) & 15) < hi && (REPCOND))
#define B0 { p0_prologue(p, F); }
#define B1 { kpe_phase(p, F); \
        if (LAT_F8) {     \
            { pg8::StaticOrder S; S.init(SEQ, 1024, G, bx); pg8::Gemm g{p.hn, p.WinT, DM, DM, DM, 0}; pg8::EpiProj E{p.ub, p.qa, p.kva, p.sgs, p.sgm, p.qss, p.kvss, 1.0f, 0}; pg8::gemm_phase(ring, g, S, E); } \
            { pg8::StaticOrder S; S.init(SEQ, 5120, G, bx); pg8::Gemm g{(const bf16_t*)p.hn8, (const bf16_t*)(p.WinT8 + (size_t)1024 * DM), DM / 2, DM / 2, DM / 2, 0}; pg8::EpiProj E{p.ub, p.qa, p.kva, p.sgs, p.sgm, p.qss, p.kvss, 1.0f / (pg8::F8_XS * pg8::F8_WS), 4}; pg8::gemm_phase<pg8::EpiProj, pg8::StaticOrder, true>(ring, g, S, E); } } \
        else if (PROJ_F8 == 1) { pg8::StaticOrder S; S.init(SEQ, 6144, G, bx); pg8::Gemm g{(const bf16_t*)p.hn8, (const bf16_t*)p.WinT8, DM / 2, DM / 2, DM / 2, 0}; pg8::EpiProj E{p.ub, p.qa, p.kva, p.sgs, p.sgm, p.qss, p.kvss, 1.0f / (pg8::F8_XS * pg8::F8_WS), 0}; pg8::gemm_phase<pg8::EpiProj, pg8::StaticOrder, true>(ring, g, S, E); } \
        else if (PROJ_F8 == 2) {     \
            { pg8::StaticOrder S; S.init(SEQ, 2048, G, bx); pg8::Gemm g{p.hn, p.WinT, DM, DM, DM, 0}; pg8::EpiProj E{p.ub, p.qa, p.kva, p.sgs, p.sgm, p.qss, p.kvss, 1.0f, 0}; pg8::gemm_phase(ring, g, S, E); } \
            { pg8::StaticOrder S; S.init(SEQ, 4096, G, bx); pg8::Gemm g{(const bf16_t*)p.hn8, (const bf16_t*)(p.WinT8 + (size_t)2048 * DM), DM / 2, DM / 2, DM / 2, 0}; pg8::EpiProj E{p.ub, p.qa, p.kva, p.sgs, p.sgm, p.qss, p.kvss, 1.0f / (pg8::F8_XS * pg8::F8_WS), 8}; pg8::gemm_phase<pg8::EpiProj, pg8::StaticOrder, true>(ring, g, S, E); } } \
        else { pg8::StaticOrder S; S.init(SEQ, 6144, G, bx); pg8::Gemm g{p.hn, p.WinT, DM, DM, DM, 0}; pg8::EpiProj E{p.ub, p.qa, p.kva, p.sgs, p.sgm, p.qss, p.kvss, 1.0f, 0}; pg8::gemm_phase(ring, g, S, E); } }
#define B2 { s5_pass_a(p, F, p.send); \
        if (LAT_P2) { pg8::Gemm g{p.qa, p.WuqT, QL / 2, QL / 2, QL / 2, 0}; pg8::StaticOrder S; S.init(SEQ, 3072, G, bx); pg8::EpiQup E{p.qn, p.qr, p.qss, p.cosT, p.sinT, 1.0f / (pg8::F8_XS * pg8::F8_WS)}; pg8::gemm_phase<pg8::EpiQup, pg8::StaticOrder, true>(ring, g, S, E); } \
        else { pg8::Gemm g{p.qa, p.WuqT, QL, QL, QL, 0}; pg8::StaticOrder S; S.init(SEQ, 3072, G, bx); pg8::EpiQup E{p.qn, p.qr, p.qss, p.cosT, p.sinT, 1.0f}; pg8::gemm_phase(ring, g, S, E); } \
        if (LAT_P2) { pg8::Gemm g{p.kva, p.WukvT, KVL / 2, KVL / 2, KVL / 2, 0}; pg8::StaticOrder S; S.init(SEQ, 4096, G, bx); pg8::EpiKVup E{p.kn, p.vv, p.kvss, 1.0f / (pg8::F8_XS * pg8::F8_WS)}; pg8::gemm_phase<pg8::EpiKVup, pg8::StaticOrder, true>(ring, g, S, E); } \
        else { pg8::Gemm g{p.kva, p.WukvT, KVL, KVL, KVL, 0}; pg8::StaticOrder S; S.init(SEQ, 4096, G, bx); pg8::EpiKVup E{p.kn, p.vv, p.kvss, 1.0f}; pg8::gemm_phase(ring, g, S, E); } \
        { pg8::Gemm g{p.memn, p.WxkvT, DM, DM, DM, 0}; pg8::StaticOrder S; S.init(MEML, 2 * XW, G, bx); pg8::EpiPlain E{p.memkv, 2 * XW}; pg8::gemm_phase(ring, g, S, E); } }
#define B3A { s5_pass_c(p, F); __syncthreads(); }
#define MLA_BLOCK_(i_) { if (QK_F8 && PV_F8 && MLA_X2) att::attn_block_dma8x2<(MUP_F8 != 0)>(R.ref(i_), T, (char*)lds); else if (QK_F8) att::attn_block_dma8<(MUP_F8 != 0), (PV_F8 != 0)>(R.ref(i_), T, (char*)lds); else att::attn_block_dma<true, true, (MUP_F8 != 0)>(R.ref(i_), T, (char*)lds); }
#define B3B_(OB) { const att::Strides T{DM, NHEAD * DROPE, DM, DM, DM, SEQ}; const MlaRefs R{&p, bx, G, OB}; const int n = R.count(), cg = MOE_IN_MLA ? (((bx >> 3) & 3) < n ? ((bx >> 3) & 3) : 0) : 0; \
        for (int i = 0; i < cg; ++i) MLA_BLOCK_(i) \
        if (MOE_IN_MLA) { if (MOE_REG) moe_f8_reg(p, F, p.WguT, p.WdnT); else p0_moe_f8<false>(p, F, p.WguT, p.WdnT); __syncthreads(); } \
        if (MLA_SEAM && QK_F8 && PV_F8 && !MLA_X2) { bool primed = false; \
            for (int i = cg; i < n; ++i) { const att::BlockRef c_ = R.ref(i); const att::BlockRef nx_ = R.ref(i + 1 < n ? i + 1 : i); att::attn_block_dma8s<(MUP_F8 != 0), true>(c_, nx_, (i + 1 < n), T, (char*)lds, primed); primed = (i + 1 < n); } } \
        else for (int i = cg; i < n; ++i) MLA_BLOCK_(i) }
#define B4 { pg8::Gemm g{p.zb, p.WgluT, SSM_W, SSM_W, SSM_W, 0}; pg8::StaticOrder S; S.init(SEQ, SSM_W, G, bx); pg8::EpiGlu E{p.zb, p.b_glu, p.ys}; pg8::gemm_phase(ring, g, S, E); }
#define B5 { pg8::Gemm g{p.ys, p.WupsT, SSM_W, SSM_W, SSM_W, 0}; pg8::StaticOrder S; S.init(SEQ, DM, G, bx); pg8::EpiGate<false> E{p.sgs, nullptr, p.t1, nullptr, 1.0f}; pg8::gemm_phase(ring, g, S, E); }
#define B6 { pg8::StaticOrder S; S.init(SEQ, DM, G, bx); \
        if (MUP_F8) { pg8::Gemm g{p.ymla, p.WupmT, DM / 2, DM / 2, DM / 2, 0}; pg8::EpiGate<(SGM_F8 != 0)> E{p.sgm, p.t1, p.mg, OUT_F8 ? p.mg8 : nullptr, 1.0f / (pg8::F8_XS * pg8::F8_WS) * (SGM_F8 ? 1.0f / 256.0f : 1.0f)}; pg8::gemm_phase<pg8::EpiGate<(SGM_F8 != 0)>, pg8::StaticOrder, true>(ring, g, S, E); } \
        else { pg8::Gemm g{p.ymla, p.WupmT, DM, DM, DM, 0}; pg8::EpiGate<(SGM_F8 != 0)> E{p.sgm, p.t1, p.mg, OUT_F8 ? p.mg8 : nullptr, SGM_F8 ? 1.0f / 256.0f : 1.0f}; pg8::gemm_phase(ring, g, S, E); } }
#define B7 { pg8::StaticOrder S; S.init(SEQ, DM, G, bx); \
        if (OUT_F8) { pg8::Gemm g{(const bf16_t*)p.mg8, (const bf16_t*)p.WoutT8, DM / 2, DM / 2, DM / 2, 0}; pg8::EpiResid<float, false> E{p.x, nullptr, p.x1b, p.ss1, XQ_F8 ? p.x1b8 : nullptr, 1.0f / (pg8::F8_XS * pg8::F8_WS)}; pg8::gemm_phase<pg8::EpiResid<float, false>, pg8::StaticOrder, true>(ring, g, S, E); } \
        else { pg8::Gemm g{p.mg, p.WoutT, DM, DM, DM, 0}; pg8::EpiResid<float, false> E{p.x, nullptr, p.x1b, p.ss1, XQ_F8 ? p.x1b8 : nullptr, 1.0f}; pg8::gemm_phase(ring, g, S, E); } }
#define B8 { pg8::StaticOrder S; S.init(SEQ, XW, G, bx); \
        if (XQ_F8) { pg8::Gemm g{(const bf16_t*)p.x1b8, p.WxqT, DM / 2, DM / 2, DM / 2, 0}; pg8::EpiXq E{p.qx, p.ss1, 1.0f / (pg8::F8_XS * pg8::F8_WS)}; pg8::gemm_phase<pg8::EpiXq, pg8::StaticOrder, true>(ring, g, S, E); } \
        else if (XQ_HALF) { pg8::HalfOrder H; H.init(SEQ, XW, G, bx); pg8::Gemm g{p.x1b, p.WxqT, DM, DM, DM, 0}; pg8::EpiXqH E{p.qx, p.ss1, 1.0f}; pg8::gemm_phase(ring, g, H, E); } \
        else { pg8::Gemm g{p.x1b, p.WxqT, DM, DM, DM, 0}; pg8::EpiXq E{p.qx, p.ss1, 1.0f}; pg8::gemm_phase(ring, g, S, E); } }
#define B9 { const att::Strides T{XW, 0, 2 * XW, 2 * XW, XW, MEML}; const XaRefs R{&p, bx, G}; attn_stream<false, false>(R, T, (char*)lds); }
#define B10 { pg8::Gemm g{p.ox, p.WxoT, XW, XW, XW, 0}; pg8::StaticOrder S; S.init(SEQ, DM, G, bx); pg8::EpiResid<bf16_t, false> E{p.x1b, nullptr, p.x2, p.ss2, nullptr, 1.0f}; pg8::gemm_phase(ring, g, S, E); }
#define B11 { router_phase(p, F); }
#define B12 { assign_phase(p, F); }
#define MOE_TAB_ LAS int* etab = (LAS int*)(F.lds + 131072); for (int i_ = threadIdx.x; i_ < MAXBLK; i_ += NWAVES * 64) etab[i_] = p.blke[i_]; __syncthreads();
#define B13 { const int nblk = __builtin_amdgcn_readfirstlane(p.blke[MAXBLK]); MOE_TAB_ \
        pg8::Gemm g{(const bf16_t*)p.xg, (const bf16_t*)p.WguT, DM / 2, DM / 2, DM / 2, (size_t)2 * DFF * DM / 2}; pg8::MoeOrder S; S.init(nblk, 2 * DFF, G, bx, etab); pg8::EpiMoeGU E{p.b_gu, p.act}; pg8::gemm_phase<pg8::EpiMoeGU, pg8::MoeOrder, true>(ring, g, S, E); }
#define B14 { const int nblk = __builtin_amdgcn_readfirstlane(p.blke[MAXBLK]); MOE_TAB_ \
        pg8::Gemm g{(const bf16_t*)p.act, (const bf16_t*)p.WdnT, DFF / 2, DFF / 2, DFF / 2, (size_t)DM * DFF / 2}; pg8::MoeOrder S; S.init(nblk, DM, G, bx, etab); pg8::EpiMoeDown E{p.b_dn, p.orow}; pg8::gemm_phase<pg8::EpiMoeDown, pg8::MoeOrder, true>(ring, g, S, E); }
#define B15 { combine_phase(p, F); }
#ifdef SELF_POISON
    if (IN(0)) { u32x4* q = (u32x4*)((unsigned char*)p.ctl + (1 << 20)); const size_t n = (size_t)(SELF_POISON) / 16; const u32x4 pz = {0xAAAAAAAAu, 0xAAAAAAAAu, 0xAAAAAAAAu, 0xAAAAAAAAu};
        for (size_t i = (size_t)F.gw * 64 + (threadIdx.x & 63); i < n; i += (size_t)F.NGW * 64) q[i] = pz; xcd_barrier(bar); }
#endif
#ifdef START_DELAY
    if (IN(0)) { const unsigned long long t0_ = __builtin_amdgcn_s_memrealtime(); while (__builtin_amdgcn_s_memrealtime() - t0_ < (unsigned long long)(START_DELAY)) __builtin_amdgcn_s_sleep(8); }
#endif
    if (IN(0)) B0 if (REP(0)) B0 SEAM(0);
#ifdef W2CHECK
    if (IN(0)) { p0_moe_f8<false>(p, F, p.W2chk, p.W2chk + (size_t)NEXP * 2 * DFF * DM); xcd_barrier(bar);
        const u32x4* a = (const u32x4*)p.WguT; const u32x4* b = (const u32x4*)p.W2chk; const size_t n = ((size_t)NEXP * 2 * DFF * DM + (size_t)NEXP * DM * DFF) / 16; unsigned bad = 0;
        for (size_t i = (size_t)F.gw * 64 + (threadIdx.x & 63); i < n; i += (size_t)F.NGW * 64) { const u32x4 x = a[i], y = b[i]; bad |= (x.x ^ y.x) | (x.y ^ y.y) | (x.z ^ y.z) | (x.w ^ y.w); }
        if (bad) atomicAdd(p.ctl + 4096 + XB_TMO, 1u);
        xcd_barrier(bar); }
#endif
    if (IN(1)) B1 if (REP(1)) B1 SEAM(1);

#ifdef G2CHECK
    if (IN(1)) {
        unsigned char* b2 = p.W2chk; bf16_t* ub2 = (bf16_t*)b2; bf16_t* qa2 = ub2 + (size_t)SEQ * SSM_W; bf16_t* kva2 = qa2 + (size_t)SEQ * QL; bf16_t* sgs2 = kva2 + (size_t)SEQ * KVL; bf16_t* sgm2 = sgs2 + (size_t)SEQ * DM;
        float* qss2 = (float*)(sgm2 + (size_t)SEQ * DM); float* kvss2 = qss2 + (size_t)SEQ * 8;
        pg8::StaticOrder S; S.init(SEQ, 6144, G, (bx + G2CHECK) % G);
        pg8::Gemm g{p.hn, p.WinT, DM, DM, DM, 0}; pg8::EpiProj E{ub2, qa2, kva2, sgs2, sgm2, qss2, kvss2, 1.0f, 0}; pg8::gemm_phase(ring, g, S, E);
        xcd_barrier(bar);
        unsigned bad = 0;
#define CMP(A_, B_, BYTES_) { const u32x4* a_ = (const u32x4*)(A_); const u32x4* b_ = (const u32x4*)(B_); const size_t n_ = (size_t)(BYTES_) / 16; \
            for (size_t i = (size_t)F.gw * 64 + (threadIdx.x & 63); i < n_; i += (size_t)F.NGW * 64) { const u32x4 x = a_[i], y = b_[i]; bad |= (x.x ^ y.x) | (x.y ^ y.y) | (x.z ^ y.z) | (x.w ^ y.w); } }
        CMP(p.ub, ub2, (size_t)SEQ * SSM_W * 2); CMP(p.qa, qa2, (size_t)SEQ * QL * 2); CMP(p.kva, kva2, (size_t)SEQ * KVL * 2); CMP(p.sgs, sgs2, (size_t)SEQ * DM * 2); CMP(p.sgm, sgm2, (size_t)SEQ * DM * 2);
        CMP(p.qss, qss2, (size_t)SEQ * 8 * 4); CMP(p.kvss, kvss2, (size_t)SEQ * 8 * 4);
#undef CMP
        if (bad) atomicAdd(p.ctl + 4096 + XB_TMO, 1u);
        xcd_barrier(bar); }
#endif
    if (IN(2)) B2 if (REP(2)) B2 SEAM(2);
#ifdef CSPROBE
    if (IN(2)) { CS(2, p.send, (size_t)S5_NCH*SSM_G*64*8); }
#endif
#ifdef S5CHECK
    if (IN(2)) { float* send2 = (float*)p.W2chk; s5_pass_a(p, F, send2); xcd_barrier(bar); unsigned bad = 0;
        { const u32x4* a_ = (const u32x4*)p.send; const u32x4* b_ = (const u32x4*)send2; const size_t n_ = (size_t)S5_NCH * SSM_G * 64 * 8 / 16;
          for (size_t i = (size_t)F.gw * 64 + (threadIdx.x & 63); i < n_; i += (size_t)F.NGW * 64) { const u32x4 x = a_[i], y = b_[i]; bad |= (x.x ^ y.x) | (x.y ^ y.y) | (x.z ^ y.z) | (x.w ^ y.w); } }
        if (bad) atomicAdd(p.ctl + 4096 + XB_TMO, 1u); xcd_barrier(bar); }
#endif
    if (IN(3)) { B3A if (REP(16)) B3A B3B_(p.ymla) if (REP(3)) B3B_(REP3_OBUF) } SEAM(3);
    if (IN(4)) B4 if (REP(4)) B4 SEAM(4);
    if (IN(5)) B5 if (REP(5)) B5 if (P56_MERGE && IN(5) && IN(6)) { asm volatile("s_waitcnt vmcnt(0)" ::: "memory"); __syncthreads(); } else SEAM(5);
    if (IN(6)) B6 if (REP(6)) B6 SEAM(6);
    if (IN(7)) B7 if (REP(7)) B7 SEAM(7);
    if (IN(8)) B8 if (REP(8)) B8 SEAM(8);
    if (IN(9)) B9 if (REP(9)) B9 SEAM(9);
    if (IN(10)) B10 if (REP(10)) B10 SEAM(10);
    if (IN(11)) B11 if (REP(11)) B11 SEAM(11);
    if (IN(12)) B12 if (REP(12)) B12 SEAM(12);
    if (IN(13)) B13 if (REP(13)) B13 SEAM(13);
    if (IN(14)) B14 if (REP(14)) B14 SEAM(14);
#ifdef CSPROBE
    if (IN(15)) { CS(0, p.hn, (size_t)SEQ*DM*2); CS(0, p.WinT, (size_t)6144*DM*2); CS(0, p.WguT, (size_t)NEXP*2*DFF*DM); CS(0, p.WdnT, (size_t)NEXP*DM*DFF); CS(0, p.WuqT, (size_t)3072*QL*2); CS(0, p.WukvT, (size_t)4096*KVL*2); CS(0, p.cosT, (size_t)SEQ*32*4); CS(0, p.sinT, (size_t)SEQ*32*4); CS(0, p.bbarT, (size_t)SSM_G*128*16*2); CS(0, p.cmat, (size_t)SSM_G*16*128*2); CS(0, p.abar, (size_t)SSM_G*SSM_P*8); CS(0, p.WrT, (size_t)DM*NEXP*4); CS(0, p.WkpeT, (size_t)64*DM*2); CS(0, p.WgluT, (size_t)SSM_W*SSM_W*2); CS(0, p.WupsT, (size_t)DM*SSM_W*2); CS(0, p.WupmT, (size_t)DM*DM*2); CS(0, p.WoutT, (size_t)DM*DM*2); CS(0, p.WxqT, (size_t)XW*DM*2); CS(0, p.WxkvT, (size_t)2*XW*DM*2); CS(0, p.WxoT, (size_t)DM*XW*2); CS(0, p.memn, (size_t)MEML*DM*2); CS(1, p.ub, (size_t)SEQ*SSM_W*2); CS(1, p.qa, (size_t)SEQ*QL*2); CS(1, p.kva, (size_t)SEQ*KVL*2); CS(1, p.qss, (size_t)SEQ*8*4); CS(1, p.kvss, (size_t)SEQ*8*4); CS(1, p.sgs, (size_t)SEQ*DM*2); CS(1, p.sgm, (size_t)SEQ*DM*2); CS(1, p.kpe, (size_t)SEQ*DROPE*2); CS(3, p.send, (size_t)S5_NCH*SSM_G*64*8); CS(8, p.qn, (size_t)SEQ*DM*2); CS(8, p.qr, (size_t)SEQ*NHEAD*DROPE*2); CS(8, p.kn, (size_t)SEQ*DM*2); CS(8, p.vv, (size_t)SEQ*DM*2); CS(8, p.memkv, (size_t)MEML*2*XW*2); CS(8, p.zb, (size_t)SEQ*SSM_W*2); CS(8, p.ymla, (size_t)SEQ*DM*2); CS(9, p.ys, (size_t)SEQ*SSM_W*2); CS(9, p.t1, (size_t)SEQ*DM*2); CS(9, p.mg, (size_t)SEQ*DM*2); CS(9, p.x1b, (size_t)SEQ*DM*2); CS(9, p.ss1, (size_t)SEQ*32*4); CS(10, p.qx, (size_t)SEQ*XW*2); CS(10, p.ox, (size_t)SEQ*XW*2); CS(11, p.x2, (size_t)SEQ*DM*2); CS(11, p.ss2, (size_t)SEQ*32*4); CS(12, p.topi, (size_t)SEQ*16); CS(12, p.topw, (size_t)SEQ*16); CS(12, p.rank, (size_t)SEQ*16); CS(12, p.wgcnt, (size_t)256*32*4); CS(13, p.slot, (size_t)SEQ*16); cs_rows(p, F); xcd_barrier(bar); }
#endif
    if (IN(15)) B15 if (REP(15)) B15
#undef IN
#undef SEAM
}

extern "C" void kernel_launch(void* const* d_in, const int* in_sizes, int n_in, void* d_out, int out_size, void* d_ws, size_t ws_size, hipStream_t stream) {
    static int grid = 0;
    if (grid == 0) {
        if (n_in != 37 || in_sizes[0] != SEQ * DM || out_size != SEQ * DM) { fprintf(stderr, "kernel_launch: unexpected shapes (n_in %d)\n", n_in); grid = -1; return; }
        int dev = 0, cus = 0;
        if (hipGetDevice(&dev) != hipSuccess || hipDeviceGetAttribute(&cus, hipDeviceAttributeMultiprocessorCount, dev) != hipSuccess) { grid = -1; return; }
        if (hipFuncSetAttribute((const void*)hybrid_fwd, hipFuncAttributeMaxDynamicSharedMemorySize, LDS_BYTES) != hipSuccess) { fprintf(stderr, "kernel_launch: hipFuncSetAttribute failed\n"); grid = -1; return; }
        int per_cu = 0;
        if (hipOccupancyMaxActiveBlocksPerMultiprocessor(&per_cu, (const void*)hybrid_fwd, NWAVES * 64, LDS_BYTES) != hipSuccess || per_cu < 1) { fprintf(stderr, "kernel_launch: occupancy query says %d\n", per_cu); }
        (void)hipGetLastError();
        grid = cus > 0 ? cus : 256;
    }
    if (grid < 0) return;
    Params p; memset(&p, 0, sizeof(p));
    const float* const* in = (const float* const*)d_in;
    p.x = in[0]; p.mem = in[1]; p.pos = (const int*)d_in[2]; p.norm_mix = in[3]; p.w_in = in[4]; p.lam_re = in[5]; p.lam_im = in[6]; p.log_step = in[7]; p.b_re = in[8]; p.b_im = in[9];
    p.c_re = in[10]; p.c_im = in[11]; p.ssm_d = in[12]; p.w_glu = in[13]; p.b_glu = in[14]; p.q_norm = in[15]; p.w_uq = in[16]; p.kv_norm = in[17]; p.w_uk = in[18]; p.w_uv = in[19];
    p.w_up_ssm = in[20]; p.w_up_mla = in[21]; p.w_out = in[22]; p.norm_xattn = in[23]; p.norm_mem = in[24]; p.xa_wq = in[25]; p.xa_wk = in[26]; p.xa_wv = in[27]; p.xa_wo = in[28];
    p.norm_moe = in[29]; p.router_w = in[30]; p.router_b = in[31]; p.w_gu = in[32]; p.b_gu = in[33]; p.w_dn = in[34]; p.b_dn = in[35]; p.final_norm = in[36];
    p.out = (float*)d_out;
    size_t off = 0; unsigned char* ws = (unsigned char*)d_ws;
    auto take = [&](size_t bytes) { unsigned char* r = ws + off; off += (bytes + 4095) & ~(size_t)4095; return r; };
    p.ctl = (unsigned*)take(1 << 20);
    p.WinT = (bf16_t*)take((size_t)6144 * DM * 2); p.WkpeT = (bf16_t*)take((size_t)64 * DM * 2); p.WgluT = (bf16_t*)take((size_t)SSM_W * SSM_W * 2); p.WuqT = (bf16_t*)take((size_t)3072 * QL * 2);
    p.WukvT = (bf16_t*)take((size_t)4096 * KVL * 2); p.WupsT = (bf16_t*)take((size_t)DM * SSM_W * 2); p.WupmT = (bf16_t*)take((size_t)DM * DM * 2); p.WoutT = (bf16_t*)take((size_t)DM * DM * 2);
    p.WxqT = (bf16_t*)take((size_t)XW * DM * 2); p.WxkvT = (bf16_t*)take((size_t)2 * XW * DM * 2); p.WxoT = (bf16_t*)take((size_t)DM * XW * 2);
    p.WguT = (unsigned char*)take((size_t)NEXP * 2 * DFF * DM); p.WdnT = (unsigned char*)take((size_t)NEXP * DM * DFF); p.WrT = (float*)take((size_t)DM * NEXP * 4);
    p.hn = (bf16_t*)take((size_t)SEQ * DM * 2); p.hn8 = (unsigned char*)take((size_t)SEQ * DM); p.WinT8 = (unsigned char*)take((size_t)6144 * DM); p.memn = (bf16_t*)take((size_t)MEML * DM * 2); p.cosT = (float*)take((size_t)SEQ * 32 * 4); p.sinT = (float*)take((size_t)SEQ * 32 * 4);
    p.abar = (float*)take((size_t)SSM_G * SSM_P * 8); p.bbarT = (bf16_t*)take((size_t)SSM_G * 128 * 16 * 2); p.cmat = (bf16_t*)take((size_t)SSM_G * 16 * 128 * 2);
    p.ub = (bf16_t*)take((size_t)SEQ * SSM_W * 2); p.qa = (bf16_t*)take((size_t)SEQ * QL * 2); p.kva = (bf16_t*)take((size_t)SEQ * KVL * 2); p.qss = (float*)take((size_t)SEQ * 8 * 4); p.kvss = (float*)take((size_t)SEQ * 8 * 4);
    p.sgs = (bf16_t*)take((size_t)SEQ * DM * 2); p.sgm = (bf16_t*)take((size_t)SEQ * DM * 2); p.kpe = (bf16_t*)take((size_t)SEQ * DROPE * 2);
    p.qn = (bf16_t*)take((size_t)SEQ * DM * 2); p.qr = (bf16_t*)take((size_t)SEQ * NHEAD * DROPE * 2); p.kn = (bf16_t*)take((size_t)SEQ * DM * 2); p.vv = (bf16_t*)take((size_t)SEQ * DM * 2); p.ymla = (bf16_t*)take((size_t)SEQ * DM * 2);
    p.send = (float*)take((size_t)S5_NCH * SSM_G * 64 * 8); p.mg8 = (unsigned char*)take((size_t)SEQ * DM); p.WoutT8 = (unsigned char*)take((size_t)DM * DM); p.zb = (bf16_t*)take((size_t)SEQ * SSM_W * 2); p.ys = (bf16_t*)take((size_t)SEQ * SSM_W * 2); p.t1 = (bf16_t*)take((size_t)SEQ * DM * 2); p.mg = (bf16_t*)take((size_t)SEQ * DM * 2);
    p.x1 = nullptr; p.x1b8 = (unsigned char*)take((size_t)SEQ * DM); p.x1b = (bf16_t*)take((size_t)SEQ * DM * 2); p.ss1 = (float*)take((size_t)SEQ * 32 * 4);
    p.memkv = (bf16_t*)take((size_t)MEML * 2 * XW * 2); p.qx = (bf16_t*)take((size_t)SEQ * XW * 2); p.ox = (bf16_t*)take((size_t)SEQ * XW * 2);
    p.x2 = (bf16_t*)take((size_t)SEQ * DM * 2); p.ss2 = (float*)take((size_t)SEQ * 32 * 4);
    p.csprev = (unsigned*)take(4096); p.W2chk = (unsigned char*)take((size_t)NEXP * 2 * DFF * DM + (size_t)NEXP * DM * DFF + 4096); p.topi = (int*)take((size_t)SEQ * 4 * 4); p.topw = (float*)take((size_t)SEQ * 4 * 4); p.rank = (int*)take((size_t)SEQ * 4 * 4); p.slot = (int*)take((size_t)SEQ * 4 * 4); p.wgcnt = (int*)take((size_t)256 * 32 * 4); p.blke = (int*)take((size_t)(MAXBLK + 8) * 4);
    p.xg = (unsigned char*)take((size_t)NSLOT * DM); p.act = (unsigned char*)take((size_t)NSLOT * DFF); p.orow = (bf16_t*)take((size_t)NSLOT * DM * 2);
    if (off > ws_size) { fprintf(stderr, "kernel_launch: workspace too small: need %zu have %zu\n", off, ws_size); return; }
    (void)hipMemsetAsync(p.ctl, 0, 1 << 20, stream);
#if MK_ONE_LAUNCH
    p.ph_lo = 0; p.ph_hi = NPHASE;
#ifdef USE_CG
    { void* args[] = {&p}; hipError_t e_ = hipLaunchCooperativeKernel((const void*)hybrid_fwd, dim3(grid), dim3(NWAVES * 64), args, LDS_BYTES, stream); if (e_ != hipSuccess) fprintf(stderr, "coop launch failed: %s\n", hipGetErrorName(e_)); }
#else
    hipLaunchKernelGGL(hybrid_fwd, dim3(grid), dim3(NWAVES * 64), LDS_BYTES, stream, p);
#endif
#else
    for (int k = 0; k < NPHASE; ++k) { p.ph_lo = k; p.ph_hi = k + 1; hipLaunchKernelGGL(hybrid_fwd, dim3(grid), dim3(NWAVES * 64), LDS_BYTES, stream, p); }
#endif
}
```
